# Optimizing an MI355X kernel written in HIP

```python
import math
import jax, jax.numpy as jnp
from jax import lax
import numpy as np

D_MODEL = 2048
BATCH = 8
SEQ = 2048
DEPTH = 2

A_HEADS = 6
A_QK_DIM = 64
A_V_DIM = 2 * A_QK_DIM
B_HEADS = 12
B_KV_HEADS = 3
B_HEAD_DIM = 64
B_WINDOW = 128
C_HEADS = 4
C_QK_DIM = 64
C_V_DIM = 128
C_CHUNK = 128
Q_BLOCK = 128

A_WIDTH = A_HEADS * A_V_DIM
B_WIDTH = B_HEADS * B_HEAD_DIM
C_WIDTH = C_HEADS * C_V_DIM
MIX_WIDTH = A_WIDTH + B_WIDTH + C_WIDTH

PROJ_SIZES = [
    A_HEADS * 2 * A_QK_DIM,
    A_HEADS * 2 * A_QK_DIM,
    A_HEADS * A_V_DIM,
    B_HEADS * B_HEAD_DIM,
    B_KV_HEADS * B_HEAD_DIM,
    B_KV_HEADS * B_HEAD_DIM,
    C_HEADS * C_QK_DIM,
    C_HEADS * C_QK_DIM,
    C_HEADS * C_V_DIM,
    C_HEADS * C_V_DIM,
]
PROJ_WIDTH = int(sum(PROJ_SIZES))
SPLIT_POINTS = [int(v) for v in np.cumsum(PROJ_SIZES)[:-1]]

REL_BUCKETS = 32
REL_MAX_DIST = 128
N_BIAS_HEADS = A_HEADS + B_HEADS

D_FF = 5632
N_EXPERTS = 8
TOP_K = 2
EXPERT_FF = 5632
N_DENSE = (DEPTH + 1) // 2
N_MOE = DEPTH // 2

ALPHA = (2.0 * DEPTH) ** 0.25
BETA = (8.0 * DEPTH) ** -0.25
LN_EPS = 1e-5
NEG = -1e30

kernel_name = "hymba_style_diff_swa_retention_moe_deepnorm"

F32 = jnp.float32


def layer_norm(x, g, b):
    xf = x.astype(F32)
    mu = jnp.mean(xf, axis=-1, keepdims=True)
    xc = xf - mu
    var = jnp.mean(xc * xc, axis=-1, keepdims=True)
    return (xc * lax.rsqrt(var + LN_EPS) * g.astype(F32) + b.astype(F32)).astype(x.dtype)


def rel_bucket(dist):
    max_exact = REL_BUCKETS // 2
    d = jnp.maximum(dist, 0)
    ratio = jnp.maximum(d, 1).astype(F32) / max_exact
    large = max_exact + (jnp.log(ratio) / math.log(REL_MAX_DIST / max_exact)
                         * (REL_BUCKETS - max_exact)).astype(jnp.int32)
    large = jnp.minimum(large, REL_BUCKETS - 1)
    return jnp.where(d < max_exact, d, large)


def lambda_init(layer_idx):
    return 0.8 - 0.6 * math.exp(-0.3 * layer_idx)


def diff_attention(q, k, v, lam_params, lam_init, subln_g, bias_tab):
    Bsz, S = q.shape[0], q.shape[1]
    nblk = S // Q_BLOCK
    qf = q.astype(F32) * (A_QK_DIM ** -0.5)
    kf = k.astype(F32)
    vf = v.astype(F32)
    lp = lam_params.astype(F32)
    lam = jnp.exp(jnp.sum(lp[0] * lp[1])) - jnp.exp(jnp.sum(lp[2] * lp[3])) + lam_init
    qb = qf.reshape(Bsz, nblk, Q_BLOCK, A_HEADS, 2, A_QK_DIM).transpose(1, 0, 2, 3, 4, 5)
    k_pos = jnp.arange(S)
    tab = bias_tab.astype(F32)

    def block(args):
        qi, i = args
        q_pos = i * Q_BLOCK + jnp.arange(Q_BLOCK)
        dist = q_pos[:, None] - k_pos[None, :]
        bias = tab[rel_bucket(dist)].transpose(2, 0, 1)
        s = jnp.einsum('bqhmd,bkhmd->bhmqk', qi, kf) + bias[None, :, None]
        s = jnp.where(dist >= 0, s, NEG)
        p = jax.nn.softmax(s, axis=-1)
        a = p[:, :, 0] - lam * p[:, :, 1]
        return jnp.einsum('bhqk,bkhe->bqhe', a, vf)

    o = lax.map(block, (qb, jnp.arange(nblk)))
    o = o.transpose(1, 0, 2, 3, 4).reshape(Bsz, S, A_HEADS, A_V_DIM)
    o = o * lax.rsqrt(jnp.mean(o * o, axis=-1, keepdims=True) + LN_EPS) * subln_g.astype(F32)
    o = o * (1.0 - lam_init)
    return o.reshape(Bsz, S, A_WIDTH).astype(q.dtype)


def swa_sink_attention(q, k, v, sinks, bias_tab):
    Bsz, S = q.shape[0], q.shape[1]
    W = B_WINDOW
    G = B_HEADS // B_KV_HEADS
    nb = S // W
    qb = q.astype(F32).reshape(Bsz, nb, W, B_KV_HEADS, G, B_HEAD_DIM) * (B_HEAD_DIM ** -0.5)
    kb = k.astype(F32).reshape(Bsz, nb, W, B_KV_HEADS, B_HEAD_DIM)
    vb = v.astype(F32).reshape(Bsz, nb, W, B_KV_HEADS, B_HEAD_DIM)
    pad = ((0, 0), (1, 0), (0, 0), (0, 0), (0, 0))
    kk = jnp.concatenate([jnp.pad(kb, pad)[:, :-1], kb], axis=2)
    vv = jnp.concatenate([jnp.pad(vb, pad)[:, :-1], vb], axis=2)
    q_loc = jnp.arange(W)
    k_loc = jnp.arange(2 * W)
    dist = q_loc[:, None] + W - k_loc[None, :]
    band = (dist >= 0) & (dist < W)
    blk_ok = (jnp.arange(nb)[:, None] > 0) | (k_loc[None, :] >= W)
    mask = band[None] & blk_ok[:, None, :]
    bias = bias_tab.astype(F32)[rel_bucket(dist)]
    bias = bias.transpose(2, 0, 1).reshape(B_KV_HEADS, G, W, 2 * W)
    s = jnp.einsum('bnqhgd,bnkhd->bnhgqk', qb, kk) + bias[None, None]
    s = jnp.where(mask[None, :, None, None], s, NEG)
    sink = sinks.astype(F32).reshape(B_KV_HEADS, G)[None, None, :, :, None, None]
    m = jnp.maximum(jnp.max(s, axis=-1, keepdims=True), sink)
    e = jnp.exp(s - m)
    p = e / (jnp.sum(e, axis=-1, keepdims=True) + jnp.exp(sink - m))
    o = jnp.einsum('bnhgqk,bnkhd->bnqhgd', p, vv)
    return o.reshape(Bsz, S, B_WIDTH).astype(q.dtype)


def rotate_every_two(x):
    x1 = x[..., 0::2]
    x2 = x[..., 1::2]
    return jnp.stack([-x2, x1], axis=-1).reshape(x.shape)


def retention(q, k, v, g, sin, cos):
    Bsz, S = q.shape[0], q.shape[1]
    C = C_CHUNK
    nc = S // C
    sn = sin[None, :, None, :]
    cs = cos[None, :, None, :]
    qf = q.astype(F32)
    kf = k.astype(F32) * (C_QK_DIM ** -0.5)
    qf = qf * cs + rotate_every_two(qf) * sn
    kf = kf * cs + rotate_every_two(kf) * sn
    vf = v.astype(F32)
    log_g = jnp.log(1.0 - jnp.exp2(-5.0 - jnp.arange(C_HEADS, dtype=F32)))
    qc = qf.reshape(Bsz, nc, C, C_HEADS, C_QK_DIM)
    kc = kf.reshape(Bsz, nc, C, C_HEADS, C_QK_DIM)
    vc = vf.reshape(Bsz, nc, C, C_HEADS, C_V_DIM)
    pos = jnp.arange(C)
    rel = (pos[:, None] - pos[None, :]).astype(F32)
    decay = jnp.where((rel >= 0)[None], jnp.exp(jnp.maximum(rel, 0.0)[None] * log_g[:, None, None]), 0.0)
    inner = jnp.einsum('bnqhd,bnkhd->bnhqk', qc, kc) * decay[None, None]
    inner_o = jnp.einsum('bnhqk,bnkhe->bnqhe', inner, vc)
    zeta = jnp.exp((C - 1 - pos).astype(F32)[:, None] * log_g[None, :])
    xi = jnp.exp((pos + 1).astype(F32)[:, None] * log_g[None, :])
    kv = jnp.einsum('bnkhd,bnkhe,kh->nbhde', kc, vc, zeta)
    g_chunk = jnp.exp(C * log_g)[None, :, None, None]

    def step(state, kv_i):
        return state * g_chunk + kv_i, state

    init = jnp.zeros((Bsz, C_HEADS, C_QK_DIM, C_V_DIM), F32)
    _, prev = lax.scan(step, init, kv)
    cross = jnp.einsum('bnqhd,nbhde,qh->bnqhe', qc, prev, xi)
    o = (inner_o + cross).reshape(Bsz, S, C_HEADS, C_V_DIM)
    mu = jnp.mean(o, axis=-1, keepdims=True)
    oc = o - mu
    o = oc * lax.rsqrt(jnp.mean(oc * oc, axis=-1, keepdims=True) + LN_EPS)
    y = jax.nn.silu(g.astype(F32)) * o.reshape(Bsz, S, C_WIDTH)
    return y.astype(q.dtype)


def swiglu(x, w_gate, w_up, w_down):
    h = jax.nn.silu(x @ w_gate) * (x @ w_up)
    return h @ w_down


def moe_swiglu(x, w_router, w_gate, w_up, w_down):
    Bsz, S, D = x.shape
    xt = x.reshape(Bsz * S, D)
    logits = (xt @ w_router).astype(F32)
    top_v, top_i = lax.top_k(logits, TOP_K)
    top_w = jax.nn.softmax(top_v, axis=-1)
    gates = jnp.sum(jax.nn.one_hot(top_i, N_EXPERTS, dtype=F32) * top_w[..., None], axis=1)
    y = jnp.zeros((Bsz * S, D), F32)
    for e in range(N_EXPERTS):
        y = y + gates[:, e:e + 1] * swiglu(xt, w_gate[e], w_up[e], w_down[e]).astype(F32)
    return y.reshape(Bsz, S, D).astype(x.dtype)


def setup_inputs(seed: int = 0) -> dict:
    key = jax.random.key(seed)
    ks = jax.random.split(key, 20)
    nrm = jax.random.normal
    D = D_MODEL
    return {
        "x": nrm(ks[0], (BATCH, SEQ, D), F32),
        "w_in": nrm(ks[1], (DEPTH, D, PROJ_WIDTH), F32) * D ** -0.5,
        "rel_bias": nrm(ks[2], (REL_BUCKETS, N_BIAS_HEADS), F32) * 0.3,
        "a_lambda": nrm(ks[3], (DEPTH, 4, A_QK_DIM), F32) * 0.1,
        "a_subln_g": 1.0 + 0.02 * nrm(ks[4], (DEPTH, A_V_DIM), F32),
        "b_sinks": nrm(ks[5], (DEPTH, B_HEADS), F32) * 0.5,
        "w_out": nrm(ks[6], (DEPTH, MIX_WIDTH, D), F32) * (MIX_WIDTH ** -0.5) * BETA,
        "ln_mix_g": 1.0 + 0.02 * nrm(ks[7], (DEPTH, D), F32),
        "ln_mix_b": 0.02 * nrm(ks[8], (DEPTH, D), F32),
        "ln_ffn_g": 1.0 + 0.02 * nrm(ks[9], (DEPTH, D), F32),
        "ln_ffn_b": 0.02 * nrm(ks[10], (DEPTH, D), F32),
        "dense_w_gate": nrm(ks[11], (N_DENSE, D, D_FF), F32) * D ** -0.5,
        "dense_w_up": nrm(ks[12], (N_DENSE, D, D_FF), F32) * D ** -0.5,
        "dense_w_down": nrm(ks[13], (N_DENSE, D_FF, D), F32) * (D_FF ** -0.5) * BETA,
        "moe_router": nrm(ks[14], (N_MOE, D, N_EXPERTS), F32) * D ** -0.5,
        "moe_w_gate": nrm(ks[15], (N_MOE, N_EXPERTS, D, EXPERT_FF), F32) * D ** -0.5,
        "moe_w_up": nrm(ks[16], (N_MOE, N_EXPERTS, D, EXPERT_FF), F32) * D ** -0.5,
        "moe_w_down": nrm(ks[17], (N_MOE, N_EXPERTS, EXPERT_FF, D), F32) * (EXPERT_FF ** -0.5) * BETA,
    }


def reference(x, w_in, rel_bias, a_lambda, a_subln_g, b_sinks, w_out, ln_mix_g, ln_mix_b,
              ln_ffn_g, ln_ffn_b, dense_w_gate, dense_w_up, dense_w_down, moe_router,
              moe_w_gate, moe_w_up, moe_w_down):
    Bsz, S, _ = x.shape
    ang = jnp.repeat(1.0 / (10000.0 ** jnp.linspace(0.0, 1.0, C_QK_DIM // 2, dtype=F32)), 2)
    ang = jnp.arange(S, dtype=F32)[:, None] * ang[None, :]
    sin, cos = jnp.sin(ang), jnp.cos(ang)
    bias_a = rel_bias[:, :A_HEADS]
    bias_b = rel_bias[:, A_HEADS:]
    for l in range(DEPTH):
        proj = jnp.einsum('bsd,dp->bsp', x, w_in[l])
        aq, ak, av, bq, bk, bv, cq, ck, cv, cg = jnp.split(proj, SPLIT_POINTS, axis=-1)
        ya = diff_attention(aq.reshape(Bsz, S, A_HEADS, 2, A_QK_DIM),
                            ak.reshape(Bsz, S, A_HEADS, 2, A_QK_DIM),
                            av.reshape(Bsz, S, A_HEADS, A_V_DIM),
                            a_lambda[l], lambda_init(l), a_subln_g[l], bias_a)
        yb = swa_sink_attention(bq.reshape(Bsz, S, B_HEADS, B_HEAD_DIM),
                                bk.reshape(Bsz, S, B_KV_HEADS, B_HEAD_DIM),
                                bv.reshape(Bsz, S, B_KV_HEADS, B_HEAD_DIM),
                                b_sinks[l], bias_b)
        yc = retention(cq.reshape(Bsz, S, C_HEADS, C_QK_DIM),
                       ck.reshape(Bsz, S, C_HEADS, C_QK_DIM),
                       cv.reshape(Bsz, S, C_HEADS, C_V_DIM), cg, sin, cos)
        mix = jnp.einsum('bsm,md->bsd', jnp.concatenate([ya, yb, yc], axis=-1), w_out[l])
        x = layer_norm(ALPHA * x + mix, ln_mix_g[l], ln_mix_b[l])
        if l % 2 == 0:
            j = l // 2
            f = swiglu(x, dense_w_gate[j], dense_w_up[j], dense_w_down[j])
        else:
            j = l // 2
            f = moe_swiglu(x, moe_router[j], moe_w_gate[j], moe_w_up[j], moe_w_down[j])
        x = layer_norm(ALPHA * x + f, ln_ffn_g[l], ln_ffn_b[l])
    return x
```

```cpp
#include <hip/hip_runtime.h>
#include <cstdio>
#include <cstdint>
#include <cmath>
namespace pg8 {
#define PG8_LAS __attribute__((address_space(3)))
typedef unsigned short bf16_t;
typedef short bf16x8 __attribute__((ext_vector_type(8)));
typedef float f32x4 __attribute__((ext_vector_type(4)));
typedef unsigned u32x4 __attribute__((ext_vector_type(4)));
constexpr int BM = 256, BK = 64, HALF = 128, HTB = HALF * BK * 2  , STAGE_BYTES = 8 * HTB, NXCD = 8, WGM = 8;

__host__ __device__ __forceinline__ int lds_byte(int r, int c) { const int st = (r >> 4) * 2 + (c >> 5), rr = r & 15, cc = c & 31, ob = rr * 64 + cc * 2; return st * 1024 + (ob ^ (((ob >> 9) & 1) << 5)); }
__host__ __device__ __forceinline__ void stage_rc(int b, int& R, int& C) { const int st = b / 1024, sb = b % 1024, swz = sb ^ (((sb >> 9) & 1) << 5); R = (st >> 1) * 16 + swz / 64; C = (st & 1) * 32 + (swz % 64) / 2; }
__host__ __device__ __forceinline__ int perm32(int rho) { const int n = rho >> 4, i = rho & 15; return 8 * (i >> 2) + 4 * n + (i & 3); }

struct Unit { int pm, pn; };
struct Gemm { const bf16_t* A; const bf16_t* Bt; int M, N, K; };

struct StaticOrder {
    int nM, nN, nwg, G, c;
    __host__ __device__ void init(int M, int N, int G_, int c_) { nM = M / BM; nN = N / BM; nwg = nM * nN; G = G_; c = c_; }
    __host__ __device__ bool next(int i, Unit& u) const {
        const long L = (long)i * G + c; if (L >= nwg) return false;
        int wgid = (int)L; { const int q = nwg / NXCD, r = nwg % NXCD, xcd = wgid % NXCD, off = wgid / NXCD; wgid = (xcd < r ? xcd * (q + 1) : r * (q + 1) + (xcd - r) * q) + off; }
        const int nig = WGM * nN, gid = wgid / nig, fm = gid * WGM, gsz = (nM - fm) < WGM ? (nM - fm) : WGM;
        u.pm = fm + ((wgid % nig) % gsz); u.pn = (wgid % nig) / gsz; return true;
    }
    __device__ __forceinline__ void a_ready(const Unit&) const {}
    __device__ __forceinline__ void done(const Unit&) const {}
};

__device__ __forceinline__ unsigned cvt_pk_bf16(float lo, float hi) { unsigned r; asm volatile("v_cvt_pk_bf16_f32 %0, %1, %2" : "=v"(r) : "v"(lo), "v"(hi)); return r; }
typedef float f32x2 __attribute__((ext_vector_type(2)));
typedef float f32x2 __attribute__((ext_vector_type(2)));
constexpr float ALPHA_F = 1.41421356237309515f;
constexpr float C2_F = 0.125f * 1.4426950408889634f;
__device__ __forceinline__ u32x4 pack8(const f32x4 v0, const f32x4 v1) { u32x4 w; w.x = cvt_pk_bf16(v0[0], v0[1]); w.y = cvt_pk_bf16(v0[2], v0[3]); w.z = cvt_pk_bf16(v1[0], v1[1]); w.w = cvt_pk_bf16(v1[2], v1[3]); return w; }

struct EpiProj {
    static constexpr bool PERM = true, AFTER_DRAIN = false;
    bf16_t* O; const float* sinT; const float* cosT;
    __device__ __forceinline__ void operator()(const f32x4 (&acc)[2][2][4][2], const Unit& u, int wr, int wc, int fr, int fq) const {
        const int row0 = u.pm * BM + wr * 64 + fr;
#pragma unroll
        for (int bj = 0; bj < 2; ++bj) {
            const int cw = u.pn * BM + bj * HALF + wc * 32;
            const int c0 = cw + 8 * fq;
            float sc = 1.f; bool rope = false;
            if (cw < 768 || (cw >= 2304 && cw < 3072)) sc = C2_F;
            else if (cw >= 3456 && cw < 3968) { rope = true; if (cw >= 3712) sc = 0.125f; }
            const int i0 = ((c0 - 3456) & 63) >> 1;
#pragma unroll
            for (int ai = 0; ai < 2; ++ai)
#pragma unroll
                for (int m = 0; m < 4; ++m) {
                    const int row = row0 + ai * HALF + m * 16;
                    f32x4 v0 = acc[ai][bj][m][0] * sc, v1 = acc[ai][bj][m][1] * sc;
                    if (rope) {
                        const int pos = row & 2047;
                        const f32x4 sn = *(const f32x4*)(sinT + pos * 32 + i0), cs = *(const f32x4*)(cosT + pos * 32 + i0);
                        f32x4 w0, w1;
                        w0[0] = v0[0] * cs[0] - v0[1] * sn[0]; w0[1] = v0[1] * cs[0] + v0[0] * sn[0];
                        w0[2] = v0[2] * cs[1] - v0[3] * sn[1]; w0[3] = v0[3] * cs[1] + v0[2] * sn[1];
                        w1[0] = v1[0] * cs[2] - v1[1] * sn[2]; w1[1] = v1[1] * cs[2] + v1[0] * sn[2];
                        w1[2] = v1[2] * cs[3] - v1[3] * sn[3]; w1[3] = v1[3] * cs[3] + v1[2] * sn[3];
                        v0 = w0; v1 = w1;
                    }
                    *(u32x4*)(O + (size_t)row * 5120 + c0) = pack8(v0, v1);
                }
        }
    }
};
struct EpiResid {
    static constexpr bool PERM = true, AFTER_DRAIN = false;
    float* T; const float* R;
    __device__ __forceinline__ void operator()(const f32x4 (&acc)[2][2][4][2], const Unit& u, int wr, int wc, int fr, int fq) const {
        const int row0 = u.pm * BM + wr * 64 + fr, col0 = u.pn * BM + wc * 32 + 8 * fq;
#pragma unroll
        for (int ai = 0; ai < 2; ++ai)
#pragma unroll
            for (int m = 0; m < 4; ++m) {
                const size_t ro = (size_t)(row0 + ai * HALF + m * 16) * 2048 + col0;
#pragma unroll
                for (int bj = 0; bj < 2; ++bj) {
                    const f32x4 r0 = *(const f32x4*)(R + ro + bj * HALF), r1 = *(const f32x4*)(R + ro + bj * HALF + 4);
                    *(f32x4*)(T + ro + bj * HALF) = r0 * ALPHA_F + acc[ai][bj][m][0];
                    *(f32x4*)(T + ro + bj * HALF + 4) = r1 * ALPHA_F + acc[ai][bj][m][1];
                }
            }
    }
};
__device__ __forceinline__ float silu_f(float x) { return x * __builtin_amdgcn_rcpf(1.f + __builtin_amdgcn_exp2f(-1.4426950408889634f * x)); }
struct EpiSwiGLU {
    static constexpr bool PERM = true, AFTER_DRAIN = false;
    bf16_t* H; int ntn;
    __device__ __forceinline__ void operator()(const f32x4 (&acc)[2][2][4][2], const Unit& u, int wr, int wc, int fr, int fq) const {
        const int row0 = u.pm * BM + wr * 64 + fr, col0 = (u.pn % ntn) * HALF + wc * 32 + 8 * fq;
#pragma unroll
        for (int ai = 0; ai < 2; ++ai)
#pragma unroll
            for (int m = 0; m < 4; ++m) {
                f32x4 h0, h1;
#pragma unroll
                for (int j = 0; j < 4; ++j) { h0[j] = silu_f(acc[ai][0][m][0][j]) * acc[ai][1][m][0][j]; h1[j] = silu_f(acc[ai][0][m][1][j]) * acc[ai][1][m][1][j]; }
                *(u32x4*)(H + (size_t)(row0 + ai * HALF + m * 16) * 5632 + col0) = pack8(h0, h1);
            }
    }
};
struct EpiY {
    static constexpr bool PERM = true, AFTER_DRAIN = false;
    bf16_t* Y; int ntn;
    __device__ __forceinline__ void operator()(const f32x4 (&acc)[2][2][4][2], const Unit& u, int wr, int wc, int fr, int fq) const {
        const int row0 = u.pm * BM + wr * 64 + fr, col0 = (u.pn % ntn) * BM + wc * 32 + 8 * fq;
#pragma unroll
        for (int ai = 0; ai < 2; ++ai)
#pragma unroll
            for (int m = 0; m < 4; ++m)
#pragma unroll
                for (int bj = 0; bj < 2; ++bj)
                    *(u32x4*)(Y + (size_t)(row0 + ai * HALF + m * 16) * 2048 + col0 + bj * HALF) = pack8(acc[ai][bj][m][0], acc[ai][bj][m][1]);
    }
};
struct GroupedOrder {
    int nM, nN, nwg, G, c; int cum[8];
    __device__ __forceinline__ bool next(int i, Unit& u) const {
        const long L = (long)i * G + c; if (L >= nwg) return false;
        int wgid = (int)L; { const int q = nwg / NXCD, r = nwg % NXCD, xcd = wgid % NXCD, off = wgid / NXCD; wgid = (xcd < r ? xcd * (q + 1) : r * (q + 1) + (xcd - r) * q) + off; }
        const int nig = WGM * nN, gid = wgid / nig, fm = gid * WGM, gsz = (nM - fm) < WGM ? (nM - fm) : WGM;
        const int pm = fm + ((wgid % nig) % gsz), pn = (wgid % nig) / gsz;
        int e = 0;
#pragma unroll
        for (int j = 0; j < 7; ++j) e += (pm >= cum[j]) ? 1 : 0;
        u.pm = pm; u.pn = e * nN + pn; return true;
    }
    __device__ __forceinline__ void a_ready(const Unit&) const {}
    __device__ __forceinline__ void done(const Unit&) const {}
};
template <class Epi, class Sched, bool ALIGN_EPI = false, bool SP2 = false>
__device__ __forceinline__ void gemm_phase(PG8_LAS unsigned char* lds, const Gemm g, const Sched& S, const Epi& E) {
    const int tid = threadIdx.x, wid = __builtin_amdgcn_readfirstlane(tid >> 6), lane = tid & 63, wr = wid >> 2, wc = wid & 3, fr = lane & 15, fq = lane >> 4;
    const int K = g.K, nt = K / BK;
    unsigned voffA[2], voffB[2];
#pragma unroll
    for (int i = 0; i < 2; ++i) { int R, C; stage_rc(tid * 16 + i * 8192, R, C); const int Rb = Epi::PERM ? ((R & ~31) + perm32(R & 31)) : R;
        voffA[i] = (unsigned)(R * K + C) * 2u; voffB[i] = (unsigned)(Rb * K + C) * 2u; }
    const size_t kstep = (size_t)(BK * 2);
    const size_t hstep = (size_t)HALF * K * 2;
    const size_t tstep = 2 * hstep;
    const unsigned ldsw = (unsigned)wid * 1024u;
    const int aoff = lds_byte(wr * 64 + fr, fq * 8), boff = lds_byte(wc * 32 + fr, fq * 8);
#define PG8_SA(b, h) (((b) * 2 + (h)) * HTB)
#define PG8_SB(b, h) ((4 + (b) * 2 + (h)) * HTB)
#define PG8_STAGE(bufoff, gbase, voff) do { _Pragma("unroll") for (int _i = 0; _i < 2; ++_i) \
        __builtin_amdgcn_global_load_lds((const unsigned*)((const char*)(gbase) + (voff)[_i]), (PG8_LAS unsigned*)(lds + (bufoff) + ldsw + _i * 8192), 16, 0, 0); } while (0)
#define PG8_LDA(dst, b, h) do { _Pragma("unroll") for (int m = 0; m < 4; ++m) _Pragma("unroll") for (int k = 0; k < 2; ++k) dst[m][k] = *(const PG8_LAS bf16x8*)(lds + PG8_SA(b, h) + aoff + m * 2048 + k * 1024); } while (0)
#define PG8_LDB(dst, b, h) do { _Pragma("unroll") for (int n = 0; n < 2; ++n) _Pragma("unroll") for (int k = 0; k < 2; ++k) dst[n][k] = *(const PG8_LAS bf16x8*)(lds + PG8_SB(b, h) + boff + n * 2048 + k * 1024); } while (0)
#define PG8_MMA(ai, bj, At, Bt) do { __builtin_amdgcn_s_setprio(1); _Pragma("unroll") for (int m = 0; m < 4; ++m) _Pragma("unroll") for (int n = 0; n < 2; ++n) _Pragma("unroll") for (int k = 0; k < 2; ++k) \
        acc[ai][bj][m][n] = __builtin_amdgcn_mfma_f32_16x16x32_bf16(Bt[n][k], At[m][k], acc[ai][bj][m][n], 0, 0, 0); __builtin_amdgcn_s_setprio(0); } while (0)
#define PG8_WAIT_V(n) asm volatile("s_waitcnt vmcnt(" #n ")" ::: "memory")
#define PG8_WAIT_L(n) asm volatile("s_waitcnt lgkmcnt(" #n ")" ::: "memory")
#define PG8_BAR __builtin_amdgcn_s_barrier()
#define PG8_SCHED __builtin_amdgcn_sched_barrier(0)
    Unit cur, nxt; int ui = 0;
    if (!S.next(0, cur)) return;
    f32x4 acc[2][2][4][2];
#pragma unroll
    for (int a = 0; a < 2; ++a)
#pragma unroll
        for (int b = 0; b < 2; ++b)
#pragma unroll
            for (int m = 0; m < 4; ++m)
#pragma unroll
                for (int n = 0; n < 2; ++n) acc[a][b][m][n] = (f32x4){0.f, 0.f, 0.f, 0.f};
    bf16x8 At[4][2], B0[2][2], B1[2][2];
    const char* cA = (const char*)g.A + (size_t)cur.pm * tstep; const char* cB = (const char*)g.Bt + (size_t)cur.pn * tstep;
    S.a_ready(cur);
    if constexpr (SP2) {
        PG8_STAGE(PG8_SB(0, 0), cB, voffB); PG8_STAGE(PG8_SB(0, 1), cB + hstep, voffB); PG8_STAGE(PG8_SA(0, 0), cA, voffA); PG8_STAGE(PG8_SA(0, 1), cA + hstep, voffA);
        if (wr == 1) PG8_BAR;
        PG8_WAIT_V(2); PG8_BAR;
        PG8_STAGE(PG8_SB(1, 0), cB + kstep, voffB); PG8_STAGE(PG8_SA(1, 0), cA + kstep, voffA); PG8_STAGE(PG8_SB(1, 1), cB + hstep + kstep, voffB);
        PG8_WAIT_V(6); PG8_BAR;
    } else {
        PG8_STAGE(PG8_SB(0, 0), cB, voffB); PG8_STAGE(PG8_SA(0, 0), cA, voffA); PG8_STAGE(PG8_SB(0, 1), cB + hstep, voffB); PG8_STAGE(PG8_SA(0, 1), cA + hstep, voffA);
        if (wr == 1) PG8_BAR;
        PG8_WAIT_V(4); PG8_BAR;
        PG8_STAGE(PG8_SB(1, 0), cB + kstep, voffB); PG8_STAGE(PG8_SA(1, 0), cA + kstep, voffA); PG8_STAGE(PG8_SB(1, 1), cB + hstep + kstep, voffB);
        PG8_WAIT_V(6); PG8_BAR;
    }
    for (;;) {
        const bool has_next = S.next(ui + 1, nxt);
        const char* nA = has_next ? (const char*)g.A + (size_t)nxt.pm * tstep : cA; const char* nB = has_next ? (const char*)g.Bt + (size_t)nxt.pn * tstep : cB;
        for (int t = 0; t < nt; t += 2) {
            const bool last = (t == nt - 2);
            const char* a1 = cA + (size_t)(t + 1) * kstep;
            const char* a2 = last ? nA : cA + (size_t)(t + 2) * kstep; const char* b2 = last ? nB : cB + (size_t)(t + 2) * kstep;
            const char* a3 = a2 + kstep; const char* b3 = b2 + kstep;
            if (last && has_next) S.a_ready(nxt);
            if constexpr (SP2) {
            PG8_LDB(B0, 0, 0); PG8_LDB(B1, 0, 1); PG8_SCHED; PG8_LDA(At, 0, 0); PG8_STAGE(PG8_SA(1, 1), a1 + hstep, voffA);
            PG8_WAIT_V(8); PG8_WAIT_L(0); PG8_BAR; PG8_MMA(0, 0, At, B0); PG8_MMA(0, 1, At, B1); PG8_BAR; PG8_SCHED;
            PG8_LDA(At, 0, 1); PG8_STAGE(PG8_SB(0, 0), b2, voffB); PG8_STAGE(PG8_SB(0, 1), b2 + hstep, voffB); PG8_STAGE(PG8_SA(0, 0), a2, voffA);
            PG8_WAIT_V(8); PG8_WAIT_L(0); PG8_BAR; PG8_MMA(1, 0, At, B0); PG8_MMA(1, 1, At, B1); PG8_BAR; PG8_SCHED;
            PG8_LDB(B0, 1, 0); PG8_LDB(B1, 1, 1); PG8_SCHED; PG8_LDA(At, 1, 0); PG8_STAGE(PG8_SA(0, 1), a2 + hstep, voffA);
            PG8_WAIT_V(8); PG8_WAIT_L(0); PG8_BAR; PG8_MMA(0, 0, At, B0); PG8_MMA(0, 1, At, B1); PG8_BAR; PG8_SCHED;
            PG8_LDA(At, 1, 1); PG8_STAGE(PG8_SB(1, 0), b3, voffB); PG8_STAGE(PG8_SB(1, 1), b3 + hstep, voffB); PG8_STAGE(PG8_SA(1, 0), a3, voffA);
            PG8_WAIT_V(8); PG8_WAIT_L(0); PG8_BAR; PG8_MMA(1, 0, At, B0); PG8_MMA(1, 1, At, B1); PG8_BAR; PG8_SCHED;
            } else {
            PG8_LDB(B0, 0, 0); PG8_SCHED; PG8_LDA(At, 0, 0); PG8_STAGE(PG8_SA(1, 1), a1 + hstep, voffA);
            PG8_WAIT_L(8); PG8_BAR; PG8_WAIT_L(0); PG8_MMA(0, 0, At, B0); PG8_BAR; PG8_SCHED;
            PG8_LDB(B1, 0, 1); PG8_STAGE(PG8_SB(0, 0), b2, voffB);
            PG8_BAR; PG8_WAIT_L(0); PG8_MMA(0, 1, At, B1); PG8_BAR;
            PG8_LDA(At, 0, 1); PG8_STAGE(PG8_SA(0, 0), a2, voffA);
            PG8_BAR; PG8_WAIT_L(0); PG8_MMA(1, 0, At, B0); PG8_BAR; PG8_SCHED;
            PG8_STAGE(PG8_SB(0, 1), b2 + hstep, voffB);
            PG8_WAIT_V(6); PG8_BAR; PG8_MMA(1, 1, At, B1); PG8_BAR;
            PG8_LDB(B0, 1, 0); PG8_SCHED; PG8_LDA(At, 1, 0); PG8_STAGE(PG8_SA(0, 1), a2 + hstep, voffA);
            PG8_WAIT_L(8); PG8_BAR; PG8_WAIT_L(0); PG8_MMA(0, 0, At, B0); PG8_BAR; PG8_SCHED;
            PG8_LDB(B1, 1, 1); PG8_STAGE(PG8_SB(1, 0), b3, voffB);
            PG8_BAR; PG8_WAIT_L(0); PG8_MMA(0, 1, At, B1); PG8_BAR;
            PG8_LDA(At, 1, 1); PG8_STAGE(PG8_SA(1, 0), a3, voffA);
            PG8_BAR; PG8_WAIT_L(0); PG8_MMA(1, 0, At, B0); PG8_BAR; PG8_SCHED;
            PG8_STAGE(PG8_SB(1, 1), b3 + hstep, voffB);
            PG8_WAIT_V(6); PG8_BAR; PG8_MMA(1, 1, At, B1); PG8_BAR;
            }
        }
        if constexpr (ALIGN_EPI) { if (wr == 0) PG8_BAR; }
        if constexpr (!Epi::AFTER_DRAIN) { E(acc, cur, wr, wc, fr, fq); S.done(cur); }
        if (!has_next) break;
#pragma unroll
        for (int a = 0; a < 2; ++a)
#pragma unroll
            for (int b = 0; b < 2; ++b)
#pragma unroll
                for (int m = 0; m < 4; ++m)
#pragma unroll
                    for (int n = 0; n < 2; ++n) acc[a][b][m][n] = (f32x4){0.f, 0.f, 0.f, 0.f};
        cur = nxt; cA = nA; cB = nB; ++ui;
        if constexpr (ALIGN_EPI) { if (wr == 1) PG8_BAR; }
    }
    PG8_WAIT_V(0);
    if constexpr (!ALIGN_EPI) { if (wr == 0) PG8_BAR; }
    PG8_BAR;
    if constexpr (Epi::AFTER_DRAIN) { E.fused(acc, cur, wr, wc, fr, fq, lds, wid, lane); S.done(cur); }
#undef PG8_SA
#undef PG8_SB
#undef PG8_STAGE
#undef PG8_LDA
#undef PG8_LDB
#undef PG8_MMA
#undef PG8_WAIT_V
#undef PG8_WAIT_L
#undef PG8_BAR
#undef PG8_SCHED
}
}
constexpr int NWAVES = 8;
constexpr int NTOK = 16384, SEQ = 2048, DM = 2048, PW = 4992, PWP = 5120, DFF = 5632, NEXP = 8, MAXTILES = 136;
constexpr float LN_EPS = 1e-5f;
constexpr float LOG2E = 1.4426950408889634f;
constexpr int C_AQ = 0, C_AK = 768, C_AV = 1536, C_BQ = 2304, C_BK = 3072, C_BV = 3264, C_CQ = 3456, C_CK = 3712, C_CV = 3968, C_CG = 4480;
constexpr size_t MiB = 1u << 20;
constexpr size_t WS_CTL = 0, CTL_ZERO_BYTES = 1 * MiB;
constexpr size_t WS_TAB = 1 * MiB;
constexpr size_t WS_ROUTE = 2 * MiB;
constexpr size_t WS_WIN = 4 * MiB, WS_WOUT = 44 * MiB, WS_WDGU = 60 * MiB, WS_WDDN = 104 * MiB, WS_WMGU = 126 * MiB, WS_WMDN = 478 * MiB;
constexpr size_t WS_XB = 654 * MiB, WS_XG = 718 * MiB, WS_U1 = 854 * MiB, WS_END = 1228 * MiB;
constexpr size_t WS_PROJ = WS_U1, WS_CAT = WS_U1 + 160 * MiB, WS_H = WS_U1, WS_Y = WS_XG;
static_assert(WS_WIN + 2ull * PWP * DM * 2 <= WS_WOUT && WS_WOUT + 2ull * DM * DM * 2 <= WS_WDGU && WS_WDGU + 2ull * DFF * DM * 2 <= WS_WDDN && WS_WDDN + (size_t)DM * DFF * 2 <= WS_WMGU, "ws map 1");
static_assert(WS_WMGU + 8ull * 2 * DFF * DM * 2 <= WS_WMDN && WS_WMDN + 8ull * DM * DFF * 2 <= WS_XB && WS_XB + (size_t)NTOK * DM * 2 <= WS_XG && WS_XG + (size_t)MAXTILES * 256 * DM * 2 <= WS_U1, "ws map 2");
static_assert(WS_U1 + (size_t)MAXTILES * 256 * DFF * 2 <= WS_END && WS_PROJ + (size_t)NTOK * PWP * 2 <= WS_CAT && WS_CAT + (size_t)NTOK * DM * 2 <= WS_END, "ws map 3");
constexpr int CW_TMO = 0, CW_CODE = 1, CW_CNT = 1024  , CW_WQ = 2048  , CW_BAR = 4096  ;
constexpr int RING_OFF = 0, RING_BYTES = 131072;
constexpr int LDSCTL_OFF = RING_BYTES, MISC_OFF = LDSCTL_OFF + 320;
constexpr int LUT_OFF = LDSCTL_OFF + 1024;
constexpr int LUT_STRIDE = 132;
constexpr int LDS_BYTES = 147456;
static_assert(LUT_OFF + 18 * LUT_STRIDE * 4 <= LDS_BYTES, "LDS map");

#define GAS __attribute__((address_space(1)))
#define LAS __attribute__((address_space(3)))
typedef unsigned short bf16;
typedef unsigned v4u __attribute__((ext_vector_type(4)));
typedef unsigned v2u __attribute__((ext_vector_type(2)));
typedef float f32x4 __attribute__((ext_vector_type(4)));
typedef short bf16x8 __attribute__((ext_vector_type(8)));
typedef GAS unsigned gu32;
#define RLX_AGENT __ATOMIC_RELAXED, __HIP_MEMORY_SCOPE_AGENT
#define LDS_WAIT() asm volatile("s_waitcnt lgkmcnt(0)" ::: "memory")
#define VM_WAIT() asm volatile("s_waitcnt vmcnt(0)" ::: "memory")
__device__ __forceinline__ unsigned f2bf(float f) { unsigned u = __builtin_bit_cast(unsigned, f); return (u + 0x7fffu + ((u >> 16) & 1u)) >> 16; }
__device__ __forceinline__ unsigned pk2(float lo, float hi) { return f2bf(lo) | (f2bf(hi) << 16); }
__device__ __forceinline__ float bflo(unsigned w) { return __builtin_bit_cast(float, w << 16); }
__device__ __forceinline__ float bfhi(unsigned w) { return __builtin_bit_cast(float, w & 0xffff0000u); }
__device__ __forceinline__ float bf2f(bf16 h) { return __builtin_bit_cast(float, (unsigned)h << 16); }
__device__ const unsigned char BUCKET[129] = {0,1,2,3,4,5,6,7,8,9,10,11,12,13,14,15,16,16,16,17,17,18,18,18,19,19,19,20,20,20,20,21,21,21,21,22,22,22,22,22,23,23,23,23,23,23,24,24,24,24,24,24,25,25,25,25,25,25,25,
    26,26,26,26,26,26,26,26,27,27,27,27,27,27,27,27,27,27,28,28,28,28,28,28,28,28,28,28,29,29,29,29,29,29,29,29,29,29,29,29,30,30,30,30,30,30,30,30,30,30,30,30,30,30,31,31,31,31,31,31,31,31,31,31,31,31,31,31,31,31};
#define XB_TMO      128
#define XB_XCNT(j)  (256  + 64 * (j))
#define XB_XSUB(j)  (1280 + 64 * (j))
#define XB_XGEN(j)  (2304 + 64 * (j))
#define XB_TOP      3328
#define XB_TOPGEN   3392
#define XCD_BAR_WORDS 3456
#define XB_SPIN_CAP (1u << 18)

__device__ __forceinline__ unsigned xb_ld(unsigned* p)              { return __hip_atomic_load(p, __ATOMIC_RELAXED, __HIP_MEMORY_SCOPE_AGENT); }
__device__ __forceinline__ unsigned xb_add(unsigned* p, unsigned v) { return __hip_atomic_fetch_add(p, v, __ATOMIC_RELAXED, __HIP_MEMORY_SCOPE_AGENT); }
__device__ __forceinline__ unsigned xb_xcc_id() { return (unsigned)__builtin_amdgcn_s_getreg((3 << 11) | 20) & 0xFu; }
#define XB_SPIN(cond, bar) do { unsigned _sp = 0; while (cond) { __builtin_amdgcn_s_sleep(1); \
    if ((++_sp & 255u) == 0u) { if (xb_ld(&(bar)[XB_TMO])) break; if (_sp > XB_SPIN_CAP) { atomicAdd(&(bar)[XB_TMO], 1u); break; } } } } while (0)

struct XcdBarrier {
    unsigned* bar; unsigned x;
    volatile LAS unsigned* st;
};

__device__ __forceinline__ XcdBarrier xcd_barrier_post(unsigned* bar, volatile LAS unsigned* st) {
    XcdBarrier b; b.bar = bar; b.x = xb_xcc_id(); b.st = st;
    if (threadIdx.x == 0) (void)xb_add(&bar[XB_XCNT(b.x)], 1u);
    return b;
}
__device__ __forceinline__ void xcd_barrier_complete(unsigned* bar, unsigned x, unsigned& nloc, unsigned& nx) {
    const unsigned G = gridDim.x * gridDim.y * gridDim.z;
    unsigned sum, cnt, mine, sp = 0u;
    for (;;) {
        sum = 0u; cnt = 0u; mine = 0u;
#pragma unroll
        for (unsigned j = 0; j < 16; ++j) { const unsigned c = xb_ld(&bar[XB_XCNT(j)]); sum += c; cnt += (c > 0u) ? 1u : 0u; mine = (j == x) ? c : mine; }
        if (sum == G) break;
        __builtin_amdgcn_s_sleep(1);
        if ((++sp & 255u) == 0u) { if (xb_ld(&bar[XB_TMO])) break; if (sp > XB_SPIN_CAP) { atomicAdd(&bar[XB_TMO], 1u); break; } }
    }
    nloc = mine > 0u ? mine : 1u; nx = cnt > 0u ? cnt : 1u;
}

__device__ __forceinline__ void xcd_barrier(const XcdBarrier& b) {
    asm volatile("s_waitcnt vmcnt(0)" ::: "memory");
    __syncthreads();
    if (threadIdx.x == 0) {
        unsigned* bar = b.bar;
        __builtin_amdgcn_s_waitcnt(0);
        unsigned nloc = b.st[0], nx = b.st[1];
        if (nloc == 0u) { xcd_barrier_complete(bar, b.x, nloc, nx); b.st[0] = nloc; b.st[1] = nx; }
        const unsigned old = xb_add(&bar[XB_XSUB(b.x)], 1u);
        const unsigned gen = old / nloc;
        if (old + 1u == (gen + 1u) * nloc) {
            __builtin_amdgcn_fence(__ATOMIC_RELEASE, "agent");
            asm volatile("s_waitcnt vmcnt(0)" ::: "memory");
            const unsigned og = xb_add(&bar[XB_TOP], 1u);
            const unsigned tg = og / nx;
            if (og + 1u == (tg + 1u) * nx) xb_add(&bar[XB_TOPGEN], 1u);
            else XB_SPIN(xb_ld(&bar[XB_TOPGEN]) == tg, bar);
            __builtin_amdgcn_fence(__ATOMIC_ACQUIRE, "agent");
            xb_add(&bar[XB_XGEN(b.x)], 1u);
            asm volatile("s_waitcnt vmcnt(0)" ::: "memory");
        } else {
            XB_SPIN(xb_ld(&bar[XB_XGEN(b.x)]) == gen, bar);
            __builtin_amdgcn_fence(__ATOMIC_ACQUIRE, "agent");
            asm volatile("s_waitcnt vmcnt(0)" ::: "memory");
        }
    }
    __syncthreads();
}
struct Args { const float* in[18]; float* out; unsigned char* ws; int ph_lo, ph_hi, li, pad; float invf[32]; };
static_assert(sizeof(Args) == 20 * 8 + 16 + 128, "Args has no padding bytes");
struct Frame {
    LAS unsigned char* lds;
    gu32* ctl;
    int tid, lane, wave, vcu, G;
};
__device__ __forceinline__ float wave_sum(float v) {
#pragma unroll
    for (int o = 1; o < 64; o <<= 1) v += __shfl_xor(v, o);
    return v;
}
__device__ __forceinline__ float wave_max(float v) {
#pragma unroll
    for (int o = 1; o < 64; o <<= 1) v = fmaxf(v, __shfl_xor(v, o));
    return v;
}
__device__ __forceinline__ void p0_transpose_item(const float* W, int K, int N, bf16* WT, int k0, int n0, int drow0, LAS float* scr, int lane) {
#pragma unroll 8
    for (int i = 0; i < 32; ++i) { const int kk = 2 * i + (lane >> 5); scr[kk * 33 + (lane & 31)] = W[(size_t)(k0 + kk) * N + n0 + (lane & 31)]; }
    LDS_WAIT(); asm volatile("" ::: "memory");
    const int c = lane & 7;
#pragma unroll
    for (int j = 0; j < 4; ++j) { const int n = (lane >> 3) + 8 * j; const LAS float* s = scr + (8 * c) * 33 + n;
        v4u o; o.x = pk2(s[0 * 33], s[1 * 33]); o.y = pk2(s[2 * 33], s[3 * 33]); o.z = pk2(s[4 * 33], s[5 * 33]); o.w = pk2(s[6 * 33], s[7 * 33]);
        *(GAS v4u*)(WT + (size_t)(drow0 + n) * K + k0 + 8 * c) = o; }
    LDS_WAIT(); asm volatile("" ::: "memory");
}
template <int MODE> __device__ __forceinline__ void p0_matrix_item(const float* W, int K, int N, bf16* WT, int item, LAS float* scr, int lane) {
    const int nblk = N / 32, kb = item / nblk, nb = item % nblk, n0 = 32 * nb;
    const int drow0 = (MODE == 0) ? n0 : ((n0 >> 7) * 256 + (n0 & 127) + (MODE == 2 ? 128 : 0));
    p0_transpose_item(W, K, N, WT, 64 * kb, n0, drow0, scr, lane);
}
__device__ __forceinline__ void p0_prologue(Frame& F, const Args& a) {
    LAS float* scr = (LAS float*)(F.lds + RING_OFF + F.wave * 16384);
    const int gw = F.vcu * NWAVES + F.wave, NGW = F.G * NWAVES;
    unsigned char* ws = a.ws;
    constexpr int I_IN = (DM / 64) * (PW / 32), I_OUT = (DM / 64) * (DM / 32), I_GU = (DM / 64) * (DFF / 32), I_DN = (DFF / 64) * (DM / 32);
    constexpr int NITEMS = 2 * I_IN + 2 * I_OUT + 2 * I_GU + I_DN + 8 * (2 * I_GU + I_DN);
    for (int it = gw; it < NITEMS; it += NGW) {
        int r = it;
        if (r < 2 * I_IN) { const int l = r / I_IN; p0_matrix_item<0>(a.in[1] + (size_t)l * DM * PW, DM, PW, (bf16*)(ws + WS_WIN) + (size_t)l * PWP * DM, r % I_IN, scr, F.lane); continue; } r -= 2 * I_IN;
        if (r < 2 * I_OUT) { const int l = r / I_OUT; p0_matrix_item<0>(a.in[6] + (size_t)l * DM * DM, DM, DM, (bf16*)(ws + WS_WOUT) + (size_t)l * DM * DM, r % I_OUT, scr, F.lane); continue; } r -= 2 * I_OUT;
        if (r < I_GU) { p0_matrix_item<1>(a.in[11], DM, DFF, (bf16*)(ws + WS_WDGU), r, scr, F.lane); continue; } r -= I_GU;
        if (r < I_GU) { p0_matrix_item<2>(a.in[12], DM, DFF, (bf16*)(ws + WS_WDGU), r, scr, F.lane); continue; } r -= I_GU;
        if (r < I_DN) { p0_matrix_item<0>(a.in[13], DFF, DM, (bf16*)(ws + WS_WDDN), r, scr, F.lane); continue; } r -= I_DN;
        if (r < 8 * I_GU) { const int e = r / I_GU; p0_matrix_item<1>(a.in[15] + (size_t)e * DM * DFF, DM, DFF, (bf16*)(ws + WS_WMGU) + (size_t)e * 2 * DFF * DM, r % I_GU, scr, F.lane); continue; } r -= 8 * I_GU;
        if (r < 8 * I_GU) { const int e = r / I_GU; p0_matrix_item<2>(a.in[16] + (size_t)e * DM * DFF, DM, DFF, (bf16*)(ws + WS_WMGU) + (size_t)e * 2 * DFF * DM, r % I_GU, scr, F.lane); continue; } r -= 8 * I_GU;
        { const int e = r / I_DN; p0_matrix_item<0>(a.in[17] + (size_t)e * DFF * DM, DFF, DM, (bf16*)(ws + WS_WMDN) + (size_t)e * DM * DFF, r % I_DN, scr, F.lane); }
    }
    { const int gt = gw * 64 + F.lane, NGT = NGW * 64; const GAS f32x4* x4 = (const GAS f32x4*)a.in[0]; GAS v4u* o4 = (GAS v4u*)(ws + WS_XB);
      for (int i = gt; i < NTOK * DM / 8; i += NGT) { const f32x4 p = x4[2 * i], q = x4[2 * i + 1]; v4u o; o.x = pk2(p[0], p[1]); o.y = pk2(p[2], p[3]); o.z = pk2(q[0], q[1]); o.w = pk2(q[2], q[3]); o4[i] = o; } }
    { const int gt = gw * 64 + F.lane; if (gt < SEQ * 32) { const int pos = gt >> 5, i = gt & 31; const float ang = (float)pos * a.invf[i];
        const double t = (double)ang * 0.15915494309189535; const float fr = (float)(t - __builtin_rint(t));
        ((float*)(ws + WS_TAB))[gt] = __builtin_amdgcn_sinf(fr); ((float*)(ws + WS_TAB + 256 * 1024))[gt] = __builtin_amdgcn_cosf(fr); } }
}
__device__ __forceinline__ void build_lut(Frame& F, const float* rel_bias) {
    LAS float* lut = (LAS float*)(F.lds + LUT_OFF);
    for (int i = F.tid; i < 18 * 129; i += NWAVES * 64) { const int hh = i / 129, d = i % 129; lut[hh * LUT_STRIDE + d] = rel_bias[BUCKET[d] * 18 + hh] * LOG2E; }
}
__device__ __forceinline__ void ln_stats(f32x4 (&v)[8], float& mean, float& rstd) {
    float s = 0.f;
#pragma unroll
    for (int j = 0; j < 8; ++j) s += (v[j][0] + v[j][1]) + (v[j][2] + v[j][3]);
    mean = wave_sum(s) * (1.f / DM); float s2 = 0.f;
#pragma unroll
    for (int j = 0; j < 8; ++j) { v[j] = v[j] - mean; s2 += (v[j][0] * v[j][0] + v[j][1] * v[j][1]) + (v[j][2] * v[j][2] + v[j][3] * v[j][3]); }
    rstd = 1.f / sqrtf(wave_sum(s2) * (1.f / DM) + LN_EPS);
}
__device__ __forceinline__ int expert_offsets(Frame& F, int& ntiles) {
    const unsigned c = (F.lane < 8) ? __hip_atomic_load(F.ctl + CW_CNT + 64 * F.lane, RLX_AGENT) : 0u;
    const int t = (int)((c + 255u) >> 8);
    int inc = t;
#pragma unroll
    for (int o = 1; o < 8; o <<= 1) { const int u = __shfl_up(inc, o); if (F.lane >= o) inc += u; }
    ntiles = __shfl(inc, 7);
    return (inc - t) * 256;
}
template <int MODE> __device__ __forceinline__ void ln_phase(Frame& F, const Args& a, float* T, const float* gam, const float* bet, const float* w_router) {
    unsigned char* ws = a.ws;
    bf16* XB = (bf16*)(ws + WS_XB);
    const int lane = F.lane;
    LAS float* wrT = (LAS float*)(F.lds + RING_OFF);
    LAS int* cwL = (LAS int*)(F.lds + RING_OFF + 65536);
    LAS int* baseL = (LAS int*)(F.lds + RING_OFF + 65536 + 256);
    if (MODE == 1) {
        for (int i = F.tid; i < DM * 8; i += NWAVES * 64) wrT[(i & 7) * DM + (i >> 3)] = w_router[i];
        __syncthreads();
    }
    f32x4 g4[8], b4[8];
#pragma unroll
    for (int j = 0; j < 8; ++j) { g4[j] = *(const f32x4*)(gam + 4 * lane + 256 * j); b4[j] = *(const f32x4*)(bet + 4 * lane + 256 * j); }
    int offv = 0, ntl = 0;
    if (MODE == 2) offv = expert_offsets(F, ntl);
    const int rb = (F.vcu * NWAVES + F.wave) * 8;
    unsigned long long cntp = 0ull; int me1 = 0, me2 = 0, mr1 = 0, mr2 = 0; float mg1 = 0.f, mg2 = 0.f;
    for (int r = 0; r < 8; ++r) {
        const int row = rb + r;
        float* trow = T + (size_t)row * DM;
        f32x4 v[8];
#pragma unroll
        for (int j = 0; j < 8; ++j) v[j] = *(const f32x4*)(trow + 4 * lane + 256 * j);
        if (MODE == 2) {
            const int* rt = (const int*)(ws + WS_ROUTE) + row * 8;
            const int e1 = rt[0], p1 = rt[1], e2 = rt[2], p2 = rt[3]; const float g1 = __builtin_bit_cast(float, rt[4]), g2 = __builtin_bit_cast(float, rt[5]);
            const int r1 = __shfl(offv, e1) + p1, r2 = __shfl(offv, e2) + p2;
            const bf16* y1 = (const bf16*)(ws + WS_Y) + (size_t)r1 * DM; const bf16* y2 = (const bf16*)(ws + WS_Y) + (size_t)r2 * DM;
#pragma unroll
            for (int j = 0; j < 8; ++j) { const v2u a1 = *(const v2u*)(y1 + 4 * lane + 256 * j), a2 = *(const v2u*)(y2 + 4 * lane + 256 * j);
                v[j][0] = v[j][0] * pg8::ALPHA_F + g1 * bflo(a1.x) + g2 * bflo(a2.x); v[j][1] = v[j][1] * pg8::ALPHA_F + g1 * bfhi(a1.x) + g2 * bfhi(a2.x);
                v[j][2] = v[j][2] * pg8::ALPHA_F + g1 * bflo(a1.y) + g2 * bflo(a2.y); v[j][3] = v[j][3] * pg8::ALPHA_F + g1 * bfhi(a1.y) + g2 * bfhi(a2.y); }
        }
        float mean, rstd; ln_stats(v, mean, rstd);
#pragma unroll
        for (int j = 0; j < 8; ++j) v[j] = v[j] * rstd * g4[j] + b4[j];
        if (MODE == 2) {
            float* orow = a.out + (size_t)row * DM;
#pragma unroll
            for (int j = 0; j < 8; ++j) *(f32x4*)(orow + 4 * lane + 256 * j) = v[j];
        } else {
            bf16* xrow = XB + (size_t)row * DM;
#pragma unroll
            for (int j = 0; j < 8; ++j) { *(f32x4*)(trow + 4 * lane + 256 * j) = v[j]; v2u o; o.x = pk2(v[j][0], v[j][1]); o.y = pk2(v[j][2], v[j][3]); *(v2u*)(xrow + 4 * lane + 256 * j) = o; }
        }
        if (MODE == 1) {
            int i1 = -1, i2 = -1; float v1 = -3.0e38f, v2 = -3.0e38f;
#pragma unroll 1
            for (int e = 0; e < 8; ++e) { float s = 0.f;
#pragma unroll
                for (int j = 0; j < 8; ++j) { const f32x4 w = *(const LAS f32x4*)(wrT + e * DM + 4 * lane + 256 * j); s += (v[j][0] * w[0] + v[j][1] * w[1]) + (v[j][2] * w[2] + v[j][3] * w[3]); }
                const float t = wave_sum(s);
                if (t > v1) { v2 = v1; i2 = i1; v1 = t; i1 = e; } else if (t > v2) { v2 = t; i2 = e; } }
            if (i1 < 0) i1 = 0;
            if (i2 < 0) i2 = (i1 + 1) & 7;
            const float ex = __expf(v2 - v1), w1 = 1.f / (1.f + ex), w2 = ex * w1;
            const int k1 = (int)((cntp >> (8 * i1)) & 0xffull); cntp += 1ull << (8 * i1);
            const int k2 = (int)((cntp >> (8 * i2)) & 0xffull); cntp += 1ull << (8 * i2);
            if (lane == r) { me1 = i1; me2 = i2; mr1 = k1; mr2 = k2; mg1 = w1; mg2 = w2; }
        }
    }
    if (MODE == 1) {
        if (lane < 8) cwL[F.wave * 8 + lane] = (int)((cntp >> (8 * lane)) & 0xffull);
        __syncthreads();
        if (F.tid < 8) { int tot = 0;
#pragma unroll
            for (int w = 0; w < 8; ++w) tot += cwL[w * 8 + F.tid];
            baseL[F.tid] = (int)__hip_atomic_fetch_add(F.ctl + CW_CNT + 64 * F.tid, (unsigned)tot, RLX_AGENT); }
        __syncthreads();
        if (lane < 8) {
            int p1 = baseL[me1] + mr1, p2 = baseL[me2] + mr2;
            for (int w = 0; w < F.wave; ++w) { p1 += cwL[w * 8 + me1]; p2 += cwL[w * 8 + me2]; }
            int* rt = (int*)(ws + WS_ROUTE) + (rb + lane) * 8;
            rt[0] = me1; rt[1] = p1; rt[2] = me2; rt[3] = p2; rt[4] = __builtin_bit_cast(int, mg1); rt[5] = __builtin_bit_cast(int, mg2);
        }
    }
}
__device__ __forceinline__ void gather_phase(Frame& F, const Args& a) {
    unsigned char* ws = a.ws; int ntl; const int offv = expert_offsets(F, ntl);
    const int gw = F.vcu * NWAVES + F.wave, NGW = F.G * NWAVES;
    for (int p = gw; p < 2 * NTOK; p += NGW) {
        const int tok = p >> 1, k = p & 1; const int* rt = (const int*)(ws + WS_ROUTE) + tok * 8;
        const int e = rt[2 * k], pos = rt[2 * k + 1]; const int dst = __shfl(offv, e) + pos;
        const GAS v4u* s = (const GAS v4u*)(ws + WS_XB + (size_t)tok * DM * 2); GAS v4u* d = (GAS v4u*)(ws + WS_XG + (size_t)dst * DM * 2);
#pragma unroll
        for (int j = 0; j < 4; ++j) d[F.lane + 64 * j] = s[F.lane + 64 * j];
    }
}
__device__ __forceinline__ float dot8(const v4u q, const v4u k) {
    return (bflo(q.x) * bflo(k.x) + bfhi(q.x) * bfhi(k.x)) + (bflo(q.y) * bflo(k.y) + bfhi(q.y) * bfhi(k.y)) + (bflo(q.z) * bflo(k.z) + bfhi(q.z) * bfhi(k.z)) + (bflo(q.w) * bflo(k.w) + bfhi(q.w) * bfhi(k.w));
}
__device__ __forceinline__ float lambda_of(const float* lp, int lane, float lam_init) {
    const float s1 = wave_sum(lp[lane] * lp[64 + lane]), s2 = wave_sum(lp[128 + lane] * lp[192 + lane]);
    return __expf(s1) - __expf(s2) + lam_init;
}
__device__ __forceinline__ void naive_mixers(Frame& F, const Args& a, int layer) {
    unsigned char* ws = a.ws; const bf16* PROJ = (const bf16*)(ws + WS_PROJ); bf16* CAT = (bf16*)(ws + WS_CAT);
    const int lane = F.lane; const int gw = F.vcu * NWAVES + F.wave, NGW = F.G * NWAVES;
    LAS float* sc = (LAS float*)(F.lds + RING_OFF + F.wave * 16384);
    const LAS float* lut = (const LAS float*)(F.lds + LUT_OFF);
    const float lam_init = 0.8f - 0.6f * __expf(-0.3f * (float)layer);
    const float lam = lambda_of(a.in[3] + layer * 256, lane, lam_init);
    const float* subg = a.in[4] + layer * 128; const float* sinks = a.in[5] + layer * 12;
    for (int task = gw; task < NTOK * 6; task += NGW) {
        const int tok = task / 6, h = task - tok * 6, q = tok & (SEQ - 1), base = tok - q;
        v4u qv[16]; { const v4u* qp = (const v4u*)(PROJ + (size_t)tok * PWP + C_AQ + h * 128);
#pragma unroll
            for (int c = 0; c < 16; ++c) qv[c] = qp[c]; }
        float m1 = -3.0e38f, m2 = -3.0e38f;
        for (int j = lane; j <= q; j += 64) {
            const v4u* kp = (const v4u*)(PROJ + (size_t)(base + j) * PWP + C_AK + h * 128); float d1 = 0.f, d2 = 0.f;
#pragma unroll
            for (int c = 0; c < 8; ++c) { d1 += dot8(qv[c], kp[c]); d2 += dot8(qv[8 + c], kp[8 + c]); }
            const int dd = q - j; const float bias = lut[h * LUT_STRIDE + (dd < 128 ? dd : 128)];
            d1 += bias; d2 += bias; sc[j] = d1; sc[2048 + j] = d2; m1 = fmaxf(m1, d1); m2 = fmaxf(m2, d2);
        }
        m1 = wave_max(m1); m2 = wave_max(m2); float l1 = 0.f, l2 = 0.f;
        for (int j = lane; j <= q; j += 64) { const float p1 = __builtin_amdgcn_exp2f(sc[j] - m1), p2 = __builtin_amdgcn_exp2f(sc[2048 + j] - m2); sc[j] = p1; sc[2048 + j] = p2; l1 += p1; l2 += p2; }
        l1 = wave_sum(l1); l2 = wave_sum(l2); const float c1 = 1.f / l1, c2 = lam / l2;
        float o0 = 0.f, o1 = 0.f;
        for (int j = 0; j <= q; ++j) { const float w = sc[j] * c1 - sc[2048 + j] * c2; const bf16* vr = PROJ + (size_t)(base + j) * PWP + C_AV + h * 128; o0 += w * bf2f(vr[lane]); o1 += w * bf2f(vr[64 + lane]); }
        const float ss = wave_sum(o0 * o0 + o1 * o1), rr = (1.f / sqrtf(ss * (1.f / 128.f) + LN_EPS)) * (1.f - lam_init);
        bf16* orow = CAT + (size_t)tok * DM + h * 128; orow[lane] = (bf16)f2bf(o0 * rr * subg[lane]); orow[64 + lane] = (bf16)f2bf(o1 * rr * subg[64 + lane]);
    }
    for (int task = gw; task < NTOK * 12; task += NGW) {
        const int tok = task / 12, hq = task - tok * 12, kvh = hq >> 2, q = tok & (SEQ - 1), base = tok - q;
        v4u qv[8]; { const v4u* qp = (const v4u*)(PROJ + (size_t)tok * PWP + C_BQ + hq * 64);
#pragma unroll
            for (int c = 0; c < 8; ++c) qv[c] = qp[c]; }
        float s[2];
#pragma unroll
        for (int i = 0; i < 2; ++i) { const int dd = lane + 64 * i, j = q - dd; s[i] = -3.0e38f;
            if (j >= 0) { const v4u* kp = (const v4u*)(PROJ + (size_t)(base + j) * PWP + C_BK + kvh * 64); float d = 0.f;
#pragma unroll
                for (int c = 0; c < 8; ++c) d += dot8(qv[c], kp[c]);
                s[i] = d + lut[(6 + hq) * LUT_STRIDE + dd]; } }
        const float sink2 = sinks[hq] * LOG2E; const float m = fmaxf(wave_max(fmaxf(s[0], s[1])), sink2);
        const float p0 = (q - lane >= 0) ? __builtin_amdgcn_exp2f(s[0] - m) : 0.f, p1 = (q - lane - 64 >= 0) ? __builtin_amdgcn_exp2f(s[1] - m) : 0.f;
        const float l = wave_sum(p0 + p1) + __builtin_amdgcn_exp2f(sink2 - m);
        sc[lane] = p0; sc[64 + lane] = p1;
        float o = 0.f; const int nk = (q + 1 < 128) ? q + 1 : 128;
        for (int dd = 0; dd < nk; ++dd) o += sc[dd] * bf2f(PROJ[(size_t)(base + q - dd) * PWP + C_BV + kvh * 64 + lane]);
        CAT[(size_t)tok * DM + 768 + hq * 64 + lane] = (bf16)f2bf(o / l);
    }
    for (int task = gw; task < NTOK * 4; task += NGW) {
        const int tok = task >> 2, h = task & 3, q = tok & (SEQ - 1), base = tok - q;
        const float lg2 = log2f(1.f - exp2f(-5.f - (float)h));
        v4u qv[8]; { const v4u* qp = (const v4u*)(PROJ + (size_t)tok * PWP + C_CQ + h * 64);
#pragma unroll
            for (int c = 0; c < 8; ++c) qv[c] = qp[c]; }
        for (int j = lane; j <= q; j += 64) { const v4u* kp = (const v4u*)(PROJ + (size_t)(base + j) * PWP + C_CK + h * 64); float d = 0.f;
#pragma unroll
            for (int c = 0; c < 8; ++c) d += dot8(qv[c], kp[c]);
            sc[j] = d * __builtin_amdgcn_exp2f((float)(q - j) * lg2); }
        float o0 = 0.f, o1 = 0.f;
        for (int j = 0; j <= q; ++j) { const float w = sc[j]; const bf16* vr = PROJ + (size_t)(base + j) * PWP + C_CV + h * 128; o0 += w * bf2f(vr[lane]); o1 += w * bf2f(vr[64 + lane]); }
        const float mu = wave_sum(o0 + o1) * (1.f / 128.f); o0 -= mu; o1 -= mu;
        const float rs = 1.f / sqrtf(wave_sum(o0 * o0 + o1 * o1) * (1.f / 128.f) + LN_EPS);
        const bf16* gr = PROJ + (size_t)tok * PWP + C_CG + h * 128;
        bf16* orow = CAT + (size_t)tok * DM + 1536 + h * 128;
        orow[lane] = (bf16)f2bf(pg8::silu_f(bf2f(gr[lane])) * o0 * rs); orow[64 + lane] = (bf16)f2bf(pg8::silu_f(bf2f(gr[64 + lane])) * o1 * rs);
    }
}
#ifndef MIXER_NAIVE
#define MIXER_NAIVE 1
#endif
#define IN(k) (lo <= (k) && (k) < hi)
#define SEAM(k) do { if (IN(k) && IN((k) + 1)) xcd_barrier(bar); } while (0)
template <int l> __device__ __forceinline__ void run_layer(Frame& F, const Args& args, const XcdBarrier& bar, int lo, int hi) {
    unsigned char* ws = args.ws;
    bf16* XB = (bf16*)(ws + WS_XB); bf16* PROJ = (bf16*)(ws + WS_PROJ); bf16* CAT = (bf16*)(ws + WS_CAT); bf16* HB = (bf16*)(ws + WS_H);
    float* T = args.out;
        const int pb = 1 + 7 * l;
        if (IN(pb)) {
            pg8::Gemm g{XB, (const bf16*)(ws + WS_WIN) + (size_t)l * PWP * DM, NTOK, PWP, DM}; pg8::StaticOrder S; S.init(NTOK, PWP, F.G, (int)blockIdx.x);
            pg8::EpiProj E{PROJ, (const float*)(ws + WS_TAB), (const float*)(ws + WS_TAB + 256 * 1024)};
            pg8::gemm_phase<pg8::EpiProj, pg8::StaticOrder, true, true>(F.lds + RING_OFF, g, S, E);
        } SEAM(pb);
        if (IN(pb + 1)) { naive_mixers(F, args, l); } SEAM(pb + 1);
        if (IN(pb + 2)) {
            pg8::Gemm g{CAT, (const bf16*)(ws + WS_WOUT) + (size_t)l * DM * DM, NTOK, DM, DM}; pg8::StaticOrder S; S.init(NTOK, DM, F.G, (int)blockIdx.x);
            pg8::EpiResid E{T, l == 0 ? args.in[0] : T};
            pg8::gemm_phase<pg8::EpiResid, pg8::StaticOrder, true, true>(F.lds + RING_OFF, g, S, E);
        } SEAM(pb + 2);
        if constexpr (l == 0) {
            if (IN(4)) { ln_phase<0>(F, args, T, args.in[7], args.in[8], nullptr); } SEAM(4);
            if (IN(5)) {
                pg8::Gemm g{XB, (const bf16*)(ws + WS_WDGU), NTOK, 2 * DFF, DM}; pg8::StaticOrder S; S.init(NTOK, 2 * DFF, F.G, (int)blockIdx.x);
                pg8::EpiSwiGLU E{HB, 44};
                pg8::gemm_phase<pg8::EpiSwiGLU, pg8::StaticOrder, true, true>(F.lds + RING_OFF, g, S, E);
            } SEAM(5);
            if (IN(6)) {
                pg8::Gemm g{HB, (const bf16*)(ws + WS_WDDN), NTOK, DM, DFF}; pg8::StaticOrder S; S.init(NTOK, DM, F.G, (int)blockIdx.x);
                pg8::EpiResid E{T, T};
                pg8::gemm_phase<pg8::EpiResid, pg8::StaticOrder, true, true>(F.lds + RING_OFF, g, S, E);
            } SEAM(6);
            if (IN(7)) { ln_phase<0>(F, args, T, args.in[9], args.in[10], nullptr); } SEAM(7);
        } else {
            if (IN(11)) { ln_phase<1>(F, args, T, args.in[7] + DM, args.in[8] + DM, args.in[14]); } SEAM(11);
            if (IN(12)) { gather_phase(F, args); } SEAM(12);
            if (IN(13) || IN(14)) {
                int ntl; const int offv = expert_offsets(F, ntl);
                pg8::GroupedOrder S; S.nM = ntl; S.G = F.G; S.c = (int)blockIdx.x;
#pragma unroll
                for (int e = 0; e < 8; ++e) S.cum[e] = (e < 7) ? (__shfl(offv, e + 1) >> 8) : ntl;
                if (IN(13)) {
                    S.nN = 44; S.nwg = ntl * 44;
                    pg8::Gemm g{(const bf16*)(ws + WS_XG), (const bf16*)(ws + WS_WMGU), ntl * 256, 8 * 2 * DFF, DM};
                    pg8::EpiSwiGLU E{HB, 44};
                    pg8::gemm_phase<pg8::EpiSwiGLU, pg8::GroupedOrder, true, true>(F.lds + RING_OFF, g, S, E);
                } SEAM(13);
                if (IN(14)) {
                    S.nN = 8; S.nwg = ntl * 8;
                    pg8::Gemm g{HB, (const bf16*)(ws + WS_WMDN), ntl * 256, 8 * DM, DFF};
                    pg8::EpiY E{(bf16*)(ws + WS_Y), 8};
                    pg8::gemm_phase<pg8::EpiY, pg8::GroupedOrder, true, true>(F.lds + RING_OFF, g, S, E);
                } SEAM(14);
            }
            if (IN(15)) { ln_phase<2>(F, args, T, args.in[9] + DM, args.in[10] + DM, nullptr); }
        }
}
constexpr int N_PHASES = 16;
__global__ void __launch_bounds__(NWAVES * 64, 2) hymba_fwd(Args args) {
    extern __shared__ __attribute__((aligned(16))) unsigned char lds[];
    Frame F;
    F.lds = (LAS unsigned char*)lds;
    volatile LAS unsigned* MISC = (volatile LAS unsigned*)(F.lds + MISC_OFF);
    F.tid = threadIdx.x; F.lane = F.tid & 63; F.wave = __builtin_amdgcn_readfirstlane(F.tid >> 6);
    F.G = gridDim.x; { const int bx = blockIdx.x; F.vcu = (F.G % 8 == 0) ? (bx % 8) * (F.G / 8) + bx / 8 : bx; }
    unsigned char* ws = args.ws;
    F.ctl = (gu32*)(ws + WS_CTL);
    for (int u = F.tid; u < 1024 / 4; u += NWAVES * 64) ((LAS unsigned*)(F.lds + LDSCTL_OFF))[u] = 0u;
    __syncthreads();
    XcdBarrier bar = xcd_barrier_post((unsigned*)(F.ctl + CW_BAR) + args.li * 4096, MISC + 8);
    build_lut(F, args.in[2]);
    __syncthreads();
    const int lo = args.ph_lo, hi = args.ph_hi;
    if (IN(0)) { p0_prologue(F, args); } SEAM(0);
    run_layer<0>(F, args, bar, lo, hi);
    run_layer<1>(F, args, bar, lo, hi);
#undef IN
#undef SEAM
}

#ifndef N_LAUNCHES
#define N_LAUNCHES 1
#endif
extern "C" void kernel_launch(void* const* d_in, const int* in_sizes, int n_in, void* d_out, int out_size, void* d_ws, size_t ws_size, hipStream_t stream) {
    static int grid = 0;
    if (grid == 0) {
        if (n_in != 18 || in_sizes[0] != NTOK * DM || out_size != NTOK * DM || ws_size < WS_END) { fprintf(stderr, "kernel_launch: unexpected shapes / workspace (%d inputs, ws %zu < %zu)\n", n_in, ws_size, (size_t)WS_END); grid = -1; return; }
        int dev = 0, cus = 0, per_cu = 0;
        if (hipGetDevice(&dev) != hipSuccess || hipDeviceGetAttribute(&cus, hipDeviceAttributeMultiprocessorCount, dev) != hipSuccess) { grid = -1; return; }
        if (hipFuncSetAttribute((const void*)hymba_fwd, hipFuncAttributeMaxDynamicSharedMemorySize, LDS_BYTES) != hipSuccess) { fprintf(stderr, "kernel_launch: hipFuncSetAttribute failed\n"); grid = -1; return; }
        if (hipOccupancyMaxActiveBlocksPerMultiprocessor(&per_cu, (const void*)hymba_fwd, NWAVES * 64, LDS_BYTES) != hipSuccess || per_cu < 1) fprintf(stderr, "kernel_launch: occupancy query reports %d\n", per_cu);
        (void)hipGetLastError();
        grid = (cus == 256) ? 256 : -1;
        if (grid < 0) { fprintf(stderr, "kernel_launch: built for a 256-CU device, found %d CUs\n", cus); return; }
    }
    if (grid < 0) return;
    if (hipMemsetAsync((char*)d_ws + WS_CTL, 0, CTL_ZERO_BYTES, stream) != hipSuccess) return;
    Args a{};
    for (int i = 0; i < 18; ++i) a.in[i] = (const float*)d_in[i];
    a.out = (float*)d_out; a.ws = (unsigned char*)d_ws;
    for (int i = 0; i < 32; ++i) a.invf[i] = (float)(1.0 / pow(10000.0, (double)((float)i / 31.0f)));
#if N_LAUNCHES == 1
    const int cuts[2] = {0, N_PHASES};
#else
    int cuts[N_PHASES + 1]; for (int i = 0; i <= N_PHASES; ++i) cuts[i] = i;
#endif
    const int nl = (N_LAUNCHES == 1) ? 1 : N_PHASES;
    for (int li = 0; li < nl; ++li) {
        a.ph_lo = cuts[li]; a.ph_hi = cuts[li + 1]; a.li = li; a.pad = 0;
        hipLaunchKernelGGL(hymba_fwd, dim3(grid), dim3(NWAVES * 64), LDS_BYTES, stream, a);
        const hipError_t le = hipPeekAtLastError();
        if (le != hipSuccess) { fprintf(stderr, "kernel_launch: launch %d failed: %s\n", li, hipGetErrorName(le)); break; }
    }
}
```

```cpp
#include <hip/hip_runtime.h>
#include <cstdio>
#include <cstdint>
#include <cmath>
namespace pg8 {
#define PG8_LAS __attribute__((address_space(3)))
typedef unsigned short bf16_t;
typedef short bf16x8 __attribute__((ext_vector_type(8)));
typedef float f32x4 __attribute__((ext_vector_type(4)));
typedef unsigned u32x4 __attribute__((ext_vector_type(4)));
constexpr int BM = 256, BK = 64, HALF = 128, HTB = HALF * BK * 2  , STAGE_BYTES = 8 * HTB, NXCD = 8, WGM = 8;

__host__ __device__ __forceinline__ int lds_byte(int r, int c) { const int st = (r >> 4) * 2 + (c >> 5), rr = r & 15, cc = c & 31, ob = rr * 64 + cc * 2; return st * 1024 + (ob ^ (((ob >> 9) & 1) << 5)); }
__host__ __device__ __forceinline__ void stage_rc(int b, int& R, int& C) { const int st = b / 1024, sb = b % 1024, swz = sb ^ (((sb >> 9) & 1) << 5); R = (st >> 1) * 16 + swz / 64; C = (st & 1) * 32 + (swz % 64) / 2; }
__host__ __device__ __forceinline__ int perm32(int rho) { const int n = rho >> 4, i = rho & 15; return 8 * (i >> 2) + 4 * n + (i & 3); }

struct Unit { int pm, pn; };
struct Gemm { const bf16_t* A; const bf16_t* Bt; int M, N, K; };

struct StaticOrder {
    int nM, nN, nwg, G, c;
    __host__ __device__ void init(int M, int N, int G_, int c_) { nM = M / BM; nN = N / BM; nwg = nM * nN; G = G_; c = c_; }
    __host__ __device__ bool next(int i, Unit& u) const {
        const long L = (long)i * G + c; if (L >= nwg) return false;
        int wgid = (int)L; { const int q = nwg / NXCD, r = nwg % NXCD, xcd = wgid % NXCD, off = wgid / NXCD; wgid = (xcd < r ? xcd * (q + 1) : r * (q + 1) + (xcd - r) * q) + off; }
        const int nig = WGM * nN, gid = wgid / nig, fm = gid * WGM, gsz = (nM - fm) < WGM ? (nM - fm) : WGM;
        u.pm = fm + ((wgid % nig) % gsz); u.pn = (wgid % nig) / gsz; return true;
    }
    __device__ __forceinline__ void a_ready(const Unit&) const {}
    __device__ __forceinline__ void done(const Unit&) const {}
};

__device__ __forceinline__ unsigned cvt_pk_bf16(float lo, float hi) { unsigned r; asm volatile("v_cvt_pk_bf16_f32 %0, %1, %2" : "=v"(r) : "v"(lo), "v"(hi)); return r; }
typedef float f32x2 __attribute__((ext_vector_type(2)));
typedef float f32x2 __attribute__((ext_vector_type(2)));
constexpr float ALPHA_F = 1.41421356237309515f;
constexpr float C2_F = 0.125f * 1.4426950408889634f;
__device__ __forceinline__ u32x4 pack8(const f32x4 v0, const f32x4 v1) { u32x4 w; w.x = cvt_pk_bf16(v0[0], v0[1]); w.y = cvt_pk_bf16(v0[2], v0[3]); w.z = cvt_pk_bf16(v1[0], v1[1]); w.w = cvt_pk_bf16(v1[2], v1[3]); return w; }

struct EpiProj {
    static constexpr bool PERM = true, AFTER_DRAIN = false;
    bf16_t* O; const float* sinT; const float* cosT;
    __device__ __forceinline__ void operator()(const f32x4 (&acc)[2][2][4][2], const Unit& u, int wr, int wc, int fr, int fq) const {
        const int row0 = u.pm * BM + wr * 64 + fr;
#pragma unroll
        for (int bj = 0; bj < 2; ++bj) {
            const int cw = u.pn * BM + bj * HALF + wc * 32;
            const int c0 = cw + 8 * fq;
            float sc = 1.f; bool rope = false;
            if (cw < 768 || (cw >= 2304 && cw < 3072)) sc = C2_F;
            else if (cw >= 3456 && cw < 3968) { rope = true; if (cw >= 3712) sc = 0.125f; }
            const int i0 = ((c0 - 3456) & 63) >> 1;
#pragma unroll
            for (int ai = 0; ai < 2; ++ai)
#pragma unroll
                for (int m = 0; m < 4; ++m) {
                    const int row = row0 + ai * HALF + m * 16;
                    f32x4 v0 = acc[ai][bj][m][0] * sc, v1 = acc[ai][bj][m][1] * sc;
                    if (rope) {
                        const int pos = row & 2047;
                        const f32x4 sn = *(const f32x4*)(sinT + pos * 32 + i0), cs = *(const f32x4*)(cosT + pos * 32 + i0);
                        f32x4 w0, w1;
                        w0[0] = v0[0] * cs[0] - v0[1] * sn[0]; w0[1] = v0[1] * cs[0] + v0[0] * sn[0];
                        w0[2] = v0[2] * cs[1] - v0[3] * sn[1]; w0[3] = v0[3] * cs[1] + v0[2] * sn[1];
                        w1[0] = v1[0] * cs[2] - v1[1] * sn[2]; w1[1] = v1[1] * cs[2] + v1[0] * sn[2];
                        w1[2] = v1[2] * cs[3] - v1[3] * sn[3]; w1[3] = v1[3] * cs[3] + v1[2] * sn[3];
                        v0 = w0; v1 = w1;
                    }
                    *(u32x4*)(O + (size_t)row * 5120 + c0) = pack8(v0, v1);
                }
        }
    }
};
struct EpiResid {
    static constexpr bool PERM = true, AFTER_DRAIN = false;
    float* T; const float* R;
    __device__ __forceinline__ void operator()(const f32x4 (&acc)[2][2][4][2], const Unit& u, int wr, int wc, int fr, int fq) const {
        const int row0 = u.pm * BM + wr * 64 + fr, col0 = u.pn * BM + wc * 32 + 8 * fq;
#pragma unroll
        for (int ai = 0; ai < 2; ++ai)
#pragma unroll
            for (int m = 0; m < 4; ++m) {
                const size_t ro = (size_t)(row0 + ai * HALF + m * 16) * 2048 + col0;
#pragma unroll
                for (int bj = 0; bj < 2; ++bj) {
                    const f32x4 r0 = *(const f32x4*)(R + ro + bj * HALF), r1 = *(const f32x4*)(R + ro + bj * HALF + 4);
                    *(f32x4*)(T + ro + bj * HALF) = r0 * ALPHA_F + acc[ai][bj][m][0];
                    *(f32x4*)(T + ro + bj * HALF + 4) = r1 * ALPHA_F + acc[ai][bj][m][1];
                }
            }
    }
};
__device__ __forceinline__ float silu_f(float x) { return x * __builtin_amdgcn_rcpf(1.f + __builtin_amdgcn_exp2f(-1.4426950408889634f * x)); }
struct EpiSwiGLU {
    static constexpr bool PERM = true, AFTER_DRAIN = false;
    bf16_t* H; int ntn;
    __device__ __forceinline__ void operator()(const f32x4 (&acc)[2][2][4][2], const Unit& u, int wr, int wc, int fr, int fq) const {
        const int row0 = u.pm * BM + wr * 64 + fr, col0 = (u.pn % ntn) * HALF + wc * 32 + 8 * fq;
#pragma unroll
        for (int ai = 0; ai < 2; ++ai)
#pragma unroll
            for (int m = 0; m < 4; ++m) {
                f32x4 h0, h1;
#pragma unroll
                for (int j = 0; j < 4; ++j) { h0[j] = silu_f(acc[ai][0][m][0][j]) * acc[ai][1][m][0][j]; h1[j] = silu_f(acc[ai][0][m][1][j]) * acc[ai][1][m][1][j]; }
                *(u32x4*)(H + (size_t)(row0 + ai * HALF + m * 16) * 5632 + col0) = pack8(h0, h1);
            }
    }
};
struct EpiY {
    static constexpr bool PERM = true, AFTER_DRAIN = false;
    bf16_t* Y; int ntn;
    __device__ __forceinline__ void operator()(const f32x4 (&acc)[2][2][4][2], const Unit& u, int wr, int wc, int fr, int fq) const {
        const int row0 = u.pm * BM + wr * 64 + fr, col0 = (u.pn % ntn) * BM + wc * 32 + 8 * fq;
#pragma unroll
        for (int ai = 0; ai < 2; ++ai)
#pragma unroll
            for (int m = 0; m < 4; ++m)
#pragma unroll
                for (int bj = 0; bj < 2; ++bj)
                    *(u32x4*)(Y + (size_t)(row0 + ai * HALF + m * 16) * 2048 + col0 + bj * HALF) = pack8(acc[ai][bj][m][0], acc[ai][bj][m][1]);
    }
};
struct GroupedOrder {
    int nM, nN, nwg, G, c; int cum[8];
    __device__ __forceinline__ bool next(int i, Unit& u) const {
        const long L = (long)i * G + c; if (L >= nwg) return false;
        int wgid = (int)L; { const int q = nwg / NXCD, r = nwg % NXCD, xcd = wgid % NXCD, off = wgid / NXCD; wgid = (xcd < r ? xcd * (q + 1) : r * (q + 1) + (xcd - r) * q) + off; }
        const int nig = WGM * nN, gid = wgid / nig, fm = gid * WGM, gsz = (nM - fm) < WGM ? (nM - fm) : WGM;
        const int pm = fm + ((wgid % nig) % gsz), pn = (wgid % nig) / gsz;
        int e = 0;
#pragma unroll
        for (int j = 0; j < 7; ++j) e += (pm >= cum[j]) ? 1 : 0;
        u.pm = pm; u.pn = e * nN + pn; return true;
    }
    __device__ __forceinline__ void a_ready(const Unit&) const {}
    __device__ __forceinline__ void done(const Unit&) const {}
};
template <class Epi, class Sched, bool ALIGN_EPI = false, bool SP2 = false>
__device__ __forceinline__ void gemm_phase(PG8_LAS unsigned char* lds, const Gemm g, const Sched& S, const Epi& E) {
    const int tid = threadIdx.x, wid = __builtin_amdgcn_readfirstlane(tid >> 6), lane = tid & 63, wr = wid >> 2, wc = wid & 3, fr = lane & 15, fq = lane >> 4;
    const int K = g.K, nt = K / BK;
    unsigned voffA[2], voffB[2];
#pragma unroll
    for (int i = 0; i < 2; ++i) { int R, C; stage_rc(tid * 16 + i * 8192, R, C); const int Rb = Epi::PERM ? ((R & ~31) + perm32(R & 31)) : R;
        voffA[i] = (unsigned)(R * K + C) * 2u; voffB[i] = (unsigned)(Rb * K + C) * 2u; }
    const size_t kstep = (size_t)(BK * 2);
    const size_t hstep = (size_t)HALF * K * 2;
    const size_t tstep = 2 * hstep;
    const unsigned ldsw = (unsigned)wid * 1024u;
    const int aoff = lds_byte(wr * 64 + fr, fq * 8), boff = lds_byte(wc * 32 + fr, fq * 8);
#define PG8_SA(b, h) (((b) * 2 + (h)) * HTB)
#define PG8_SB(b, h) ((4 + (b) * 2 + (h)) * HTB)
#define PG8_STAGE(bufoff, gbase, voff) do { _Pragma("unroll") for (int _i = 0; _i < 2; ++_i) \
        __builtin_amdgcn_global_load_lds((const unsigned*)((const char*)(gbase) + (voff)[_i]), (PG8_LAS unsigned*)(lds + (bufoff) + ldsw + _i * 8192), 16, 0, 0); } while (0)
#define PG8_LDA(dst, b, h) do { _Pragma("unroll") for (int m = 0; m < 4; ++m) _Pragma("unroll") for (int k = 0; k < 2; ++k) dst[m][k] = *(const PG8_LAS bf16x8*)(lds + PG8_SA(b, h) + aoff + m * 2048 + k * 1024); } while (0)
#define PG8_LDB(dst, b, h) do { _Pragma("unroll") for (int n = 0; n < 2; ++n) _Pragma("unroll") for (int k = 0; k < 2; ++k) dst[n][k] = *(const PG8_LAS bf16x8*)(lds + PG8_SB(b, h) + boff + n * 2048 + k * 1024); } while (0)
#define PG8_MMA(ai, bj, At, Bt) do { __builtin_amdgcn_s_setprio(1); _Pragma("unroll") for (int m = 0; m < 4; ++m) _Pragma("unroll") for (int n = 0; n < 2; ++n) _Pragma("unroll") for (int k = 0; k < 2; ++k) \
        acc[ai][bj][m][n] = __builtin_amdgcn_mfma_f32_16x16x32_bf16(Bt[n][k], At[m][k], acc[ai][bj][m][n], 0, 0, 0); __builtin_amdgcn_s_setprio(0); } while (0)
#define PG8_WAIT_V(n) asm volatile("s_waitcnt vmcnt(" #n ")" ::: "memory")
#define PG8_WAIT_L(n) asm volatile("s_waitcnt lgkmcnt(" #n ")" ::: "memory")
#define PG8_BAR __builtin_amdgcn_s_barrier()
#define PG8_SCHED __builtin_amdgcn_sched_barrier(0)
    Unit cur, nxt; int ui = 0;
    if (!S.next(0, cur)) return;
    f32x4 acc[2][2][4][2];
#pragma unroll
    for (int a = 0; a < 2; ++a)
#pragma unroll
        for (int b = 0; b < 2; ++b)
#pragma unroll
            for (int m = 0; m < 4; ++m)
#pragma unroll
                for (int n = 0; n < 2; ++n) acc[a][b][m][n] = (f32x4){0.f, 0.f, 0.f, 0.f};
    bf16x8 At[4][2], B0[2][2], B1[2][2];
    const char* cA = (const char*)g.A + (size_t)cur.pm * tstep; const char* cB = (const char*)g.Bt + (size_t)cur.pn * tstep;
    S.a_ready(cur);
    if constexpr (SP2) {
        PG8_STAGE(PG8_SB(0, 0), cB, voffB); PG8_STAGE(PG8_SB(0, 1), cB + hstep, voffB); PG8_STAGE(PG8_SA(0, 0), cA, voffA); PG8_STAGE(PG8_SA(0, 1), cA + hstep, voffA);
        if (wr == 1) PG8_BAR;
        PG8_WAIT_V(2); PG8_BAR;
        PG8_STAGE(PG8_SB(1, 0), cB + kstep, voffB); PG8_STAGE(PG8_SA(1, 0), cA + kstep, voffA); PG8_STAGE(PG8_SB(1, 1), cB + hstep + kstep, voffB);
        PG8_WAIT_V(6); PG8_BAR;
    } else {
        PG8_STAGE(PG8_SB(0, 0), cB, voffB); PG8_STAGE(PG8_SA(0, 0), cA, voffA); PG8_STAGE(PG8_SB(0, 1), cB + hstep, voffB); PG8_STAGE(PG8_SA(0, 1), cA + hstep, voffA);
        if (wr == 1) PG8_BAR;
        PG8_WAIT_V(4); PG8_BAR;
        PG8_STAGE(PG8_SB(1, 0), cB + kstep, voffB); PG8_STAGE(PG8_SA(1, 0), cA + kstep, voffA); PG8_STAGE(PG8_SB(1, 1), cB + hstep + kstep, voffB);
        PG8_WAIT_V(6); PG8_BAR;
    }
    for (;;) {
        const bool has_next = S.next(ui + 1, nxt);
        const char* nA = has_next ? (const char*)g.A + (size_t)nxt.pm * tstep : cA; const char* nB = has_next ? (const char*)g.Bt + (size_t)nxt.pn * tstep : cB;
        for (int t = 0; t < nt; t += 2) {
            const bool last = (t == nt - 2);
            const char* a1 = cA + (size_t)(t + 1) * kstep;
            const char* a2 = last ? nA : cA + (size_t)(t + 2) * kstep; const char* b2 = last ? nB : cB + (size_t)(t + 2) * kstep;
            const char* a3 = a2 + kstep; const char* b3 = b2 + kstep;
            if (last && has_next) S.a_ready(nxt);
            if constexpr (SP2) {
            PG8_LDB(B0, 0, 0); PG8_LDB(B1, 0, 1); PG8_SCHED; PG8_LDA(At, 0, 0); PG8_STAGE(PG8_SA(1, 1), a1 + hstep, voffA);
            PG8_WAIT_V(8); PG8_WAIT_L(0); PG8_BAR; PG8_MMA(0, 0, At, B0); PG8_MMA(0, 1, At, B1); PG8_BAR; PG8_SCHED;
            PG8_LDA(At, 0, 1); PG8_STAGE(PG8_SB(0, 0), b2, voffB); PG8_STAGE(PG8_SB(0, 1), b2 + hstep, voffB); PG8_STAGE(PG8_SA(0, 0), a2, voffA);
            PG8_WAIT_V(8); PG8_WAIT_L(0); PG8_BAR; PG8_MMA(1, 0, At, B0); PG8_MMA(1, 1, At, B1); PG8_BAR; PG8_SCHED;
            PG8_LDB(B0, 1, 0); PG8_LDB(B1, 1, 1); PG8_SCHED; PG8_LDA(At, 1, 0); PG8_STAGE(PG8_SA(0, 1), a2 + hstep, voffA);
            PG8_WAIT_V(8); PG8_WAIT_L(0); PG8_BAR; PG8_MMA(0, 0, At, B0); PG8_MMA(0, 1, At, B1); PG8_BAR; PG8_SCHED;
            PG8_LDA(At, 1, 1); PG8_STAGE(PG8_SB(1, 0), b3, voffB); PG8_STAGE(PG8_SB(1, 1), b3 + hstep, voffB); PG8_STAGE(PG8_SA(1, 0), a3, voffA);
            PG8_WAIT_V(8); PG8_WAIT_L(0); PG8_BAR; PG8_MMA(1, 0, At, B0); PG8_MMA(1, 1, At, B1); PG8_BAR; PG8_SCHED;
            } else {
            PG8_LDB(B0, 0, 0); PG8_SCHED; PG8_LDA(At, 0, 0); PG8_STAGE(PG8_SA(1, 1), a1 + hstep, voffA);
            PG8_WAIT_L(8); PG8_BAR; PG8_WAIT_L(0); PG8_MMA(0, 0, At, B0); PG8_BAR; PG8_SCHED;
            PG8_LDB(B1, 0, 1); PG8_STAGE(PG8_SB(0, 0), b2, voffB);
            PG8_BAR; PG8_WAIT_L(0); PG8_MMA(0, 1, At, B1); PG8_BAR;
            PG8_LDA(At, 0, 1); PG8_STAGE(PG8_SA(0, 0), a2, voffA);
            PG8_BAR; PG8_WAIT_L(0); PG8_MMA(1, 0, At, B0); PG8_BAR; PG8_SCHED;
            PG8_STAGE(PG8_SB(0, 1), b2 + hstep, voffB);
            PG8_WAIT_V(6); PG8_BAR; PG8_MMA(1, 1, At, B1); PG8_BAR;
            PG8_LDB(B0, 1, 0); PG8_SCHED; PG8_LDA(At, 1, 0); PG8_STAGE(PG8_SA(0, 1), a2 + hstep, voffA);
            PG8_WAIT_L(8); PG8_BAR; PG8_WAIT_L(0); PG8_MMA(0, 0, At, B0); PG8_BAR; PG8_SCHED;
            PG8_LDB(B1, 1, 1); PG8_STAGE(PG8_SB(1, 0), b3, voffB);
            PG8_BAR; PG8_WAIT_L(0); PG8_MMA(0, 1, At, B1); PG8_BAR;
            PG8_LDA(At, 1, 1); PG8_STAGE(PG8_SA(1, 0), a3, voffA);
            PG8_BAR; PG8_WAIT_L(0); PG8_MMA(1, 0, At, B0); PG8_BAR; PG8_SCHED;
            PG8_STAGE(PG8_SB(1, 1), b3 + hstep, voffB);
            PG8_WAIT_V(6); PG8_BAR; PG8_MMA(1, 1, At, B1); PG8_BAR;
            }
        }
        if constexpr (ALIGN_EPI) { if (wr == 0) PG8_BAR; }
        if constexpr (!Epi::AFTER_DRAIN) { E(acc, cur, wr, wc, fr, fq); S.done(cur); }
        if (!has_next) break;
#pragma unroll
        for (int a = 0; a < 2; ++a)
#pragma unroll
            for (int b = 0; b < 2; ++b)
#pragma unroll
                for (int m = 0; m < 4; ++m)
#pragma unroll
                    for (int n = 0; n < 2; ++n) acc[a][b][m][n] = (f32x4){0.f, 0.f, 0.f, 0.f};
        cur = nxt; cA = nA; cB = nB; ++ui;
        if constexpr (ALIGN_EPI) { if (wr == 1) PG8_BAR; }
    }
    PG8_WAIT_V(0);
    if constexpr (!ALIGN_EPI) { if (wr == 0) PG8_BAR; }
    PG8_BAR;
    if constexpr (Epi::AFTER_DRAIN) { E.fused(acc, cur, wr, wc, fr, fq, lds, wid, lane); S.done(cur); }
#undef PG8_SA
#undef PG8_SB
#undef PG8_STAGE
#undef PG8_LDA
#undef PG8_LDB
#undef PG8_MMA
#undef PG8_WAIT_V
#undef PG8_WAIT_L
#undef PG8_BAR
#undef PG8_SCHED
}
}
constexpr int NWAVES = 8;
constexpr int NTOK = 16384, SEQ = 2048, DM = 2048, PW = 4992, PWP = 5120, DFF = 5632, NEXP = 8, MAXTILES = 136;
constexpr float LN_EPS = 1e-5f;
constexpr float LOG2E = 1.4426950408889634f;
constexpr int C_AQ = 0, C_AK = 768, C_AV = 1536, C_BQ = 2304, C_BK = 3072, C_BV = 3264, C_CQ = 3456, C_CK = 3712, C_CV = 3968, C_CG = 4480;
constexpr size_t MiB = 1u << 20;
constexpr size_t WS_CTL = 0, CTL_ZERO_BYTES = 1 * MiB;
constexpr size_t WS_TAB = 1 * MiB;
constexpr size_t WS_ROUTE = 2 * MiB;
constexpr size_t WS_WIN = 4 * MiB, WS_WOUT = 44 * MiB, WS_WDGU = 60 * MiB, WS_WDDN = 104 * MiB, WS_WMGU = 126 * MiB, WS_WMDN = 478 * MiB;
constexpr size_t WS_XB = 654 * MiB, WS_XG = 718 * MiB, WS_U1 = 854 * MiB, WS_END = 1228 * MiB;
constexpr size_t WS_PROJ = WS_U1, WS_CAT = WS_U1 + 160 * MiB, WS_H = WS_U1, WS_Y = WS_XG;
static_assert(WS_WIN + 2ull * PWP * DM * 2 <= WS_WOUT && WS_WOUT + 2ull * DM * DM * 2 <= WS_WDGU && WS_WDGU + 2ull * DFF * DM * 2 <= WS_WDDN && WS_WDDN + (size_t)DM * DFF * 2 <= WS_WMGU, "ws map 1");
static_assert(WS_WMGU + 8ull * 2 * DFF * DM * 2 <= WS_WMDN && WS_WMDN + 8ull * DM * DFF * 2 <= WS_XB && WS_XB + (size_t)NTOK * DM * 2 <= WS_XG && WS_XG + (size_t)MAXTILES * 256 * DM * 2 <= WS_U1, "ws map 2");
static_assert(WS_U1 + (size_t)MAXTILES * 256 * DFF * 2 <= WS_END && WS_PROJ + (size_t)NTOK * PWP * 2 <= WS_CAT && WS_CAT + (size_t)NTOK * DM * 2 <= WS_END, "ws map 3");
constexpr int CW_TMO = 0, CW_CODE = 1, CW_CNT = 1024  , CW_WQ = 2048  , CW_BAR = 4096  ;
constexpr int RING_OFF = 0, RING_BYTES = 131072;
constexpr int LDSCTL_OFF = RING_BYTES, MISC_OFF = LDSCTL_OFF + 320;
constexpr int LUT_OFF = LDSCTL_OFF + 1024;
constexpr int LUT_STRIDE = 132;
constexpr int LDS_BYTES = 147456;
static_assert(LUT_OFF + 18 * LUT_STRIDE * 4 <= LDS_BYTES, "LDS map");

#define GAS __attribute__((address_space(1)))
#define LAS __attribute__((address_space(3)))
typedef unsigned short bf16;
typedef unsigned v4u __attribute__((ext_vector_type(4)));
typedef unsigned v2u __attribute__((ext_vector_type(2)));
typedef float f32x4 __attribute__((ext_vector_type(4)));
typedef short bf16x8 __attribute__((ext_vector_type(8)));
typedef GAS unsigned gu32;
#define RLX_AGENT __ATOMIC_RELAXED, __HIP_MEMORY_SCOPE_AGENT
#define LDS_WAIT() asm volatile("s_waitcnt lgkmcnt(0)" ::: "memory")
#define VM_WAIT() asm volatile("s_waitcnt vmcnt(0)" ::: "memory")
__device__ __forceinline__ unsigned f2bf(float f) { unsigned u = __builtin_bit_cast(unsigned, f); return (u + 0x7fffu + ((u >> 16) & 1u)) >> 16; }
__device__ __forceinline__ unsigned pk2(float lo, float hi) { return f2bf(lo) | (f2bf(hi) << 16); }
__device__ __forceinline__ float bflo(unsigned w) { return __builtin_bit_cast(float, w << 16); }
__device__ __forceinline__ float bfhi(unsigned w) { return __builtin_bit_cast(float, w & 0xffff0000u); }
__device__ __forceinline__ float bf2f(bf16 h) { return __builtin_bit_cast(float, (unsigned)h << 16); }
__device__ const unsigned char BUCKET[129] = {0,1,2,3,4,5,6,7,8,9,10,11,12,13,14,15,16,16,16,17,17,18,18,18,19,19,19,20,20,20,20,21,21,21,21,22,22,22,22,22,23,23,23,23,23,23,24,24,24,24,24,24,25,25,25,25,25,25,25,
    26,26,26,26,26,26,26,26,27,27,27,27,27,27,27,27,27,27,28,28,28,28,28,28,28,28,28,28,29,29,29,29,29,29,29,29,29,29,29,29,30,30,30,30,30,30,30,30,30,30,30,30,30,30,31,31,31,31,31,31,31,31,31,31,31,31,31,31,31,31};
#define XB_TMO      128
#define XB_XCNT(j)  (256  + 64 * (j))
#define XB_XSUB(j)  (1280 + 64 * (j))
#define XB_XGEN(j)  (2304 + 64 * (j))
#define XB_TOP      3328
#define XB_TOPGEN   3392
#define XCD_BAR_WORDS 3456
#define XB_SPIN_CAP (1u << 18)

__device__ __forceinline__ unsigned xb_ld(unsigned* p)              { return __hip_atomic_load(p, __ATOMIC_RELAXED, __HIP_MEMORY_SCOPE_AGENT); }
__device__ __forceinline__ unsigned xb_add(unsigned* p, unsigned v) { return __hip_atomic_fetch_add(p, v, __ATOMIC_RELAXED, __HIP_MEMORY_SCOPE_AGENT); }
__device__ __forceinline__ unsigned xb_xcc_id() { return (unsigned)__builtin_amdgcn_s_getreg((3 << 11) | 20) & 0xFu; }
#define XB_SPIN(cond, bar) do { unsigned _sp = 0; while (cond) { __builtin_amdgcn_s_sleep(1); \
    if ((++_sp & 255u) == 0u) { if (xb_ld(&(bar)[XB_TMO])) break; if (_sp > XB_SPIN_CAP) { atomicAdd(&(bar)[XB_TMO], 1u); break; } } } } while (0)

struct XcdBarrier {
    unsigned* bar; unsigned x;
    volatile LAS unsigned* st;
};

__device__ __forceinline__ XcdBarrier xcd_barrier_post(unsigned* bar, volatile LAS unsigned* st) {
    XcdBarrier b; b.bar = bar; b.x = xb_xcc_id(); b.st = st;
    if (threadIdx.x == 0) (void)xb_add(&bar[XB_XCNT(b.x)], 1u);
    return b;
}
__device__ __forceinline__ void xcd_barrier_complete(unsigned* bar, unsigned x, unsigned& nloc, unsigned& nx) {
    const unsigned G = gridDim.x * gridDim.y * gridDim.z;
    unsigned sum, cnt, mine, sp = 0u;
    for (;;) {
        sum = 0u; cnt = 0u; mine = 0u;
#pragma unroll
        for (unsigned j = 0; j < 16; ++j) { const unsigned c = xb_ld(&bar[XB_XCNT(j)]); sum += c; cnt += (c > 0u) ? 1u : 0u; mine = (j == x) ? c : mine; }
        if (sum == G) break;
        __builtin_amdgcn_s_sleep(1);
        if ((++sp & 255u) == 0u) { if (xb_ld(&bar[XB_TMO])) break; if (sp > XB_SPIN_CAP) { atomicAdd(&bar[XB_TMO], 1u); break; } }
    }
    nloc = mine > 0u ? mine : 1u; nx = cnt > 0u ? cnt : 1u;
}

__device__ __forceinline__ void xcd_barrier(const XcdBarrier& b) {
    asm volatile("s_waitcnt vmcnt(0)" ::: "memory");
    __syncthreads();
    if (threadIdx.x == 0) {
        unsigned* bar = b.bar;
        __builtin_amdgcn_s_waitcnt(0);
        unsigned nloc = b.st[0], nx = b.st[1];
        if (nloc == 0u) { xcd_barrier_complete(bar, b.x, nloc, nx); b.st[0] = nloc; b.st[1] = nx; }
        const unsigned old = xb_add(&bar[XB_XSUB(b.x)], 1u);
        const unsigned gen = old / nloc;
        if (old + 1u == (gen + 1u) * nloc) {
            __builtin_amdgcn_fence(__ATOMIC_RELEASE, "agent");
            asm volatile("s_waitcnt vmcnt(0)" ::: "memory");
            const unsigned og = xb_add(&bar[XB_TOP], 1u);
            const unsigned tg = og / nx;
            if (og + 1u == (tg + 1u) * nx) xb_add(&bar[XB_TOPGEN], 1u);
            else XB_SPIN(xb_ld(&bar[XB_TOPGEN]) == tg, bar);
            __builtin_amdgcn_fence(__ATOMIC_ACQUIRE, "agent");
            xb_add(&bar[XB_XGEN(b.x)], 1u);
            asm volatile("s_waitcnt vmcnt(0)" ::: "memory");
        } else {
            XB_SPIN(xb_ld(&bar[XB_XGEN(b.x)]) == gen, bar);
            __builtin_amdgcn_fence(__ATOMIC_ACQUIRE, "agent");
            asm volatile("s_waitcnt vmcnt(0)" ::: "memory");
        }
    }
    __syncthreads();
}
struct Args { const float* in[18]; float* out; unsigned char* ws; int ph_lo, ph_hi, li, pad; float invf[32]; };
static_assert(sizeof(Args) == 20 * 8 + 16 + 128, "Args has no padding bytes");
struct Frame {
    LAS unsigned char* lds;
    gu32* ctl;
    int tid, lane, wave, vcu, G;
};
__device__ __forceinline__ float wave_sum(float v) {
#pragma unroll
    for (int o = 1; o < 64; o <<= 1) v += __shfl_xor(v, o);
    return v;
}
__device__ __forceinline__ float wave_max(float v) {
#pragma unroll
    for (int o = 1; o < 64; o <<= 1) v = fmaxf(v, __shfl_xor(v, o));
    return v;
}
__device__ __forceinline__ void p0_transpose_item(const float* W, int K, int N, bf16* WT, int k0, int n0, int drow0, LAS float* scr, int lane) {
#pragma unroll 8
    for (int i = 0; i < 32; ++i) { const int kk = 2 * i + (lane >> 5); scr[kk * 33 + (lane & 31)] = W[(size_t)(k0 + kk) * N + n0 + (lane & 31)]; }
    LDS_WAIT(); asm volatile("" ::: "memory");
    const int c = lane & 7;
#pragma unroll
    for (int j = 0; j < 4; ++j) { const int n = (lane >> 3) + 8 * j; const LAS float* s = scr + (8 * c) * 33 + n;
        v4u o; o.x = pk2(s[0 * 33], s[1 * 33]); o.y = pk2(s[2 * 33], s[3 * 33]); o.z = pk2(s[4 * 33], s[5 * 33]); o.w = pk2(s[6 * 33], s[7 * 33]);
        *(GAS v4u*)(WT + (size_t)(drow0 + n) * K + k0 + 8 * c) = o; }
    LDS_WAIT(); asm volatile("" ::: "memory");
}
template <int MODE> __device__ __forceinline__ void p0_matrix_item(const float* W, int K, int N, bf16* WT, int item, LAS float* scr, int lane) {
    const int nblk = N / 32, kb = item / nblk, nb = item % nblk, n0 = 32 * nb;
    const int drow0 = (MODE == 0) ? n0 : ((n0 >> 7) * 256 + (n0 & 127) + (MODE == 2 ? 128 : 0));
    p0_transpose_item(W, K, N, WT, 64 * kb, n0, drow0, scr, lane);
}
__device__ __forceinline__ void p0_prologue(Frame& F, const Args& a) {
    LAS float* scr = (LAS float*)(F.lds + RING_OFF + F.wave * 16384);
    const int gw = F.vcu * NWAVES + F.wave, NGW = F.G * NWAVES;
    unsigned char* ws = a.ws;
    constexpr int I_IN = (DM / 64) * (PW / 32), I_OUT = (DM / 64) * (DM / 32), I_GU = (DM / 64) * (DFF / 32), I_DN = (DFF / 64) * (DM / 32);
    constexpr int NITEMS = 2 * I_IN + 2 * I_OUT + 2 * I_GU + I_DN + 8 * (2 * I_GU + I_DN);
    for (int it = gw; it < NITEMS; it += NGW) {
        int r = it;
        if (r < 2 * I_IN) { const int l = r / I_IN; p0_matrix_item<0>(a.in[1] + (size_t)l * DM * PW, DM, PW, (bf16*)(ws + WS_WIN) + (size_t)l * PWP * DM, r % I_IN, scr, F.lane); continue; } r -= 2 * I_IN;
        if (r < 2 * I_OUT) { const int l = r / I_OUT; p0_matrix_item<0>(a.in[6] + (size_t)l * DM * DM, DM, DM, (bf16*)(ws + WS_WOUT) + (size_t)l * DM * DM, r % I_OUT, scr, F.lane); continue; } r -= 2 * I_OUT;
        if (r < I_GU) { p0_matrix_item<1>(a.in[11], DM, DFF, (bf16*)(ws + WS_WDGU), r, scr, F.lane); continue; } r -= I_GU;
        if (r < I_GU) { p0_matrix_item<2>(a.in[12], DM, DFF, (bf16*)(ws + WS_WDGU), r, scr, F.lane); continue; } r -= I_GU;
        if (r < I_DN) { p0_matrix_item<0>(a.in[13], DFF, DM, (bf16*)(ws + WS_WDDN), r, scr, F.lane); continue; } r -= I_DN;
        if (r < 8 * I_GU) { const int e = r / I_GU; p0_matrix_item<1>(a.in[15] + (size_t)e * DM * DFF, DM, DFF, (bf16*)(ws + WS_WMGU) + (size_t)e * 2 * DFF * DM, r % I_GU, scr, F.lane); continue; } r -= 8 * I_GU;
        if (r < 8 * I_GU) { const int e = r / I_GU; p0_matrix_item<2>(a.in[16] + (size_t)e * DM * DFF, DM, DFF, (bf16*)(ws + WS_WMGU) + (size_t)e * 2 * DFF * DM, r % I_GU, scr, F.lane); continue; } r -= 8 * I_GU;
        { const int e = r / I_DN; p0_matrix_item<0>(a.in[17] + (size_t)e * DFF * DM, DFF, DM, (bf16*)(ws + WS_WMDN) + (size_t)e * DM * DFF, r % I_DN, scr, F.lane); }
    }
    { const int gt = gw * 64 + F.lane, NGT = NGW * 64; const GAS f32x4* x4 = (const GAS f32x4*)a.in[0]; GAS v4u* o4 = (GAS v4u*)(ws + WS_XB);
      for (int i = gt; i < NTOK * DM / 8; i += NGT) { const f32x4 p = x4[2 * i], q = x4[2 * i + 1]; v4u o; o.x = pk2(p[0], p[1]); o.y = pk2(p[2], p[3]); o.z = pk2(q[0], q[1]); o.w = pk2(q[2], q[3]); o4[i] = o; } }
    { const int gt = gw * 64 + F.lane; if (gt < SEQ * 32) { const int pos = gt >> 5, i = gt & 31; const float ang = (float)pos * a.invf[i];
        const double t = (double)ang * 0.15915494309189535; const float fr = (float)(t - __builtin_rint(t));
        ((float*)(ws + WS_TAB))[gt] = __builtin_amdgcn_sinf(fr); ((float*)(ws + WS_TAB + 256 * 1024))[gt] = __builtin_amdgcn_cosf(fr); } }
}
__device__ __forceinline__ void build_lut(Frame& F, const float* rel_bias) {
    LAS float* lut = (LAS float*)(F.lds + LUT_OFF);
    for (int i = F.tid; i < 18 * 129; i += NWAVES * 64) { const int hh = i / 129, d = i % 129; lut[hh * LUT_STRIDE + d] = (rel_bias[BUCKET[d] * 18 + hh] - (hh < 6 ? rel_bias[31 * 18 + hh] : 0.f)) * LOG2E; }
}
__device__ __forceinline__ void ln_stats(f32x4 (&v)[8], float& mean, float& rstd) {
    float s = 0.f;
#pragma unroll
    for (int j = 0; j < 8; ++j) s += (v[j][0] + v[j][1]) + (v[j][2] + v[j][3]);
    mean = wave_sum(s) * (1.f / DM); float s2 = 0.f;
#pragma unroll
    for (int j = 0; j < 8; ++j) { v[j] = v[j] - mean; s2 += (v[j][0] * v[j][0] + v[j][1] * v[j][1]) + (v[j][2] * v[j][2] + v[j][3] * v[j][3]); }
    rstd = 1.f / sqrtf(wave_sum(s2) * (1.f / DM) + LN_EPS);
}
__device__ __forceinline__ int expert_offsets(Frame& F, int& ntiles) {
    const unsigned c = (F.lane < 8) ? __hip_atomic_load(F.ctl + CW_CNT + 64 * F.lane, RLX_AGENT) : 0u;
    const int t = (int)((c + 255u) >> 8);
    int inc = t;
#pragma unroll
    for (int o = 1; o < 8; o <<= 1) { const int u = __shfl_up(inc, o); if (F.lane >= o) inc += u; }
    ntiles = __shfl(inc, 7);
    return (inc - t) * 256;
}
template <int MODE> __device__ __forceinline__ void ln_phase(Frame& F, const Args& a, float* T, const float* gam, const float* bet, const float* w_router) {
    unsigned char* ws = a.ws;
    bf16* XB = (bf16*)(ws + WS_XB);
    const int lane = F.lane;
    LAS float* wrT = (LAS float*)(F.lds + RING_OFF);
    LAS int* cwL = (LAS int*)(F.lds + RING_OFF + 65536);
    LAS int* baseL = (LAS int*)(F.lds + RING_OFF + 65536 + 256);
    if (MODE == 1) {
        for (int i = F.tid; i < DM * 8; i += NWAVES * 64) wrT[(i & 7) * DM + (i >> 3)] = w_router[i];
        __syncthreads();
    }
    f32x4 g4[8], b4[8];
#pragma unroll
    for (int j = 0; j < 8; ++j) { g4[j] = *(const f32x4*)(gam + 4 * lane + 256 * j); b4[j] = *(const f32x4*)(bet + 4 * lane + 256 * j); }
    int offv = 0, ntl = 0;
    if (MODE == 2) offv = expert_offsets(F, ntl);
    const int rb = (F.vcu * NWAVES + F.wave) * 8;
    unsigned long long cntp = 0ull; int me1 = 0, me2 = 0, mr1 = 0, mr2 = 0; float mg1 = 0.f, mg2 = 0.f;
    for (int r = 0; r < 8; ++r) {
        const int row = rb + r;
        float* trow = T + (size_t)row * DM;
        f32x4 v[8];
#pragma unroll
        for (int j = 0; j < 8; ++j) v[j] = *(const f32x4*)(trow + 4 * lane + 256 * j);
        if (MODE == 2) {
            const int* rt = (const int*)(ws + WS_ROUTE) + row * 8;
            const int e1 = rt[0], p1 = rt[1], e2 = rt[2], p2 = rt[3]; const float g1 = __builtin_bit_cast(float, rt[4]), g2 = __builtin_bit_cast(float, rt[5]);
            const int r1 = __shfl(offv, e1) + p1, r2 = __shfl(offv, e2) + p2;
            const bf16* y1 = (const bf16*)(ws + WS_Y) + (size_t)r1 * DM; const bf16* y2 = (const bf16*)(ws + WS_Y) + (size_t)r2 * DM;
#pragma unroll
            for (int j = 0; j < 8; ++j) { const v2u a1 = *(const v2u*)(y1 + 4 * lane + 256 * j), a2 = *(const v2u*)(y2 + 4 * lane + 256 * j);
                v[j][0] = v[j][0] * pg8::ALPHA_F + g1 * bflo(a1.x) + g2 * bflo(a2.x); v[j][1] = v[j][1] * pg8::ALPHA_F + g1 * bfhi(a1.x) + g2 * bfhi(a2.x);
                v[j][2] = v[j][2] * pg8::ALPHA_F + g1 * bflo(a1.y) + g2 * bflo(a2.y); v[j][3] = v[j][3] * pg8::ALPHA_F + g1 * bfhi(a1.y) + g2 * bfhi(a2.y); }
        }
        float mean, rstd; ln_stats(v, mean, rstd);
#pragma unroll
        for (int j = 0; j < 8; ++j) v[j] = v[j] * rstd * g4[j] + b4[j];
        if (MODE == 2) {
            float* orow = a.out + (size_t)row * DM;
#pragma unroll
            for (int j = 0; j < 8; ++j) *(f32x4*)(orow + 4 * lane + 256 * j) = v[j];
        } else {
            bf16* xrow = XB + (size_t)row * DM;
#pragma unroll
            for (int j = 0; j < 8; ++j) { *(f32x4*)(trow + 4 * lane + 256 * j) = v[j]; v2u o; o.x = pk2(v[j][0], v[j][1]); o.y = pk2(v[j][2], v[j][3]); *(v2u*)(xrow + 4 * lane + 256 * j) = o; }
        }
        if (MODE == 1) {
            int i1 = -1, i2 = -1; float v1 = -3.0e38f, v2 = -3.0e38f;
#pragma unroll 1
            for (int e = 0; e < 8; ++e) { float s = 0.f;
#pragma unroll
                for (int j = 0; j < 8; ++j) { const f32x4 w = *(const LAS f32x4*)(wrT + e * DM + 4 * lane + 256 * j); s += (v[j][0] * w[0] + v[j][1] * w[1]) + (v[j][2] * w[2] + v[j][3] * w[3]); }
                const float t = wave_sum(s);
                if (t > v1) { v2 = v1; i2 = i1; v1 = t; i1 = e; } else if (t > v2) { v2 = t; i2 = e; } }
            if (i1 < 0) i1 = 0;
            if (i2 < 0) i2 = (i1 + 1) & 7;
            const float ex = __expf(v2 - v1), w1 = 1.f / (1.f + ex), w2 = ex * w1;
            const int k1 = (int)((cntp >> (8 * i1)) & 0xffull); cntp += 1ull << (8 * i1);
            const int k2 = (int)((cntp >> (8 * i2)) & 0xffull); cntp += 1ull << (8 * i2);
            if (lane == r) { me1 = i1; me2 = i2; mr1 = k1; mr2 = k2; mg1 = w1; mg2 = w2; }
        }
    }
    if (MODE == 1) {
        if (lane < 8) cwL[F.wave * 8 + lane] = (int)((cntp >> (8 * lane)) & 0xffull);
        __syncthreads();
        if (F.tid < 8) { int tot = 0;
#pragma unroll
            for (int w = 0; w < 8; ++w) tot += cwL[w * 8 + F.tid];
            baseL[F.tid] = (int)__hip_atomic_fetch_add(F.ctl + CW_CNT + 64 * F.tid, (unsigned)tot, RLX_AGENT); }
        __syncthreads();
        if (lane < 8) {
            int p1 = baseL[me1] + mr1, p2 = baseL[me2] + mr2;
            for (int w = 0; w < F.wave; ++w) { p1 += cwL[w * 8 + me1]; p2 += cwL[w * 8 + me2]; }
            int* rt = (int*)(ws + WS_ROUTE) + (rb + lane) * 8;
            rt[0] = me1; rt[1] = p1; rt[2] = me2; rt[3] = p2; rt[4] = __builtin_bit_cast(int, mg1); rt[5] = __builtin_bit_cast(int, mg2);
        }
    }
}
__device__ __forceinline__ void gather_phase(Frame& F, const Args& a) {
    unsigned char* ws = a.ws; int ntl; const int offv = expert_offsets(F, ntl);
    const int gw = F.vcu * NWAVES + F.wave, NGW = F.G * NWAVES;
    for (int p = gw; p < 2 * NTOK; p += NGW) {
        const int tok = p >> 1, k = p & 1; const int* rt = (const int*)(ws + WS_ROUTE) + tok * 8;
        const int e = rt[2 * k], pos = rt[2 * k + 1]; const int dst = __shfl(offv, e) + pos;
        const GAS v4u* s = (const GAS v4u*)(ws + WS_XB + (size_t)tok * DM * 2); GAS v4u* d = (GAS v4u*)(ws + WS_XG + (size_t)dst * DM * 2);
#pragma unroll
        for (int j = 0; j < 4; ++j) d[F.lane + 64 * j] = s[F.lane + 64 * j];
    }
}
__device__ __forceinline__ float dot8(const v4u q, const v4u k) {
    return (bflo(q.x) * bflo(k.x) + bfhi(q.x) * bfhi(k.x)) + (bflo(q.y) * bflo(k.y) + bfhi(q.y) * bfhi(k.y)) + (bflo(q.z) * bflo(k.z) + bfhi(q.z) * bfhi(k.z)) + (bflo(q.w) * bflo(k.w) + bfhi(q.w) * bfhi(k.w));
}
__device__ __forceinline__ float lambda_of(const float* lp, int lane, float lam_init) {
    const float s1 = wave_sum(lp[lane] * lp[64 + lane]), s2 = wave_sum(lp[128 + lane] * lp[192 + lane]);
    return __expf(s1) - __expf(s2) + lam_init;
}
__device__ __forceinline__ void naive_mixers(Frame& F, const Args& a, int layer) {
    unsigned char* ws = a.ws; const bf16* PROJ = (const bf16*)(ws + WS_PROJ); bf16* CAT = (bf16*)(ws + WS_CAT);
    const int lane = F.lane; const int gw = F.vcu * NWAVES + F.wave, NGW = F.G * NWAVES;
    LAS float* sc = (LAS float*)(F.lds + RING_OFF + F.wave * 16384);
    const LAS float* lut = (const LAS float*)(F.lds + LUT_OFF);
    const float lam_init = 0.8f - 0.6f * __expf(-0.3f * (float)layer);
    const float lam = lambda_of(a.in[3] + layer * 256, lane, lam_init);
    const float* subg = a.in[4] + layer * 128; const float* sinks = a.in[5] + layer * 12;
    for (int task = gw; task < NTOK * 6; task += NGW) {
        const int tok = task / 6, h = task - tok * 6, q = tok & (SEQ - 1), base = tok - q;
        v4u qv[16]; { const v4u* qp = (const v4u*)(PROJ + (size_t)tok * PWP + C_AQ + h * 128);
#pragma unroll
            for (int c = 0; c < 16; ++c) qv[c] = qp[c]; }
        float m1 = -3.0e38f, m2 = -3.0e38f;
        for (int j = lane; j <= q; j += 64) {
            const v4u* kp = (const v4u*)(PROJ + (size_t)(base + j) * PWP + C_AK + h * 128); float d1 = 0.f, d2 = 0.f;
#pragma unroll
            for (int c = 0; c < 8; ++c) { d1 += dot8(qv[c], kp[c]); d2 += dot8(qv[8 + c], kp[8 + c]); }
            const int dd = q - j; const float bias = lut[h * LUT_STRIDE + (dd < 128 ? dd : 128)];
            d1 += bias; d2 += bias; sc[j] = d1; sc[2048 + j] = d2; m1 = fmaxf(m1, d1); m2 = fmaxf(m2, d2);
        }
        m1 = wave_max(m1); m2 = wave_max(m2); float l1 = 0.f, l2 = 0.f;
        for (int j = lane; j <= q; j += 64) { const float p1 = __builtin_amdgcn_exp2f(sc[j] - m1), p2 = __builtin_amdgcn_exp2f(sc[2048 + j] - m2); sc[j] = p1; sc[2048 + j] = p2; l1 += p1; l2 += p2; }
        l1 = wave_sum(l1); l2 = wave_sum(l2); const float c1 = 1.f / l1, c2 = lam / l2;
        float o0 = 0.f, o1 = 0.f;
        for (int j = 0; j <= q; ++j) { const float w = sc[j] * c1 - sc[2048 + j] * c2; const bf16* vr = PROJ + (size_t)(base + j) * PWP + C_AV + h * 128; o0 += w * bf2f(vr[lane]); o1 += w * bf2f(vr[64 + lane]); }
        const float ss = wave_sum(o0 * o0 + o1 * o1), rr = (1.f / sqrtf(ss * (1.f / 128.f) + LN_EPS)) * (1.f - lam_init);
        bf16* orow = CAT + (size_t)tok * DM + h * 128; orow[lane] = (bf16)f2bf(o0 * rr * subg[lane]); orow[64 + lane] = (bf16)f2bf(o1 * rr * subg[64 + lane]);
    }
    for (int task = gw; task < NTOK * 12; task += NGW) {
        const int tok = task / 12, hq = task - tok * 12, kvh = hq >> 2, q = tok & (SEQ - 1), base = tok - q;
        v4u qv[8]; { const v4u* qp = (const v4u*)(PROJ + (size_t)tok * PWP + C_BQ + hq * 64);
#pragma unroll
            for (int c = 0; c < 8; ++c) qv[c] = qp[c]; }
        float s[2];
#pragma unroll
        for (int i = 0; i < 2; ++i) { const int dd = lane + 64 * i, j = q - dd; s[i] = -3.0e38f;
            if (j >= 0) { const v4u* kp = (const v4u*)(PROJ + (size_t)(base + j) * PWP + C_BK + kvh * 64); float d = 0.f;
#pragma unroll
                for (int c = 0; c < 8; ++c) d += dot8(qv[c], kp[c]);
                s[i] = d + lut[(6 + hq) * LUT_STRIDE + dd]; } }
        const float sink2 = sinks[hq] * LOG2E; const float m = fmaxf(wave_max(fmaxf(s[0], s[1])), sink2);
        const float p0 = (q - lane >= 0) ? __builtin_amdgcn_exp2f(s[0] - m) : 0.f, p1 = (q - lane - 64 >= 0) ? __builtin_amdgcn_exp2f(s[1] - m) : 0.f;
        const float l = wave_sum(p0 + p1) + __builtin_amdgcn_exp2f(sink2 - m);
        sc[lane] = p0; sc[64 + lane] = p1;
        float o = 0.f; const int nk = (q + 1 < 128) ? q + 1 : 128;
        for (int dd = 0; dd < nk; ++dd) o += sc[dd] * bf2f(PROJ[(size_t)(base + q - dd) * PWP + C_BV + kvh * 64 + lane]);
        CAT[(size_t)tok * DM + 768 + hq * 64 + lane] = (bf16)f2bf(o / l);
    }
    for (int task = gw; task < NTOK * 4; task += NGW) {
        const int tok = task >> 2, h = task & 3, q = tok & (SEQ - 1), base = tok - q;
        const float lg2 = log2f(1.f - exp2f(-5.f - (float)h));
        v4u qv[8]; { const v4u* qp = (const v4u*)(PROJ + (size_t)tok * PWP + C_CQ + h * 64);
#pragma unroll
            for (int c = 0; c < 8; ++c) qv[c] = qp[c]; }
        for (int j = lane; j <= q; j += 64) { const v4u* kp = (const v4u*)(PROJ + (size_t)(base + j) * PWP + C_CK + h * 64); float d = 0.f;
#pragma unroll
            for (int c = 0; c < 8; ++c) d += dot8(qv[c], kp[c]);
            sc[j] = d * __builtin_amdgcn_exp2f((float)(q - j) * lg2); }
        float o0 = 0.f, o1 = 0.f;
        for (int j = 0; j <= q; ++j) { const float w = sc[j]; const bf16* vr = PROJ + (size_t)(base + j) * PWP + C_CV + h * 128; o0 += w * bf2f(vr[lane]); o1 += w * bf2f(vr[64 + lane]); }
        const float mu = wave_sum(o0 + o1) * (1.f / 128.f); o0 -= mu; o1 -= mu;
        const float rs = 1.f / sqrtf(wave_sum(o0 * o0 + o1 * o1) * (1.f / 128.f) + LN_EPS);
        const bf16* gr = PROJ + (size_t)tok * PWP + C_CG + h * 128;
        bf16* orow = CAT + (size_t)tok * DM + 1536 + h * 128;
        orow[lane] = (bf16)f2bf(pg8::silu_f(bf2f(gr[lane])) * o0 * rs); orow[64 + lane] = (bf16)f2bf(pg8::silu_f(bf2f(gr[64 + lane])) * o1 * rs);
    }
}
typedef float f32x16 __attribute__((ext_vector_type(16)));
typedef short s16x4 __attribute__((ext_vector_type(4)));
typedef short v4i16_t __attribute__((ext_vector_type(4)));
typedef float f32x2_t __attribute__((ext_vector_type(2))); typedef __bf16 bf16x2_t __attribute__((ext_vector_type(2)));
__device__ __forceinline__ int crow(int r, int hi) { return (r & 3) + 8 * (r >> 2) + 4 * hi; }
__device__ __forceinline__ s16x4 vtr(const LAS unsigned char* p) { return __builtin_bit_cast(s16x4, __builtin_amdgcn_ds_read_tr16_b64_v4i16((LAS v4i16_t*)p)); }
__device__ __forceinline__ unsigned cvtpk_s(float lo, float hi) { f32x2_t v = {lo, hi}; bf16x2_t b = __builtin_convertvector(v, bf16x2_t); return __builtin_bit_cast(unsigned, b); }
__device__ __forceinline__ bf16x8 pack_p(const f32x16& p, int s2) {
    v4u w; w.x = cvtpk_s(p[8 * s2 + 0], p[8 * s2 + 1]); w.y = cvtpk_s(p[8 * s2 + 2], p[8 * s2 + 3]); w.z = cvtpk_s(p[8 * s2 + 4], p[8 * s2 + 5]); w.w = cvtpk_s(p[8 * s2 + 6], p[8 * s2 + 7]);
    return __builtin_bit_cast(bf16x8, w);
}
constexpr int MIX_WSF = 67584, MIX_QW = 69632;
constexpr float MIX_THR = 6.f;
template <int MODE> __device__ __forceinline__ void mix_unit(Frame& F, const Args& a, int layer, int b, int hh, int qb, float lam, float lam_init) {
    constexpr int KW = (MODE == 0) ? 128 : 64, VW = (MODE == 1) ? 64 : 128, NEB = VW / 32, NSUB = (MODE == 1) ? 2 : 1;
    constexpr int KSTR = KW * 2 + 16, KBYTES = 64 * KSTR, VBYTES = 64 * VW * 2, BUFB = KBYTES + VBYTES, KC = KW / 64, VC = VW / 64;
    static_assert(2 * BUFB <= MIX_WSF, "mixer LDS map");
    unsigned char* ws = a.ws; const bf16* PROJ = (const bf16*)(ws + WS_PROJ); bf16* CAT = (bf16*)(ws + WS_CAT);
    int tid = F.tid; asm volatile("" : "+v"(tid));
    const int lane = tid & 63, wave = __builtin_amdgcn_readfirstlane(tid >> 6), r32 = lane & 31, hi = lane >> 5;
    LAS unsigned char* L = F.lds + RING_OFF;
    LAS float* wsf = (LAS float*)(L + MIX_WSF) + wave * 64;
    const LAS float* lut = (const LAS float*)(F.lds + LUT_OFF);
    const int rowbase = b * SEQ;
    const int q0 = (MODE == 2) ? qb * 256 : qb * 128;
    const int rg = (MODE == 2) ? wave : (wave & 3), wsel = (MODE == 2) ? 0 : (wave >> 2);
    const int qw0 = q0 + 32 * rg;
    const int kcol = (MODE == 0) ? C_AK + hh * 128 : (MODE == 1) ? C_BK + hh * 64 : C_CK + hh * 64;
    const int vcol = (MODE == 0) ? C_AV + hh * 128 : (MODE == 1) ? C_BV + hh * 64 : C_CV + hh * 128;
    const int koff = (MODE == 0) ? wsel * 128 : 0;
    const int t_lo = (MODE == 1) ? (qb > 0 ? 2 * qb - 2 : 0) : 0, t_hi = (MODE == 2) ? 4 * qb + 4 : 2 * qb + 2;
    bf16x8 qf[NSUB][4];
#pragma unroll
    for (int s = 0; s < NSUB; ++s) {
        const int qcol = (MODE == 0) ? C_AQ + hh * 128 + wsel * 64 : (MODE == 1) ? C_BQ + (hh * 4 + wsel * 2 + s) * 64 : C_CQ + hh * 64;
        const bf16* qp = PROJ + (size_t)(rowbase + qw0 + r32) * PWP + qcol + hi * 8;
#pragma unroll
        for (int d0 = 0; d0 < 4; ++d0) qf[s][d0] = *(const bf16x8*)(qp + d0 * 16);
    }
    float m_run[NSUB], l_run[NSUB]; f32x16 o[NSUB][NEB];
#pragma unroll
    for (int s = 0; s < NSUB; ++s) {
        m_run[s] = (MODE == 1) ? a.in[5][layer * 12 + hh * 4 + wsel * 2 + s] * LOG2E : -1.0e30f; l_run[s] = (MODE == 1) ? 1.f : 0.f;
#pragma unroll
        for (int e = 0; e < NEB; ++e) o[s][e] = f32x16{};
    }
    const float lg2 = (MODE == 2) ? log2f(1.f - exp2f(-5.f - (float)hh)) : 0.f;
    v4u kreg[KC], vreg[VC];
    int kdst[KC], vdst[VC]; const bf16* ksrc[KC]; const bf16* vsrc[VC];
#pragma unroll
    for (int i = 0; i < KC; ++i) { const int c = tid + 512 * i, row = c / (KW / 8), ch = c % (KW / 8); kdst[i] = row * KSTR + ch * 16; ksrc[i] = PROJ + (size_t)(rowbase + row) * PWP + kcol + ch * 8; }
#pragma unroll
    for (int i = 0; i < VC; ++i) { const int c = tid + 512 * i, row = c / (VW / 8), ch = c % (VW / 8), e0 = ch * 8;
        vdst[i] = KBYTES + (e0 >> 5) * 4096 + (row >> 3) * 512 + (row & 7) * 64 + (e0 & 31) * 2; vsrc[i] = PROJ + (size_t)(rowbase + row) * PWP + vcol + e0; }
#define MIX_GLOAD(t) do { _Pragma("unroll") for (int i_ = 0; i_ < KC; ++i_) kreg[i_] = *(const v4u*)(ksrc[i_] + (size_t)(t) * 64 * PWP); \
                          _Pragma("unroll") for (int i_ = 0; i_ < VC; ++i_) vreg[i_] = *(const v4u*)(vsrc[i_] + (size_t)(t) * 64 * PWP); } while (0)
#define MIX_LSTORE(buf) do { _Pragma("unroll") for (int i_ = 0; i_ < KC; ++i_) *(LAS v4u*)(L + (buf) * BUFB + kdst[i_]) = kreg[i_]; \
                             _Pragma("unroll") for (int i_ = 0; i_ < VC; ++i_) *(LAS v4u*)(L + (buf) * BUFB + vdst[i_]) = vreg[i_]; } while (0)
    const int vlane = (4 * hi + ((lane & 15) >> 2)) * 64 + ((lane >> 4) & 1) * 32 + (lane & 3) * 8;
    MIX_GLOAD(t_lo); MIX_LSTORE(0);
    __syncthreads();
#pragma unroll 1
    for (int t = t_lo; t < t_hi; ++t) {
        const int cur = (t - t_lo) & 1;
        if (t + 1 < t_hi) MIX_GLOAD(t + 1);
        const LAS unsigned char* Kb = L + cur * BUFB; const LAS unsigned char* Vb = Kb + KBYTES;
        const int k0 = 64 * t;
        const bool active = (k0 <= qw0 + 31) && (MODE != 1 || k0 + 63 >= qw0 - 127);
        if (active) {
#pragma unroll
            for (int s = 0; s < NSUB; ++s) {
                f32x16 p0 = f32x16{}, p1 = f32x16{};
#pragma unroll
                for (int d0 = 0; d0 < 4; ++d0) {
                    const bf16x8 ka = *(const LAS bf16x8*)(Kb + r32 * KSTR + koff + (16 * d0 + 8 * hi) * 2);
                    const bf16x8 kb2 = *(const LAS bf16x8*)(Kb + (32 + r32) * KSTR + koff + (16 * d0 + 8 * hi) * 2);
                    p0 = __builtin_amdgcn_mfma_f32_32x32x16_bf16(ka, qf[s][d0], p0, 0, 0, 0);
                    p1 = __builtin_amdgcn_mfma_f32_32x32x16_bf16(kb2, qf[s][d0], p1, 0, 0, 0);
                }
                __builtin_amdgcn_sched_barrier(0);
                const int qi = qw0 + r32;
                if (MODE == 2) {
#pragma unroll
                    for (int r = 0; r < 16; ++r) { const int d0_ = qi - (k0 + crow(r, hi)), d1_ = d0_ - 32;
                        p0[r] = d0_ >= 0 ? p0[r] * __builtin_amdgcn_exp2f((float)d0_ * lg2) : 0.f; p1[r] = d1_ >= 0 ? p1[r] * __builtin_amdgcn_exp2f((float)d1_ * lg2) : 0.f; }
                } else {
                    const bool nearb = (MODE == 1) || (k0 + 63 + 128 > qw0);
                    if (nearb) {
                        const LAS float* lrow = lut + ((MODE == 0) ? hh : 6 + hh * 4 + wsel * 2 + s) * LUT_STRIDE;
#pragma unroll
                        for (int r = 0; r < 16; ++r) { const int d0_ = qi - (k0 + crow(r, hi)), d1_ = d0_ - 32;
                            const bool ok0 = (MODE == 0) ? (d0_ >= 0) : (d0_ >= 0 && d0_ < 128), ok1 = (MODE == 0) ? (d1_ >= 0) : (d1_ >= 0 && d1_ < 128);
                            const int i0_ = d0_ < 0 ? 0 : (d0_ > 128 ? 128 : d0_), i1_ = d1_ < 0 ? 0 : (d1_ > 128 ? 128 : d1_);
                            p0[r] = ok0 ? p0[r] + lrow[i0_] : -INFINITY; p1[r] = ok1 ? p1[r] + lrow[i1_] : -INFINITY; }
                    }
                    __builtin_amdgcn_sched_barrier(0);
                    float rm = fmaxf(p0[0], p1[0]);
#pragma unroll
                    for (int r = 1; r < 16; ++r) rm = fmaxf(rm, fmaxf(p0[r], p1[r]));
                    rm = fmaxf(rm, __shfl_xor(rm, 32));
                    if (__any(rm > m_run[s] + MIX_THR)) {
                        const float mn = fmaxf(m_run[s], rm), al = __builtin_amdgcn_exp2f(m_run[s] - mn);
                        m_run[s] = mn; l_run[s] *= al;
                        if (hi == 0) wsf[r32] = al;
                        LDS_WAIT();
#pragma unroll
                        for (int r = 0; r < 16; ++r) { const float f = wsf[crow(r, hi)];
#pragma unroll
                            for (int e = 0; e < NEB; ++e) o[s][e][r] *= f; }
                        LDS_WAIT();
                    }
                    float ls = 0.f; const float mm = m_run[s];
#pragma unroll
                    for (int r = 0; r < 16; ++r) { p0[r] = __builtin_amdgcn_exp2f(p0[r] - mm); p1[r] = __builtin_amdgcn_exp2f(p1[r] - mm); ls += p0[r] + p1[r]; }
                    l_run[s] += ls;
                }
                __builtin_amdgcn_sched_barrier(0);
#pragma unroll
                for (int kb = 0; kb < 2; ++kb)
#pragma unroll
                    for (int s2 = 0; s2 < 2; ++s2) {
                        const bf16x8 pa = pack_p(kb == 0 ? p0 : p1, s2);
#pragma unroll
                        for (int e = 0; e < NEB; ++e) {
                            const LAS unsigned char* vp = Vb + e * 4096 + (4 * kb + 2 * s2) * 512 + vlane;
                            const s16x4 lo = vtr(vp), hh2 = vtr(vp + 512);
                            const bf16x8 vb = (bf16x8){lo[0], lo[1], lo[2], lo[3], hh2[0], hh2[1], hh2[2], hh2[3]};
                            o[s][e] = __builtin_amdgcn_mfma_f32_32x32x16_bf16(pa, vb, o[s][e], 0, 0, 0);
                        }
                        __builtin_amdgcn_sched_barrier(0);
                    }
            }
        }
        if (t + 1 < t_hi) MIX_LSTORE(cur ^ 1);
        __syncthreads();
    }
#undef MIX_GLOAD
#undef MIX_LSTORE
    if (MODE == 1) {
#pragma unroll
        for (int s = 0; s < NSUB; ++s) {
            const float sink2 = a.in[5][layer * 12 + hh * 4 + wsel * 2 + s] * LOG2E;
            const float lt = l_run[s] + __shfl_xor(l_run[s], 32) - __builtin_amdgcn_exp2f(sink2 - m_run[s]);
            if (hi == 0) wsf[r32] = 1.f / lt;
            LDS_WAIT();
            bf16* orow = CAT + (size_t)(rowbase + qw0) * DM + 768 + (hh * 4 + wsel * 2 + s) * 64 + r32;
#pragma unroll
            for (int r = 0; r < 16; ++r) { const int qr = crow(r, hi); const float f = wsf[qr];
#pragma unroll
                for (int e = 0; e < NEB; ++e) orow[(size_t)qr * DM + 32 * e] = (bf16)f2bf(o[s][e][r] * f); }
            LDS_WAIT();
        }
    } else if (MODE == 2) {
        const bf16* grow = PROJ + (size_t)(rowbase + qw0) * PWP + C_CG + hh * 128 + r32;
        bf16* orow = CAT + (size_t)(rowbase + qw0) * DM + 1536 + hh * 128 + r32;
#pragma unroll
        for (int r = 0; r < 16; ++r) {
            float s1 = 0.f;
#pragma unroll
            for (int e = 0; e < NEB; ++e) s1 += o[0][e][r];
#pragma unroll
            for (int sh = 1; sh < 32; sh <<= 1) s1 += __shfl_xor(s1, sh);
            const float mu = s1 * (1.f / 128.f); float s2 = 0.f;
#pragma unroll
            for (int e = 0; e < NEB; ++e) { const float d = o[0][e][r] - mu; s2 += d * d; }
#pragma unroll
            for (int sh = 1; sh < 32; sh <<= 1) s2 += __shfl_xor(s2, sh);
            const float rs = 1.f / sqrtf(s2 * (1.f / 128.f) + LN_EPS); const int qr = crow(r, hi);
#pragma unroll
            for (int e = 0; e < NEB; ++e) orow[(size_t)qr * DM + 32 * e] = (bf16)f2bf(pg8::silu_f(bf2f(grow[(size_t)qr * PWP + 32 * e])) * (o[0][e][r] - mu) * rs);
        }
    } else {
        const float lt = l_run[0] + __shfl_xor(l_run[0], 32);
        if (hi == 0) wsf[r32] = 1.f / lt;
        LDS_WAIT();
        LAS float* xb = (LAS float*)L + rg * 4096;
        if (wsel == 1) {
#pragma unroll
            for (int r = 0; r < 16; ++r) { const float f = wsf[crow(r, hi)];
#pragma unroll
                for (int e = 0; e < NEB; ++e) xb[(e * 16 + r) * 64 + lane] = o[0][e][r] * f; }
        }
        __syncthreads();
        if (wsel == 0) {
            const float* subg = a.in[4] + layer * 128; const float post = 1.f - lam_init;
            bf16* orow = CAT + (size_t)(rowbase + qw0) * DM + hh * 128 + r32;
#pragma unroll
            for (int r = 0; r < 16; ++r) { const float f = wsf[crow(r, hi)]; float d[NEB]; float ss = 0.f;
#pragma unroll
                for (int e = 0; e < NEB; ++e) { d[e] = o[0][e][r] * f - lam * xb[(e * 16 + r) * 64 + lane]; ss += d[e] * d[e]; }
#pragma unroll
                for (int sh = 1; sh < 32; sh <<= 1) ss += __shfl_xor(ss, sh);
                const float rs = (1.f / sqrtf(ss * (1.f / 128.f) + LN_EPS)) * post; const int qr = crow(r, hi);
#pragma unroll
                for (int e = 0; e < NEB; ++e) orow[(size_t)qr * DM + 32 * e] = (bf16)f2bf(d[e] * rs * subg[32 * e + r32]); }
        }
    }
    __syncthreads();
}
__device__ __forceinline__ void mixer_phase(Frame& F, const Args& a, int layer) {
    const float lam_init = 0.8f - 0.6f * __expf(-0.3f * (float)layer);
    const float lam = lambda_of(a.in[3] + layer * 256, F.lane, lam_init);
    LAS int* qw = (LAS int*)(F.lds + RING_OFF + MIX_QW);
    for (;;) {
        if (F.tid == 0) *qw = (int)__hip_atomic_fetch_add(F.ctl + CW_WQ + 64 * layer, 1u, RLX_AGENT);
        __syncthreads();
        const int it = __builtin_amdgcn_readfirstlane(*qw);
        __syncthreads();
        if (it >= 1408) break;
        int mode, ub, uh, uq;
        if (it < 1024) {
            const int j = it >> 7, r = it & 127;
            if (r < 48) { mode = 0; ub = r / 6; uh = r % 6; uq = 15 - 2 * j; }
            else if (r < 80) { mode = 2; ub = (r - 48) >> 2; uh = (r - 48) & 3; uq = 7 - j; }
            else { mode = 0; ub = (r - 80) / 6; uh = (r - 80) % 6; uq = 14 - 2 * j; }
        } else { const int r = it - 1024; mode = 1; ub = r / 48; uh = (r % 48) / 16; uq = r & 15; }
        if (mode == 0) mix_unit<0>(F, a, layer, ub, uh, uq, lam, lam_init);
        else if (mode == 2) mix_unit<2>(F, a, layer, ub, uh, uq, lam, lam_init);
        else mix_unit<1>(F, a, layer, ub, uh, uq, lam, lam_init);
    }
}
#ifndef MIXER_NAIVE
#define MIXER_NAIVE 0
#endif
#define IN(k) (lo <= (k) && (k) < hi)
#define SEAM(k) do { if (IN(k) && IN((k) + 1)) xcd_barrier(bar); } while (0)
template <int l> __device__ __forceinline__ void run_layer(Frame& F, const Args& args, const XcdBarrier& bar, int lo, int hi) {
    unsigned char* ws = args.ws;
    bf16* XB = (bf16*)(ws + WS_XB); bf16* PROJ = (bf16*)(ws + WS_PROJ); bf16* CAT = (bf16*)(ws + WS_CAT); bf16* HB = (bf16*)(ws + WS_H);
    float* T = args.out;
        const int pb = 1 + 7 * l;
        if (IN(pb)) {
            pg8::Gemm g{XB, (const bf16*)(ws + WS_WIN) + (size_t)l * PWP * DM, NTOK, PWP, DM}; pg8::StaticOrder S; S.init(NTOK, PWP, F.G, (int)blockIdx.x);
            pg8::EpiProj E{PROJ, (const float*)(ws + WS_TAB), (const float*)(ws + WS_TAB + 256 * 1024)};
            pg8::gemm_phase<pg8::EpiProj, pg8::StaticOrder, true, true>(F.lds + RING_OFF, g, S, E);
        } SEAM(pb);
        if (IN(pb + 1)) {
#if MIXER_NAIVE
            naive_mixers(F, args, l);
#else
            mixer_phase(F, args, l);
#endif
        } SEAM(pb + 1);
        if (IN(pb + 2)) {
            pg8::Gemm g{CAT, (const bf16*)(ws + WS_WOUT) + (size_t)l * DM * DM, NTOK, DM, DM}; pg8::StaticOrder S; S.init(NTOK, DM, F.G, (int)blockIdx.x);
            pg8::EpiResid E{T, l == 0 ? args.in[0] : T};
            pg8::gemm_phase<pg8::EpiResid, pg8::StaticOrder, true, true>(F.lds + RING_OFF, g, S, E);
        } SEAM(pb + 2);
        if constexpr (l == 0) {
            if (IN(4)) { ln_phase<0>(F, args, T, args.in[7], args.in[8], nullptr); } SEAM(4);
            if (IN(5)) {
                pg8::Gemm g{XB, (const bf16*)(ws + WS_WDGU), NTOK, 2 * DFF, DM}; pg8::StaticOrder S; S.init(NTOK, 2 * DFF, F.G, (int)blockIdx.x);
                pg8::EpiSwiGLU E{HB, 44};
                pg8::gemm_phase<pg8::EpiSwiGLU, pg8::StaticOrder, true, true>(F.lds + RING_OFF, g, S, E);
            } SEAM(5);
            if (IN(6)) {
                pg8::Gemm g{HB, (const bf16*)(ws + WS_WDDN), NTOK, DM, DFF}; pg8::StaticOrder S; S.init(NTOK, DM, F.G, (int)blockIdx.x);
                pg8::EpiResid E{T, T};
                pg8::gemm_phase<pg8::EpiResid, pg8::StaticOrder, true, true>(F.lds + RING_OFF, g, S, E);
            } SEAM(6);
            if (IN(7)) { ln_phase<0>(F, args, T, args.in[9], args.in[10], nullptr); } SEAM(7);
        } else {
            if (IN(11)) { ln_phase<1>(F, args, T, args.in[7] + DM, args.in[8] + DM, args.in[14]); } SEAM(11);
            if (IN(12)) { gather_phase(F, args); } SEAM(12);
            if (IN(13) || IN(14)) {
                int ntl_v; const int offv = expert_offsets(F, ntl_v); const int ntl = __builtin_amdgcn_readfirstlane(ntl_v);
                pg8::GroupedOrder S; S.nM = ntl; S.G = F.G; S.c = (int)blockIdx.x;
#pragma unroll
                for (int e = 0; e < 8; ++e) S.cum[e] = (e < 7) ? __builtin_amdgcn_readfirstlane(__shfl(offv, e + 1) >> 8) : ntl;
                if (IN(13)) {
                    S.nN = 44; S.nwg = ntl * 44;
                    pg8::Gemm g{(const bf16*)(ws + WS_XG), (const bf16*)(ws + WS_WMGU), ntl * 256, 8 * 2 * DFF, DM};
                    pg8::EpiSwiGLU E{HB, 44};
                    pg8::gemm_phase<pg8::EpiSwiGLU, pg8::GroupedOrder, true, true>(F.lds + RING_OFF, g, S, E);
                } SEAM(13);
                if (IN(14)) {
                    S.nN = 8; S.nwg = ntl * 8;
                    pg8::Gemm g{HB, (const bf16*)(ws + WS_WMDN), ntl * 256, 8 * DM, DFF};
                    pg8::EpiY E{(bf16*)(ws + WS_Y), 8};
                    pg8::gemm_phase<pg8::EpiY, pg8::GroupedOrder, true, true>(F.lds + RING_OFF, g, S, E);
                } SEAM(14);
            }
            if (IN(15)) { ln_phase<2>(F, args, T, args.in[9] + DM, args.in[10] + DM, nullptr); }
        }
}
constexpr int N_PHASES = 16;
__global__ void __launch_bounds__(NWAVES * 64, 2) hymba_fwd(Args args) {
    extern __shared__ __attribute__((aligned(16))) unsigned char lds[];
    Frame F;
    F.lds = (LAS unsigned char*)lds;
    volatile LAS unsigned* MISC = (volatile LAS unsigned*)(F.lds + MISC_OFF);
    F.tid = threadIdx.x; F.lane = F.tid & 63; F.wave = __builtin_amdgcn_readfirstlane(F.tid >> 6);
    F.G = gridDim.x; { const int bx = blockIdx.x; F.vcu = (F.G % 8 == 0) ? (bx % 8) * (F.G / 8) + bx / 8 : bx; }
    unsigned char* ws = args.ws;
    F.ctl = (gu32*)(ws + WS_CTL);
    for (int u = F.tid; u < 1024 / 4; u += NWAVES * 64) ((LAS unsigned*)(F.lds + LDSCTL_OFF))[u] = 0u;
    __syncthreads();
    XcdBarrier bar = xcd_barrier_post((unsigned*)(F.ctl + CW_BAR) + args.li * 4096, MISC + 8);
    build_lut(F, args.in[2]);
    __syncthreads();
    const int lo = args.ph_lo, hi = args.ph_hi;
    if (IN(0)) { p0_prologue(F, args); } SEAM(0);
    run_layer<0>(F, args, bar, lo, hi);
    run_layer<1>(F, args, bar, lo, hi);
#undef IN
#undef SEAM
}

#ifndef N_LAUNCHES
#define N_LAUNCHES 1
#endif
extern "C" void kernel_launch(void* const* d_in, const int* in_sizes, int n_in, void* d_out, int out_size, void* d_ws, size_t ws_size, hipStream_t stream) {
    static int grid = 0;
    if (grid == 0) {
        if (n_in != 18 || in_sizes[0] != NTOK * DM || out_size != NTOK * DM || ws_size < WS_END) { fprintf(stderr, "kernel_launch: unexpected shapes / workspace (%d inputs, ws %zu < %zu)\n", n_in, ws_size, (size_t)WS_END); grid = -1; return; }
        int dev = 0, cus = 0, per_cu = 0;
        if (hipGetDevice(&dev) != hipSuccess || hipDeviceGetAttribute(&cus, hipDeviceAttributeMultiprocessorCount, dev) != hipSuccess) { grid = -1; return; }
        if (hipFuncSetAttribute((const void*)hymba_fwd, hipFuncAttributeMaxDynamicSharedMemorySize, LDS_BYTES) != hipSuccess) { fprintf(stderr, "kernel_launch: hipFuncSetAttribute failed\n"); grid = -1; return; }
        if (hipOccupancyMaxActiveBlocksPerMultiprocessor(&per_cu, (const void*)hymba_fwd, NWAVES * 64, LDS_BYTES) != hipSuccess || per_cu < 1) fprintf(stderr, "kernel_launch: occupancy query reports %d\n", per_cu);
        (void)hipGetLastError();
        grid = (cus == 256) ? 256 : -1;
        if (grid < 0) { fprintf(stderr, "kernel_launch: built for a 256-CU device, found %d CUs\n", cus); return; }
    }
    if (grid < 0) return;
    if (hipMemsetAsync((char*)d_ws + WS_CTL, 0, CTL_ZERO_BYTES, stream) != hipSuccess) return;
    Args a{};
    for (int i = 0; i < 18; ++i) a.in[i] = (const float*)d_in[i];
    a.out = (float*)d_out; a.ws = (unsigned char*)d_ws;
    for (int i = 0; i < 32; ++i) a.invf[i] = (float)(1.0 / pow(10000.0, (double)((float)i / 31.0f)));
#if N_LAUNCHES == 1
    const int cuts[2] = {0, N_PHASES};
#else
    int cuts[N_PHASES + 1]; for (int i = 0; i <= N_PHASES; ++i) cuts[i] = i;
#endif
    const int nl = (N_LAUNCHES == 1) ? 1 : N_PHASES;
    for (int li = 0; li < nl; ++li) {
        a.ph_lo = cuts[li]; a.ph_hi = cuts[li + 1]; a.li = li; a.pad = 0;
        hipLaunchKernelGGL(hymba_fwd, dim3(grid), dim3(NWAVES * 64), LDS_BYTES, stream, a);
        const hipError_t le = hipPeekAtLastError();
        if (le != hipSuccess) { fprintf(stderr, "kernel_launch: launch %d failed: %s\n", li, hipGetErrorName(le)); break; }
    }
}
```

```cpp
#include <hip/hip_runtime.h>
#include <cstdio>
#include <cstdint>
#include <cmath>
namespace pg8 {
#define PG8_LAS __attribute__((address_space(3)))
typedef unsigned short bf16_t;
typedef short bf16x8 __attribute__((ext_vector_type(8)));
typedef float f32x4 __attribute__((ext_vector_type(4)));
typedef unsigned u32x4 __attribute__((ext_vector_type(4)));
constexpr int BM = 256, BK = 64, HALF = 128, HTB = HALF * BK * 2  , STAGE_BYTES = 8 * HTB, NXCD = 8, WGM = 8;

__host__ __device__ __forceinline__ int lds_byte(int r, int c) { const int st = (r >> 4) * 2 + (c >> 5), rr = r & 15, cc = c & 31, ob = rr * 64 + cc * 2; return st * 1024 + (ob ^ (((ob >> 9) & 1) << 5)); }
__host__ __device__ __forceinline__ void stage_rc(int b, int& R, int& C) { const int st = b / 1024, sb = b % 1024, swz = sb ^ (((sb >> 9) & 1) << 5); R = (st >> 1) * 16 + swz / 64; C = (st & 1) * 32 + (swz % 64) / 2; }
__host__ __device__ __forceinline__ int perm32(int rho) { const int n = rho >> 4, i = rho & 15; return 8 * (i >> 2) + 4 * n + (i & 3); }

struct Unit { int pm, pn; };
struct Gemm { const void* A; const void* Bt; int M, N, KB; };
typedef int v4i_t __attribute__((ext_vector_type(4)));
typedef int v8i_t __attribute__((ext_vector_type(8)));

struct StaticOrder {
    int nM, nN, nwg, G, c;
    __host__ __device__ void init(int M, int N, int G_, int c_) { nM = M / BM; nN = N / BM; nwg = nM * nN; G = G_; c = c_; }
    __host__ __device__ bool next(int i, Unit& u) const {
        const long L = (long)i * G + c; if (L >= nwg) return false;
        int wgid = (int)L; { const int q = nwg / NXCD, r = nwg % NXCD, xcd = wgid % NXCD, off = wgid / NXCD; wgid = (xcd < r ? xcd * (q + 1) : r * (q + 1) + (xcd - r) * q) + off; }
        const int nig = WGM * nN, gid = wgid / nig, fm = gid * WGM, gsz = (nM - fm) < WGM ? (nM - fm) : WGM;
        u.pm = fm + ((wgid % nig) % gsz); u.pn = (wgid % nig) / gsz; return true;
    }
    __device__ __forceinline__ void a_ready(const Unit&) const {}
    __device__ __forceinline__ void done(const Unit&) const {}
};

__device__ __forceinline__ unsigned cvt_pk_bf16(float lo, float hi) { unsigned r; asm volatile("v_cvt_pk_bf16_f32 %0, %1, %2" : "=v"(r) : "v"(lo), "v"(hi)); return r; }
typedef float f32x2 __attribute__((ext_vector_type(2)));
typedef float f32x2 __attribute__((ext_vector_type(2)));
typedef unsigned u32x2 __attribute__((ext_vector_type(2)));
constexpr float ALPHA_F = 1.41421356237309515f;
constexpr float C2_F = 0.125f * 1.4426950408889634f;
__device__ __forceinline__ u32x4 pack8(const f32x4 v0, const f32x4 v1) { u32x4 w; w.x = cvt_pk_bf16(v0[0], v0[1]); w.y = cvt_pk_bf16(v0[2], v0[3]); w.z = cvt_pk_bf16(v1[0], v1[1]); w.w = cvt_pk_bf16(v1[2], v1[3]); return w; }

struct EpiProj {
    static constexpr bool PERM = true, AFTER_DRAIN = false;
    bf16_t* O; const float* sinT; const float* cosT;
    __device__ __forceinline__ void operator()(const f32x4 (&acc)[2][2][4][2], const Unit& u, int wr, int wc, int fr, int fq) const {
        const int row0 = u.pm * BM + wr * 64 + fr;
#pragma unroll
        for (int bj = 0; bj < 2; ++bj) {
            const int cw = u.pn * BM + bj * HALF + wc * 32;
            const int c0 = cw + 8 * fq;
            float sc = 1.f; bool rope = false;
            if (cw < 768 || (cw >= 2304 && cw < 3072)) sc = C2_F;
            else if (cw >= 3456 && cw < 3968) { rope = true; if (cw >= 3712) sc = 0.125f; }
            const int i0 = ((c0 - 3456) & 63) >> 1;
#pragma unroll
            for (int ai = 0; ai < 2; ++ai)
#pragma unroll
                for (int m = 0; m < 4; ++m) {
                    const int row = row0 + ai * HALF + m * 16;
                    f32x4 v0 = acc[ai][bj][m][0] * sc, v1 = acc[ai][bj][m][1] * sc;
                    if (rope) {
                        const int pos = row & 2047;
                        const f32x4 sn = *(const f32x4*)(sinT + pos * 32 + i0), cs = *(const f32x4*)(cosT + pos * 32 + i0);
                        f32x4 w0, w1;
                        w0[0] = v0[0] * cs[0] - v0[1] * sn[0]; w0[1] = v0[1] * cs[0] + v0[0] * sn[0];
                        w0[2] = v0[2] * cs[1] - v0[3] * sn[1]; w0[3] = v0[3] * cs[1] + v0[2] * sn[1];
                        w1[0] = v1[0] * cs[2] - v1[1] * sn[2]; w1[1] = v1[1] * cs[2] + v1[0] * sn[2];
                        w1[2] = v1[2] * cs[3] - v1[3] * sn[3]; w1[3] = v1[3] * cs[3] + v1[2] * sn[3];
                        v0 = w0; v1 = w1;
                    }
                    *(u32x4*)(O + (size_t)row * 5120 + c0) = pack8(v0, v1);
                }
        }
    }
};
struct EpiResid {
    static constexpr bool PERM = true, AFTER_DRAIN = false;
    float* T; const float* R;
    __device__ __forceinline__ void operator()(const f32x4 (&acc)[2][2][4][2], const Unit& u, int wr, int wc, int fr, int fq) const {
        const int row0 = u.pm * BM + wr * 64 + fr, col0 = u.pn * BM + wc * 32 + 8 * fq;
#pragma unroll
        for (int ai = 0; ai < 2; ++ai)
#pragma unroll
            for (int m = 0; m < 4; ++m) {
                const size_t ro = (size_t)(row0 + ai * HALF + m * 16) * 2048 + col0;
#pragma unroll
                for (int bj = 0; bj < 2; ++bj) {
                    const f32x4 r0 = *(const f32x4*)(R + ro + bj * HALF), r1 = *(const f32x4*)(R + ro + bj * HALF + 4);
                    *(f32x4*)(T + ro + bj * HALF) = r0 * ALPHA_F + acc[ai][bj][m][0];
                    *(f32x4*)(T + ro + bj * HALF + 4) = r1 * ALPHA_F + acc[ai][bj][m][1];
                }
            }
    }
};
__device__ __forceinline__ float silu_f(float x) { return x * __builtin_amdgcn_rcpf(1.f + __builtin_amdgcn_exp2f(-1.4426950408889634f * x)); }
struct EpiSwiGLU {
    static constexpr bool PERM = true, AFTER_DRAIN = false;
    bf16_t* H; int ntn;
    __device__ __forceinline__ void operator()(const f32x4 (&acc)[2][2][4][2], const Unit& u, int wr, int wc, int fr, int fq) const {
        const int row0 = u.pm * BM + wr * 64 + fr, col0 = (u.pn % ntn) * HALF + wc * 32 + 8 * fq;
#pragma unroll
        for (int ai = 0; ai < 2; ++ai)
#pragma unroll
            for (int m = 0; m < 4; ++m) {
                f32x4 h0, h1;
#pragma unroll
                for (int j = 0; j < 4; ++j) { h0[j] = silu_f(acc[ai][0][m][0][j]) * acc[ai][1][m][0][j]; h1[j] = silu_f(acc[ai][0][m][1][j]) * acc[ai][1][m][1][j]; }
                *(u32x4*)(H + (size_t)(row0 + ai * HALF + m * 16) * 5632 + col0) = pack8(h0, h1);
            }
    }
};
constexpr float FP8_SX = 16.f, FP8_SWU = 512.f, FP8_SH = 8.f, FP8_SWD = 2048.f;
__device__ __forceinline__ unsigned pack4_fp8(float a, float b, float c, float d) {
    a = __builtin_amdgcn_fmed3f(a, -448.f, 448.f); b = __builtin_amdgcn_fmed3f(b, -448.f, 448.f); c = __builtin_amdgcn_fmed3f(c, -448.f, 448.f); d = __builtin_amdgcn_fmed3f(d, -448.f, 448.f);
    int w = __builtin_amdgcn_cvt_pk_fp8_f32(a, b, 0, false); w = __builtin_amdgcn_cvt_pk_fp8_f32(c, d, w, true); return (unsigned)w;
}
struct EpiSwiGLU8 {
    static constexpr bool PERM = true, AFTER_DRAIN = false;
    unsigned char* H; int ntn;
    __device__ __forceinline__ void operator()(const f32x4 (&acc)[2][2][4][2], const Unit& u, int wr, int wc, int fr, int fq) const {
        const int row0 = u.pm * BM + wr * 64 + fr, col0 = (u.pn % ntn) * HALF + wc * 32 + 8 * fq;
        constexpr float si = 1.f / (FP8_SX * FP8_SWU);
#pragma unroll
        for (int ai = 0; ai < 2; ++ai)
#pragma unroll
            for (int m = 0; m < 4; ++m) {
                f32x4 h0, h1;
#pragma unroll
                for (int j = 0; j < 4; ++j) { h0[j] = silu_f(acc[ai][0][m][0][j] * si) * (acc[ai][1][m][0][j] * (si * FP8_SH)); h1[j] = silu_f(acc[ai][0][m][1][j] * si) * (acc[ai][1][m][1][j] * (si * FP8_SH)); }
                u32x2 w; w.x = pack4_fp8(h0[0], h0[1], h0[2], h0[3]); w.y = pack4_fp8(h1[0], h1[1], h1[2], h1[3]);
                *(u32x2*)(H + (size_t)(row0 + ai * HALF + m * 16) * 5632 + col0) = w;
            }
    }
};
struct EpiY {
    static constexpr bool PERM = true, AFTER_DRAIN = false;
    bf16_t* Y; int ntn; float scale;
    __device__ __forceinline__ void operator()(const f32x4 (&acc)[2][2][4][2], const Unit& u, int wr, int wc, int fr, int fq) const {
        const int row0 = u.pm * BM + wr * 64 + fr, col0 = (u.pn % ntn) * BM + wc * 32 + 8 * fq;
#pragma unroll
        for (int ai = 0; ai < 2; ++ai)
#pragma unroll
            for (int m = 0; m < 4; ++m)
#pragma unroll
                for (int bj = 0; bj < 2; ++bj)
                    *(u32x4*)(Y + (size_t)(row0 + ai * HALF + m * 16) * 2048 + col0 + bj * HALF) = pack8(acc[ai][bj][m][0] * scale, acc[ai][bj][m][1] * scale);
    }
};
struct GroupedOrder {
    int nM, nN, nwg, G, c; int cum[8];
    __device__ __forceinline__ bool next(int i, Unit& u) const {
        const long L = (long)i * G + c; if (L >= nwg) return false;
        int wgid = (int)L; { const int q = nwg / NXCD, r = nwg % NXCD, xcd = wgid % NXCD, off = wgid / NXCD; wgid = (xcd < r ? xcd * (q + 1) : r * (q + 1) + (xcd - r) * q) + off; }
        const int nig = WGM * nN, gid = wgid / nig, fm = gid * WGM, gsz = (nM - fm) < WGM ? (nM - fm) : WGM;
        const int pm = fm + ((wgid % nig) % gsz), pn = (wgid % nig) / gsz;
        int e = 0;
#pragma unroll
        for (int j = 0; j < 7; ++j) e += (pm >= cum[j]) ? 1 : 0;
        u.pm = pm; u.pn = e * nN + pn; return true;
    }
    __device__ __forceinline__ void a_ready(const Unit&) const {}
    __device__ __forceinline__ void done(const Unit&) const {}
};
template <class Epi, class Sched, bool ALIGN_EPI = false, bool SP2 = false, bool FP8 = false>
__device__ __forceinline__ void gemm_phase(PG8_LAS unsigned char* lds, const Gemm g, const Sched& S, const Epi& E) {
    int tid = threadIdx.x; asm volatile("" : "+v"(tid));
    const int wid = __builtin_amdgcn_readfirstlane(tid >> 6), lane = tid & 63, wr = wid >> 2, wc = wid & 3, fr = lane & 15, fq = lane >> 4;
    const int KB = g.KB, nt = KB / 128;
    unsigned voffA[2], voffB[2];
#pragma unroll
    for (int i = 0; i < 2; ++i) { int R, C; stage_rc(tid * 16 + i * 8192, R, C); const int Rb = Epi::PERM ? ((R & ~31) + perm32(R & 31)) : R;
        voffA[i] = (unsigned)(R * KB + C * 2); voffB[i] = (unsigned)(Rb * KB + C * 2); }
    const size_t kstep = (size_t)128;
    const size_t hstep = (size_t)HALF * KB;
    const size_t tstep = 2 * hstep;
    const unsigned ldsw = (unsigned)wid * 1024u;
    const int aoff = lds_byte(wr * 64 + fr, fq * 8), boff = lds_byte(wc * 32 + fr, fq * 8);
#define PG8_SA(b, h) (((b) * 2 + (h)) * HTB)
#define PG8_SB(b, h) ((4 + (b) * 2 + (h)) * HTB)
#define PG8_STAGE(bufoff, gbase, voff) do { _Pragma("unroll") for (int _i = 0; _i < 2; ++_i) \
        __builtin_amdgcn_global_load_lds((const unsigned*)((const char*)(gbase) + (voff)[_i]), (PG8_LAS unsigned*)(lds + (bufoff) + ldsw + _i * 8192), 16, 0, 0); } while (0)
#define PG8_LDA(dst, b, h) do { _Pragma("unroll") for (int m = 0; m < 4; ++m) _Pragma("unroll") for (int k = 0; k < 2; ++k) dst[m][k] = *(const PG8_LAS bf16x8*)(lds + PG8_SA(b, h) + aoff + m * 2048 + k * 1024); } while (0)
#define PG8_LDB(dst, b, h) do { _Pragma("unroll") for (int n = 0; n < 2; ++n) _Pragma("unroll") for (int k = 0; k < 2; ++k) dst[n][k] = *(const PG8_LAS bf16x8*)(lds + PG8_SB(b, h) + boff + n * 2048 + k * 1024); } while (0)
#define PG8_MMA(ai, bj, At, Bt) do { __builtin_amdgcn_s_setprio(1); _Pragma("unroll") for (int m = 0; m < 4; ++m) _Pragma("unroll") for (int n = 0; n < 2; ++n) { \
        if constexpr (FP8) { const v4i_t b0_ = __builtin_bit_cast(v4i_t, Bt[n][0]), b1_ = __builtin_bit_cast(v4i_t, Bt[n][1]), a0_ = __builtin_bit_cast(v4i_t, At[m][0]), a1_ = __builtin_bit_cast(v4i_t, At[m][1]); \
            const v8i_t b8_ = __builtin_shufflevector(b0_, b1_, 0, 1, 2, 3, 4, 5, 6, 7), a8_ = __builtin_shufflevector(a0_, a1_, 0, 1, 2, 3, 4, 5, 6, 7); \
            asm volatile("v_mfma_f32_16x16x128_f8f6f4 %0, %1, %2, %0" : "+v"(acc[ai][bj][m][n]) : "v"(b8_), "v"(a8_)); } \
        else { _Pragma("unroll") for (int k = 0; k < 2; ++k) acc[ai][bj][m][n] = __builtin_amdgcn_mfma_f32_16x16x32_bf16(Bt[n][k], At[m][k], acc[ai][bj][m][n], 0, 0, 0); } } __builtin_amdgcn_s_setprio(0); } while (0)
#define PG8_WAIT_V(n) asm volatile("s_waitcnt vmcnt(" #n ")" ::: "memory")
#define PG8_WAIT_L(n) asm volatile("s_waitcnt lgkmcnt(" #n ")" ::: "memory")
#define PG8_BAR __builtin_amdgcn_s_barrier()
#define PG8_SCHED __builtin_amdgcn_sched_barrier(0)
    Unit cur, nxt; int ui = 0;
    if (!S.next(0, cur)) return;
    f32x4 acc[2][2][4][2];
#pragma unroll
    for (int a = 0; a < 2; ++a)
#pragma unroll
        for (int b = 0; b < 2; ++b)
#pragma unroll
            for (int m = 0; m < 4; ++m)
#pragma unroll
                for (int n = 0; n < 2; ++n) acc[a][b][m][n] = (f32x4){0.f, 0.f, 0.f, 0.f};
    bf16x8 At[4][2], B0[2][2], B1[2][2];
    const char* cA = (const char*)g.A + (size_t)cur.pm * tstep; const char* cB = (const char*)g.Bt + (size_t)cur.pn * tstep;
    S.a_ready(cur);
    if constexpr (SP2) {
        PG8_STAGE(PG8_SB(0, 0), cB, voffB); PG8_STAGE(PG8_SB(0, 1), cB + hstep, voffB); PG8_STAGE(PG8_SA(0, 0), cA, voffA); PG8_STAGE(PG8_SA(0, 1), cA + hstep, voffA);
        if (wr == 1) PG8_BAR;
        PG8_WAIT_V(2); PG8_BAR;
        PG8_STAGE(PG8_SB(1, 0), cB + kstep, voffB); PG8_STAGE(PG8_SA(1, 0), cA + kstep, voffA); PG8_STAGE(PG8_SB(1, 1), cB + hstep + kstep, voffB);
        PG8_WAIT_V(6); PG8_BAR;
    } else {
        PG8_STAGE(PG8_SB(0, 0), cB, voffB); PG8_STAGE(PG8_SA(0, 0), cA, voffA); PG8_STAGE(PG8_SB(0, 1), cB + hstep, voffB); PG8_STAGE(PG8_SA(0, 1), cA + hstep, voffA);
        if (wr == 1) PG8_BAR;
        PG8_WAIT_V(4); PG8_BAR;
        PG8_STAGE(PG8_SB(1, 0), cB + kstep, voffB); PG8_STAGE(PG8_SA(1, 0), cA + kstep, voffA); PG8_STAGE(PG8_SB(1, 1), cB + hstep + kstep, voffB);
        PG8_WAIT_V(6); PG8_BAR;
    }
    for (;;) {
        const bool has_next = S.next(ui + 1, nxt);
        const char* nA = has_next ? (const char*)g.A + (size_t)nxt.pm * tstep : cA; const char* nB = has_next ? (const char*)g.Bt + (size_t)nxt.pn * tstep : cB;
        for (int t = 0; t < nt; t += 2) {
            const bool last = (t == nt - 2);
            const char* a1 = cA + (size_t)(t + 1) * kstep;
            const char* a2 = last ? nA : cA + (size_t)(t + 2) * kstep; const char* b2 = last ? nB : cB + (size_t)(t + 2) * kstep;
            const char* a3 = a2 + kstep; const char* b3 = b2 + kstep;
            if (last && has_next) S.a_ready(nxt);
            if constexpr (SP2) {
            PG8_LDB(B0, 0, 0); PG8_LDB(B1, 0, 1); PG8_SCHED; PG8_LDA(At, 0, 0); PG8_STAGE(PG8_SA(1, 1), a1 + hstep, voffA);
            PG8_WAIT_V(8); PG8_WAIT_L(0); PG8_BAR; PG8_MMA(0, 0, At, B0); PG8_MMA(0, 1, At, B1); PG8_BAR; PG8_SCHED;
            PG8_LDA(At, 0, 1); PG8_STAGE(PG8_SB(0, 0), b2, voffB); PG8_STAGE(PG8_SB(0, 1), b2 + hstep, voffB); PG8_STAGE(PG8_SA(0, 0), a2, voffA);
            PG8_WAIT_V(8); PG8_WAIT_L(0); PG8_BAR; PG8_MMA(1, 0, At, B0); PG8_MMA(1, 1, At, B1); PG8_BAR; PG8_SCHED;
            PG8_LDB(B0, 1, 0); PG8_LDB(B1, 1, 1); PG8_SCHED; PG8_LDA(At, 1, 0); PG8_STAGE(PG8_SA(0, 1), a2 + hstep, voffA);
            PG8_WAIT_V(8); PG8_WAIT_L(0); PG8_BAR; PG8_MMA(0, 0, At, B0); PG8_MMA(0, 1, At, B1); PG8_BAR; PG8_SCHED;
            PG8_LDA(At, 1, 1); PG8_STAGE(PG8_SB(1, 0), b3, voffB); PG8_STAGE(PG8_SB(1, 1), b3 + hstep, voffB); PG8_STAGE(PG8_SA(1, 0), a3, voffA);
            PG8_WAIT_V(8); PG8_WAIT_L(0); PG8_BAR; PG8_MMA(1, 0, At, B0); PG8_MMA(1, 1, At, B1); PG8_BAR; PG8_SCHED;
            } else {
            PG8_LDB(B0, 0, 0); PG8_SCHED; PG8_LDA(At, 0, 0); PG8_STAGE(PG8_SA(1, 1), a1 + hstep, voffA);
            PG8_WAIT_L(8); PG8_BAR; PG8_WAIT_L(0); PG8_MMA(0, 0, At, B0); PG8_BAR; PG8_SCHED;
            PG8_LDB(B1, 0, 1); PG8_STAGE(PG8_SB(0, 0), b2, voffB);
            PG8_BAR; PG8_WAIT_L(0); PG8_MMA(0, 1, At, B1); PG8_BAR;
            PG8_LDA(At, 0, 1); PG8_STAGE(PG8_SA(0, 0), a2, voffA);
            PG8_BAR; PG8_WAIT_L(0); PG8_MMA(1, 0, At, B0); PG8_BAR; PG8_SCHED;
            PG8_STAGE(PG8_SB(0, 1), b2 + hstep, voffB);
            PG8_WAIT_V(6); PG8_BAR; PG8_MMA(1, 1, At, B1); PG8_BAR;
            PG8_LDB(B0, 1, 0); PG8_SCHED; PG8_LDA(At, 1, 0); PG8_STAGE(PG8_SA(0, 1), a2 + hstep, voffA);
            PG8_WAIT_L(8); PG8_BAR; PG8_WAIT_L(0); PG8_MMA(0, 0, At, B0); PG8_BAR; PG8_SCHED;
            PG8_LDB(B1, 1, 1); PG8_STAGE(PG8_SB(1, 0), b3, voffB);
            PG8_BAR; PG8_WAIT_L(0); PG8_MMA(0, 1, At, B1); PG8_BAR;
            PG8_LDA(At, 1, 1); PG8_STAGE(PG8_SA(1, 0), a3, voffA);
            PG8_BAR; PG8_WAIT_L(0); PG8_MMA(1, 0, At, B0); PG8_BAR; PG8_SCHED;
            PG8_STAGE(PG8_SB(1, 1), b3 + hstep, voffB);
            PG8_WAIT_V(6); PG8_BAR; PG8_MMA(1, 1, At, B1); PG8_BAR;
            }
        }
        if constexpr (ALIGN_EPI) { if (wr == 0) PG8_BAR; }
        if constexpr (FP8) asm volatile("s_nop 15\n\ts_nop 15" ::: "memory");
        if constexpr (!Epi::AFTER_DRAIN) { E(acc, cur, wr, wc, fr, fq); S.done(cur); }
        if (!has_next) break;
#pragma unroll
        for (int a = 0; a < 2; ++a)
#pragma unroll
            for (int b = 0; b < 2; ++b)
#pragma unroll
                for (int m = 0; m < 4; ++m)
#pragma unroll
                    for (int n = 0; n < 2; ++n) acc[a][b][m][n] = (f32x4){0.f, 0.f, 0.f, 0.f};
        cur = nxt; cA = nA; cB = nB; ++ui;
        if constexpr (ALIGN_EPI) { if (wr == 1) PG8_BAR; }
    }
    PG8_WAIT_V(0);
    if constexpr (!ALIGN_EPI) { if (wr == 0) PG8_BAR; }
    PG8_BAR;
    if constexpr (Epi::AFTER_DRAIN) { E.fused(acc, cur, wr, wc, fr, fq, lds, wid, lane); S.done(cur); }
#undef PG8_SA
#undef PG8_SB
#undef PG8_STAGE
#undef PG8_LDA
#undef PG8_LDB
#undef PG8_MMA
#undef PG8_WAIT_V
#undef PG8_WAIT_L
#undef PG8_BAR
#undef PG8_SCHED
}
}
constexpr int NWAVES = 8;
constexpr int NTOK = 16384, SEQ = 2048, DM = 2048, PW = 4992, PWP = 5120, DFF = 5632, NEXP = 8, MAXTILES = 136;
constexpr float LN_EPS = 1e-5f;
constexpr float LOG2E = 1.4426950408889634f;
constexpr int C_AQ = 0, C_AK = 768, C_AV = 1536, C_BQ = 2304, C_BK = 3072, C_BV = 3264, C_CQ = 3456, C_CK = 3712, C_CV = 3968, C_CG = 4480;
constexpr size_t MiB = 1u << 20;
constexpr size_t WS_CTL = 0, CTL_ZERO_BYTES = 1 * MiB;
constexpr size_t WS_TAB = 1 * MiB;
constexpr size_t WS_ROUTE = 2 * MiB;
constexpr size_t WS_WIN = 4 * MiB, WS_WOUT = 44 * MiB, WS_WDGU = 60 * MiB, WS_WDDN = 104 * MiB, WS_WMGU = 126 * MiB, WS_WMDN = 478 * MiB;
constexpr size_t WS_XB = 654 * MiB, WS_XG = 718 * MiB, WS_U1 = 854 * MiB, WS_END = 1228 * MiB;
constexpr size_t WS_PROJ = WS_U1, WS_CAT = WS_U1 + 160 * MiB, WS_H = WS_U1, WS_Y = WS_XG;
static_assert(WS_WIN + 2ull * PWP * DM * 2 <= WS_WOUT && WS_WOUT + 2ull * DM * DM * 2 <= WS_WDGU && WS_WDGU + 2ull * DFF * DM * 2 <= WS_WDDN && WS_WDDN + (size_t)DM * DFF * 2 <= WS_WMGU, "ws map 1");
static_assert(WS_WMGU + 8ull * 2 * DFF * DM * 2 <= WS_WMDN && WS_WMDN + 8ull * DM * DFF * 2 <= WS_XB && WS_XB + (size_t)NTOK * DM * 2 <= WS_XG && WS_XG + (size_t)MAXTILES * 256 * DM * 2 <= WS_U1, "ws map 2");
static_assert(WS_U1 + (size_t)MAXTILES * 256 * DFF * 2 <= WS_END && WS_PROJ + (size_t)NTOK * PWP * 2 <= WS_CAT && WS_CAT + (size_t)NTOK * DM * 2 <= WS_END, "ws map 3");
constexpr int CW_TMO = 0, CW_CODE = 1, CW_CNT = 1024  , CW_WQ = 2048  , CW_BAR = 4096  ;
constexpr int RING_OFF = 0, RING_BYTES = 131072;
constexpr int LDSCTL_OFF = RING_BYTES, MISC_OFF = LDSCTL_OFF + 320;
constexpr int LUT_OFF = LDSCTL_OFF + 1024;
constexpr int LUT_STRIDE = 132;
constexpr int LDS_BYTES = 147456;
static_assert(LUT_OFF + 18 * LUT_STRIDE * 4 <= LDS_BYTES, "LDS map");

#define GAS __attribute__((address_space(1)))
#define LAS __attribute__((address_space(3)))
typedef unsigned short bf16;
typedef unsigned v4u __attribute__((ext_vector_type(4)));
typedef unsigned v2u __attribute__((ext_vector_type(2)));
typedef float f32x4 __attribute__((ext_vector_type(4)));
typedef short bf16x8 __attribute__((ext_vector_type(8)));
typedef GAS unsigned gu32;
#define RLX_AGENT __ATOMIC_RELAXED, __HIP_MEMORY_SCOPE_AGENT
#define LDS_WAIT() asm volatile("s_waitcnt lgkmcnt(0)" ::: "memory")
#define VM_WAIT() asm volatile("s_waitcnt vmcnt(0)" ::: "memory")
__device__ __forceinline__ unsigned f2bf(float f) { unsigned u = __builtin_bit_cast(unsigned, f); return (u + 0x7fffu + ((u >> 16) & 1u)) >> 16; }
__device__ __forceinline__ unsigned pk2(float lo, float hi) { return f2bf(lo) | (f2bf(hi) << 16); }
__device__ __forceinline__ float bflo(unsigned w) { return __builtin_bit_cast(float, w << 16); }
__device__ __forceinline__ float bfhi(unsigned w) { return __builtin_bit_cast(float, w & 0xffff0000u); }
__device__ __forceinline__ float bf2f(bf16 h) { return __builtin_bit_cast(float, (unsigned)h << 16); }
__device__ const unsigned char BUCKET[129] = {0,1,2,3,4,5,6,7,8,9,10,11,12,13,14,15,16,16,16,17,17,18,18,18,19,19,19,20,20,20,20,21,21,21,21,22,22,22,22,22,23,23,23,23,23,23,24,24,24,24,24,24,25,25,25,25,25,25,25,
    26,26,26,26,26,26,26,26,27,27,27,27,27,27,27,27,27,27,28,28,28,28,28,28,28,28,28,28,29,29,29,29,29,29,29,29,29,29,29,29,30,30,30,30,30,30,30,30,30,30,30,30,30,30,31,31,31,31,31,31,31,31,31,31,31,31,31,31,31,31};
#define XB_TMO      128
#define XB_XCNT(j)  (256  + 64 * (j))
#define XB_XSUB(j)  (1280 + 64 * (j))
#define XB_XGEN(j)  (2304 + 64 * (j))
#define XB_TOP      3328
#define XB_TOPGEN   3392
#define XCD_BAR_WORDS 3456
#define XB_SPIN_CAP (1u << 18)

__device__ __forceinline__ unsigned xb_ld(unsigned* p)              { return __hip_atomic_load(p, __ATOMIC_RELAXED, __HIP_MEMORY_SCOPE_AGENT); }
__device__ __forceinline__ unsigned xb_add(unsigned* p, unsigned v) { return __hip_atomic_fetch_add(p, v, __ATOMIC_RELAXED, __HIP_MEMORY_SCOPE_AGENT); }
__device__ __forceinline__ unsigned xb_xcc_id() { return (unsigned)__builtin_amdgcn_s_getreg((3 << 11) | 20) & 0xFu; }
#define XB_SPIN(cond, bar) do { unsigned _sp = 0; while (cond) { __builtin_amdgcn_s_sleep(1); \
    if ((++_sp & 255u) == 0u) { if (xb_ld(&(bar)[XB_TMO])) break; if (_sp > XB_SPIN_CAP) { atomicAdd(&(bar)[XB_TMO], 1u); break; } } } } while (0)

struct XcdBarrier {
    unsigned* bar; unsigned x;
    volatile LAS unsigned* st;
};

__device__ __forceinline__ XcdBarrier xcd_barrier_post(unsigned* bar, volatile LAS unsigned* st) {
    XcdBarrier b; b.bar = bar; b.x = xb_xcc_id(); b.st = st;
    if (threadIdx.x == 0) (void)xb_add(&bar[XB_XCNT(b.x)], 1u);
    return b;
}
__device__ __forceinline__ void xcd_barrier_complete(unsigned* bar, unsigned x, unsigned& nloc, unsigned& nx) {
    const unsigned G = gridDim.x * gridDim.y * gridDim.z;
    unsigned sum, cnt, mine, sp = 0u;
    for (;;) {
        sum = 0u; cnt = 0u; mine = 0u;
#pragma unroll
        for (unsigned j = 0; j < 16; ++j) { const unsigned c = xb_ld(&bar[XB_XCNT(j)]); sum += c; cnt += (c > 0u) ? 1u : 0u; mine = (j == x) ? c : mine; }
        if (sum == G) break;
        __builtin_amdgcn_s_sleep(1);
        if ((++sp & 255u) == 0u) { if (xb_ld(&bar[XB_TMO])) break; if (sp > XB_SPIN_CAP) { atomicAdd(&bar[XB_TMO], 1u); break; } }
    }
    nloc = mine > 0u ? mine : 1u; nx = cnt > 0u ? cnt : 1u;
}

__device__ __forceinline__ void xcd_barrier(const XcdBarrier& b) {
    asm volatile("s_waitcnt vmcnt(0)" ::: "memory");
    __syncthreads();
    if (threadIdx.x == 0) {
        unsigned* bar = b.bar;
        __builtin_amdgcn_s_waitcnt(0);
        unsigned nloc = b.st[0], nx = b.st[1];
        if (nloc == 0u) { xcd_barrier_complete(bar, b.x, nloc, nx); b.st[0] = nloc; b.st[1] = nx; }
        const unsigned old = xb_add(&bar[XB_XSUB(b.x)], 1u);
        const unsigned gen = old / nloc;
        if (old + 1u == (gen + 1u) * nloc) {
            __builtin_amdgcn_fence(__ATOMIC_RELEASE, "agent");
            asm volatile("s_waitcnt vmcnt(0)" ::: "memory");
            const unsigned og = xb_add(&bar[XB_TOP], 1u);
            const unsigned tg = og / nx;
            if (og + 1u == (tg + 1u) * nx) xb_add(&bar[XB_TOPGEN], 1u);
            else XB_SPIN(xb_ld(&bar[XB_TOPGEN]) == tg, bar);
            __builtin_amdgcn_fence(__ATOMIC_ACQUIRE, "agent");
            xb_add(&bar[XB_XGEN(b.x)], 1u);
            asm volatile("s_waitcnt vmcnt(0)" ::: "memory");
        } else {
            XB_SPIN(xb_ld(&bar[XB_XGEN(b.x)]) == gen, bar);
            __builtin_amdgcn_fence(__ATOMIC_ACQUIRE, "agent");
            asm volatile("s_waitcnt vmcnt(0)" ::: "memory");
        }
    }
    __syncthreads();
}
struct Args { const float* in[18]; float* out; unsigned char* ws; int ph_lo, ph_hi, li, pad; float invf[32]; };
static_assert(sizeof(Args) == 20 * 8 + 16 + 128, "Args has no padding bytes");
struct Frame {
    LAS unsigned char* lds;
    gu32* ctl;
    int tid, lane, wave, vcu, G;
};
__device__ __forceinline__ float wave_sum(float v) {
#pragma unroll
    for (int o = 1; o < 64; o <<= 1) v += __shfl_xor(v, o);
    return v;
}
__device__ __forceinline__ float wave_max(float v) {
#pragma unroll
    for (int o = 1; o < 64; o <<= 1) v = fmaxf(v, __shfl_xor(v, o));
    return v;
}
__device__ __forceinline__ void p0_transpose_item(const float* W, int K, int N, bf16* WT, int k0, int n0, int drow0, LAS float* scr, int lane) {
#pragma unroll 8
    for (int i = 0; i < 32; ++i) { const int kk = 2 * i + (lane >> 5); scr[kk * 33 + (lane & 31)] = W[(size_t)(k0 + kk) * N + n0 + (lane & 31)]; }
    LDS_WAIT(); asm volatile("" ::: "memory");
    const int c = lane & 7;
#pragma unroll
    for (int j = 0; j < 4; ++j) { const int n = (lane >> 3) + 8 * j; const LAS float* s = scr + (8 * c) * 33 + n;
        v4u o; o.x = pk2(s[0 * 33], s[1 * 33]); o.y = pk2(s[2 * 33], s[3 * 33]); o.z = pk2(s[4 * 33], s[5 * 33]); o.w = pk2(s[6 * 33], s[7 * 33]);
        *(GAS v4u*)(WT + (size_t)(drow0 + n) * K + k0 + 8 * c) = o; }
    LDS_WAIT(); asm volatile("" ::: "memory");
}
template <int MODE> __device__ __forceinline__ void p0_matrix_item(const float* W, int K, int N, bf16* WT, int item, LAS float* scr, int lane) {
    const int nblk = N / 32, kb = item / nblk, nb = item % nblk, n0 = 32 * nb;
    const int drow0 = (MODE == 0) ? n0 : ((n0 >> 7) * 256 + (n0 & 127) + (MODE == 2 ? 128 : 0));
    p0_transpose_item(W, K, N, WT, 64 * kb, n0, drow0, scr, lane);
}
__device__ __forceinline__ void p0_transpose_item8(const float* W, int K, int N, unsigned char* WT, int k0, int n0, int drow0, float scale, LAS float* scr, int lane) {
#pragma unroll 8
    for (int i = 0; i < 32; ++i) { const int kk = 2 * i + (lane >> 5); scr[kk * 33 + (lane & 31)] = W[(size_t)(k0 + kk) * N + n0 + (lane & 31)] * scale; }
    LDS_WAIT(); asm volatile("" ::: "memory");
    const int c = lane & 7;
#pragma unroll
    for (int j = 0; j < 4; ++j) { const int n = (lane >> 3) + 8 * j; const LAS float* s = scr + (8 * c) * 33 + n;
        v2u o; o.x = pg8::pack4_fp8(s[0 * 33], s[1 * 33], s[2 * 33], s[3 * 33]); o.y = pg8::pack4_fp8(s[4 * 33], s[5 * 33], s[6 * 33], s[7 * 33]);
        *(GAS v2u*)(WT + (size_t)(drow0 + n) * K + k0 + 8 * c) = o; }
    LDS_WAIT(); asm volatile("" ::: "memory");
}
template <int MODE> __device__ __forceinline__ void p0_matrix_item8(const float* W, int K, int N, unsigned char* WT, int item, float scale, LAS float* scr, int lane) {
    const int nblk = N / 32, kb = item / nblk, nb = item % nblk, n0 = 32 * nb;
    const int drow0 = (MODE == 0) ? n0 : ((n0 >> 7) * 256 + (n0 & 127) + (MODE == 2 ? 128 : 0));
    p0_transpose_item8(W, K, N, WT, 64 * kb, n0, drow0, scale, scr, lane);
}
__device__ __forceinline__ void p0_prologue(Frame& F, const Args& a) {
    LAS float* scr = (LAS float*)(F.lds + RING_OFF + F.wave * 16384);
    const int gw = F.vcu * NWAVES + F.wave, NGW = F.G * NWAVES;
    unsigned char* ws = a.ws;
    constexpr int I_IN = (DM / 64) * (PW / 32), I_OUT = (DM / 64) * (DM / 32), I_GU = (DM / 64) * (DFF / 32), I_DN = (DFF / 64) * (DM / 32);
    constexpr int NITEMS = 2 * I_IN + 2 * I_OUT + 2 * I_GU + I_DN + 8 * (2 * I_GU + I_DN);
    for (int it = gw; it < NITEMS; it += NGW) {
        int r = it;
        if (r < 2 * I_IN) { const int l = r / I_IN; p0_matrix_item<0>(a.in[1] + (size_t)l * DM * PW, DM, PW, (bf16*)(ws + WS_WIN) + (size_t)l * PWP * DM, r % I_IN, scr, F.lane); continue; } r -= 2 * I_IN;
        if (r < 2 * I_OUT) { const int l = r / I_OUT; p0_matrix_item<0>(a.in[6] + (size_t)l * DM * DM, DM, DM, (bf16*)(ws + WS_WOUT) + (size_t)l * DM * DM, r % I_OUT, scr, F.lane); continue; } r -= 2 * I_OUT;
        if (r < I_GU) { p0_matrix_item<1>(a.in[11], DM, DFF, (bf16*)(ws + WS_WDGU), r, scr, F.lane); continue; } r -= I_GU;
        if (r < I_GU) { p0_matrix_item<2>(a.in[12], DM, DFF, (bf16*)(ws + WS_WDGU), r, scr, F.lane); continue; } r -= I_GU;
        if (r < I_DN) { p0_matrix_item<0>(a.in[13], DFF, DM, (bf16*)(ws + WS_WDDN), r, scr, F.lane); continue; } r -= I_DN;
        if (r < 8 * I_GU) { const int e = r / I_GU; p0_matrix_item8<1>(a.in[15] + (size_t)e * DM * DFF, DM, DFF, ws + WS_WMGU + (size_t)e * 2 * DFF * DM, r % I_GU, pg8::FP8_SWU, scr, F.lane); continue; } r -= 8 * I_GU;
        if (r < 8 * I_GU) { const int e = r / I_GU; p0_matrix_item8<2>(a.in[16] + (size_t)e * DM * DFF, DM, DFF, ws + WS_WMGU + (size_t)e * 2 * DFF * DM, r % I_GU, pg8::FP8_SWU, scr, F.lane); continue; } r -= 8 * I_GU;
        { const int e = r / I_DN; p0_matrix_item8<0>(a.in[17] + (size_t)e * DFF * DM, DFF, DM, ws + WS_WMDN + (size_t)e * DM * DFF, r % I_DN, pg8::FP8_SWD, scr, F.lane); }
    }
    { const int gt = gw * 64 + F.lane, NGT = NGW * 64; const GAS f32x4* x4 = (const GAS f32x4*)a.in[0]; GAS v4u* o4 = (GAS v4u*)(ws + WS_XB);
      for (int i = gt; i < NTOK * DM / 8; i += NGT) { const f32x4 p = x4[2 * i], q = x4[2 * i + 1]; v4u o; o.x = pk2(p[0], p[1]); o.y = pk2(p[2], p[3]); o.z = pk2(q[0], q[1]); o.w = pk2(q[2], q[3]); o4[i] = o; } }
    { const int gt = gw * 64 + F.lane; if (gt < SEQ * 32) { const int pos = gt >> 5, i = gt & 31; const float ang = (float)pos * a.invf[i];
        const double t = (double)ang * 0.15915494309189535; const float fr = (float)(t - __builtin_rint(t));
        ((float*)(ws + WS_TAB))[gt] = __builtin_amdgcn_sinf(fr); ((float*)(ws + WS_TAB + 256 * 1024))[gt] = __builtin_amdgcn_cosf(fr); } }
}
__device__ __forceinline__ void build_lut(Frame& F, const float* rel_bias) {
    LAS float* lut = (LAS float*)(F.lds + LUT_OFF);
    for (int i = F.tid; i < 18 * 129; i += NWAVES * 64) { const int hh = i / 129, d = i % 129; lut[hh * LUT_STRIDE + d] = (rel_bias[BUCKET[d] * 18 + hh] - (hh < 6 ? rel_bias[31 * 18 + hh] : 0.f)) * LOG2E; }
}
__device__ __forceinline__ void ln_stats(f32x4 (&v)[8], float& mean, float& rstd) {
    float s = 0.f;
#pragma unroll
    for (int j = 0; j < 8; ++j) s += (v[j][0] + v[j][1]) + (v[j][2] + v[j][3]);
    mean = wave_sum(s) * (1.f / DM); float s2 = 0.f;
#pragma unroll
    for (int j = 0; j < 8; ++j) { v[j] = v[j] - mean; s2 += (v[j][0] * v[j][0] + v[j][1] * v[j][1]) + (v[j][2] * v[j][2] + v[j][3] * v[j][3]); }
    rstd = 1.f / sqrtf(wave_sum(s2) * (1.f / DM) + LN_EPS);
}
__device__ __forceinline__ int expert_offsets(Frame& F, int& ntiles) {
    const unsigned c = (F.lane < 8) ? __hip_atomic_load(F.ctl + CW_CNT + 64 * F.lane, RLX_AGENT) : 0u;
    const int t = (int)((c + 255u) >> 8);
    int inc = t;
#pragma unroll
    for (int o = 1; o < 8; o <<= 1) { const int u = __shfl_up(inc, o); if (F.lane >= o) inc += u; }
    ntiles = __shfl(inc, 7);
    return (inc - t) * 256;
}
template <int MODE> __device__ __forceinline__ void ln_phase(Frame& F, const Args& a, float* T, const float* gam, const float* bet, const float* w_router) {
    unsigned char* ws = a.ws;
    bf16* XB = (bf16*)(ws + WS_XB);
    const int lane = F.lane;
    LAS float* wrT = (LAS float*)(F.lds + RING_OFF);
    LAS int* cwL = (LAS int*)(F.lds + RING_OFF + 65536);
    LAS int* baseL = (LAS int*)(F.lds + RING_OFF + 65536 + 256);
    if (MODE == 1) {
        for (int i = F.tid; i < DM * 8; i += NWAVES * 64) wrT[(i & 7) * DM + (i >> 3)] = w_router[i];
        __syncthreads();
    }
    f32x4 g4[8], b4[8];
#pragma unroll
    for (int j = 0; j < 8; ++j) { g4[j] = *(const f32x4*)(gam + 4 * lane + 256 * j); b4[j] = *(const f32x4*)(bet + 4 * lane + 256 * j); }
    int offv = 0, ntl = 0;
    if (MODE == 2) offv = expert_offsets(F, ntl);
    const int rb = (F.vcu * NWAVES + F.wave) * 8;
    unsigned long long cntp = 0ull; int me1 = 0, me2 = 0, mr1 = 0, mr2 = 0; float mg1 = 0.f, mg2 = 0.f;
    for (int r = 0; r < 8; ++r) {
        const int row = rb + r;
        float* trow = T + (size_t)row * DM;
        f32x4 v[8];
#pragma unroll
        for (int j = 0; j < 8; ++j) v[j] = *(const f32x4*)(trow + 4 * lane + 256 * j);
        if (MODE == 2) {
            const int* rt = (const int*)(ws + WS_ROUTE) + row * 8;
            const int e1 = rt[0], p1 = rt[1], e2 = rt[2], p2 = rt[3]; const float g1 = __builtin_bit_cast(float, rt[4]), g2 = __builtin_bit_cast(float, rt[5]);
            const int r1 = __shfl(offv, e1) + p1, r2 = __shfl(offv, e2) + p2;
            const bf16* y1 = (const bf16*)(ws + WS_Y) + (size_t)r1 * DM; const bf16* y2 = (const bf16*)(ws + WS_Y) + (size_t)r2 * DM;
#pragma unroll
            for (int j = 0; j < 8; ++j) { const v2u a1 = *(const v2u*)(y1 + 4 * lane + 256 * j), a2 = *(const v2u*)(y2 + 4 * lane + 256 * j);
                v[j][0] = v[j][0] * pg8::ALPHA_F + g1 * bflo(a1.x) + g2 * bflo(a2.x); v[j][1] = v[j][1] * pg8::ALPHA_F + g1 * bfhi(a1.x) + g2 * bfhi(a2.x);
                v[j][2] = v[j][2] * pg8::ALPHA_F + g1 * bflo(a1.y) + g2 * bflo(a2.y); v[j][3] = v[j][3] * pg8::ALPHA_F + g1 * bfhi(a1.y) + g2 * bfhi(a2.y); }
        }
        float mean, rstd; ln_stats(v, mean, rstd);
#pragma unroll
        for (int j = 0; j < 8; ++j) v[j] = v[j] * rstd * g4[j] + b4[j];
        if (MODE == 2) {
            float* orow = a.out + (size_t)row * DM;
#pragma unroll
            for (int j = 0; j < 8; ++j) *(f32x4*)(orow + 4 * lane + 256 * j) = v[j];
        } else {
            bf16* xrow = XB + (size_t)row * DM;
#pragma unroll
            for (int j = 0; j < 8; ++j) { *(f32x4*)(trow + 4 * lane + 256 * j) = v[j]; if (MODE == 0) { v2u o; o.x = pk2(v[j][0], v[j][1]); o.y = pk2(v[j][2], v[j][3]); *(v2u*)(xrow + 4 * lane + 256 * j) = o; } }
        }
        if (MODE == 1) {
            int i1 = -1, i2 = -1; float v1 = -3.0e38f, v2 = -3.0e38f;
#pragma unroll 1
            for (int e = 0; e < 8; ++e) { float s = 0.f;
#pragma unroll
                for (int j = 0; j < 8; ++j) { const f32x4 w = *(const LAS f32x4*)(wrT + e * DM + 4 * lane + 256 * j); s += (v[j][0] * w[0] + v[j][1] * w[1]) + (v[j][2] * w[2] + v[j][3] * w[3]); }
                const float t = wave_sum(s);
                if (t > v1) { v2 = v1; i2 = i1; v1 = t; i1 = e; } else if (t > v2) { v2 = t; i2 = e; } }
            if (i1 < 0) i1 = 0;
            if (i2 < 0) i2 = (i1 + 1) & 7;
            const float ex = __expf(v2 - v1), w1 = 1.f / (1.f + ex), w2 = ex * w1;
            const int k1 = (int)((cntp >> (8 * i1)) & 0xffull); cntp += 1ull << (8 * i1);
            const int k2 = (int)((cntp >> (8 * i2)) & 0xffull); cntp += 1ull << (8 * i2);
            if (lane == r) { me1 = i1; me2 = i2; mr1 = k1; mr2 = k2; mg1 = w1; mg2 = w2; }
        }
    }
    if (MODE == 1) {
        if (lane < 8) cwL[F.wave * 8 + lane] = (int)((cntp >> (8 * lane)) & 0xffull);
        __syncthreads();
        if (F.tid < 8) { int tot = 0;
#pragma unroll
            for (int w = 0; w < 8; ++w) tot += cwL[w * 8 + F.tid];
            baseL[F.tid] = (int)__hip_atomic_fetch_add(F.ctl + CW_CNT + 64 * F.tid, (unsigned)tot, RLX_AGENT); }
        __syncthreads();
        if (lane < 8) {
            int p1 = baseL[me1] + mr1, p2 = baseL[me2] + mr2;
            for (int w = 0; w < F.wave; ++w) { p1 += cwL[w * 8 + me1]; p2 += cwL[w * 8 + me2]; }
            int* rt = (int*)(ws + WS_ROUTE) + (rb + lane) * 8;
            rt[0] = me1; rt[1] = p1; rt[2] = me2; rt[3] = p2; rt[4] = __builtin_bit_cast(int, mg1); rt[5] = __builtin_bit_cast(int, mg2);
        }
    }
}
__device__ __forceinline__ void gather_phase(Frame& F, const Args& a, const float* T) {
    unsigned char* ws = a.ws; int ntl; const int offv = expert_offsets(F, ntl);
    const int gw = F.vcu * NWAVES + F.wave, NGW = F.G * NWAVES;
    for (int tok = gw; tok < NTOK; tok += NGW) {
        const int* rt = (const int*)(ws + WS_ROUTE) + tok * 8;
        const int d1 = __shfl(offv, rt[0]) + rt[1], d2 = __shfl(offv, rt[2]) + rt[3];
        const GAS f32x4* s = (const GAS f32x4*)(T + (size_t)tok * DM);
        GAS unsigned* o1 = (GAS unsigned*)(ws + WS_XG + (size_t)d1 * DM); GAS unsigned* o2 = (GAS unsigned*)(ws + WS_XG + (size_t)d2 * DM);
#pragma unroll
        for (int j = 0; j < 8; ++j) { const f32x4 v = s[F.lane + 64 * j] * pg8::FP8_SX; const unsigned w = pg8::pack4_fp8(v[0], v[1], v[2], v[3]); o1[F.lane + 64 * j] = w; o2[F.lane + 64 * j] = w; }
    }
}
__device__ __forceinline__ float dot8(const v4u q, const v4u k) {
    return (bflo(q.x) * bflo(k.x) + bfhi(q.x) * bfhi(k.x)) + (bflo(q.y) * bflo(k.y) + bfhi(q.y) * bfhi(k.y)) + (bflo(q.z) * bflo(k.z) + bfhi(q.z) * bfhi(k.z)) + (bflo(q.w) * bflo(k.w) + bfhi(q.w) * bfhi(k.w));
}
__device__ __forceinline__ float lambda_of(const float* lp, int lane, float lam_init) {
    const float s1 = wave_sum(lp[lane] * lp[64 + lane]), s2 = wave_sum(lp[128 + lane] * lp[192 + lane]);
    return __expf(s1) - __expf(s2) + lam_init;
}
__device__ __forceinline__ void naive_mixers(Frame& F, const Args& a, int layer) {
    unsigned char* ws = a.ws; const bf16* PROJ = (const bf16*)(ws + WS_PROJ); bf16* CAT = (bf16*)(ws + WS_CAT);
    const int lane = F.lane; const int gw = F.vcu * NWAVES + F.wave, NGW = F.G * NWAVES;
    LAS float* sc = (LAS float*)(F.lds + RING_OFF + F.wave * 16384);
    const LAS float* lut = (const LAS float*)(F.lds + LUT_OFF);
    const float lam_init = 0.8f - 0.6f * __expf(-0.3f * (float)layer);
    const float lam = lambda_of(a.in[3] + layer * 256, lane, lam_init);
    const float* subg = a.in[4] + layer * 128; const float* sinks = a.in[5] + layer * 12;
    for (int task = gw; task < NTOK * 6; task += NGW) {
        const int tok = task / 6, h = task - tok * 6, q = tok & (SEQ - 1), base = tok - q;
        v4u qv[16]; { const v4u* qp = (const v4u*)(PROJ + (size_t)tok * PWP + C_AQ + h * 128);
#pragma unroll
            for (int c = 0; c < 16; ++c) qv[c] = qp[c]; }
        float m1 = -3.0e38f, m2 = -3.0e38f;
        for (int j = lane; j <= q; j += 64) {
            const v4u* kp = (const v4u*)(PROJ + (size_t)(base + j) * PWP + C_AK + h * 128); float d1 = 0.f, d2 = 0.f;
#pragma unroll
            for (int c = 0; c < 8; ++c) { d1 += dot8(qv[c], kp[c]); d2 += dot8(qv[8 + c], kp[8 + c]); }
            const int dd = q - j; const float bias = lut[h * LUT_STRIDE + (dd < 128 ? dd : 128)];
            d1 += bias; d2 += bias; sc[j] = d1; sc[2048 + j] = d2; m1 = fmaxf(m1, d1); m2 = fmaxf(m2, d2);
        }
        m1 = wave_max(m1); m2 = wave_max(m2); float l1 = 0.f, l2 = 0.f;
        for (int j = lane; j <= q; j += 64) { const float p1 = __builtin_amdgcn_exp2f(sc[j] - m1), p2 = __builtin_amdgcn_exp2f(sc[2048 + j] - m2); sc[j] = p1; sc[2048 + j] = p2; l1 += p1; l2 += p2; }
        l1 = wave_sum(l1); l2 = wave_sum(l2); const float c1 = 1.f / l1, c2 = lam / l2;
        float o0 = 0.f, o1 = 0.f;
        for (int j = 0; j <= q; ++j) { const float w = sc[j] * c1 - sc[2048 + j] * c2; const bf16* vr = PROJ + (size_t)(base + j) * PWP + C_AV + h * 128; o0 += w * bf2f(vr[lane]); o1 += w * bf2f(vr[64 + lane]); }
        const float ss = wave_sum(o0 * o0 + o1 * o1), rr = (1.f / sqrtf(ss * (1.f / 128.f) + LN_EPS)) * (1.f - lam_init);
        bf16* orow = CAT + (size_t)tok * DM + h * 128; orow[lane] = (bf16)f2bf(o0 * rr * subg[lane]); orow[64 + lane] = (bf16)f2bf(o1 * rr * subg[64 + lane]);
    }
    for (int task = gw; task < NTOK * 12; task += NGW) {
        const int tok = task / 12, hq = task - tok * 12, kvh = hq >> 2, q = tok & (SEQ - 1), base = tok - q;
        v4u qv[8]; { const v4u* qp = (const v4u*)(PROJ + (size_t)tok * PWP + C_BQ + hq * 64);
#pragma unroll
            for (int c = 0; c < 8; ++c) qv[c] = qp[c]; }
        float s[2];
#pragma unroll
        for (int i = 0; i < 2; ++i) { const int dd = lane + 64 * i, j = q - dd; s[i] = -3.0e38f;
            if (j >= 0) { const v4u* kp = (const v4u*)(PROJ + (size_t)(base + j) * PWP + C_BK + kvh * 64); float d = 0.f;
#pragma unroll
                for (int c = 0; c < 8; ++c) d += dot8(qv[c], kp[c]);
                s[i] = d + lut[(6 + hq) * LUT_STRIDE + dd]; } }
        const float sink2 = sinks[hq] * LOG2E; const float m = fmaxf(wave_max(fmaxf(s[0], s[1])), sink2);
        const float p0 = (q - lane >= 0) ? __builtin_amdgcn_exp2f(s[0] - m) : 0.f, p1 = (q - lane - 64 >= 0) ? __builtin_amdgcn_exp2f(s[1] - m) : 0.f;
        const float l = wave_sum(p0 + p1) + __builtin_amdgcn_exp2f(sink2 - m);
        sc[lane] = p0; sc[64 + lane] = p1;
        float o = 0.f; const int nk = (q + 1 < 128) ? q + 1 : 128;
        for (int dd = 0; dd < nk; ++dd) o += sc[dd] * bf2f(PROJ[(size_t)(base + q - dd) * PWP + C_BV + kvh * 64 + lane]);
        CAT[(size_t)tok * DM + 768 + hq * 64 + lane] = (bf16)f2bf(o / l);
    }
    for (int task = gw; task < NTOK * 4; task += NGW) {
        const int tok = task >> 2, h = task & 3, q = tok & (SEQ - 1), base = tok - q;
        const float lg2 = log2f(1.f - exp2f(-5.f - (float)h));
        v4u qv[8]; { const v4u* qp = (const v4u*)(PROJ + (size_t)tok * PWP + C_CQ + h * 64);
#pragma unroll
            for (int c = 0; c < 8; ++c) qv[c] = qp[c]; }
        for (int j = lane; j <= q; j += 64) { const v4u* kp = (const v4u*)(PROJ + (size_t)(base + j) * PWP + C_CK + h * 64); float d = 0.f;
#pragma unroll
            for (int c = 0; c < 8; ++c) d += dot8(qv[c], kp[c]);
            sc[j] = d * __builtin_amdgcn_exp2f((float)(q - j) * lg2); }
        float o0 = 0.f, o1 = 0.f;
        for (int j = 0; j <= q; ++j) { const float w = sc[j]; const bf16* vr = PROJ + (size_t)(base + j) * PWP + C_CV + h * 128; o0 += w * bf2f(vr[lane]); o1 += w * bf2f(vr[64 + lane]); }
        const float mu = wave_sum(o0 + o1) * (1.f / 128.f); o0 -= mu; o1 -= mu;
        const float rs = 1.f / sqrtf(wave_sum(o0 * o0 + o1 * o1) * (1.f / 128.f) + LN_EPS);
        const bf16* gr = PROJ + (size_t)tok * PWP + C_CG + h * 128;
        bf16* orow = CAT + (size_t)tok * DM + 1536 + h * 128;
        orow[lane] = (bf16)f2bf(pg8::silu_f(bf2f(gr[lane])) * o0 * rs); orow[64 + lane] = (bf16)f2bf(pg8::silu_f(bf2f(gr[64 + lane])) * o1 * rs);
    }
}
typedef float f32x16 __attribute__((ext_vector_type(16)));
typedef short s16x4 __attribute__((ext_vector_type(4)));
typedef short v4i16_t __attribute__((ext_vector_type(4)));
typedef float f32x2_t __attribute__((ext_vector_type(2))); typedef __bf16 bf16x2_t __attribute__((ext_vector_type(2)));
__device__ __forceinline__ int crow(int r, int hi) { return (r & 3) + 8 * (r >> 2) + 4 * hi; }
__device__ __forceinline__ s16x4 vtr(const LAS unsigned char* p) { return __builtin_bit_cast(s16x4, __builtin_amdgcn_ds_read_tr16_b64_v4i16((LAS v4i16_t*)p)); }
__device__ __forceinline__ unsigned cvtpk_s(float lo, float hi) { f32x2_t v = {lo, hi}; bf16x2_t b = __builtin_convertvector(v, bf16x2_t); return __builtin_bit_cast(unsigned, b); }
__device__ __forceinline__ bf16x8 pack_p(const f32x16& p, int s2) {
    v4u w; w.x = cvtpk_s(p[8 * s2 + 0], p[8 * s2 + 1]); w.y = cvtpk_s(p[8 * s2 + 2], p[8 * s2 + 3]); w.z = cvtpk_s(p[8 * s2 + 4], p[8 * s2 + 5]); w.w = cvtpk_s(p[8 * s2 + 6], p[8 * s2 + 7]);
    return __builtin_bit_cast(bf16x8, w);
}
constexpr int MIX_WSF = 67584, MIX_QW = 69632;
constexpr float MIX_THR = 6.f;
template <int MODE> __device__ __forceinline__ void mix_unit(Frame& F, const Args& a, int layer, int b, int hh, int qb, float lam, float lam_init) {
    constexpr int KW = (MODE == 0) ? 128 : 64, VW = (MODE == 1) ? 64 : 128, NEB = VW / 32, NSUB = (MODE == 1) ? 2 : 1;
    constexpr int KSTR = KW * 2 + 16, KBYTES = 64 * KSTR, VBYTES = 64 * VW * 2, BUFB = KBYTES + VBYTES, KC = KW / 64, VC = VW / 64;
    static_assert(2 * BUFB <= MIX_WSF, "mixer LDS map");
    unsigned char* ws = a.ws; const bf16* PROJ = (const bf16*)(ws + WS_PROJ); bf16* CAT = (bf16*)(ws + WS_CAT);
    int tid = F.tid; asm volatile("" : "+v"(tid));
    const int lane = tid & 63, wave = __builtin_amdgcn_readfirstlane(tid >> 6), r32 = lane & 31, hi = lane >> 5;
    LAS unsigned char* L = F.lds + RING_OFF;
    LAS float* wsf = (LAS float*)(L + MIX_WSF) + wave * 64;
    const LAS float* lut = (const LAS float*)(F.lds + LUT_OFF);
    const int rowbase = b * SEQ;
    const int q0 = (MODE == 2) ? qb * 256 : qb * 128;
    const int rg = (MODE == 2) ? wave : (wave & 3), wsel = (MODE == 2) ? 0 : (wave >> 2);
    const int qw0 = q0 + 32 * rg;
    const int kcol = (MODE == 0) ? C_AK + hh * 128 : (MODE == 1) ? C_BK + hh * 64 : C_CK + hh * 64;
    const int vcol = (MODE == 0) ? C_AV + hh * 128 : (MODE == 1) ? C_BV + hh * 64 : C_CV + hh * 128;
    const int koff = (MODE == 0) ? wsel * 128 : 0;
    const int t_lo = (MODE == 1) ? (qb > 0 ? 2 * qb - 2 : 0) : 0, t_hi = (MODE == 2) ? 4 * qb + 4 : 2 * qb + 2;
    bf16x8 qf[NSUB][4];
#pragma unroll
    for (int s = 0; s < NSUB; ++s) {
        const int qcol = (MODE == 0) ? C_AQ + hh * 128 + wsel * 64 : (MODE == 1) ? C_BQ + (hh * 4 + wsel * 2 + s) * 64 : C_CQ + hh * 64;
        const bf16* qp = PROJ + (size_t)(rowbase + qw0 + r32) * PWP + qcol + hi * 8;
#pragma unroll
        for (int d0 = 0; d0 < 4; ++d0) qf[s][d0] = *(const bf16x8*)(qp + d0 * 16);
    }
    float m_run[NSUB], l_run[NSUB]; f32x16 o[NSUB][NEB];
#pragma unroll
    for (int s = 0; s < NSUB; ++s) {
        m_run[s] = (MODE == 1) ? a.in[5][layer * 12 + hh * 4 + wsel * 2 + s] * LOG2E : -1.0e30f; l_run[s] = (MODE == 1) ? 1.f : 0.f;
#pragma unroll
        for (int e = 0; e < NEB; ++e) o[s][e] = f32x16{};
    }
    const float lg2 = (MODE == 2) ? log2f(1.f - exp2f(-5.f - (float)hh)) : 0.f;
    v4u kreg[KC], vreg[VC];
    int kdst[KC], vdst[VC]; const bf16* ksrc[KC]; const bf16* vsrc[VC];
#pragma unroll
    for (int i = 0; i < KC; ++i) { const int c = tid + 512 * i, row = c / (KW / 8), ch = c % (KW / 8); kdst[i] = row * KSTR + ch * 16; ksrc[i] = PROJ + (size_t)(rowbase + row) * PWP + kcol + ch * 8; }
#pragma unroll
    for (int i = 0; i < VC; ++i) { const int c = tid + 512 * i, row = c / (VW / 8), ch = c % (VW / 8), e0 = ch * 8;
        vdst[i] = KBYTES + (e0 >> 5) * 4096 + (row >> 3) * 512 + (row & 7) * 64 + (e0 & 31) * 2; vsrc[i] = PROJ + (size_t)(rowbase + row) * PWP + vcol + e0; }
#define MIX_GLOAD(t) do { _Pragma("unroll") for (int i_ = 0; i_ < KC; ++i_) kreg[i_] = *(const v4u*)(ksrc[i_] + (size_t)(t) * 64 * PWP); \
                          _Pragma("unroll") for (int i_ = 0; i_ < VC; ++i_) vreg[i_] = *(const v4u*)(vsrc[i_] + (size_t)(t) * 64 * PWP); } while (0)
#define MIX_LSTORE(buf) do { _Pragma("unroll") for (int i_ = 0; i_ < KC; ++i_) *(LAS v4u*)(L + (buf) * BUFB + kdst[i_]) = kreg[i_]; \
                             _Pragma("unroll") for (int i_ = 0; i_ < VC; ++i_) *(LAS v4u*)(L + (buf) * BUFB + vdst[i_]) = vreg[i_]; } while (0)
    const int vlane = (4 * hi + ((lane & 15) >> 2)) * 64 + ((lane >> 4) & 1) * 32 + (lane & 3) * 8;
    MIX_GLOAD(t_lo); MIX_LSTORE(0);
    __syncthreads();
#pragma unroll 1
    for (int t = t_lo; t < t_hi; ++t) {
        const int cur = (t - t_lo) & 1;
        if (t + 1 < t_hi) MIX_GLOAD(t + 1);
        const LAS unsigned char* Kb = L + cur * BUFB; const LAS unsigned char* Vb = Kb + KBYTES;
        const int k0 = 64 * t;
        const bool active = (k0 <= qw0 + 31) && (MODE != 1 || k0 + 63 >= qw0 - 127);
        if (active) {
#pragma unroll
            for (int s = 0; s < NSUB; ++s) {
                f32x16 p0 = f32x16{}, p1 = f32x16{};
#pragma unroll
                for (int d0 = 0; d0 < 4; ++d0) {
                    const bf16x8 ka = *(const LAS bf16x8*)(Kb + r32 * KSTR + koff + (16 * d0 + 8 * hi) * 2);
                    const bf16x8 kb2 = *(const LAS bf16x8*)(Kb + (32 + r32) * KSTR + koff + (16 * d0 + 8 * hi) * 2);
                    p0 = __builtin_amdgcn_mfma_f32_32x32x16_bf16(ka, qf[s][d0], p0, 0, 0, 0);
                    p1 = __builtin_amdgcn_mfma_f32_32x32x16_bf16(kb2, qf[s][d0], p1, 0, 0, 0);
                }
                __builtin_amdgcn_sched_barrier(0);
                const int qi = qw0 + r32;
                if (MODE == 2) {
#pragma unroll
                    for (int r = 0; r < 16; ++r) { const int d0_ = qi - (k0 + crow(r, hi)), d1_ = d0_ - 32;
                        p0[r] = d0_ >= 0 ? p0[r] * __builtin_amdgcn_exp2f((float)d0_ * lg2) : 0.f; p1[r] = d1_ >= 0 ? p1[r] * __builtin_amdgcn_exp2f((float)d1_ * lg2) : 0.f; }
                } else {
                    const bool nearb = (MODE == 1) || (k0 + 63 + 128 > qw0);
                    if (nearb) {
                        const LAS float* lrow = lut + ((MODE == 0) ? hh : 6 + hh * 4 + wsel * 2 + s) * LUT_STRIDE;
#pragma unroll
                        for (int r = 0; r < 16; ++r) { const int d0_ = qi - (k0 + crow(r, hi)), d1_ = d0_ - 32;
                            const bool ok0 = (MODE == 0) ? (d0_ >= 0) : (d0_ >= 0 && d0_ < 128), ok1 = (MODE == 0) ? (d1_ >= 0) : (d1_ >= 0 && d1_ < 128);
                            const int i0_ = d0_ < 0 ? 0 : (d0_ > 128 ? 128 : d0_), i1_ = d1_ < 0 ? 0 : (d1_ > 128 ? 128 : d1_);
                            p0[r] = ok0 ? p0[r] + lrow[i0_] : -INFINITY; p1[r] = ok1 ? p1[r] + lrow[i1_] : -INFINITY; }
                    }
                    __builtin_amdgcn_sched_barrier(0);
                    float rm = fmaxf(p0[0], p1[0]);
#pragma unroll
                    for (int r = 1; r < 16; ++r) rm = fmaxf(rm, fmaxf(p0[r], p1[r]));
                    rm = fmaxf(rm, __shfl_xor(rm, 32));
                    if (__any(rm > m_run[s] + MIX_THR)) {
                        const float mn = fmaxf(m_run[s], rm), al = __builtin_amdgcn_exp2f(m_run[s] - mn);
                        m_run[s] = mn; l_run[s] *= al;
                        if (hi == 0) wsf[r32] = al;
                        LDS_WAIT();
#pragma unroll
                        for (int r = 0; r < 16; ++r) { const float f = wsf[crow(r, hi)];
#pragma unroll
                            for (int e = 0; e < NEB; ++e) o[s][e][r] *= f; }
                        LDS_WAIT();
                    }
                    float ls = 0.f; const float mm = m_run[s];
#pragma unroll
                    for (int r = 0; r < 16; ++r) { p0[r] = __builtin_amdgcn_exp2f(p0[r] - mm); p1[r] = __builtin_amdgcn_exp2f(p1[r] - mm); ls += p0[r] + p1[r]; }
                    l_run[s] += ls;
                }
                __builtin_amdgcn_sched_barrier(0);
#pragma unroll
                for (int kb = 0; kb < 2; ++kb)
#pragma unroll
                    for (int s2 = 0; s2 < 2; ++s2) {
                        const bf16x8 pa = pack_p(kb == 0 ? p0 : p1, s2);
#pragma unroll
                        for (int e = 0; e < NEB; ++e) {
                            const LAS unsigned char* vp = Vb + e * 4096 + (4 * kb + 2 * s2) * 512 + vlane;
                            const s16x4 lo = vtr(vp), hh2 = vtr(vp + 512);
                            const bf16x8 vb = (bf16x8){lo[0], lo[1], lo[2], lo[3], hh2[0], hh2[1], hh2[2], hh2[3]};
                            o[s][e] = __builtin_amdgcn_mfma_f32_32x32x16_bf16(pa, vb, o[s][e], 0, 0, 0);
                        }
                        __builtin_amdgcn_sched_barrier(0);
                    }
            }
        }
        if (t + 1 < t_hi) MIX_LSTORE(cur ^ 1);
        __syncthreads();
    }
#undef MIX_GLOAD
#undef MIX_LSTORE
    if (MODE == 1) {
#pragma unroll
        for (int s = 0; s < NSUB; ++s) {
            const float sink2 = a.in[5][layer * 12 + hh * 4 + wsel * 2 + s] * LOG2E;
            const float lt = l_run[s] + __shfl_xor(l_run[s], 32) - __builtin_amdgcn_exp2f(sink2 - m_run[s]);
            if (hi == 0) wsf[r32] = 1.f / lt;
            LDS_WAIT();
            bf16* orow = CAT + (size_t)(rowbase + qw0) * DM + 768 + (hh * 4 + wsel * 2 + s) * 64 + r32;
#pragma unroll
            for (int r = 0; r < 16; ++r) { const int qr = crow(r, hi); const float f = wsf[qr];
#pragma unroll
                for (int e = 0; e < NEB; ++e) orow[(size_t)qr * DM + 32 * e] = (bf16)f2bf(o[s][e][r] * f); }
            LDS_WAIT();
        }
    } else if (MODE == 2) {
        const bf16* grow = PROJ + (size_t)(rowbase + qw0) * PWP + C_CG + hh * 128 + r32;
        bf16* orow = CAT + (size_t)(rowbase + qw0) * DM + 1536 + hh * 128 + r32;
#pragma unroll
        for (int r = 0; r < 16; ++r) {
            float s1 = 0.f;
#pragma unroll
            for (int e = 0; e < NEB; ++e) s1 += o[0][e][r];
#pragma unroll
            for (int sh = 1; sh < 32; sh <<= 1) s1 += __shfl_xor(s1, sh);
            const float mu = s1 * (1.f / 128.f); float s2 = 0.f;
#pragma unroll
            for (int e = 0; e < NEB; ++e) { const float d = o[0][e][r] - mu; s2 += d * d; }
#pragma unroll
            for (int sh = 1; sh < 32; sh <<= 1) s2 += __shfl_xor(s2, sh);
            const float rs = 1.f / sqrtf(s2 * (1.f / 128.f) + LN_EPS); const int qr = crow(r, hi);
#pragma unroll
            for (int e = 0; e < NEB; ++e) orow[(size_t)qr * DM + 32 * e] = (bf16)f2bf(pg8::silu_f(bf2f(grow[(size_t)qr * PWP + 32 * e])) * (o[0][e][r] - mu) * rs);
        }
    } else {
        const float lt = l_run[0] + __shfl_xor(l_run[0], 32);
        if (hi == 0) wsf[r32] = 1.f / lt;
        LDS_WAIT();
        LAS float* xb = (LAS float*)L + rg * 4096;
        if (wsel == 1) {
#pragma unroll
            for (int r = 0; r < 16; ++r) { const float f = wsf[crow(r, hi)];
#pragma unroll
                for (int e = 0; e < NEB; ++e) xb[(e * 16 + r) * 64 + lane] = o[0][e][r] * f; }
        }
        __syncthreads();
        if (wsel == 0) {
            const float* subg = a.in[4] + layer * 128; const float post = 1.f - lam_init;
            bf16* orow = CAT + (size_t)(rowbase + qw0) * DM + hh * 128 + r32;
#pragma unroll
            for (int r = 0; r < 16; ++r) { const float f = wsf[crow(r, hi)]; float d[NEB]; float ss = 0.f;
#pragma unroll
                for (int e = 0; e < NEB; ++e) { d[e] = o[0][e][r] * f - lam * xb[(e * 16 + r) * 64 + lane]; ss += d[e] * d[e]; }
#pragma unroll
                for (int sh = 1; sh < 32; sh <<= 1) ss += __shfl_xor(ss, sh);
                const float rs = (1.f / sqrtf(ss * (1.f / 128.f) + LN_EPS)) * post; const int qr = crow(r, hi);
#pragma unroll
                for (int e = 0; e < NEB; ++e) orow[(size_t)qr * DM + 32 * e] = (bf16)f2bf(d[e] * rs * subg[32 * e + r32]); }
        }
    }
    __syncthreads();
}
__device__ __forceinline__ void mixer_phase(Frame& F, const Args& a, int layer, int rep) {
    const float lam_init = 0.8f - 0.6f * __expf(-0.3f * (float)layer);
    const float lam = lambda_of(a.in[3] + layer * 256, F.lane, lam_init);
    LAS int* qw = (LAS int*)(F.lds + RING_OFF + MIX_QW);
    for (;;) {
        if (F.tid == 0) *qw = (int)__hip_atomic_fetch_add(F.ctl + CW_WQ + 64 * (layer + 2 * rep), 1u, RLX_AGENT);
        __syncthreads();
        const int it = __builtin_amdgcn_readfirstlane(*qw);
        __syncthreads();
        if (it >= 1408) break;
        int mode, ub, uh, uq;
        if (it < 1024) {
            const int j = it >> 7, r = it & 127;
            if (r < 48) { mode = 0; ub = r / 6; uh = r % 6; uq = 15 - 2 * j; }
            else if (r < 80) { mode = 2; ub = (r - 48) >> 2; uh = (r - 48) & 3; uq = 7 - j; }
            else { mode = 0; ub = (r - 80) / 6; uh = (r - 80) % 6; uq = 14 - 2 * j; }
        } else { const int r = it - 1024; mode = 1; ub = r / 48; uh = (r % 48) / 16; uq = r & 15; }
        if (mode == 0) mix_unit<0>(F, a, layer, ub, uh, uq, lam, lam_init);
        else if (mode == 2) mix_unit<2>(F, a, layer, ub, uh, uq, lam, lam_init);
        else mix_unit<1>(F, a, layer, ub, uh, uq, lam, lam_init);
    }
}
#ifndef MIXER_NAIVE
#define MIXER_NAIVE 0
#endif
#ifndef PROBE_P0
#define PROBE_P0 1
#endif
#ifndef PROBE_MIX
#define PROBE_MIX 1
#endif
#ifndef PROBE_PROJ
#define PROBE_PROJ 1
#endif
#ifndef PROBE_DUP
#define PROBE_DUP 1
#endif
#ifndef PROBE_MUP
#define PROBE_MUP 1
#endif
#ifndef PROBE_MDN
#define PROBE_MDN 1
#endif
#define REPEAT(N) for (int rep = 0; rep < (N); ++rep)
#define TWICE_IF(N, CALL) do { CALL; if ((N) == 2) { xcd_barrier(bar); CALL; } } while (0)
#define REPBAR(N) do { if (rep + 1 < (N)) xcd_barrier(bar); } while (0)
#define IN(k) (lo <= (k) && (k) < hi)
#define SEAM(k) do { if (IN(k) && IN((k) + 1)) xcd_barrier(bar); } while (0)
template <int l> __device__ __forceinline__ void run_layer(Frame& F, const Args& args, const XcdBarrier& bar, int lo, int hi) {
    unsigned char* ws = args.ws;
    bf16* XB = (bf16*)(ws + WS_XB); bf16* PROJ = (bf16*)(ws + WS_PROJ); bf16* CAT = (bf16*)(ws + WS_CAT); bf16* HB = (bf16*)(ws + WS_H);
    float* T = args.out;
        const int pb = 1 + 7 * l;
        if (IN(pb)) {
            pg8::Gemm g{XB, (const bf16*)(ws + WS_WIN) + (size_t)l * PWP * DM, NTOK, PWP, DM * 2}; pg8::StaticOrder S; S.init(NTOK, PWP, F.G, (int)blockIdx.x);
            pg8::EpiProj E{PROJ, (const float*)(ws + WS_TAB), (const float*)(ws + WS_TAB + 256 * 1024)};
            TWICE_IF(PROBE_PROJ, (pg8::gemm_phase<pg8::EpiProj, pg8::StaticOrder, true, true>(F.lds + RING_OFF, g, S, E)));
        } SEAM(pb);
        if (IN(pb + 1)) {
#if MIXER_NAIVE
            naive_mixers(F, args, l);
#else
            REPEAT(PROBE_MIX) { mixer_phase(F, args, l, rep); REPBAR(PROBE_MIX); }
#endif
        } SEAM(pb + 1);
        if (IN(pb + 2)) {
            pg8::Gemm g{CAT, (const bf16*)(ws + WS_WOUT) + (size_t)l * DM * DM, NTOK, DM, DM * 2}; pg8::StaticOrder S; S.init(NTOK, DM, F.G, (int)blockIdx.x);
            pg8::EpiResid E{T, l == 0 ? args.in[0] : T};
            pg8::gemm_phase<pg8::EpiResid, pg8::StaticOrder, true, true>(F.lds + RING_OFF, g, S, E);
        } SEAM(pb + 2);
        if constexpr (l == 0) {
            if (IN(4)) { ln_phase<0>(F, args, T, args.in[7], args.in[8], nullptr); } SEAM(4);
            if (IN(5)) {
                pg8::Gemm g{XB, (const bf16*)(ws + WS_WDGU), NTOK, 2 * DFF, DM * 2}; pg8::StaticOrder S; S.init(NTOK, 2 * DFF, F.G, (int)blockIdx.x);
                pg8::EpiSwiGLU E{HB, 44};
                TWICE_IF(PROBE_DUP, (pg8::gemm_phase<pg8::EpiSwiGLU, pg8::StaticOrder, true, true>(F.lds + RING_OFF, g, S, E)));
            } SEAM(5);
            if (IN(6)) {
                pg8::Gemm g{HB, (const bf16*)(ws + WS_WDDN), NTOK, DM, DFF * 2}; pg8::StaticOrder S; S.init(NTOK, DM, F.G, (int)blockIdx.x);
                pg8::EpiResid E{T, T};
                pg8::gemm_phase<pg8::EpiResid, pg8::StaticOrder, true, true>(F.lds + RING_OFF, g, S, E);
            } SEAM(6);
            if (IN(7)) { ln_phase<0>(F, args, T, args.in[9], args.in[10], nullptr); } SEAM(7);
        } else {
            if (IN(11)) { ln_phase<1>(F, args, T, args.in[7] + DM, args.in[8] + DM, args.in[14]); } SEAM(11);
            if (IN(12)) { gather_phase(F, args, T); } SEAM(12);
            if (IN(13) || IN(14)) {
                int ntl_v; const int offv = expert_offsets(F, ntl_v); const int ntl = __builtin_amdgcn_readfirstlane(ntl_v);
                pg8::GroupedOrder S; S.nM = ntl; S.G = F.G; S.c = (int)blockIdx.x;
#pragma unroll
                for (int e = 0; e < 8; ++e) S.cum[e] = (e < 7) ? __builtin_amdgcn_readfirstlane(__shfl(offv, e + 1) >> 8) : ntl;
                if (IN(13)) {
                    S.nN = 44; S.nwg = ntl * 44;
                    pg8::Gemm g{ws + WS_XG, ws + WS_WMGU, ntl * 256, 8 * 2 * DFF, DM};
                    pg8::EpiSwiGLU8 E{ws + WS_H, 44};
                    TWICE_IF(PROBE_MUP, (pg8::gemm_phase<pg8::EpiSwiGLU8, pg8::GroupedOrder, true, true, true>(F.lds + RING_OFF, g, S, E)));
                } SEAM(13);
                if (IN(14)) {
                    S.nN = 8; S.nwg = ntl * 8;
                    pg8::Gemm g{ws + WS_H, ws + WS_WMDN, ntl * 256, 8 * DM, DFF};
                    pg8::EpiY E{(bf16*)(ws + WS_Y), 8, 1.f / (pg8::FP8_SH * pg8::FP8_SWD)};
                    TWICE_IF(PROBE_MDN, (pg8::gemm_phase<pg8::EpiY, pg8::GroupedOrder, true, true, true>(F.lds + RING_OFF, g, S, E)));
                } SEAM(14);
            }
            if (IN(15)) { ln_phase<2>(F, args, T, args.in[9] + DM, args.in[10] + DM, nullptr); }
        }
}
constexpr int N_PHASES = 16;
__global__ void __launch_bounds__(NWAVES * 64, 2) hymba_fwd(Args args) {
    extern __shared__ __attribute__((aligned(16))) unsigned char lds[];
    Frame F;
    F.lds = (LAS unsigned char*)lds;
    volatile LAS unsigned* MISC = (volatile LAS unsigned*)(F.lds + MISC_OFF);
    F.tid = threadIdx.x; F.lane = F.tid & 63; F.wave = __builtin_amdgcn_readfirstlane(F.tid >> 6);
    F.G = gridDim.x; { const int bx = blockIdx.x; F.vcu = (F.G % 8 == 0) ? (bx % 8) * (F.G / 8) + bx / 8 : bx; }
    unsigned char* ws = args.ws;
    F.ctl = (gu32*)(ws + WS_CTL);
    for (int u = F.tid; u < 1024 / 4; u += NWAVES * 64) ((LAS unsigned*)(F.lds + LDSCTL_OFF))[u] = 0u;
    __syncthreads();
    XcdBarrier bar = xcd_barrier_post((unsigned*)(F.ctl + CW_BAR) + args.li * 4096, MISC + 8);
    build_lut(F, args.in[2]);
    __syncthreads();
    const int lo = args.ph_lo, hi = args.ph_hi;
    if (IN(0)) { REPEAT(PROBE_P0) { p0_prologue(F, args); REPBAR(PROBE_P0); } } SEAM(0);
    run_layer<0>(F, args, bar, lo, hi);
    run_layer<1>(F, args, bar, lo, hi);
#undef IN
#undef SEAM
}

#ifndef N_LAUNCHES
#define N_LAUNCHES 1
#endif
extern "C" void kernel_launch(void* const* d_in, const int* in_sizes, int n_in, void* d_out, int out_size, void* d_ws, size_t ws_size, hipStream_t stream) {
    static int grid = 0;
    if (grid == 0) {
        if (n_in != 18 || in_sizes[0] != NTOK * DM || out_size != NTOK * DM || ws_size < WS_END) { fprintf(stderr, "kernel_launch: unexpected shapes / workspace (%d inputs, ws %zu < %zu)\n", n_in, ws_size, (size_t)WS_END); grid = -1; return; }
        int dev = 0, cus = 0, per_cu = 0;
        if (hipGetDevice(&dev) != hipSuccess || hipDeviceGetAttribute(&cus, hipDeviceAttributeMultiprocessorCount, dev) != hipSuccess) { grid = -1; return; }
        if (hipFuncSetAttribute((const void*)hymba_fwd, hipFuncAttributeMaxDynamicSharedMemorySize, LDS_BYTES) != hipSuccess) { fprintf(stderr, "kernel_launch: hipFuncSetAttribute failed\n"); grid = -1; return; }
        if (hipOccupancyMaxActiveBlocksPerMultiprocessor(&per_cu, (const void*)hymba_fwd, NWAVES * 64, LDS_BYTES) != hipSuccess || per_cu < 1) fprintf(stderr, "kernel_launch: occupancy query reports %d\n", per_cu);
        (void)hipGetLastError();
        grid = (cus == 256) ? 256 : -1;
        if (grid < 0) { fprintf(stderr, "kernel_launch: built for a 256-CU device, found %d CUs\n", cus); return; }
    }
    if (grid < 0) return;
    if (hipMemsetAsync((char*)d_ws + WS_CTL, 0, CTL_ZERO_BYTES, stream) != hipSuccess) return;
    Args a{};
    for (int i = 0; i < 18; ++i) a.in[i] = (const float*)d_in[i];
    a.out = (float*)d_out; a.ws = (unsigned char*)d_ws;
    for (int i = 0; i < 32; ++i) a.invf[i] = (float)(1.0 / pow(10000.0, (double)((float)i / 31.0f)));
#if N_LAUNCHES == 1
    const int cuts[2] = {0, N_PHASES};
#else
    int cuts[N_PHASES + 1]; for (int i = 0; i <= N_PHASES; ++i) cuts[i] = i;
#endif
    const int nl = (N_LAUNCHES == 1) ? 1 : N_PHASES;
    for (int li = 0; li < nl; ++li) {
        a.ph_lo = cuts[li]; a.ph_hi = cuts[li + 1]; a.li = li; a.pad = 0;
        hipLaunchKernelGGL(hymba_fwd, dim3(grid), dim3(NWAVES * 64), LDS_BYTES, stream, a);
        const hipError_t le = hipPeekAtLastError();
        if (le != hipSuccess) { fprintf(stderr, "kernel_launch: launch %d failed: %s\n", li, hipGetErrorName(le)); break; }
    }
}
```

```cpp
#include <hip/hip_runtime.h>
#include <cstdio>
#include <cstdint>
#include <cmath>
namespace pg8 {
#define PG8_LAS __attribute__((address_space(3)))
typedef unsigned short bf16_t;
typedef short bf16x8 __attribute__((ext_vector_type(8)));
typedef float f32x4 __attribute__((ext_vector_type(4)));
typedef unsigned u32x4 __attribute__((ext_vector_type(4)));
constexpr int BM = 256, BK = 64, HALF = 128, HTB = HALF * BK * 2  , STAGE_BYTES = 8 * HTB, NXCD = 8, WGM = 8;

__host__ __device__ __forceinline__ int lds_byte(int r, int c) { const int st = (r >> 4) * 2 + (c >> 5), rr = r & 15, cc = c & 31, ob = rr * 64 + cc * 2; return st * 1024 + (ob ^ (((ob >> 9) & 1) << 5)); }
__host__ __device__ __forceinline__ void stage_rc(int b, int& R, int& C) { const int st = b / 1024, sb = b % 1024, swz = sb ^ (((sb >> 9) & 1) << 5); R = (st >> 1) * 16 + swz / 64; C = (st & 1) * 32 + (swz % 64) / 2; }
__host__ __device__ __forceinline__ int perm32(int rho) { const int n = rho >> 4, i = rho & 15; return 8 * (i >> 2) + 4 * n + (i & 3); }

struct Unit { int pm, pn; };
struct Gemm { const void* A; const void* Bt; int M, N, KB; };
typedef int v4i_t __attribute__((ext_vector_type(4)));
typedef int v8i_t __attribute__((ext_vector_type(8)));

struct StaticOrder {
    int nM, nN, nwg, G, c;
    __host__ __device__ void init(int M, int N, int G_, int c_) { nM = M / BM; nN = N / BM; nwg = nM * nN; G = G_; c = c_; }
    __host__ __device__ bool next(int i, Unit& u) const {
        const long L = (long)i * G + c; if (L >= nwg) return false;
        int wgid = (int)L; { const int q = nwg / NXCD, r = nwg % NXCD, xcd = wgid % NXCD, off = wgid / NXCD; wgid = (xcd < r ? xcd * (q + 1) : r * (q + 1) + (xcd - r) * q) + off; }
        const int nig = WGM * nN, gid = wgid / nig, fm = gid * WGM, gsz = (nM - fm) < WGM ? (nM - fm) : WGM;
        u.pm = fm + ((wgid % nig) % gsz); u.pn = (wgid % nig) / gsz; return true;
    }
    __device__ __forceinline__ void a_ready(const Unit&) const {}
    __device__ __forceinline__ void done(const Unit&) const {}
};

__device__ __forceinline__ unsigned cvt_pk_bf16(float lo, float hi) { unsigned r; asm volatile("v_cvt_pk_bf16_f32 %0, %1, %2" : "=v"(r) : "v"(lo), "v"(hi)); return r; }
typedef float f32x2 __attribute__((ext_vector_type(2)));
typedef float f32x2 __attribute__((ext_vector_type(2)));
typedef unsigned u32x2 __attribute__((ext_vector_type(2)));
constexpr float ALPHA_F = 1.41421356237309515f;
constexpr float C2_F = 0.125f * 1.4426950408889634f;
__device__ __forceinline__ u32x4 pack8(const f32x4 v0, const f32x4 v1) { u32x4 w; w.x = cvt_pk_bf16(v0[0], v0[1]); w.y = cvt_pk_bf16(v0[2], v0[3]); w.z = cvt_pk_bf16(v1[0], v1[1]); w.w = cvt_pk_bf16(v1[2], v1[3]); return w; }

struct EpiProj {
    static constexpr bool PERM = true, AFTER_DRAIN = false;
    bf16_t* O; const float* sinT; const float* cosT;
    __device__ __forceinline__ void operator()(const f32x4 (&acc)[2][2][4][2], const Unit& u, int wr, int wc, int fr, int fq) const {
        const int row0 = u.pm * BM + wr * 64 + fr;
#pragma unroll
        for (int bj = 0; bj < 2; ++bj) {
            const int cw = u.pn * BM + bj * HALF + wc * 32;
            const int c0 = cw + 8 * fq;
            float sc = 1.f; bool rope = false;
            if (cw < 768 || (cw >= 2304 && cw < 3072)) sc = C2_F;
            else if (cw >= 3456 && cw < 3968) { rope = true; if (cw >= 3712) sc = 0.125f; }
            const int i0 = ((c0 - 3456) & 63) >> 1;
#pragma unroll
            for (int ai = 0; ai < 2; ++ai)
#pragma unroll
                for (int m = 0; m < 4; ++m) {
                    const int row = row0 + ai * HALF + m * 16;
                    f32x4 v0 = acc[ai][bj][m][0] * sc, v1 = acc[ai][bj][m][1] * sc;
                    if (rope) {
                        const int pos = row & 2047;
                        const f32x4 sn = *(const f32x4*)(sinT + pos * 32 + i0), cs = *(const f32x4*)(cosT + pos * 32 + i0);
                        f32x4 w0, w1;
                        w0[0] = v0[0] * cs[0] - v0[1] * sn[0]; w0[1] = v0[1] * cs[0] + v0[0] * sn[0];
                        w0[2] = v0[2] * cs[1] - v0[3] * sn[1]; w0[3] = v0[3] * cs[1] + v0[2] * sn[1];
                        w1[0] = v1[0] * cs[2] - v1[1] * sn[2]; w1[1] = v1[1] * cs[2] + v1[0] * sn[2];
                        w1[2] = v1[2] * cs[3] - v1[3] * sn[3]; w1[3] = v1[3] * cs[3] + v1[2] * sn[3];
                        v0 = w0; v1 = w1;
                    }
                    *(u32x4*)(O + (size_t)row * 5120 + c0) = pack8(v0, v1);
                }
        }
    }
};
struct EpiResid {
    static constexpr bool PERM = true, AFTER_DRAIN = false;
    float* T; const float* R;
    __device__ __forceinline__ void operator()(const f32x4 (&acc)[2][2][4][2], const Unit& u, int wr, int wc, int fr, int fq) const {
        const int row0 = u.pm * BM + wr * 64 + fr, col0 = u.pn * BM + wc * 32 + 8 * fq;
#pragma unroll
        for (int ai = 0; ai < 2; ++ai)
#pragma unroll
            for (int m = 0; m < 4; ++m) {
                const size_t ro = (size_t)(row0 + ai * HALF + m * 16) * 2048 + col0;
#pragma unroll
                for (int bj = 0; bj < 2; ++bj) {
                    const f32x4 r0 = *(const f32x4*)(R + ro + bj * HALF), r1 = *(const f32x4*)(R + ro + bj * HALF + 4);
                    *(f32x4*)(T + ro + bj * HALF) = r0 * ALPHA_F + acc[ai][bj][m][0];
                    *(f32x4*)(T + ro + bj * HALF + 4) = r1 * ALPHA_F + acc[ai][bj][m][1];
                }
            }
    }
};
__device__ __forceinline__ float silu_f(float x) { return x * __builtin_amdgcn_rcpf(1.f + __builtin_amdgcn_exp2f(-1.4426950408889634f * x)); }
struct EpiSwiGLU {
    static constexpr bool PERM = true, AFTER_DRAIN = false;
    bf16_t* H; int ntn;
    __device__ __forceinline__ void operator()(const f32x4 (&acc)[2][2][4][2], const Unit& u, int wr, int wc, int fr, int fq) const {
        const int row0 = u.pm * BM + wr * 64 + fr, col0 = (u.pn % ntn) * HALF + wc * 32 + 8 * fq;
#pragma unroll
        for (int ai = 0; ai < 2; ++ai)
#pragma unroll
            for (int m = 0; m < 4; ++m) {
                f32x4 h0, h1;
#pragma unroll
                for (int j = 0; j < 4; ++j) { h0[j] = silu_f(acc[ai][0][m][0][j]) * acc[ai][1][m][0][j]; h1[j] = silu_f(acc[ai][0][m][1][j]) * acc[ai][1][m][1][j]; }
                *(u32x4*)(H + (size_t)(row0 + ai * HALF + m * 16) * 5632 + col0) = pack8(h0, h1);
            }
    }
};
constexpr float FP8_SX = 16.f, FP8_SWU = 512.f, FP8_SH = 8.f, FP8_SWD = 2048.f;
__device__ __forceinline__ unsigned pack4_fp8(float a, float b, float c, float d) {
    a = __builtin_amdgcn_fmed3f(a, -448.f, 448.f); b = __builtin_amdgcn_fmed3f(b, -448.f, 448.f); c = __builtin_amdgcn_fmed3f(c, -448.f, 448.f); d = __builtin_amdgcn_fmed3f(d, -448.f, 448.f);
    int w = __builtin_amdgcn_cvt_pk_fp8_f32(a, b, 0, false); w = __builtin_amdgcn_cvt_pk_fp8_f32(c, d, w, true); return (unsigned)w;
}
struct EpiSwiGLU8 {
    static constexpr bool PERM = true, AFTER_DRAIN = false;
    unsigned char* H; int ntn;
    __device__ __forceinline__ void operator()(const f32x4 (&acc)[2][2][4][2], const Unit& u, int wr, int wc, int fr, int fq) const {
        const int row0 = u.pm * BM + wr * 64 + fr, col0 = (u.pn % ntn) * HALF + wc * 32 + 8 * fq;
        constexpr float si = 1.f / (FP8_SX * FP8_SWU);
#pragma unroll
        for (int ai = 0; ai < 2; ++ai)
#pragma unroll
            for (int m = 0; m < 4; ++m) {
                f32x4 h0, h1;
#pragma unroll
                for (int j = 0; j < 4; ++j) { h0[j] = silu_f(acc[ai][0][m][0][j] * si) * (acc[ai][1][m][0][j] * (si * FP8_SH)); h1[j] = silu_f(acc[ai][0][m][1][j] * si) * (acc[ai][1][m][1][j] * (si * FP8_SH)); }
                u32x2 w; w.x = pack4_fp8(h0[0], h0[1], h0[2], h0[3]); w.y = pack4_fp8(h1[0], h1[1], h1[2], h1[3]);
                *(u32x2*)(H + (size_t)(row0 + ai * HALF + m * 16) * 5632 + col0) = w;
            }
    }
};
struct EpiY {
    static constexpr bool PERM = true, AFTER_DRAIN = false;
    bf16_t* Y; int ntn; float scale;
    __device__ __forceinline__ void operator()(const f32x4 (&acc)[2][2][4][2], const Unit& u, int wr, int wc, int fr, int fq) const {
        const int row0 = u.pm * BM + wr * 64 + fr, col0 = (u.pn % ntn) * BM + wc * 32 + 8 * fq;
#pragma unroll
        for (int ai = 0; ai < 2; ++ai)
#pragma unroll
            for (int m = 0; m < 4; ++m)
#pragma unroll
                for (int bj = 0; bj < 2; ++bj)
                    *(u32x4*)(Y + (size_t)(row0 + ai * HALF + m * 16) * 2048 + col0 + bj * HALF) = pack8(acc[ai][bj][m][0] * scale, acc[ai][bj][m][1] * scale);
    }
};
struct GroupedOrder {
    int nM, nN, nwg, G, c; int cum[8];
    __device__ __forceinline__ bool next(int i, Unit& u) const {
        const long L = (long)i * G + c; if (L >= nwg) return false;
        int wgid = (int)L; { const int q = nwg / NXCD, r = nwg % NXCD, xcd = wgid % NXCD, off = wgid / NXCD; wgid = (xcd < r ? xcd * (q + 1) : r * (q + 1) + (xcd - r) * q) + off; }
        const int nig = WGM * nN, gid = wgid / nig, fm = gid * WGM, gsz = (nM - fm) < WGM ? (nM - fm) : WGM;
        const int pm = fm + ((wgid % nig) % gsz), pn = (wgid % nig) / gsz;
        int e = 0;
#pragma unroll
        for (int j = 0; j < 7; ++j) e += (pm >= cum[j]) ? 1 : 0;
        u.pm = pm; u.pn = e * nN + pn; return true;
    }
    __device__ __forceinline__ void a_ready(const Unit&) const {}
    __device__ __forceinline__ void done(const Unit&) const {}
};
template <class Epi, class Sched, bool ALIGN_EPI = false, bool SP2 = false, bool FP8 = false>
__device__ __forceinline__ void gemm_phase(PG8_LAS unsigned char* lds, const int wid, const Gemm g, const Sched& S, const Epi& E) {
    const int lane = (int)__builtin_amdgcn_mbcnt_hi(~0u, __builtin_amdgcn_mbcnt_lo(~0u, 0u)), tid = wid * 64 + lane,
        wr = wid >> 2, wc = wid & 3, fr = lane & 15, fq = lane >> 4;
    const int KB = g.KB, nt = KB / 128;
    unsigned voffA[2], voffB[2];
#pragma unroll
    for (int i = 0; i < 2; ++i) { int R, C; stage_rc(tid * 16 + i * 8192, R, C); const int Rb = Epi::PERM ? ((R & ~31) + perm32(R & 31)) : R;
        voffA[i] = (unsigned)(R * KB + C * 2); voffB[i] = (unsigned)(Rb * KB + C * 2); }
    const size_t kstep = (size_t)128;
    const size_t hstep = (size_t)HALF * KB;
    const size_t tstep = 2 * hstep;
    const unsigned ldsw = (unsigned)wid * 1024u;
    const int aoff = lds_byte(wr * 64 + fr, fq * 8), boff = lds_byte(wc * 32 + fr, fq * 8);
#define PG8_SA(b, h) (((b) * 2 + (h)) * HTB)
#define PG8_SB(b, h) ((4 + (b) * 2 + (h)) * HTB)
#define PG8_STAGE(bufoff, gbase, voff) do { _Pragma("unroll") for (int _i = 0; _i < 2; ++_i) \
        __builtin_amdgcn_global_load_lds((const unsigned*)((const char*)(gbase) + (voff)[_i]), (PG8_LAS unsigned*)(lds + (bufoff) + ldsw + _i * 8192), 16, 0, 0); } while (0)
#define PG8_LDA(dst, b, h) do { _Pragma("unroll") for (int m = 0; m < 4; ++m) _Pragma("unroll") for (int k = 0; k < 2; ++k) dst[m][k] = *(const PG8_LAS bf16x8*)(lds + PG8_SA(b, h) + aoff + m * 2048 + k * 1024); } while (0)
#define PG8_LDB(dst, b, h) do { _Pragma("unroll") for (int n = 0; n < 2; ++n) _Pragma("unroll") for (int k = 0; k < 2; ++k) dst[n][k] = *(const PG8_LAS bf16x8*)(lds + PG8_SB(b, h) + boff + n * 2048 + k * 1024); } while (0)
#define PG8_MMA(ai, bj, At, Bt) do { __builtin_amdgcn_s_setprio(1); _Pragma("unroll") for (int m = 0; m < 4; ++m) _Pragma("unroll") for (int n = 0; n < 2; ++n) { \
        if constexpr (FP8) { const v4i_t b0_ = __builtin_bit_cast(v4i_t, Bt[n][0]), b1_ = __builtin_bit_cast(v4i_t, Bt[n][1]), a0_ = __builtin_bit_cast(v4i_t, At[m][0]), a1_ = __builtin_bit_cast(v4i_t, At[m][1]); \
            const v8i_t b8_ = __builtin_shufflevector(b0_, b1_, 0, 1, 2, 3, 4, 5, 6, 7), a8_ = __builtin_shufflevector(a0_, a1_, 0, 1, 2, 3, 4, 5, 6, 7); \
            asm volatile("v_mfma_f32_16x16x128_f8f6f4 %0, %1, %2, %0" : "+v"(acc[ai][bj][m][n]) : "v"(b8_), "v"(a8_)); } \
        else { _Pragma("unroll") for (int k = 0; k < 2; ++k) acc[ai][bj][m][n] = __builtin_amdgcn_mfma_f32_16x16x32_bf16(Bt[n][k], At[m][k], acc[ai][bj][m][n], 0, 0, 0); } } __builtin_amdgcn_s_setprio(0); } while (0)
#define PG8_WAIT_V(n) asm volatile("s_waitcnt vmcnt(" #n ")" ::: "memory")
#define PG8_WAIT_L(n) asm volatile("s_waitcnt lgkmcnt(" #n ")" ::: "memory")
#define PG8_BAR __builtin_amdgcn_s_barrier()
#define PG8_SCHED __builtin_amdgcn_sched_barrier(0)
    Unit cur, nxt; int ui = 0;
    if (!S.next(0, cur)) return;
    f32x4 acc[2][2][4][2];
#pragma unroll
    for (int a = 0; a < 2; ++a)
#pragma unroll
        for (int b = 0; b < 2; ++b)
#pragma unroll
            for (int m = 0; m < 4; ++m)
#pragma unroll
                for (int n = 0; n < 2; ++n) acc[a][b][m][n] = (f32x4){0.f, 0.f, 0.f, 0.f};
    bf16x8 At[4][2], B0[2][2], B1[2][2];
    const char* cA = (const char*)g.A + (size_t)cur.pm * tstep; const char* cB = (const char*)g.Bt + (size_t)cur.pn * tstep;
    S.a_ready(cur);
    if constexpr (SP2) {
        PG8_STAGE(PG8_SB(0, 0), cB, voffB); PG8_STAGE(PG8_SB(0, 1), cB + hstep, voffB); PG8_STAGE(PG8_SA(0, 0), cA, voffA); PG8_STAGE(PG8_SA(0, 1), cA + hstep, voffA);
        if (wr == 1) PG8_BAR;
        PG8_WAIT_V(2); PG8_BAR;
        PG8_STAGE(PG8_SB(1, 0), cB + kstep, voffB); PG8_STAGE(PG8_SA(1, 0), cA + kstep, voffA); PG8_STAGE(PG8_SB(1, 1), cB + hstep + kstep, voffB);
        PG8_WAIT_V(6); PG8_BAR;
    } else {
        PG8_STAGE(PG8_SB(0, 0), cB, voffB); PG8_STAGE(PG8_SA(0, 0), cA, voffA); PG8_STAGE(PG8_SB(0, 1), cB + hstep, voffB); PG8_STAGE(PG8_SA(0, 1), cA + hstep, voffA);
        if (wr == 1) PG8_BAR;
        PG8_WAIT_V(4); PG8_BAR;
        PG8_STAGE(PG8_SB(1, 0), cB + kstep, voffB); PG8_STAGE(PG8_SA(1, 0), cA + kstep, voffA); PG8_STAGE(PG8_SB(1, 1), cB + hstep + kstep, voffB);
        PG8_WAIT_V(6); PG8_BAR;
    }
    for (;;) {
        const bool has_next = S.next(ui + 1, nxt);
        const char* nA = has_next ? (const char*)g.A + (size_t)nxt.pm * tstep : cA; const char* nB = has_next ? (const char*)g.Bt + (size_t)nxt.pn * tstep : cB;
        for (int t = 0; t < nt; t += 2) {
            const bool last = (t == nt - 2);
            const char* a1 = cA + (size_t)(t + 1) * kstep;
            const char* a2 = last ? nA : cA + (size_t)(t + 2) * kstep; const char* b2 = last ? nB : cB + (size_t)(t + 2) * kstep;
            const char* a3 = a2 + kstep; const char* b3 = b2 + kstep;
            if (last && has_next) S.a_ready(nxt);
            if constexpr (SP2) {
            PG8_LDB(B0, 0, 0); PG8_LDB(B1, 0, 1); PG8_SCHED; PG8_LDA(At, 0, 0); PG8_STAGE(PG8_SA(1, 1), a1 + hstep, voffA);
            PG8_WAIT_V(8); PG8_WAIT_L(0); PG8_BAR; PG8_MMA(0, 0, At, B0); PG8_MMA(0, 1, At, B1); PG8_BAR; PG8_SCHED;
            PG8_LDA(At, 0, 1); PG8_STAGE(PG8_SB(0, 0), b2, voffB); PG8_STAGE(PG8_SB(0, 1), b2 + hstep, voffB); PG8_STAGE(PG8_SA(0, 0), a2, voffA);
            PG8_WAIT_V(8); PG8_WAIT_L(0); PG8_BAR; PG8_MMA(1, 0, At, B0); PG8_MMA(1, 1, At, B1); PG8_BAR; PG8_SCHED;
            PG8_LDB(B0, 1, 0); PG8_LDB(B1, 1, 1); PG8_SCHED; PG8_LDA(At, 1, 0); PG8_STAGE(PG8_SA(0, 1), a2 + hstep, voffA);
            PG8_WAIT_V(8); PG8_WAIT_L(0); PG8_BAR; PG8_MMA(0, 0, At, B0); PG8_MMA(0, 1, At, B1); PG8_BAR; PG8_SCHED;
            PG8_LDA(At, 1, 1); PG8_STAGE(PG8_SB(1, 0), b3, voffB); PG8_STAGE(PG8_SB(1, 1), b3 + hstep, voffB); PG8_STAGE(PG8_SA(1, 0), a3, voffA);
            PG8_WAIT_V(8); PG8_WAIT_L(0); PG8_BAR; PG8_MMA(1, 0, At, B0); PG8_MMA(1, 1, At, B1); PG8_BAR; PG8_SCHED;
            } else {
            PG8_LDB(B0, 0, 0); PG8_SCHED; PG8_LDA(At, 0, 0); PG8_STAGE(PG8_SA(1, 1), a1 + hstep, voffA);
            PG8_WAIT_L(8); PG8_BAR; PG8_WAIT_L(0); PG8_MMA(0, 0, At, B0); PG8_BAR; PG8_SCHED;
            PG8_LDB(B1, 0, 1); PG8_STAGE(PG8_SB(0, 0), b2, voffB);
            PG8_BAR; PG8_WAIT_L(0); PG8_MMA(0, 1, At, B1); PG8_BAR;
            PG8_LDA(At, 0, 1); PG8_STAGE(PG8_SA(0, 0), a2, voffA);
            PG8_BAR; PG8_WAIT_L(0); PG8_MMA(1, 0, At, B0); PG8_BAR; PG8_SCHED;
            PG8_STAGE(PG8_SB(0, 1), b2 + hstep, voffB);
            PG8_WAIT_V(6); PG8_BAR; PG8_MMA(1, 1, At, B1); PG8_BAR;
            PG8_LDB(B0, 1, 0); PG8_SCHED; PG8_LDA(At, 1, 0); PG8_STAGE(PG8_SA(0, 1), a2 + hstep, voffA);
            PG8_WAIT_L(8); PG8_BAR; PG8_WAIT_L(0); PG8_MMA(0, 0, At, B0); PG8_BAR; PG8_SCHED;
            PG8_LDB(B1, 1, 1); PG8_STAGE(PG8_SB(1, 0), b3, voffB);
            PG8_BAR; PG8_WAIT_L(0); PG8_MMA(0, 1, At, B1); PG8_BAR;
            PG8_LDA(At, 1, 1); PG8_STAGE(PG8_SA(1, 0), a3, voffA);
            PG8_BAR; PG8_WAIT_L(0); PG8_MMA(1, 0, At, B0); PG8_BAR; PG8_SCHED;
            PG8_STAGE(PG8_SB(1, 1), b3 + hstep, voffB);
            PG8_WAIT_V(6); PG8_BAR; PG8_MMA(1, 1, At, B1); PG8_BAR;
            }
        }
        if constexpr (ALIGN_EPI) { if (wr == 0) PG8_BAR; }
        if constexpr (FP8) asm volatile("s_nop 15\n\ts_nop 15" ::: "memory");
        if constexpr (!Epi::AFTER_DRAIN) { E(acc, cur, wr, wc, fr, fq); S.done(cur); }
        if (!has_next) break;
#pragma unroll
        for (int a = 0; a < 2; ++a)
#pragma unroll
            for (int b = 0; b < 2; ++b)
#pragma unroll
                for (int m = 0; m < 4; ++m)
#pragma unroll
                    for (int n = 0; n < 2; ++n) acc[a][b][m][n] = (f32x4){0.f, 0.f, 0.f, 0.f};
        cur = nxt; cA = nA; cB = nB; ++ui;
        if constexpr (ALIGN_EPI) { if (wr == 1) PG8_BAR; }
    }
    PG8_WAIT_V(0);
    if constexpr (!ALIGN_EPI) { if (wr == 0) PG8_BAR; }
    PG8_BAR;
    if constexpr (Epi::AFTER_DRAIN) { E.fused(acc, cur, wr, wc, fr, fq, lds, wid, lane); S.done(cur); }
#undef PG8_SA
#undef PG8_SB
#undef PG8_STAGE
#undef PG8_LDA
#undef PG8_LDB
#undef PG8_MMA
#undef PG8_WAIT_V
#undef PG8_WAIT_L
#undef PG8_BAR
#undef PG8_SCHED
}
}
constexpr int NWAVES = 8;
constexpr int NTOK = 16384, SEQ = 2048, DM = 2048, PW = 4992, PWP = 5120, DFF = 5632, NEXP = 8, MAXTILES = 136;
constexpr float LN_EPS = 1e-5f;
constexpr float LOG2E = 1.4426950408889634f;
constexpr int C_AQ = 0, C_AK = 768, C_AV = 1536, C_BQ = 2304, C_BK = 3072, C_BV = 3264, C_CQ = 3456, C_CK = 3712, C_CV = 3968, C_CG = 4480;
constexpr size_t MiB = 1u << 20;
constexpr size_t WS_CTL = 0, CTL_ZERO_BYTES = 1 * MiB;
constexpr size_t WS_TAB = 1 * MiB;
constexpr size_t WS_ROUTE = 2 * MiB;
constexpr size_t WS_WIN = 4 * MiB, WS_WOUT = 44 * MiB, WS_WDGU = 60 * MiB, WS_WDDN = 104 * MiB, WS_WMGU = 126 * MiB, WS_WMDN = 478 * MiB;
constexpr size_t WS_XB = 654 * MiB, WS_XG = 718 * MiB, WS_U1 = 854 * MiB, WS_END = 1228 * MiB;
constexpr size_t WS_PROJ = WS_U1, WS_CAT = WS_U1 + 160 * MiB, WS_H = WS_U1, WS_Y = WS_XG;
static_assert(WS_WIN + 2ull * PWP * DM * 2 <= WS_WOUT && WS_WOUT + 2ull * DM * DM * 2 <= WS_WDGU && WS_WDGU + 2ull * DFF * DM * 2 <= WS_WDDN && WS_WDDN + (size_t)DM * DFF * 2 <= WS_WMGU, "ws map 1");
static_assert(WS_WMGU + 8ull * 2 * DFF * DM * 2 <= WS_WMDN && WS_WMDN + 8ull * DM * DFF * 2 <= WS_XB && WS_XB + (size_t)NTOK * DM * 2 <= WS_XG && WS_XG + (size_t)MAXTILES * 256 * DM * 2 <= WS_U1, "ws map 2");
static_assert(WS_U1 + (size_t)MAXTILES * 256 * DFF * 2 <= WS_END && WS_PROJ + (size_t)NTOK * PWP * 2 <= WS_CAT && WS_CAT + (size_t)NTOK * DM * 2 <= WS_END, "ws map 3");
constexpr int CW_TMO = 0, CW_CODE = 1, CW_CNT = 1024  , CW_WQ = 2048  , CW_BAR = 4096  ;
constexpr int RING_OFF = 0, RING_BYTES = 131072;
constexpr int LDSCTL_OFF = RING_BYTES, MISC_OFF = LDSCTL_OFF + 320;
constexpr int LUT_OFF = LDSCTL_OFF + 1024;
constexpr int LUT_STRIDE = 132;
constexpr int LDS_BYTES = 147456;
static_assert(LUT_OFF + 18 * LUT_STRIDE * 4 <= LDS_BYTES, "LDS map");

#define GAS __attribute__((address_space(1)))
#define LAS __attribute__((address_space(3)))
typedef unsigned short bf16;
typedef unsigned v4u __attribute__((ext_vector_type(4)));
typedef unsigned v2u __attribute__((ext_vector_type(2)));
typedef float f32x4 __attribute__((ext_vector_type(4)));
typedef short bf16x8 __attribute__((ext_vector_type(8)));
typedef GAS unsigned gu32;
#define RLX_AGENT __ATOMIC_RELAXED, __HIP_MEMORY_SCOPE_AGENT
#define LDS_WAIT() asm volatile("s_waitcnt lgkmcnt(0)" ::: "memory")
#define VM_WAIT() asm volatile("s_waitcnt vmcnt(0)" ::: "memory")
__device__ __forceinline__ unsigned f2bf(float f) { unsigned u = __builtin_bit_cast(unsigned, f); return (u + 0x7fffu + ((u >> 16) & 1u)) >> 16; }
__device__ __forceinline__ unsigned pk2(float lo, float hi) { return f2bf(lo) | (f2bf(hi) << 16); }
__device__ __forceinline__ float bflo(unsigned w) { return __builtin_bit_cast(float, w << 16); }
__device__ __forceinline__ float bfhi(unsigned w) { return __builtin_bit_cast(float, w & 0xffff0000u); }
__device__ __forceinline__ float bf2f(bf16 h) { return __builtin_bit_cast(float, (unsigned)h << 16); }
__device__ const unsigned char BUCKET[129] = {0,1,2,3,4,5,6,7,8,9,10,11,12,13,14,15,16,16,16,17,17,18,18,18,19,19,19,20,20,20,20,21,21,21,21,22,22,22,22,22,23,23,23,23,23,23,24,24,24,24,24,24,25,25,25,25,25,25,25,
    26,26,26,26,26,26,26,26,27,27,27,27,27,27,27,27,27,27,28,28,28,28,28,28,28,28,28,28,29,29,29,29,29,29,29,29,29,29,29,29,30,30,30,30,30,30,30,30,30,30,30,30,30,30,31,31,31,31,31,31,31,31,31,31,31,31,31,31,31,31};
#define XB_TMO      128
#define XB_XCNT(j)  (256  + 64 * (j))
#define XB_XSUB(j)  (1280 + 64 * (j))
#define XB_XGEN(j)  (2304 + 64 * (j))
#define XB_TOP      3328
#define XB_TOPGEN   3392
#define XCD_BAR_WORDS 3456
#define XB_SPIN_CAP (1u << 18)

__device__ __forceinline__ unsigned xb_ld(unsigned* p)              { return __hip_atomic_load(p, __ATOMIC_RELAXED, __HIP_MEMORY_SCOPE_AGENT); }
__device__ __forceinline__ unsigned xb_add(unsigned* p, unsigned v) { return __hip_atomic_fetch_add(p, v, __ATOMIC_RELAXED, __HIP_MEMORY_SCOPE_AGENT); }
__device__ __forceinline__ unsigned xb_xcc_id() { return (unsigned)__builtin_amdgcn_s_getreg((3 << 11) | 20) & 0xFu; }
#define XB_SPIN(cond, bar) do { unsigned _sp = 0; while (cond) { __builtin_amdgcn_s_sleep(1); \
    if ((++_sp & 255u) == 0u) { if (xb_ld(&(bar)[XB_TMO])) break; if (_sp > XB_SPIN_CAP) { atomicAdd(&(bar)[XB_TMO], 1u); break; } } } } while (0)

struct XcdBarrier {
    unsigned* bar; unsigned x;
    volatile LAS unsigned* st;
};

__device__ __forceinline__ XcdBarrier xcd_barrier_post(unsigned* bar, volatile LAS unsigned* st) {
    XcdBarrier b; b.bar = bar; b.x = xb_xcc_id(); b.st = st;
    if (threadIdx.x == 0) (void)xb_add(&bar[XB_XCNT(b.x)], 1u);
    return b;
}
__device__ __forceinline__ void xcd_barrier_complete(unsigned* bar, unsigned x, unsigned& nloc, unsigned& nx) {
    const unsigned G = gridDim.x * gridDim.y * gridDim.z;
    unsigned sum, cnt, mine, sp = 0u;
    for (;;) {
        sum = 0u; cnt = 0u; mine = 0u;
#pragma unroll
        for (unsigned j = 0; j < 16; ++j) { const unsigned c = xb_ld(&bar[XB_XCNT(j)]); sum += c; cnt += (c > 0u) ? 1u : 0u; mine = (j == x) ? c : mine; }
        if (sum == G) break;
        __builtin_amdgcn_s_sleep(1);
        if ((++sp & 255u) == 0u) { if (xb_ld(&bar[XB_TMO])) break; if (sp > XB_SPIN_CAP) { atomicAdd(&bar[XB_TMO], 1u); break; } }
    }
    nloc = mine > 0u ? mine : 1u; nx = cnt > 0u ? cnt : 1u;
}

__device__ __forceinline__ void xcd_barrier(const XcdBarrier& b) {
    asm volatile("s_waitcnt vmcnt(0)" ::: "memory");
    __syncthreads();
    if (threadIdx.x == 0) {
        unsigned* bar = b.bar;
        __builtin_amdgcn_s_waitcnt(0);
        unsigned nloc = b.st[0], nx = b.st[1];
        if (nloc == 0u) { xcd_barrier_complete(bar, b.x, nloc, nx); b.st[0] = nloc; b.st[1] = nx; }
        const unsigned old = xb_add(&bar[XB_XSUB(b.x)], 1u);
        const unsigned gen = old / nloc;
        if (old + 1u == (gen + 1u) * nloc) {
            __builtin_amdgcn_fence(__ATOMIC_RELEASE, "agent");
            asm volatile("s_waitcnt vmcnt(0)" ::: "memory");
            const unsigned og = xb_add(&bar[XB_TOP], 1u);
            const unsigned tg = og / nx;
            if (og + 1u == (tg + 1u) * nx) xb_add(&bar[XB_TOPGEN], 1u);
            else XB_SPIN(xb_ld(&bar[XB_TOPGEN]) == tg, bar);
            __builtin_amdgcn_fence(__ATOMIC_ACQUIRE, "agent");
            xb_add(&bar[XB_XGEN(b.x)], 1u);
            asm volatile("s_waitcnt vmcnt(0)" ::: "memory");
        } else {
            XB_SPIN(xb_ld(&bar[XB_XGEN(b.x)]) == gen, bar);
            __builtin_amdgcn_fence(__ATOMIC_ACQUIRE, "agent");
            asm volatile("s_waitcnt vmcnt(0)" ::: "memory");
        }
    }
    __syncthreads();
}
struct Args { const float* in[18]; float* out; unsigned char* ws; int ph_lo, ph_hi, li, pad; float invf[32]; };
static_assert(sizeof(Args) == 20 * 8 + 16 + 128, "Args has no padding bytes");
struct Frame {
    LAS unsigned char* lds;
    gu32* ctl;
    int tid, lane, wave, vcu, G;
};
__device__ __forceinline__ float wave_sum(float v) {
#pragma unroll
    for (int o = 1; o < 64; o <<= 1) v += __shfl_xor(v, o);
    return v;
}
__device__ __forceinline__ float wave_max(float v) {
#pragma unroll
    for (int o = 1; o < 64; o <<= 1) v = fmaxf(v, __shfl_xor(v, o));
    return v;
}
__device__ __forceinline__ void p0_transpose_item(const float* W, int K, int N, bf16* WT, int k0, int n0, int drow0, LAS float* scr, int lane) {
#pragma unroll 8
    for (int i = 0; i < 32; ++i) { const int kk = 2 * i + (lane >> 5); scr[kk * 33 + (lane & 31)] = W[(size_t)(k0 + kk) * N + n0 + (lane & 31)]; }
    LDS_WAIT(); asm volatile("" ::: "memory");
    const int c = lane & 7;
#pragma unroll
    for (int j = 0; j < 4; ++j) { const int n = (lane >> 3) + 8 * j; const LAS float* s = scr + (8 * c) * 33 + n;
        v4u o; o.x = pk2(s[0 * 33], s[1 * 33]); o.y = pk2(s[2 * 33], s[3 * 33]); o.z = pk2(s[4 * 33], s[5 * 33]); o.w = pk2(s[6 * 33], s[7 * 33]);
        *(GAS v4u*)(WT + (size_t)(drow0 + n) * K + k0 + 8 * c) = o; }
    LDS_WAIT(); asm volatile("" ::: "memory");
}
template <int MODE> __device__ __forceinline__ void p0_matrix_item(const float* W, int K, int N, bf16* WT, int item, LAS float* scr, int lane) {
    const int nblk = N / 32, kb = item / nblk, nb = item % nblk, n0 = 32 * nb;
    const int drow0 = (MODE == 0) ? n0 : ((n0 >> 7) * 256 + (n0 & 127) + (MODE == 2 ? 128 : 0));
    p0_transpose_item(W, K, N, WT, 64 * kb, n0, drow0, scr, lane);
}
__device__ __forceinline__ void p0_transpose_item8(const float* W, int K, int N, unsigned char* WT, int k0, int n0, int drow0, float scale, LAS float* scr, int lane) {
#pragma unroll 8
    for (int i = 0; i < 32; ++i) { const int kk = 2 * i + (lane >> 5); scr[kk * 33 + (lane & 31)] = W[(size_t)(k0 + kk) * N + n0 + (lane & 31)] * scale; }
    LDS_WAIT(); asm volatile("" ::: "memory");
    const int c = lane & 7;
#pragma unroll
    for (int j = 0; j < 4; ++j) { const int n = (lane >> 3) + 8 * j; const LAS float* s = scr + (8 * c) * 33 + n;
        v2u o; o.x = pg8::pack4_fp8(s[0 * 33], s[1 * 33], s[2 * 33], s[3 * 33]); o.y = pg8::pack4_fp8(s[4 * 33], s[5 * 33], s[6 * 33], s[7 * 33]);
        *(GAS v2u*)(WT + (size_t)(drow0 + n) * K + k0 + 8 * c) = o; }
    LDS_WAIT(); asm volatile("" ::: "memory");
}
template <int MODE> __device__ __forceinline__ void p0_matrix_item8(const float* W, int K, int N, unsigned char* WT, int item, float scale, LAS float* scr, int lane) {
    const int nblk = N / 32, kb = item / nblk, nb = item % nblk, n0 = 32 * nb;
    const int drow0 = (MODE == 0) ? n0 : ((n0 >> 7) * 256 + (n0 & 127) + (MODE == 2 ? 128 : 0));
    p0_transpose_item8(W, K, N, WT, 64 * kb, n0, drow0, scale, scr, lane);
}
__device__ __forceinline__ void p0_prologue(Frame& F, const Args& a) {
    LAS float* scr = (LAS float*)(F.lds + RING_OFF + F.wave * 16384);
    const int gw = F.vcu * NWAVES + F.wave, NGW = F.G * NWAVES;
    unsigned char* ws = a.ws;
    constexpr int I_IN = (DM / 64) * (PW / 32), I_OUT = (DM / 64) * (DM / 32), I_GU = (DM / 64) * (DFF / 32), I_DN = (DFF / 64) * (DM / 32);
    constexpr int NITEMS = 2 * I_IN + 2 * I_OUT + 2 * I_GU + I_DN + 8 * (2 * I_GU + I_DN);
    for (int it = gw; it < NITEMS; it += NGW) {
        int r = it;
        if (r < 2 * I_IN) { const int l = r / I_IN; p0_matrix_item<0>(a.in[1] + (size_t)l * DM * PW, DM, PW, (bf16*)(ws + WS_WIN) + (size_t)l * PWP * DM, r % I_IN, scr, F.lane); continue; } r -= 2 * I_IN;
        if (r < 2 * I_OUT) { const int l = r / I_OUT; p0_matrix_item<0>(a.in[6] + (size_t)l * DM * DM, DM, DM, (bf16*)(ws + WS_WOUT) + (size_t)l * DM * DM, r % I_OUT, scr, F.lane); continue; } r -= 2 * I_OUT;
        if (r < I_GU) { p0_matrix_item<1>(a.in[11], DM, DFF, (bf16*)(ws + WS_WDGU), r, scr, F.lane); continue; } r -= I_GU;
        if (r < I_GU) { p0_matrix_item<2>(a.in[12], DM, DFF, (bf16*)(ws + WS_WDGU), r, scr, F.lane); continue; } r -= I_GU;
        if (r < I_DN) { p0_matrix_item<0>(a.in[13], DFF, DM, (bf16*)(ws + WS_WDDN), r, scr, F.lane); continue; } r -= I_DN;
        if (r < 8 * I_GU) { const int e = r / I_GU; p0_matrix_item8<1>(a.in[15] + (size_t)e * DM * DFF, DM, DFF, ws + WS_WMGU + (size_t)e * 2 * DFF * DM, r % I_GU, pg8::FP8_SWU, scr, F.lane); continue; } r -= 8 * I_GU;
        if (r < 8 * I_GU) { const int e = r / I_GU; p0_matrix_item8<2>(a.in[16] + (size_t)e * DM * DFF, DM, DFF, ws + WS_WMGU + (size_t)e * 2 * DFF * DM, r % I_GU, pg8::FP8_SWU, scr, F.lane); continue; } r -= 8 * I_GU;
        { const int e = r / I_DN; p0_matrix_item8<0>(a.in[17] + (size_t)e * DFF * DM, DFF, DM, ws + WS_WMDN + (size_t)e * DM * DFF, r % I_DN, pg8::FP8_SWD, scr, F.lane); }
    }
    { const int gt = gw * 64 + F.lane, NGT = NGW * 64; const GAS f32x4* x4 = (const GAS f32x4*)a.in[0]; GAS v4u* o4 = (GAS v4u*)(ws + WS_XB);
      for (int i = gt; i < NTOK * DM / 8; i += NGT) { const f32x4 p = x4[2 * i], q = x4[2 * i + 1]; v4u o; o.x = pk2(p[0], p[1]); o.y = pk2(p[2], p[3]); o.z = pk2(q[0], q[1]); o.w = pk2(q[2], q[3]); o4[i] = o; } }
    { const int gt = gw * 64 + F.lane; if (gt < SEQ * 32) { const int pos = gt >> 5, i = gt & 31; const float ang = (float)pos * a.invf[i];
        const double t = (double)ang * 0.15915494309189535; const float fr = (float)(t - __builtin_rint(t));
        ((float*)(ws + WS_TAB))[gt] = __builtin_amdgcn_sinf(fr); ((float*)(ws + WS_TAB + 256 * 1024))[gt] = __builtin_amdgcn_cosf(fr); } }
}
__device__ __forceinline__ void build_lut(Frame& F, const float* rel_bias) {
    LAS float* lut = (LAS float*)(F.lds + LUT_OFF);
    for (int i = F.tid; i < 18 * 129; i += NWAVES * 64) { const int hh = i / 129, d = i % 129; lut[hh * LUT_STRIDE + d] = (rel_bias[BUCKET[d] * 18 + hh] - (hh < 6 ? rel_bias[31 * 18 + hh] : 0.f)) * LOG2E; }
}
__device__ __forceinline__ void ln_stats(f32x4 (&v)[8], float& mean, float& rstd) {
    float s = 0.f;
#pragma unroll
    for (int j = 0; j < 8; ++j) s += (v[j][0] + v[j][1]) + (v[j][2] + v[j][3]);
    mean = wave_sum(s) * (1.f / DM); float s2 = 0.f;
#pragma unroll
    for (int j = 0; j < 8; ++j) { v[j] = v[j] - mean; s2 += (v[j][0] * v[j][0] + v[j][1] * v[j][1]) + (v[j][2] * v[j][2] + v[j][3] * v[j][3]); }
    rstd = 1.f / sqrtf(wave_sum(s2) * (1.f / DM) + LN_EPS);
}
__device__ __forceinline__ int expert_offsets(Frame& F, int& ntiles) {
    const unsigned c = (F.lane < 8) ? __hip_atomic_load(F.ctl + CW_CNT + 64 * F.lane, RLX_AGENT) : 0u;
    const int t = (int)((c + 255u) >> 8);
    int inc = t;
#pragma unroll
    for (int o = 1; o < 8; o <<= 1) { const int u = __shfl_up(inc, o); if (F.lane >= o) inc += u; }
    ntiles = __shfl(inc, 7);
    return (inc - t) * 256;
}
template <int MODE> __device__ __forceinline__ void ln_phase(Frame& F, const Args& a, float* T, const float* gam, const float* bet, const float* w_router) {
    unsigned char* ws = a.ws;
    bf16* XB = (bf16*)(ws + WS_XB);
    const int lane = F.lane;
    LAS float* wrT = (LAS float*)(F.lds + RING_OFF);
    LAS int* cwL = (LAS int*)(F.lds + RING_OFF + 65536);
    LAS int* baseL = (LAS int*)(F.lds + RING_OFF + 65536 + 256);
    if (MODE == 1) {
        for (int i = F.tid; i < DM * 8; i += NWAVES * 64) wrT[(i & 7) * DM + (i >> 3)] = w_router[i];
        __syncthreads();
    }
    f32x4 g4[8], b4[8];
#pragma unroll
    for (int j = 0; j < 8; ++j) { g4[j] = *(const f32x4*)(gam + 4 * lane + 256 * j); b4[j] = *(const f32x4*)(bet + 4 * lane + 256 * j); }
    int offv = 0, ntl = 0;
    if (MODE == 2) offv = expert_offsets(F, ntl);
    const int rb = (F.vcu * NWAVES + F.wave) * 8;
    unsigned long long cntp = 0ull; int me1 = 0, me2 = 0, mr1 = 0, mr2 = 0; float mg1 = 0.f, mg2 = 0.f;
    for (int r = 0; r < 8; ++r) {
        const int row = rb + r;
        float* trow = T + (size_t)row * DM;
        f32x4 v[8];
#pragma unroll
        for (int j = 0; j < 8; ++j) v[j] = *(const f32x4*)(trow + 4 * lane + 256 * j);
        if (MODE == 2) {
            const int* rt = (const int*)(ws + WS_ROUTE) + row * 8;
            const int e1 = rt[0], p1 = rt[1], e2 = rt[2], p2 = rt[3]; const float g1 = __builtin_bit_cast(float, rt[4]), g2 = __builtin_bit_cast(float, rt[5]);
            const int r1 = __shfl(offv, e1) + p1, r2 = __shfl(offv, e2) + p2;
            const bf16* y1 = (const bf16*)(ws + WS_Y) + (size_t)r1 * DM; const bf16* y2 = (const bf16*)(ws + WS_Y) + (size_t)r2 * DM;
#pragma unroll
            for (int j = 0; j < 8; ++j) { const v2u a1 = *(const v2u*)(y1 + 4 * lane + 256 * j), a2 = *(const v2u*)(y2 + 4 * lane + 256 * j);
                v[j][0] = v[j][0] * pg8::ALPHA_F + g1 * bflo(a1.x) + g2 * bflo(a2.x); v[j][1] = v[j][1] * pg8::ALPHA_F + g1 * bfhi(a1.x) + g2 * bfhi(a2.x);
                v[j][2] = v[j][2] * pg8::ALPHA_F + g1 * bflo(a1.y) + g2 * bflo(a2.y); v[j][3] = v[j][3] * pg8::ALPHA_F + g1 * bfhi(a1.y) + g2 * bfhi(a2.y); }
        }
        float mean, rstd; ln_stats(v, mean, rstd);
#pragma unroll
        for (int j = 0; j < 8; ++j) v[j] = v[j] * rstd * g4[j] + b4[j];
        if (MODE == 2) {
            float* orow = a.out + (size_t)row * DM;
#pragma unroll
            for (int j = 0; j < 8; ++j) *(f32x4*)(orow + 4 * lane + 256 * j) = v[j];
        } else {
            bf16* xrow = XB + (size_t)row * DM;
#pragma unroll
            for (int j = 0; j < 8; ++j) { *(f32x4*)(trow + 4 * lane + 256 * j) = v[j]; if (MODE == 0) { v2u o; o.x = pk2(v[j][0], v[j][1]); o.y = pk2(v[j][2], v[j][3]); *(v2u*)(xrow + 4 * lane + 256 * j) = o; } }
        }
        if (MODE == 1) {
            int i1 = -1, i2 = -1; float v1 = -3.0e38f, v2 = -3.0e38f;
#pragma unroll 1
            for (int e = 0; e < 8; ++e) { float s = 0.f;
#pragma unroll
                for (int j = 0; j < 8; ++j) { const f32x4 w = *(const LAS f32x4*)(wrT + e * DM + 4 * lane + 256 * j); s += (v[j][0] * w[0] + v[j][1] * w[1]) + (v[j][2] * w[2] + v[j][3] * w[3]); }
                const float t = wave_sum(s);
                if (t > v1) { v2 = v1; i2 = i1; v1 = t; i1 = e; } else if (t > v2) { v2 = t; i2 = e; } }
            if (i1 < 0) i1 = 0;
            if (i2 < 0) i2 = (i1 + 1) & 7;
            const float ex = __expf(v2 - v1), w1 = 1.f / (1.f + ex), w2 = ex * w1;
            const int k1 = (int)((cntp >> (8 * i1)) & 0xffull); cntp += 1ull << (8 * i1);
            const int k2 = (int)((cntp >> (8 * i2)) & 0xffull); cntp += 1ull << (8 * i2);
            if (lane == r) { me1 = i1; me2 = i2; mr1 = k1; mr2 = k2; mg1 = w1; mg2 = w2; }
        }
    }
    if (MODE == 1) {
        if (lane < 8) cwL[F.wave * 8 + lane] = (int)((cntp >> (8 * lane)) & 0xffull);
        __syncthreads();
        if (F.tid < 8) { int tot = 0;
#pragma unroll
            for (int w = 0; w < 8; ++w) tot += cwL[w * 8 + F.tid];
            baseL[F.tid] = (int)__hip_atomic_fetch_add(F.ctl + CW_CNT + 64 * F.tid, (unsigned)tot, RLX_AGENT); }
        __syncthreads();
        if (lane < 8) {
            int p1 = baseL[me1] + mr1, p2 = baseL[me2] + mr2;
            for (int w = 0; w < F.wave; ++w) { p1 += cwL[w * 8 + me1]; p2 += cwL[w * 8 + me2]; }
            int* rt = (int*)(ws + WS_ROUTE) + (rb + lane) * 8;
            rt[0] = me1; rt[1] = p1; rt[2] = me2; rt[3] = p2; rt[4] = __builtin_bit_cast(int, mg1); rt[5] = __builtin_bit_cast(int, mg2);
        }
    }
}
__device__ __forceinline__ void gather_phase(Frame& F, const Args& a, const float* T) {
    unsigned char* ws = a.ws; int ntl; const int offv = expert_offsets(F, ntl);
    const int gw = F.vcu * NWAVES + F.wave, NGW = F.G * NWAVES;
    for (int tok = gw; tok < NTOK; tok += NGW) {
        const int* rt = (const int*)(ws + WS_ROUTE) + tok * 8;
        const int d1 = __shfl(offv, rt[0]) + rt[1], d2 = __shfl(offv, rt[2]) + rt[3];
        const GAS f32x4* s = (const GAS f32x4*)(T + (size_t)tok * DM);
        GAS unsigned* o1 = (GAS unsigned*)(ws + WS_XG + (size_t)d1 * DM); GAS unsigned* o2 = (GAS unsigned*)(ws + WS_XG + (size_t)d2 * DM);
#pragma unroll
        for (int j = 0; j < 8; ++j) { const f32x4 v = s[F.lane + 64 * j] * pg8::FP8_SX; const unsigned w = pg8::pack4_fp8(v[0], v[1], v[2], v[3]); o1[F.lane + 64 * j] = w; o2[F.lane + 64 * j] = w; }
    }
}
__device__ __forceinline__ float dot8(const v4u q, const v4u k) {
    return (bflo(q.x) * bflo(k.x) + bfhi(q.x) * bfhi(k.x)) + (bflo(q.y) * bflo(k.y) + bfhi(q.y) * bfhi(k.y)) + (bflo(q.z) * bflo(k.z) + bfhi(q.z) * bfhi(k.z)) + (bflo(q.w) * bflo(k.w) + bfhi(q.w) * bfhi(k.w));
}
__device__ __forceinline__ float lambda_of(const float* lp, int lane, float lam_init) {
    const float s1 = wave_sum(lp[lane] * lp[64 + lane]), s2 = wave_sum(lp[128 + lane] * lp[192 + lane]);
    return __expf(s1) - __expf(s2) + lam_init;
}
__device__ __forceinline__ void naive_mixers(Frame& F, const Args& a, int layer) {
    unsigned char* ws = a.ws; const bf16* PROJ = (const bf16*)(ws + WS_PROJ); bf16* CAT = (bf16*)(ws + WS_CAT);
    const int lane = F.lane; const int gw = F.vcu * NWAVES + F.wave, NGW = F.G * NWAVES;
    LAS float* sc = (LAS float*)(F.lds + RING_OFF + F.wave * 16384);
    const LAS float* lut = (const LAS float*)(F.lds + LUT_OFF);
    const float lam_init = 0.8f - 0.6f * __expf(-0.3f * (float)layer);
    const float lam = lambda_of(a.in[3] + layer * 256, lane, lam_init);
    const float* subg = a.in[4] + layer * 128; const float* sinks = a.in[5] + layer * 12;
    for (int task = gw; task < NTOK * 6; task += NGW) {
        const int tok = task / 6, h = task - tok * 6, q = tok & (SEQ - 1), base = tok - q;
        v4u qv[16]; { const v4u* qp = (const v4u*)(PROJ + (size_t)tok * PWP + C_AQ + h * 128);
#pragma unroll
            for (int c = 0; c < 16; ++c) qv[c] = qp[c]; }
        float m1 = -3.0e38f, m2 = -3.0e38f;
        for (int j = lane; j <= q; j += 64) {
            const v4u* kp = (const v4u*)(PROJ + (size_t)(base + j) * PWP + C_AK + h * 128); float d1 = 0.f, d2 = 0.f;
#pragma unroll
            for (int c = 0; c < 8; ++c) { d1 += dot8(qv[c], kp[c]); d2 += dot8(qv[8 + c], kp[8 + c]); }
            const int dd = q - j; const float bias = lut[h * LUT_STRIDE + (dd < 128 ? dd : 128)];
            d1 += bias; d2 += bias; sc[j] = d1; sc[2048 + j] = d2; m1 = fmaxf(m1, d1); m2 = fmaxf(m2, d2);
        }
        m1 = wave_max(m1); m2 = wave_max(m2); float l1 = 0.f, l2 = 0.f;
        for (int j = lane; j <= q; j += 64) { const float p1 = __builtin_amdgcn_exp2f(sc[j] - m1), p2 = __builtin_amdgcn_exp2f(sc[2048 + j] - m2); sc[j] = p1; sc[2048 + j] = p2; l1 += p1; l2 += p2; }
        l1 = wave_sum(l1); l2 = wave_sum(l2); const float c1 = 1.f / l1, c2 = lam / l2;
        float o0 = 0.f, o1 = 0.f;
        for (int j = 0; j <= q; ++j) { const float w = sc[j] * c1 - sc[2048 + j] * c2; const bf16* vr = PROJ + (size_t)(base + j) * PWP + C_AV + h * 128; o0 += w * bf2f(vr[lane]); o1 += w * bf2f(vr[64 + lane]); }
        const float ss = wave_sum(o0 * o0 + o1 * o1), rr = (1.f / sqrtf(ss * (1.f / 128.f) + LN_EPS)) * (1.f - lam_init);
        bf16* orow = CAT + (size_t)tok * DM + h * 128; orow[lane] = (bf16)f2bf(o0 * rr * subg[lane]); orow[64 + lane] = (bf16)f2bf(o1 * rr * subg[64 + lane]);
    }
    for (int task = gw; task < NTOK * 12; task += NGW) {
        const int tok = task / 12, hq = task - tok * 12, kvh = hq >> 2, q = tok & (SEQ - 1), base = tok - q;
        v4u qv[8]; { const v4u* qp = (const v4u*)(PROJ + (size_t)tok * PWP + C_BQ + hq * 64);
#pragma unroll
            for (int c = 0; c < 8; ++c) qv[c] = qp[c]; }
        float s[2];
#pragma unroll
        for (int i = 0; i < 2; ++i) { const int dd = lane + 64 * i, j = q - dd; s[i] = -3.0e38f;
            if (j >= 0) { const v4u* kp = (const v4u*)(PROJ + (size_t)(base + j) * PWP + C_BK + kvh * 64); float d = 0.f;
#pragma unroll
                for (int c = 0; c < 8; ++c) d += dot8(qv[c], kp[c]);
                s[i] = d + lut[(6 + hq) * LUT_STRIDE + dd]; } }
        const float sink2 = sinks[hq] * LOG2E; const float m = fmaxf(wave_max(fmaxf(s[0], s[1])), sink2);
        const float p0 = (q - lane >= 0) ? __builtin_amdgcn_exp2f(s[0] - m) : 0.f, p1 = (q - lane - 64 >= 0) ? __builtin_amdgcn_exp2f(s[1] - m) : 0.f;
        const float l = wave_sum(p0 + p1) + __builtin_amdgcn_exp2f(sink2 - m);
        sc[lane] = p0; sc[64 + lane] = p1;
        float o = 0.f; const int nk = (q + 1 < 128) ? q + 1 : 128;
        for (int dd = 0; dd < nk; ++dd) o += sc[dd] * bf2f(PROJ[(size_t)(base + q - dd) * PWP + C_BV + kvh * 64 + lane]);
        CAT[(size_t)tok * DM + 768 + hq * 64 + lane] = (bf16)f2bf(o / l);
    }
    for (int task = gw; task < NTOK * 4; task += NGW) {
        const int tok = task >> 2, h = task & 3, q = tok & (SEQ - 1), base = tok - q;
        const float lg2 = log2f(1.f - exp2f(-5.f - (float)h));
        v4u qv[8]; { const v4u* qp = (const v4u*)(PROJ + (size_t)tok * PWP + C_CQ + h * 64);
#pragma unroll
            for (int c = 0; c < 8; ++c) qv[c] = qp[c]; }
        for (int j = lane; j <= q; j += 64) { const v4u* kp = (const v4u*)(PROJ + (size_t)(base + j) * PWP + C_CK + h * 64); float d = 0.f;
#pragma unroll
            for (int c = 0; c < 8; ++c) d += dot8(qv[c], kp[c]);
            sc[j] = d * __builtin_amdgcn_exp2f((float)(q - j) * lg2); }
        float o0 = 0.f, o1 = 0.f;
        for (int j = 0; j <= q; ++j) { const float w = sc[j]; const bf16* vr = PROJ + (size_t)(base + j) * PWP + C_CV + h * 128; o0 += w * bf2f(vr[lane]); o1 += w * bf2f(vr[64 + lane]); }
        const float mu = wave_sum(o0 + o1) * (1.f / 128.f); o0 -= mu; o1 -= mu;
        const float rs = 1.f / sqrtf(wave_sum(o0 * o0 + o1 * o1) * (1.f / 128.f) + LN_EPS);
        const bf16* gr = PROJ + (size_t)tok * PWP + C_CG + h * 128;
        bf16* orow = CAT + (size_t)tok * DM + 1536 + h * 128;
        orow[lane] = (bf16)f2bf(pg8::silu_f(bf2f(gr[lane])) * o0 * rs); orow[64 + lane] = (bf16)f2bf(pg8::silu_f(bf2f(gr[64 + lane])) * o1 * rs);
    }
}
typedef float f32x16 __attribute__((ext_vector_type(16)));
typedef short s16x4 __attribute__((ext_vector_type(4)));
typedef short v4i16_t __attribute__((ext_vector_type(4)));
typedef float f32x2_t __attribute__((ext_vector_type(2))); typedef __bf16 bf16x2_t __attribute__((ext_vector_type(2)));
__device__ __forceinline__ int crow(int r, int hi) { return (r & 3) + 8 * (r >> 2) + 4 * hi; }
__device__ __forceinline__ s16x4 vtr(const LAS unsigned char* p) { return __builtin_bit_cast(s16x4, __builtin_amdgcn_ds_read_tr16_b64_v4i16((LAS v4i16_t*)p)); }
__device__ __forceinline__ unsigned cvtpk_s(float lo, float hi) { f32x2_t v = {lo, hi}; bf16x2_t b = __builtin_convertvector(v, bf16x2_t); return __builtin_bit_cast(unsigned, b); }
__device__ __forceinline__ bf16x8 pack_p(const f32x16& p, int s2) {
    v4u w; w.x = cvtpk_s(p[8 * s2 + 0], p[8 * s2 + 1]); w.y = cvtpk_s(p[8 * s2 + 2], p[8 * s2 + 3]); w.z = cvtpk_s(p[8 * s2 + 4], p[8 * s2 + 5]); w.w = cvtpk_s(p[8 * s2 + 6], p[8 * s2 + 7]);
    return __builtin_bit_cast(bf16x8, w);
}
constexpr int MIX_WSF = 131072 + 1024 + 10240, MIX_QW = MIX_WSF + 2048;
static_assert(MIX_QW + 64 <= LDS_BYTES && LUT_OFF + 18 * LUT_STRIDE * 4 <= MIX_WSF, "mixer LDS map");
constexpr int LUTX_OFF = 98304, LUTX_STRIDE = 320;
constexpr float MIX_THR = 6.f;
__device__ __forceinline__ void glds16(const void* gsrc, unsigned lds_dst) { unsigned keep;
    asm volatile("s_mov_b32 %0, m0\n\ts_mov_b32 m0, %2\n\ts_nop 0\n\tglobal_load_lds_dwordx4 %1, off\n\ts_mov_b32 m0, %0" : "=&s"(keep) : "v"(gsrc), "s"(lds_dst) : "memory"); }
template <int MODE> __device__ __forceinline__ void mix_unit(Frame& F, const Args& a, int layer, int b, int hh, int qb, float lam, float lam_init) {
    constexpr int KW = (MODE == 0) ? 128 : 64, VW = (MODE == 1) ? 64 : 128, NEB = VW / 32, NSUB = 1;
    constexpr int KBYTES = 64 * KW * 2, VBYTES = 64 * VW * 2, BUFB = KBYTES + VBYTES, NST = 3;
    constexpr int KD = KBYTES / 1024, VD = VBYTES / 1024, PW = (KD + VD) / 8;
    static_assert(NST * BUFB <= LUTX_OFF && LUTX_OFF + 18 * LUTX_STRIDE * 4 <= RING_BYTES && (KD + VD) % 8 == 0, "mixer LDS ring");
    unsigned char* ws = a.ws; const bf16* PROJ = (const bf16*)(ws + WS_PROJ); bf16* CAT = (bf16*)(ws + WS_CAT);
    const int wave = F.wave; int lane = (int)__builtin_amdgcn_mbcnt_hi(~0u, __builtin_amdgcn_mbcnt_lo(~0u, 0u)); asm volatile("" : "+v"(lane));
    const int tid = wave * 64 + lane, r32 = lane & 31, hi = lane >> 5;
    LAS unsigned char* L = F.lds + RING_OFF;
    const unsigned Lb = (unsigned)(uintptr_t)L;
    LAS float* wsf = (LAS float*)(F.lds + MIX_WSF) + wave * 64;
    const LAS float* lut = (const LAS float*)(F.lds + LUT_OFF);
    const int rowbase = b * SEQ;
    const int q0 = (MODE == 2) ? qb * 256 : qb * 128;
    const int rg = (MODE == 2) ? wave : (wave & 3), wsel = (MODE == 2) ? 0 : (wave >> 2);
    const int qw0 = q0 + 32 * rg;
    const int kcol = (MODE == 0) ? C_AK + hh * 128 : (MODE == 1) ? C_BK + (hh >> 1) * 64 : C_CK + hh * 64;
    const int vcol = (MODE == 0) ? C_AV + hh * 128 : (MODE == 1) ? C_BV + (hh >> 1) * 64 : C_CV + hh * 128;
    const int kch0 = (MODE == 0) ? wsel * 8 : 0;
    const int t_lo = (MODE == 1) ? (qb > 0 ? 2 * qb - 2 : 0) : 0, t_hi = (MODE == 2) ? 4 * qb + 4 : 2 * qb + 2;
    bf16x8 qf[NSUB][4];
#pragma unroll
    for (int s = 0; s < NSUB; ++s) {
        const int qcol = (MODE == 0) ? C_AQ + hh * 128 + wsel * 64 : (MODE == 1) ? C_BQ + (hh * 2 + wsel) * 64 : C_CQ + hh * 64;
        const bf16* qp = PROJ + (size_t)(rowbase + qw0 + r32) * PWP + qcol + hi * 8;
#pragma unroll
        for (int d0 = 0; d0 < 4; ++d0) qf[s][d0] = *(const bf16x8*)(qp + d0 * 16);
    }
    float m_run[NSUB], l_run[NSUB]; f32x16 o[NSUB][NEB];
#pragma unroll
    for (int s = 0; s < NSUB; ++s) {
        m_run[s] = (MODE == 1) ? a.in[5][layer * 12 + hh * 2 + wsel] * LOG2E : -1.0e30f; l_run[s] = (MODE == 1) ? 1.f : 0.f;
#pragma unroll
        for (int e = 0; e < NEB; ++e) o[s][e] = f32x16{};
    }
    const float lg2 = (MODE == 2) ? log2f(1.f - exp2f(-5.f - (float)hh)) : 0.f;
    unsigned dsrc[PW]; unsigned ddst[PW];
#pragma unroll
    for (int i = 0; i < PW; ++i) {
        const int j = wave + 8 * i;
        if (j < KD) {
            int row, ch;
            if (KW == 128) { row = 4 * j + (lane >> 4); ch = (lane & 15) ^ (row & 15); }
            else { row = 8 * j + (lane >> 3); ch = (lane & 7) ^ ((row >> 1) & 7); }
            dsrc[i] = (unsigned)(((rowbase + row) * PWP + kcol + ch * 8) * 2); ddst[i] = (unsigned)(j * 1024);
        } else {
            const int jv = j - KD, eb = jv >> 2, key = 16 * (jv & 3) + 8 * (lane >> 5) + ((lane >> 2) & 7);
            dsrc[i] = (unsigned)(((rowbase + key) * PWP + vcol + eb * 32 + (lane & 3) * 8) * 2); ddst[i] = (unsigned)(KBYTES + jv * 1024);
        }
    }
#define MIX_DMA(t) do { const unsigned st_ = Lb + (unsigned)((((t) - t_lo) % NST) * BUFB); \
        _Pragma("unroll") for (int i_ = 0; i_ < PW; ++i_) glds16((const char*)PROJ + (size_t)(t) * (64 * PWP * 2) + dsrc[i_], (unsigned)__builtin_amdgcn_readfirstlane(st_ + ddst[i_])); } while (0)
    const int vlane = (4 * hi + ((lane & 15) >> 2)) * 64 + ((lane >> 4) & 1) * 32 + (lane & 3) * 8;
    asm volatile("s_waitcnt vmcnt(0)" ::: "memory");
#pragma unroll
    for (int s = 0; s < NSUB; ++s) {
        asm volatile("" : "+v"(m_run[s]));
#pragma unroll
        for (int d0 = 0; d0 < 4; ++d0) asm volatile("" : "+v"(qf[s][d0]));
    }
    MIX_DMA(t_lo);
    if (t_lo + 1 < t_hi) MIX_DMA(t_lo + 1);
#pragma unroll 1
    for (int t = t_lo; t < t_hi; ++t) {
        if (t + 1 < t_hi) { if (PW == 2) asm volatile("s_waitcnt vmcnt(2)" ::: "memory"); else if (PW == 3) asm volatile("s_waitcnt vmcnt(3)" ::: "memory"); else asm volatile("s_waitcnt vmcnt(4)" ::: "memory"); }
        else asm volatile("s_waitcnt vmcnt(0)" ::: "memory");
        asm volatile("s_waitcnt lgkmcnt(0)\n\ts_barrier" ::: "memory");
        if (t + 2 < t_hi) MIX_DMA(t + 2);
        const LAS unsigned char* Kb = L + ((t - t_lo) % NST) * BUFB; const LAS unsigned char* Vb = Kb + KBYTES;
        const int k0 = 64 * t;
        const bool active = (k0 <= qw0 + 31) && (MODE != 1 || k0 + 63 >= qw0 - 127);
        if (active) {
#pragma unroll
            for (int s = 0; s < NSUB; ++s) {
                f32x16 p0 = f32x16{}, p1 = f32x16{};
#pragma unroll
                for (int d0 = 0; d0 < 4; ++d0) {
                    const int ch = kch0 + 2 * d0 + hi;
                    const int ofs = (KW == 128) ? (r32 * 256 + ((ch ^ (r32 & 15)) << 4)) : (r32 * 128 + ((ch ^ ((r32 >> 1) & 7)) << 4));
                    const bf16x8 ka = *(const LAS bf16x8*)(Kb + ofs);
                    const bf16x8 kb2 = *(const LAS bf16x8*)(Kb + 32 * KW * 2 + ofs);
                    p0 = __builtin_amdgcn_mfma_f32_32x32x16_bf16(ka, qf[s][d0], p0, 0, 0, 0);
                    p1 = __builtin_amdgcn_mfma_f32_32x32x16_bf16(kb2, qf[s][d0], p1, 0, 0, 0);
                }
                const int qi = qw0 + r32;
                if (MODE == 2) {
#pragma unroll
                    for (int r = 0; r < 16; ++r) { const int d0_ = qi - (k0 + crow(r, hi)), d1_ = d0_ - 32;
                        p0[r] = d0_ >= 0 ? p0[r] * __builtin_amdgcn_exp2f((float)d0_ * lg2) : 0.f; p1[r] = d1_ >= 0 ? p1[r] * __builtin_amdgcn_exp2f((float)d1_ * lg2) : 0.f; }
                } else {
                    const bool nearb = (MODE == 1) || (k0 + 63 + 128 > qw0);
                    if (nearb) {
                        const LAS float* lrow = lut + ((MODE == 0) ? hh : 6 + hh * 2 + wsel) * LUT_STRIDE;
#pragma unroll
                        for (int r = 0; r < 16; ++r) { const int d0_ = qi - (k0 + crow(r, hi)), d1_ = d0_ - 32;
                            const bool ok0 = (MODE == 0) ? (d0_ >= 0) : (d0_ >= 0 && d0_ < 128), ok1 = (MODE == 0) ? (d1_ >= 0) : (d1_ >= 0 && d1_ < 128);
                            const int i0_ = d0_ < 0 ? 0 : (d0_ > 128 ? 128 : d0_), i1_ = d1_ < 0 ? 0 : (d1_ > 128 ? 128 : d1_);
                            p0[r] = ok0 ? p0[r] + lrow[i0_] : -INFINITY; p1[r] = ok1 ? p1[r] + lrow[i1_] : -INFINITY; }
                    }
                    float rm = fmaxf(p0[0], p1[0]);
#pragma unroll
                    for (int r = 1; r < 16; ++r) rm = fmaxf(rm, fmaxf(p0[r], p1[r]));
                    rm = fmaxf(rm, __shfl_xor(rm, 32));
                    if (__any(rm > m_run[s] + MIX_THR)) {
                        const float mn = fmaxf(m_run[s], rm), al = __builtin_amdgcn_exp2f(m_run[s] - mn);
                        m_run[s] = mn; l_run[s] *= al;
                        if (hi == 0) wsf[r32] = al;
                        LDS_WAIT();
#pragma unroll
                        for (int r = 0; r < 16; ++r) { const float f = wsf[crow(r, hi)];
#pragma unroll
                            for (int e = 0; e < NEB; ++e) o[s][e][r] *= f; }
                        LDS_WAIT();
                    }
                    float ls = 0.f; const float mm = m_run[s];
#pragma unroll
                    for (int r = 0; r < 16; ++r) { p0[r] = __builtin_amdgcn_exp2f(p0[r] - mm); p1[r] = __builtin_amdgcn_exp2f(p1[r] - mm); ls += p0[r] + p1[r]; }
                    l_run[s] += ls;
                }
                s16x4 vlo[2][NEB], vhi[2][NEB];
#pragma unroll
                for (int e = 0; e < NEB; ++e) { vlo[0][e] = vtr(Vb + e * 4096 + vlane); vhi[0][e] = vtr(Vb + e * 4096 + vlane + 512); }
#pragma unroll
                for (int g = 0; g < 4; ++g) {
                    if (g < 3) {
#pragma unroll
                        for (int e = 0; e < NEB; ++e) { vlo[(g + 1) & 1][e] = vtr(Vb + e * 4096 + (g + 1) * 1024 + vlane); vhi[(g + 1) & 1][e] = vtr(Vb + e * 4096 + (g + 1) * 1024 + vlane + 512); }
                    }
                    const bf16x8 pa = pack_p((g >> 1) == 0 ? p0 : p1, g & 1);
#pragma unroll
                    for (int e = 0; e < NEB; ++e) {
                        const s16x4 lo = vlo[g & 1][e], hh2 = vhi[g & 1][e];
                        const bf16x8 vb = (bf16x8){lo[0], lo[1], lo[2], lo[3], hh2[0], hh2[1], hh2[2], hh2[3]};
                        o[s][e] = __builtin_amdgcn_mfma_f32_32x32x16_bf16(pa, vb, o[s][e], 0, 0, 0);
                    }
                }
                if (NSUB > 1) __builtin_amdgcn_sched_barrier(0);
            }
        }
    }
#undef MIX_DMA
    __syncthreads();
    if (MODE == 1) {
#pragma unroll
        for (int s = 0; s < NSUB; ++s) {
            const float sink2 = a.in[5][layer * 12 + hh * 2 + wsel] * LOG2E;
            const float lt = l_run[s] + __shfl_xor(l_run[s], 32) - __builtin_amdgcn_exp2f(sink2 - m_run[s]);
            if (hi == 0) wsf[r32] = 1.f / lt;
            LDS_WAIT();
            bf16* orow = CAT + (size_t)(rowbase + qw0) * DM + 768 + (hh * 2 + wsel) * 64 + r32;
#pragma unroll
            for (int r = 0; r < 16; ++r) { const int qr = crow(r, hi); const float f = wsf[qr];
#pragma unroll
                for (int e = 0; e < NEB; ++e) orow[(size_t)qr * DM + 32 * e] = (bf16)f2bf(o[s][e][r] * f); }
            LDS_WAIT();
        }
    } else if (MODE == 2) {
        const bf16* grow = PROJ + (size_t)(rowbase + qw0) * PWP + C_CG + hh * 128 + r32;
        bf16* orow = CAT + (size_t)(rowbase + qw0) * DM + 1536 + hh * 128 + r32;
#pragma unroll
        for (int r = 0; r < 16; ++r) {
            float s1 = 0.f;
#pragma unroll
            for (int e = 0; e < NEB; ++e) s1 += o[0][e][r];
#pragma unroll
            for (int sh = 1; sh < 32; sh <<= 1) s1 += __shfl_xor(s1, sh);
            const float mu = s1 * (1.f / 128.f); float s2 = 0.f;
#pragma unroll
            for (int e = 0; e < NEB; ++e) { const float d = o[0][e][r] - mu; s2 += d * d; }
#pragma unroll
            for (int sh = 1; sh < 32; sh <<= 1) s2 += __shfl_xor(s2, sh);
            const float rs = 1.f / sqrtf(s2 * (1.f / 128.f) + LN_EPS); const int qr = crow(r, hi);
#pragma unroll
            for (int e = 0; e < NEB; ++e) orow[(size_t)qr * DM + 32 * e] = (bf16)f2bf(pg8::silu_f(bf2f(grow[(size_t)qr * PWP + 32 * e])) * (o[0][e][r] - mu) * rs);
        }
    } else {
        const float lt = l_run[0] + __shfl_xor(l_run[0], 32);
        if (hi == 0) wsf[r32] = 1.f / lt;
        LDS_WAIT();
        LAS float* xb = (LAS float*)L + rg * 4096;
        if (wsel == 1) {
#pragma unroll
            for (int r = 0; r < 16; ++r) { const float f = wsf[crow(r, hi)];
#pragma unroll
                for (int e = 0; e < NEB; ++e) xb[(e * 16 + r) * 64 + lane] = o[0][e][r] * f; }
        }
        __syncthreads();
        if (wsel == 0) {
            const float* subg = a.in[4] + layer * 128; const float post = 1.f - lam_init;
            bf16* orow = CAT + (size_t)(rowbase + qw0) * DM + hh * 128 + r32;
#pragma unroll
            for (int r = 0; r < 16; ++r) { const float f = wsf[crow(r, hi)]; float d[NEB]; float ss = 0.f;
#pragma unroll
                for (int e = 0; e < NEB; ++e) { d[e] = o[0][e][r] * f - lam * xb[(e * 16 + r) * 64 + lane]; ss += d[e] * d[e]; }
#pragma unroll
                for (int sh = 1; sh < 32; sh <<= 1) ss += __shfl_xor(ss, sh);
                const float rs = (1.f / sqrtf(ss * (1.f / 128.f) + LN_EPS)) * post; const int qr = crow(r, hi);
#pragma unroll
                for (int e = 0; e < NEB; ++e) orow[(size_t)qr * DM + 32 * e] = (bf16)f2bf(d[e] * rs * subg[32 * e + r32]); }
        }
    }
    __syncthreads();
}
template <int MODE> __device__ __forceinline__ void mixer_queue(Frame& F, const Args& a, int layer, int qword, float lam, float lam_init) {
    constexpr int NU = (MODE == 0) ? 768 : (MODE == 1) ? 768 : 256;
    LAS int* qw = (LAS int*)(F.lds + MIX_QW);
    for (;;) {
        if (F.tid == 0) *qw = (int)__hip_atomic_fetch_add(F.ctl + CW_WQ + 64 * qword, 1u, RLX_AGENT);
        __syncthreads();
        const int it = __builtin_amdgcn_readfirstlane(*qw);
        __syncthreads();
        if (it >= NU) break;
        if (MODE == 0) mix_unit<0>(F, a, layer, (it % 48) / 6, it % 6, 15 - it / 48, lam, lam_init);
        else if (MODE == 2) mix_unit<2>(F, a, layer, (it & 31) >> 2, it & 3, 7 - (it >> 5), lam, lam_init);
        else mix_unit<1>(F, a, layer, it / 96, (it % 96) / 16, it & 15, lam, lam_init);
    }
}
__device__ __forceinline__ void mixer_phase(Frame& F, const Args& a, int layer, int rep) {
    const float lam_init = 0.8f - 0.6f * __expf(-0.3f * (float)layer);
    const float lam = __builtin_bit_cast(float, __builtin_amdgcn_readfirstlane(__builtin_bit_cast(int, lambda_of(a.in[3] + layer * 256, F.lane, lam_init))));
    const int qbase = 3 * (layer + 2 * rep);
    mixer_queue<2>(F, a, layer, qbase + 0, lam, lam_init);
    mixer_queue<0>(F, a, layer, qbase + 1, lam, lam_init);
    mixer_queue<1>(F, a, layer, qbase + 2, lam, lam_init);
}
#ifndef MIXER_NAIVE
#define MIXER_NAIVE 0
#endif
#ifndef PROBE_P0
#define PROBE_P0 1
#endif
#ifndef PROBE_MIX
#define PROBE_MIX 1
#endif
#ifndef PROBE_PROJ
#define PROBE_PROJ 1
#endif
#ifndef PROBE_DUP
#define PROBE_DUP 1
#endif
#ifndef PROBE_MUP
#define PROBE_MUP 1
#endif
#ifndef PROBE_MDN
#define PROBE_MDN 1
#endif
#define REPEAT(N) for (int rep = 0; rep < (N); ++rep)
#define TWICE_IF(N, CALL) do { CALL; if ((N) == 2) { xcd_barrier(bar); CALL; } } while (0)
#define REPBAR(N) do { if (rep + 1 < (N)) xcd_barrier(bar); } while (0)
#define IN(k) (lo <= (k) && (k) < hi)
#define SEAM(k) do { if (IN(k) && IN((k) + 1)) xcd_barrier(bar); } while (0)
template <int l> __device__ __forceinline__ void run_layer(Frame& F, const Args& args, const XcdBarrier& bar, int lo, int hi) {
    unsigned char* ws = args.ws;
    bf16* XB = (bf16*)(ws + WS_XB); bf16* PROJ = (bf16*)(ws + WS_PROJ); bf16* CAT = (bf16*)(ws + WS_CAT); bf16* HB = (bf16*)(ws + WS_H);
    float* T = args.out;
        const int pb = 1 + 7 * l;
        if (IN(pb)) {
            pg8::Gemm g{XB, (const bf16*)(ws + WS_WIN) + (size_t)l * PWP * DM, NTOK, PWP, DM * 2}; pg8::StaticOrder S; S.init(NTOK, PWP, F.G, (int)blockIdx.x);
            pg8::EpiProj E{PROJ, (const float*)(ws + WS_TAB), (const float*)(ws + WS_TAB + 256 * 1024)};
            TWICE_IF(PROBE_PROJ, (pg8::gemm_phase<pg8::EpiProj, pg8::StaticOrder, true, true>(F.lds + RING_OFF, F.wave, g, S, E)));
        } SEAM(pb);
        if (IN(pb + 1)) {
#if MIXER_NAIVE
            naive_mixers(F, args, l);
#else
            REPEAT(PROBE_MIX) { mixer_phase(F, args, l, rep); REPBAR(PROBE_MIX); }
#endif
        } SEAM(pb + 1);
        if (IN(pb + 2)) {
            pg8::Gemm g{CAT, (const bf16*)(ws + WS_WOUT) + (size_t)l * DM * DM, NTOK, DM, DM * 2}; pg8::StaticOrder S; S.init(NTOK, DM, F.G, (int)blockIdx.x);
            pg8::EpiResid E{T, l == 0 ? args.in[0] : T};
            pg8::gemm_phase<pg8::EpiResid, pg8::StaticOrder, true, true>(F.lds + RING_OFF, F.wave, g, S, E);
        } SEAM(pb + 2);
        if constexpr (l == 0) {
            if (IN(4)) { ln_phase<0>(F, args, T, args.in[7], args.in[8], nullptr); } SEAM(4);
            if (IN(5)) {
                pg8::Gemm g{XB, (const bf16*)(ws + WS_WDGU), NTOK, 2 * DFF, DM * 2}; pg8::StaticOrder S; S.init(NTOK, 2 * DFF, F.G, (int)blockIdx.x);
                pg8::EpiSwiGLU E{HB, 44};
                TWICE_IF(PROBE_DUP, (pg8::gemm_phase<pg8::EpiSwiGLU, pg8::StaticOrder, true, true>(F.lds + RING_OFF, F.wave, g, S, E)));
            } SEAM(5);
            if (IN(6)) {
                pg8::Gemm g{HB, (const bf16*)(ws + WS_WDDN), NTOK, DM, DFF * 2}; pg8::StaticOrder S; S.init(NTOK, DM, F.G, (int)blockIdx.x);
                pg8::EpiResid E{T, T};
                pg8::gemm_phase<pg8::EpiResid, pg8::StaticOrder, true, true>(F.lds + RING_OFF, F.wave, g, S, E);
            } SEAM(6);
            if (IN(7)) { ln_phase<0>(F, args, T, args.in[9], args.in[10], nullptr); } SEAM(7);
        } else {
            if (IN(11)) { ln_phase<1>(F, args, T, args.in[7] + DM, args.in[8] + DM, args.in[14]); } SEAM(11);
            if (IN(12)) { gather_phase(F, args, T); } SEAM(12);
            if (IN(13) || IN(14)) {
                int ntl_v; const int offv = expert_offsets(F, ntl_v); const int ntl = __builtin_amdgcn_readfirstlane(ntl_v);
                pg8::GroupedOrder S; S.nM = ntl; S.G = F.G; S.c = (int)blockIdx.x;
#pragma unroll
                for (int e = 0; e < 8; ++e) S.cum[e] = (e < 7) ? __builtin_amdgcn_readfirstlane(__shfl(offv, e + 1) >> 8) : ntl;
                if (IN(13)) {
                    S.nN = 44; S.nwg = ntl * 44;
                    pg8::Gemm g{ws + WS_XG, ws + WS_WMGU, ntl * 256, 8 * 2 * DFF, DM};
                    pg8::EpiSwiGLU8 E{ws + WS_H, 44};
                    TWICE_IF(PROBE_MUP, (pg8::gemm_phase<pg8::EpiSwiGLU8, pg8::GroupedOrder, true, true, true>(F.lds + RING_OFF, F.wave, g, S, E)));
                } SEAM(13);
                if (IN(14)) {
                    S.nN = 8; S.nwg = ntl * 8;
                    pg8::Gemm g{ws + WS_H, ws + WS_WMDN, ntl * 256, 8 * DM, DFF};
                    pg8::EpiY E{(bf16*)(ws + WS_Y), 8, 1.f / (pg8::FP8_SH * pg8::FP8_SWD)};
                    TWICE_IF(PROBE_MDN, (pg8::gemm_phase<pg8::EpiY, pg8::GroupedOrder, true, true, true>(F.lds + RING_OFF, F.wave, g, S, E)));
                } SEAM(14);
            }
            if (IN(15)) { ln_phase<2>(F, args, T, args.in[9] + DM, args.in[10] + DM, nullptr); }
        }
}
constexpr int N_PHASES = 16;
__global__ void __launch_bounds__(NWAVES * 64, 2) hymba_fwd(Args args) {
    extern __shared__ __attribute__((aligned(16))) unsigned char lds[];
    Frame F;
    F.lds = (LAS unsigned char*)lds;
    volatile LAS unsigned* MISC = (volatile LAS unsigned*)(F.lds + MISC_OFF);
    F.wave = __builtin_amdgcn_readfirstlane((int)threadIdx.x >> 6); F.lane = (int)__builtin_amdgcn_mbcnt_hi(~0u, __builtin_amdgcn_mbcnt_lo(~0u, 0u)); F.tid = F.wave * 64 + F.lane;
    F.G = gridDim.x; { const int bx = blockIdx.x; F.vcu = (F.G % 8 == 0) ? (bx % 8) * (F.G / 8) + bx / 8 : bx; }
    unsigned char* ws = args.ws;
    F.ctl = (gu32*)(ws + WS_CTL);
    for (int u = F.tid; u < 1024 / 4; u += NWAVES * 64) ((LAS unsigned*)(F.lds + LDSCTL_OFF))[u] = 0u;
    __syncthreads();
    XcdBarrier bar = xcd_barrier_post((unsigned*)(F.ctl + CW_BAR) + args.li * 4096, MISC + 8);
    build_lut(F, args.in[2]);
    __syncthreads();
    const int lo = args.ph_lo, hi = args.ph_hi;
    if (IN(0)) { REPEAT(PROBE_P0) { p0_prologue(F, args); REPBAR(PROBE_P0); } } SEAM(0);
    run_layer<0>(F, args, bar, lo, hi);
    run_layer<1>(F, args, bar, lo, hi);
#undef IN
#undef SEAM
}

#ifndef N_LAUNCHES
#define N_LAUNCHES 1
#endif
extern "C" void kernel_launch(void* const* d_in, const int* in_sizes, int n_in, void* d_out, int out_size, void* d_ws, size_t ws_size, hipStream_t stream) {
    static int grid = 0;
    if (grid == 0) {
        if (n_in != 18 || in_sizes[0] != NTOK * DM || out_size != NTOK * DM || ws_size < WS_END) { fprintf(stderr, "kernel_launch: unexpected shapes / workspace (%d inputs, ws %zu < %zu)\n", n_in, ws_size, (size_t)WS_END); grid = -1; return; }
        int dev = 0, cus = 0, per_cu = 0;
        if (hipGetDevice(&dev) != hipSuccess || hipDeviceGetAttribute(&cus, hipDeviceAttributeMultiprocessorCount, dev) != hipSuccess) { grid = -1; return; }
        if (hipFuncSetAttribute((const void*)hymba_fwd, hipFuncAttributeMaxDynamicSharedMemorySize, LDS_BYTES) != hipSuccess) { fprintf(stderr, "kernel_launch: hipFuncSetAttribute failed\n"); grid = -1; return; }
        if (hipOccupancyMaxActiveBlocksPerMultiprocessor(&per_cu, (const void*)hymba_fwd, NWAVES * 64, LDS_BYTES) != hipSuccess || per_cu < 1) fprintf(stderr, "kernel_launch: occupancy query reports %d\n", per_cu);
        (void)hipGetLastError();
        grid = (cus == 256) ? 256 : -1;
        if (grid < 0) { fprintf(stderr, "kernel_launch: built for a 256-CU device, found %d CUs\n", cus); return; }
    }
    if (grid < 0) return;
    if (hipMemsetAsync((char*)d_ws + WS_CTL, 0, CTL_ZERO_BYTES, stream) != hipSuccess) return;
    Args a{};
    for (int i = 0; i < 18; ++i) a.in[i] = (const float*)d_in[i];
    a.out = (float*)d_out; a.ws = (unsigned char*)d_ws;
    for (int i = 0; i < 32; ++i) a.invf[i] = (float)(1.0 / pow(10000.0, (double)((float)i / 31.0f)));
#if N_LAUNCHES == 1
    const int cuts[2] = {0, N_PHASES};
#else
    int cuts[N_PHASES + 1]; for (int i = 0; i <= N_PHASES; ++i) cuts[i] = i;
#endif
    const int nl = (N_LAUNCHES == 1) ? 1 : N_PHASES;
    for (int li = 0; li < nl; ++li) {
        a.ph_lo = cuts[li]; a.ph_hi = cuts[li + 1]; a.li = li; a.pad = 0;
        hipLaunchKernelGGL(hymba_fwd, dim3(grid), dim3(NWAVES * 64), LDS_BYTES, stream, a);
        const hipError_t le = hipPeekAtLastError();
        if (le != hipSuccess) { fprintf(stderr, "kernel_launch: launch %d failed: %s\n", li, hipGetErrorName(le)); break; }
    }
}
```

```cpp
#include <hip/hip_runtime.h>
#include <cstdio>
#include <cstdint>
#include <cmath>
namespace pg8 {
#define PG8_LAS __attribute__((address_space(3)))
typedef unsigned short bf16_t;
typedef short bf16x8 __attribute__((ext_vector_type(8)));
typedef float f32x4 __attribute__((ext_vector_type(4)));
typedef unsigned u32x4 __attribute__((ext_vector_type(4)));
constexpr int BM = 256, BK = 64, HALF = 128, HTB = HALF * BK * 2  , STAGE_BYTES = 8 * HTB, NXCD = 8, WGM = 8;

__host__ __device__ __forceinline__ int lds_byte(int r, int c) { const int st = (r >> 4) * 2 + (c >> 5), rr = r & 15, cc = c & 31, ob = rr * 64 + cc * 2; return st * 1024 + (ob ^ (((ob >> 9) & 1) << 5)); }
__host__ __device__ __forceinline__ void stage_rc(int b, int& R, int& C) { const int st = b / 1024, sb = b % 1024, swz = sb ^ (((sb >> 9) & 1) << 5); R = (st >> 1) * 16 + swz / 64; C = (st & 1) * 32 + (swz % 64) / 2; }
__host__ __device__ __forceinline__ int perm32(int rho) { const int n = rho >> 4, i = rho & 15; return 8 * (i >> 2) + 4 * n + (i & 3); }

struct Unit { int pm, pn; };
struct Gemm { const void* A; const void* Bt; int M, N, KB; };
typedef int v4i_t __attribute__((ext_vector_type(4)));
typedef int v8i_t __attribute__((ext_vector_type(8)));

struct StaticOrder {
    int nM, nN, nwg, G, c;
    __host__ __device__ void init(int M, int N, int G_, int c_) { nM = M / BM; nN = N / BM; nwg = nM * nN; G = G_; c = c_; }
    __host__ __device__ bool next(int i, Unit& u) const {
        const long L = (long)i * G + c; if (L >= nwg) return false;
        int wgid = (int)L; { const int q = nwg / NXCD, r = nwg % NXCD, xcd = wgid % NXCD, off = wgid / NXCD; wgid = (xcd < r ? xcd * (q + 1) : r * (q + 1) + (xcd - r) * q) + off; }
        const int nig = WGM * nN, gid = wgid / nig, fm = gid * WGM, gsz = (nM - fm) < WGM ? (nM - fm) : WGM;
        u.pm = fm + ((wgid % nig) % gsz); u.pn = (wgid % nig) / gsz; return true;
    }
    __device__ __forceinline__ void a_ready(const Unit&) const {}
    __device__ __forceinline__ void done(const Unit&) const {}
};

__device__ __forceinline__ unsigned cvt_pk_bf16(float lo, float hi) { unsigned r; asm volatile("v_cvt_pk_bf16_f32 %0, %1, %2" : "=v"(r) : "v"(lo), "v"(hi)); return r; }
typedef float f32x2 __attribute__((ext_vector_type(2)));
typedef float f32x2 __attribute__((ext_vector_type(2)));
typedef unsigned u32x2 __attribute__((ext_vector_type(2)));
constexpr float ALPHA_F = 1.41421356237309515f;
constexpr float C2_F = 0.125f * 1.4426950408889634f;
__device__ __forceinline__ u32x4 pack8(const f32x4 v0, const f32x4 v1) { u32x4 w; w.x = cvt_pk_bf16(v0[0], v0[1]); w.y = cvt_pk_bf16(v0[2], v0[3]); w.z = cvt_pk_bf16(v1[0], v1[1]); w.w = cvt_pk_bf16(v1[2], v1[3]); return w; }

struct EpiProj {
    static constexpr bool PERM = true, AFTER_DRAIN = false;
    bf16_t* O; const float* sinT; const float* cosT;
    __device__ __forceinline__ void operator()(const f32x4 (&acc)[2][2][4][2], const Unit& u, int wr, int wc, int fr, int fq) const {
        const int row0 = u.pm * BM + wr * 64 + fr;
#pragma unroll
        for (int bj = 0; bj < 2; ++bj) {
            const int cw = u.pn * BM + bj * HALF + wc * 32;
            const int c0 = cw + 8 * fq;
            float sc = 1.f; bool rope = false;
            if (cw < 768 || (cw >= 2304 && cw < 3072)) sc = C2_F;
            else if (cw >= 3456 && cw < 3968) { rope = true; if (cw >= 3712) sc = 0.125f; }
            const int i0 = ((c0 - 3456) & 63) >> 1;
#pragma unroll
            for (int ai = 0; ai < 2; ++ai)
#pragma unroll
                for (int m = 0; m < 4; ++m) {
                    const int row = row0 + ai * HALF + m * 16;
                    f32x4 v0 = acc[ai][bj][m][0] * sc, v1 = acc[ai][bj][m][1] * sc;
                    if (rope) {
                        const int pos = row & 2047;
                        const f32x4 sn = *(const f32x4*)(sinT + pos * 32 + i0), cs = *(const f32x4*)(cosT + pos * 32 + i0);
                        f32x4 w0, w1;
                        w0[0] = v0[0] * cs[0] - v0[1] * sn[0]; w0[1] = v0[1] * cs[0] + v0[0] * sn[0];
                        w0[2] = v0[2] * cs[1] - v0[3] * sn[1]; w0[3] = v0[3] * cs[1] + v0[2] * sn[1];
                        w1[0] = v1[0] * cs[2] - v1[1] * sn[2]; w1[1] = v1[1] * cs[2] + v1[0] * sn[2];
                        w1[2] = v1[2] * cs[3] - v1[3] * sn[3]; w1[3] = v1[3] * cs[3] + v1[2] * sn[3];
                        v0 = w0; v1 = w1;
                    }
                    *(u32x4*)(O + (size_t)row * 5120 + c0) = pack8(v0, v1);
                }
        }
    }
};
struct EpiResid {
    static constexpr bool PERM = true, AFTER_DRAIN = false;
    float* T; const float* R; float scale;
    __device__ __forceinline__ void operator()(const f32x4 (&acc)[2][2][4][2], const Unit& u, int wr, int wc, int fr, int fq) const {
        const int row0 = u.pm * BM + wr * 64 + fr, col0 = u.pn * BM + wc * 32 + 8 * fq;
#pragma unroll
        for (int ai = 0; ai < 2; ++ai)
#pragma unroll
            for (int m = 0; m < 4; ++m) {
                const size_t ro = (size_t)(row0 + ai * HALF + m * 16) * 2048 + col0;
#pragma unroll
                for (int bj = 0; bj < 2; ++bj) {
                    const f32x4 r0 = *(const f32x4*)(R + ro + bj * HALF), r1 = *(const f32x4*)(R + ro + bj * HALF + 4);
                    *(f32x4*)(T + ro + bj * HALF) = r0 * ALPHA_F + acc[ai][bj][m][0] * scale;
                    *(f32x4*)(T + ro + bj * HALF + 4) = r1 * ALPHA_F + acc[ai][bj][m][1] * scale;
                }
            }
    }
};
__device__ __forceinline__ float silu_f(float x) { return x * __builtin_amdgcn_rcpf(1.f + __builtin_amdgcn_exp2f(-1.4426950408889634f * x)); }
struct EpiSwiGLU {
    static constexpr bool PERM = true, AFTER_DRAIN = false;
    bf16_t* H; int ntn;
    __device__ __forceinline__ void operator()(const f32x4 (&acc)[2][2][4][2], const Unit& u, int wr, int wc, int fr, int fq) const {
        const int row0 = u.pm * BM + wr * 64 + fr, col0 = (u.pn % ntn) * HALF + wc * 32 + 8 * fq;
#pragma unroll
        for (int ai = 0; ai < 2; ++ai)
#pragma unroll
            for (int m = 0; m < 4; ++m) {
                f32x4 h0, h1;
#pragma unroll
                for (int j = 0; j < 4; ++j) { h0[j] = silu_f(acc[ai][0][m][0][j]) * acc[ai][1][m][0][j]; h1[j] = silu_f(acc[ai][0][m][1][j]) * acc[ai][1][m][1][j]; }
                *(u32x4*)(H + (size_t)(row0 + ai * HALF + m * 16) * 5632 + col0) = pack8(h0, h1);
            }
    }
};
constexpr float FP8_SX = 16.f, FP8_SWU = 512.f, FP8_SH = 8.f, FP8_SWD = 2048.f;
__device__ __forceinline__ unsigned pack4_fp8(float a, float b, float c, float d) {
    a = __builtin_amdgcn_fmed3f(a, -448.f, 448.f); b = __builtin_amdgcn_fmed3f(b, -448.f, 448.f); c = __builtin_amdgcn_fmed3f(c, -448.f, 448.f); d = __builtin_amdgcn_fmed3f(d, -448.f, 448.f);
    int w = __builtin_amdgcn_cvt_pk_fp8_f32(a, b, 0, false); w = __builtin_amdgcn_cvt_pk_fp8_f32(c, d, w, true); return (unsigned)w;
}
struct EpiSwiGLU8 {
    static constexpr bool PERM = true, AFTER_DRAIN = false;
    unsigned char* H; int ntn; float si;
    __device__ __forceinline__ void operator()(const f32x4 (&acc)[2][2][4][2], const Unit& u, int wr, int wc, int fr, int fq) const {
        const int row0 = u.pm * BM + wr * 64 + fr, col0 = (u.pn % ntn) * HALF + wc * 32 + 8 * fq;
#pragma unroll
        for (int ai = 0; ai < 2; ++ai)
#pragma unroll
            for (int m = 0; m < 4; ++m) {
                f32x4 h0, h1;
#pragma unroll
                for (int j = 0; j < 4; ++j) { h0[j] = silu_f(acc[ai][0][m][0][j] * si) * (acc[ai][1][m][0][j] * (si * FP8_SH)); h1[j] = silu_f(acc[ai][0][m][1][j] * si) * (acc[ai][1][m][1][j] * (si * FP8_SH)); }
                u32x2 w; w.x = pack4_fp8(h0[0], h0[1], h0[2], h0[3]); w.y = pack4_fp8(h1[0], h1[1], h1[2], h1[3]);
                *(u32x2*)(H + (size_t)(row0 + ai * HALF + m * 16) * 5632 + col0) = w;
            }
    }
};
struct EpiY {
    static constexpr bool PERM = true, AFTER_DRAIN = false;
    bf16_t* Y; int ntn; float scale;
    __device__ __forceinline__ void operator()(const f32x4 (&acc)[2][2][4][2], const Unit& u, int wr, int wc, int fr, int fq) const {
        const int row0 = u.pm * BM + wr * 64 + fr, col0 = (u.pn % ntn) * BM + wc * 32 + 8 * fq;
#pragma unroll
        for (int ai = 0; ai < 2; ++ai)
#pragma unroll
            for (int m = 0; m < 4; ++m)
#pragma unroll
                for (int bj = 0; bj < 2; ++bj)
                    *(u32x4*)(Y + (size_t)(row0 + ai * HALF + m * 16) * 2048 + col0 + bj * HALF) = pack8(acc[ai][bj][m][0] * scale, acc[ai][bj][m][1] * scale);
    }
};
struct GroupedOrder {
    int nM, nN, nwg, G, c; int cum[8];
    __device__ __forceinline__ bool next(int i, Unit& u) const {
        const long L = (long)i * G + c; if (L >= nwg) return false;
        int wgid = (int)L; { const int q = nwg / NXCD, r = nwg % NXCD, xcd = wgid % NXCD, off = wgid / NXCD; wgid = (xcd < r ? xcd * (q + 1) : r * (q + 1) + (xcd - r) * q) + off; }
        const int nig = WGM * nN, gid = wgid / nig, fm = gid * WGM, gsz = (nM - fm) < WGM ? (nM - fm) : WGM;
        const int pm = fm + ((wgid % nig) % gsz), pn = (wgid % nig) / gsz;
        int e = 0;
#pragma unroll
        for (int j = 0; j < 7; ++j) e += (pm >= cum[j]) ? 1 : 0;
        u.pm = pm; u.pn = e * nN + pn; return true;
    }
    __device__ __forceinline__ void a_ready(const Unit&) const {}
    __device__ __forceinline__ void done(const Unit&) const {}
};
template <class Epi, class Sched, bool ALIGN_EPI = false, bool SP2 = false, bool FP8 = false>
__device__ __forceinline__ void gemm_phase(PG8_LAS unsigned char* lds, const int wid, const Gemm g, const Sched& S, const Epi& E) {
    const int lane = (int)__builtin_amdgcn_mbcnt_hi(~0u, __builtin_amdgcn_mbcnt_lo(~0u, 0u)), tid = wid * 64 + lane,
        wr = wid >> 2, wc = wid & 3, fr = lane & 15, fq = lane >> 4;
    const int KB = g.KB, nt = KB / 128;
    unsigned voffA[2], voffB[2];
#pragma unroll
    for (int i = 0; i < 2; ++i) { int R, C; stage_rc(tid * 16 + i * 8192, R, C); const int Rb = Epi::PERM ? ((R & ~31) + perm32(R & 31)) : R;
        voffA[i] = (unsigned)(R * KB + C * 2); voffB[i] = (unsigned)(Rb * KB + C * 2); }
    const size_t kstep = (size_t)128;
    const size_t hstep = (size_t)HALF * KB;
    const size_t tstep = 2 * hstep;
    const unsigned ldsw = (unsigned)wid * 1024u;
    const int aoff = lds_byte(wr * 64 + fr, fq * 8), boff = lds_byte(wc * 32 + fr, fq * 8);
#define PG8_SA(b, h) (((b) * 2 + (h)) * HTB)
#define PG8_SB(b, h) ((4 + (b) * 2 + (h)) * HTB)
#define PG8_STAGE(bufoff, gbase, voff) do { _Pragma("unroll") for (int _i = 0; _i < 2; ++_i) \
        __builtin_amdgcn_global_load_lds((const unsigned*)((const char*)(gbase) + (voff)[_i]), (PG8_LAS unsigned*)(lds + (bufoff) + ldsw + _i * 8192), 16, 0, 0); } while (0)
#define PG8_LDA(dst, b, h) do { _Pragma("unroll") for (int m = 0; m < 4; ++m) _Pragma("unroll") for (int k = 0; k < 2; ++k) dst[m][k] = *(const PG8_LAS bf16x8*)(lds + PG8_SA(b, h) + aoff + m * 2048 + k * 1024); } while (0)
#define PG8_LDB(dst, b, h) do { _Pragma("unroll") for (int n = 0; n < 2; ++n) _Pragma("unroll") for (int k = 0; k < 2; ++k) dst[n][k] = *(const PG8_LAS bf16x8*)(lds + PG8_SB(b, h) + boff + n * 2048 + k * 1024); } while (0)
#define PG8_MMA(ai, bj, At, Bt) do { __builtin_amdgcn_s_setprio(1); _Pragma("unroll") for (int m = 0; m < 4; ++m) _Pragma("unroll") for (int n = 0; n < 2; ++n) { \
        if constexpr (FP8) { const v4i_t b0_ = __builtin_bit_cast(v4i_t, Bt[n][0]), b1_ = __builtin_bit_cast(v4i_t, Bt[n][1]), a0_ = __builtin_bit_cast(v4i_t, At[m][0]), a1_ = __builtin_bit_cast(v4i_t, At[m][1]); \
            const v8i_t b8_ = __builtin_shufflevector(b0_, b1_, 0, 1, 2, 3, 4, 5, 6, 7), a8_ = __builtin_shufflevector(a0_, a1_, 0, 1, 2, 3, 4, 5, 6, 7); \
            asm volatile("v_mfma_f32_16x16x128_f8f6f4 %0, %1, %2, %0" : "+v"(acc[ai][bj][m][n]) : "v"(b8_), "v"(a8_)); } \
        else { _Pragma("unroll") for (int k = 0; k < 2; ++k) acc[ai][bj][m][n] = __builtin_amdgcn_mfma_f32_16x16x32_bf16(Bt[n][k], At[m][k], acc[ai][bj][m][n], 0, 0, 0); } } __builtin_amdgcn_s_setprio(0); } while (0)
#define PG8_WAIT_V(n) asm volatile("s_waitcnt vmcnt(" #n ")" ::: "memory")
#define PG8_WAIT_L(n) asm volatile("s_waitcnt lgkmcnt(" #n ")" ::: "memory")
#define PG8_BAR __builtin_amdgcn_s_barrier()
#define PG8_SCHED __builtin_amdgcn_sched_barrier(0)
    Unit cur, nxt; int ui = 0;
    if (!S.next(0, cur)) return;
    f32x4 acc[2][2][4][2];
#pragma unroll
    for (int a = 0; a < 2; ++a)
#pragma unroll
        for (int b = 0; b < 2; ++b)
#pragma unroll
            for (int m = 0; m < 4; ++m)
#pragma unroll
                for (int n = 0; n < 2; ++n) acc[a][b][m][n] = (f32x4){0.f, 0.f, 0.f, 0.f};
    bf16x8 At[4][2], B0[2][2], B1[2][2];
    const char* cA = (const char*)g.A + (size_t)cur.pm * tstep; const char* cB = (const char*)g.Bt + (size_t)cur.pn * tstep;
    S.a_ready(cur);
    if constexpr (SP2) {
        PG8_STAGE(PG8_SB(0, 0), cB, voffB); PG8_STAGE(PG8_SB(0, 1), cB + hstep, voffB); PG8_STAGE(PG8_SA(0, 0), cA, voffA); PG8_STAGE(PG8_SA(0, 1), cA + hstep, voffA);
        if (wr == 1) PG8_BAR;
        PG8_WAIT_V(2); PG8_BAR;
        PG8_STAGE(PG8_SB(1, 0), cB + kstep, voffB); PG8_STAGE(PG8_SA(1, 0), cA + kstep, voffA); PG8_STAGE(PG8_SB(1, 1), cB + hstep + kstep, voffB);
        PG8_WAIT_V(6); PG8_BAR;
    } else {
        PG8_STAGE(PG8_SB(0, 0), cB, voffB); PG8_STAGE(PG8_SA(0, 0), cA, voffA); PG8_STAGE(PG8_SB(0, 1), cB + hstep, voffB); PG8_STAGE(PG8_SA(0, 1), cA + hstep, voffA);
        if (wr == 1) PG8_BAR;
        PG8_WAIT_V(4); PG8_BAR;
        PG8_STAGE(PG8_SB(1, 0), cB + kstep, voffB); PG8_STAGE(PG8_SA(1, 0), cA + kstep, voffA); PG8_STAGE(PG8_SB(1, 1), cB + hstep + kstep, voffB);
        PG8_WAIT_V(6); PG8_BAR;
    }
    for (;;) {
        const bool has_next = S.next(ui + 1, nxt);
        const char* nA = has_next ? (const char*)g.A + (size_t)nxt.pm * tstep : cA; const char* nB = has_next ? (const char*)g.Bt + (size_t)nxt.pn * tstep : cB;
        for (int t = 0; t < nt; t += 2) {
            const bool last = (t == nt - 2);
            const char* a1 = cA + (size_t)(t + 1) * kstep;
            const char* a2 = last ? nA : cA + (size_t)(t + 2) * kstep; const char* b2 = last ? nB : cB + (size_t)(t + 2) * kstep;
            const char* a3 = a2 + kstep; const char* b3 = b2 + kstep;
            if (last && has_next) S.a_ready(nxt);
            if constexpr (SP2) {
            PG8_LDB(B0, 0, 0); PG8_LDB(B1, 0, 1); PG8_SCHED; PG8_LDA(At, 0, 0); PG8_STAGE(PG8_SA(1, 1), a1 + hstep, voffA);
            PG8_WAIT_V(8); PG8_WAIT_L(0); PG8_BAR; PG8_MMA(0, 0, At, B0); PG8_MMA(0, 1, At, B1); PG8_BAR; PG8_SCHED;
            PG8_LDA(At, 0, 1); PG8_STAGE(PG8_SB(0, 0), b2, voffB); PG8_STAGE(PG8_SB(0, 1), b2 + hstep, voffB); PG8_STAGE(PG8_SA(0, 0), a2, voffA);
            PG8_WAIT_V(8); PG8_WAIT_L(0); PG8_BAR; PG8_MMA(1, 0, At, B0); PG8_MMA(1, 1, At, B1); PG8_BAR; PG8_SCHED;
            PG8_LDB(B0, 1, 0); PG8_LDB(B1, 1, 1); PG8_SCHED; PG8_LDA(At, 1, 0); PG8_STAGE(PG8_SA(0, 1), a2 + hstep, voffA);
            PG8_WAIT_V(8); PG8_WAIT_L(0); PG8_BAR; PG8_MMA(0, 0, At, B0); PG8_MMA(0, 1, At, B1); PG8_BAR; PG8_SCHED;
            PG8_LDA(At, 1, 1); PG8_STAGE(PG8_SB(1, 0), b3, voffB); PG8_STAGE(PG8_SB(1, 1), b3 + hstep, voffB); PG8_STAGE(PG8_SA(1, 0), a3, voffA);
            PG8_WAIT_V(8); PG8_WAIT_L(0); PG8_BAR; PG8_MMA(1, 0, At, B0); PG8_MMA(1, 1, At, B1); PG8_BAR; PG8_SCHED;
            } else {
            PG8_LDB(B0, 0, 0); PG8_SCHED; PG8_LDA(At, 0, 0); PG8_STAGE(PG8_SA(1, 1), a1 + hstep, voffA);
            PG8_WAIT_L(8); PG8_BAR; PG8_WAIT_L(0); PG8_MMA(0, 0, At, B0); PG8_BAR; PG8_SCHED;
            PG8_LDB(B1, 0, 1); PG8_STAGE(PG8_SB(0, 0), b2, voffB);
            PG8_BAR; PG8_WAIT_L(0); PG8_MMA(0, 1, At, B1); PG8_BAR;
            PG8_LDA(At, 0, 1); PG8_STAGE(PG8_SA(0, 0), a2, voffA);
            PG8_BAR; PG8_WAIT_L(0); PG8_MMA(1, 0, At, B0); PG8_BAR; PG8_SCHED;
            PG8_STAGE(PG8_SB(0, 1), b2 + hstep, voffB);
            PG8_WAIT_V(6); PG8_BAR; PG8_MMA(1, 1, At, B1); PG8_BAR;
            PG8_LDB(B0, 1, 0); PG8_SCHED; PG8_LDA(At, 1, 0); PG8_STAGE(PG8_SA(0, 1), a2 + hstep, voffA);
            PG8_WAIT_L(8); PG8_BAR; PG8_WAIT_L(0); PG8_MMA(0, 0, At, B0); PG8_BAR; PG8_SCHED;
            PG8_LDB(B1, 1, 1); PG8_STAGE(PG8_SB(1, 0), b3, voffB);
            PG8_BAR; PG8_WAIT_L(0); PG8_MMA(0, 1, At, B1); PG8_BAR;
            PG8_LDA(At, 1, 1); PG8_STAGE(PG8_SA(1, 0), a3, voffA);
            PG8_BAR; PG8_WAIT_L(0); PG8_MMA(1, 0, At, B0); PG8_BAR; PG8_SCHED;
            PG8_STAGE(PG8_SB(1, 1), b3 + hstep, voffB);
            PG8_WAIT_V(6); PG8_BAR; PG8_MMA(1, 1, At, B1); PG8_BAR;
            }
        }
        if constexpr (ALIGN_EPI) { if (wr == 0) PG8_BAR; }
        if constexpr (FP8) asm volatile("s_nop 15\n\ts_nop 15" ::: "memory");
        if constexpr (!Epi::AFTER_DRAIN) { E(acc, cur, wr, wc, fr, fq); S.done(cur); }
        if (!has_next) break;
#pragma unroll
        for (int a = 0; a < 2; ++a)
#pragma unroll
            for (int b = 0; b < 2; ++b)
#pragma unroll
                for (int m = 0; m < 4; ++m)
#pragma unroll
                    for (int n = 0; n < 2; ++n) acc[a][b][m][n] = (f32x4){0.f, 0.f, 0.f, 0.f};
        cur = nxt; cA = nA; cB = nB; ++ui;
        if constexpr (ALIGN_EPI) { if (wr == 1) PG8_BAR; }
    }
    PG8_WAIT_V(0);
    if constexpr (!ALIGN_EPI) { if (wr == 0) PG8_BAR; }
    PG8_BAR;
    if constexpr (Epi::AFTER_DRAIN) { E.fused(acc, cur, wr, wc, fr, fq, lds, wid, lane); S.done(cur); }
#undef PG8_SA
#undef PG8_SB
#undef PG8_STAGE
#undef PG8_LDA
#undef PG8_LDB
#undef PG8_MMA
#undef PG8_WAIT_V
#undef PG8_WAIT_L
#undef PG8_BAR
#undef PG8_SCHED
}
}
constexpr int NWAVES = 8;
constexpr int NTOK = 16384, SEQ = 2048, DM = 2048, PW = 4992, PWP = 5120, DFF = 5632, NEXP = 8, MAXTILES = 136;
constexpr float LN_EPS = 1e-5f;
constexpr float LOG2E = 1.4426950408889634f;
constexpr int C_AQ = 0, C_AK = 768, C_AV = 1536, C_BQ = 2304, C_BK = 3072, C_BV = 3264, C_CQ = 3456, C_CK = 3712, C_CV = 3968, C_CG = 4480;
constexpr size_t MiB = 1u << 20;
constexpr size_t WS_CTL = 0, CTL_ZERO_BYTES = 1 * MiB;
constexpr size_t WS_TAB = 1 * MiB;
constexpr size_t WS_ROUTE = 2 * MiB;
constexpr size_t WS_WIN = 4 * MiB, WS_WOUT = 44 * MiB, WS_WDGU = 60 * MiB, WS_WDDN = 104 * MiB, WS_WMGU = 126 * MiB, WS_WMDN = 478 * MiB;
constexpr size_t WS_XB = 654 * MiB, WS_XG = 718 * MiB, WS_U1 = 854 * MiB, WS_END = 1228 * MiB;
constexpr size_t WS_PROJ = WS_U1, WS_CAT = WS_U1 + 160 * MiB, WS_H = WS_U1, WS_Y = WS_XG;
static_assert(WS_WIN + 2ull * PWP * DM * 2 <= WS_WOUT && WS_WOUT + 2ull * DM * DM * 2 <= WS_WDGU && WS_WDGU + 2ull * DFF * DM * 2 <= WS_WDDN && WS_WDDN + (size_t)DM * DFF * 2 <= WS_WMGU, "ws map 1");
static_assert(WS_WMGU + 8ull * 2 * DFF * DM * 2 <= WS_WMDN && WS_WMDN + 8ull * DM * DFF * 2 <= WS_XB && WS_XB + (size_t)NTOK * DM * 2 <= WS_XG && WS_XG + (size_t)MAXTILES * 256 * DM * 2 <= WS_U1, "ws map 2");
static_assert(WS_U1 + (size_t)MAXTILES * 256 * DFF * 2 <= WS_END && WS_PROJ + (size_t)NTOK * PWP * 2 <= WS_CAT && WS_CAT + (size_t)NTOK * DM * 2 <= WS_END, "ws map 3");
constexpr int CW_TMO = 0, CW_CODE = 1, CW_CNT = 1024  , CW_WQ = 2048  , CW_BAR = 4096  ;
constexpr int RING_OFF = 0, RING_BYTES = 131072;
constexpr int LDSCTL_OFF = RING_BYTES, MISC_OFF = LDSCTL_OFF + 320;
constexpr int LUT_OFF = LDSCTL_OFF + 1024;
constexpr int LUT_STRIDE = 132;
constexpr int LDS_BYTES = 147456;
static_assert(LUT_OFF + 18 * LUT_STRIDE * 4 <= LDS_BYTES, "LDS map");

#define GAS __attribute__((address_space(1)))
#define LAS __attribute__((address_space(3)))
typedef unsigned short bf16;
typedef unsigned v4u __attribute__((ext_vector_type(4)));
typedef unsigned v2u __attribute__((ext_vector_type(2)));
typedef float f32x4 __attribute__((ext_vector_type(4)));
typedef short bf16x8 __attribute__((ext_vector_type(8)));
typedef GAS unsigned gu32;
#define RLX_AGENT __ATOMIC_RELAXED, __HIP_MEMORY_SCOPE_AGENT
#define LDS_WAIT() asm volatile("s_waitcnt lgkmcnt(0)" ::: "memory")
#define VM_WAIT() asm volatile("s_waitcnt vmcnt(0)" ::: "memory")
__device__ __forceinline__ unsigned f2bf(float f) { unsigned u = __builtin_bit_cast(unsigned, f); return (u + 0x7fffu + ((u >> 16) & 1u)) >> 16; }
__device__ __forceinline__ unsigned pk2(float lo, float hi) { return f2bf(lo) | (f2bf(hi) << 16); }
__device__ __forceinline__ float bflo(unsigned w) { return __builtin_bit_cast(float, w << 16); }
__device__ __forceinline__ float bfhi(unsigned w) { return __builtin_bit_cast(float, w & 0xffff0000u); }
__device__ __forceinline__ float bf2f(bf16 h) { return __builtin_bit_cast(float, (unsigned)h << 16); }
__device__ const unsigned char BUCKET[129] = {0,1,2,3,4,5,6,7,8,9,10,11,12,13,14,15,16,16,16,17,17,18,18,18,19,19,19,20,20,20,20,21,21,21,21,22,22,22,22,22,23,23,23,23,23,23,24,24,24,24,24,24,25,25,25,25,25,25,25,
    26,26,26,26,26,26,26,26,27,27,27,27,27,27,27,27,27,27,28,28,28,28,28,28,28,28,28,28,29,29,29,29,29,29,29,29,29,29,29,29,30,30,30,30,30,30,30,30,30,30,30,30,30,30,31,31,31,31,31,31,31,31,31,31,31,31,31,31,31,31};
#define XB_TMO      128
#define XB_XCNT(j)  (256  + 64 * (j))
#define XB_XSUB(j)  (1280 + 64 * (j))
#define XB_XGEN(j)  (2304 + 64 * (j))
#define XB_TOP      3328
#define XB_TOPGEN   3392
#define XCD_BAR_WORDS 3456
#define XB_SPIN_CAP (1u << 18)

__device__ __forceinline__ unsigned xb_ld(unsigned* p)              { return __hip_atomic_load(p, __ATOMIC_RELAXED, __HIP_MEMORY_SCOPE_AGENT); }
__device__ __forceinline__ unsigned xb_add(unsigned* p, unsigned v) { return __hip_atomic_fetch_add(p, v, __ATOMIC_RELAXED, __HIP_MEMORY_SCOPE_AGENT); }
__device__ __forceinline__ unsigned xb_xcc_id() { return (unsigned)__builtin_amdgcn_s_getreg((3 << 11) | 20) & 0xFu; }
#define XB_SPIN(cond, bar) do { unsigned _sp = 0; while (cond) { __builtin_amdgcn_s_sleep(1); \
    if ((++_sp & 255u) == 0u) { if (xb_ld(&(bar)[XB_TMO])) break; if (_sp > XB_SPIN_CAP) { atomicAdd(&(bar)[XB_TMO], 1u); break; } } } } while (0)

struct XcdBarrier {
    unsigned* bar; unsigned x;
    volatile LAS unsigned* st;
};

__device__ __forceinline__ XcdBarrier xcd_barrier_post(unsigned* bar, volatile LAS unsigned* st) {
    XcdBarrier b; b.bar = bar; b.x = xb_xcc_id(); b.st = st;
    if (threadIdx.x == 0) (void)xb_add(&bar[XB_XCNT(b.x)], 1u);
    return b;
}
__device__ __forceinline__ void xcd_barrier_complete(unsigned* bar, unsigned x, unsigned& nloc, unsigned& nx) {
    const unsigned G = gridDim.x * gridDim.y * gridDim.z;
    unsigned sum, cnt, mine, sp = 0u;
    for (;;) {
        sum = 0u; cnt = 0u; mine = 0u;
#pragma unroll
        for (unsigned j = 0; j < 16; ++j) { const unsigned c = xb_ld(&bar[XB_XCNT(j)]); sum += c; cnt += (c > 0u) ? 1u : 0u; mine = (j == x) ? c : mine; }
        if (sum == G) break;
        __builtin_amdgcn_s_sleep(1);
        if ((++sp & 255u) == 0u) { if (xb_ld(&bar[XB_TMO])) break; if (sp > XB_SPIN_CAP) { atomicAdd(&bar[XB_TMO], 1u); break; } }
    }
    nloc = mine > 0u ? mine : 1u; nx = cnt > 0u ? cnt : 1u;
}

__device__ __forceinline__ void xcd_barrier(const XcdBarrier& b) {
    asm volatile("s_waitcnt vmcnt(0)" ::: "memory");
    __syncthreads();
    if (threadIdx.x == 0) {
        unsigned* bar = b.bar;
        __builtin_amdgcn_s_waitcnt(0);
        unsigned nloc = b.st[0], nx = b.st[1];
        if (nloc == 0u) { xcd_barrier_complete(bar, b.x, nloc, nx); b.st[0] = nloc; b.st[1] = nx; }
        const unsigned old = xb_add(&bar[XB_XSUB(b.x)], 1u);
        const unsigned gen = old / nloc;
        if (old + 1u == (gen + 1u) * nloc) {
            __builtin_amdgcn_fence(__ATOMIC_RELEASE, "agent");
            asm volatile("s_waitcnt vmcnt(0)" ::: "memory");
            const unsigned og = xb_add(&bar[XB_TOP], 1u);
            const unsigned tg = og / nx;
            if (og + 1u == (tg + 1u) * nx) xb_add(&bar[XB_TOPGEN], 1u);
            else XB_SPIN(xb_ld(&bar[XB_TOPGEN]) == tg, bar);
            __builtin_amdgcn_fence(__ATOMIC_ACQUIRE, "agent");
            xb_add(&bar[XB_XGEN(b.x)], 1u);
            asm volatile("s_waitcnt vmcnt(0)" ::: "memory");
        } else {
            XB_SPIN(xb_ld(&bar[XB_XGEN(b.x)]) == gen, bar);
            __builtin_amdgcn_fence(__ATOMIC_ACQUIRE, "agent");
            asm volatile("s_waitcnt vmcnt(0)" ::: "memory");
        }
    }
    __syncthreads();
}
struct Args { const float* in[18]; float* out; unsigned char* ws; int ph_lo, ph_hi, li, pad; float invf[32]; };
static_assert(sizeof(Args) == 20 * 8 + 16 + 128, "Args has no padding bytes");
struct Frame {
    LAS unsigned char* lds;
    gu32* ctl;
    int tid, lane, wave, vcu, G;
};
__device__ __forceinline__ float wave_sum(float v) {
#pragma unroll
    for (int o = 1; o < 64; o <<= 1) v += __shfl_xor(v, o);
    return v;
}
__device__ __forceinline__ float wave_max(float v) {
#pragma unroll
    for (int o = 1; o < 64; o <<= 1) v = fmaxf(v, __shfl_xor(v, o));
    return v;
}
__device__ __forceinline__ void p0_transpose_item(const float* W, int K, int N, bf16* WT, int k0, int n0, int drow0, LAS float* scr, int lane) {
#pragma unroll 8
    for (int i = 0; i < 32; ++i) { const int kk = 2 * i + (lane >> 5); scr[kk * 33 + (lane & 31)] = W[(size_t)(k0 + kk) * N + n0 + (lane & 31)]; }
    LDS_WAIT(); asm volatile("" ::: "memory");
    const int c = lane & 7;
#pragma unroll
    for (int j = 0; j < 4; ++j) { const int n = (lane >> 3) + 8 * j; const LAS float* s = scr + (8 * c) * 33 + n;
        v4u o; o.x = pk2(s[0 * 33], s[1 * 33]); o.y = pk2(s[2 * 33], s[3 * 33]); o.z = pk2(s[4 * 33], s[5 * 33]); o.w = pk2(s[6 * 33], s[7 * 33]);
        *(GAS v4u*)(WT + (size_t)(drow0 + n) * K + k0 + 8 * c) = o; }
    LDS_WAIT(); asm volatile("" ::: "memory");
}
template <int MODE> __device__ __forceinline__ void p0_matrix_item(const float* W, int K, int N, bf16* WT, int item, LAS float* scr, int lane) {
    const int nblk = N / 32, kb = item / nblk, nb = item % nblk, n0 = 32 * nb;
    const int drow0 = (MODE == 0) ? n0 : ((n0 >> 7) * 256 + (n0 & 127) + (MODE == 2 ? 128 : 0));
    p0_transpose_item(W, K, N, WT, 64 * kb, n0, drow0, scr, lane);
}
__device__ __forceinline__ void p0_transpose_item8(const float* W, int K, int N, unsigned char* WT, int k0, int n0, int drow0, float scale, LAS float* scr, int lane) {
#pragma unroll 8
    for (int i = 0; i < 32; ++i) { const int kk = 2 * i + (lane >> 5); scr[kk * 33 + (lane & 31)] = W[(size_t)(k0 + kk) * N + n0 + (lane & 31)] * scale; }
    LDS_WAIT(); asm volatile("" ::: "memory");
    const int c = lane & 7;
#pragma unroll
    for (int j = 0; j < 4; ++j) { const int n = (lane >> 3) + 8 * j; const LAS float* s = scr + (8 * c) * 33 + n;
        v2u o; o.x = pg8::pack4_fp8(s[0 * 33], s[1 * 33], s[2 * 33], s[3 * 33]); o.y = pg8::pack4_fp8(s[4 * 33], s[5 * 33], s[6 * 33], s[7 * 33]);
        *(GAS v2u*)(WT + (size_t)(drow0 + n) * K + k0 + 8 * c) = o; }
    LDS_WAIT(); asm volatile("" ::: "memory");
}
template <int MODE> __device__ __forceinline__ void p0_matrix_item8(const float* W, int K, int N, unsigned char* WT, int item, float scale, LAS float* scr, int lane) {
    const int nblk = N / 32, kb = item / nblk, nb = item % nblk, n0 = 32 * nb;
    const int drow0 = (MODE == 0) ? n0 : ((n0 >> 7) * 256 + (n0 & 127) + (MODE == 2 ? 128 : 0));
    p0_transpose_item8(W, K, N, WT, 64 * kb, n0, drow0, scale, scr, lane);
}
__device__ __forceinline__ void p0_prologue(Frame& F, const Args& a) {
    LAS float* scr = (LAS float*)(F.lds + RING_OFF + F.wave * 16384);
    const int gw = F.vcu * NWAVES + F.wave, NGW = F.G * NWAVES;
    unsigned char* ws = a.ws;
    constexpr int I_IN = (DM / 64) * (PW / 32), I_OUT = (DM / 64) * (DM / 32), I_GU = (DM / 64) * (DFF / 32), I_DN = (DFF / 64) * (DM / 32);
    constexpr int NITEMS = 2 * I_IN + 2 * I_OUT + 2 * I_GU + I_DN + 8 * (2 * I_GU + I_DN);
    for (int it = gw; it < NITEMS; it += NGW) {
        int r = it;
        if (r < 2 * I_IN) { const int l = r / I_IN; p0_matrix_item<0>(a.in[1] + (size_t)l * DM * PW, DM, PW, (bf16*)(ws + WS_WIN) + (size_t)l * PWP * DM, r % I_IN, scr, F.lane); continue; } r -= 2 * I_IN;
        if (r < 2 * I_OUT) { const int l = r / I_OUT; p0_matrix_item<0>(a.in[6] + (size_t)l * DM * DM, DM, DM, (bf16*)(ws + WS_WOUT) + (size_t)l * DM * DM, r % I_OUT, scr, F.lane); continue; } r -= 2 * I_OUT;
        if (r < I_GU) { p0_matrix_item<1>(a.in[11], DM, DFF, (bf16*)(ws + WS_WDGU), r, scr, F.lane); continue; } r -= I_GU;
        if (r < I_GU) { p0_matrix_item<2>(a.in[12], DM, DFF, (bf16*)(ws + WS_WDGU), r, scr, F.lane); continue; } r -= I_GU;
        if (r < I_DN) { p0_matrix_item8<0>(a.in[13], DFF, DM, ws + WS_WDDN, r, pg8::FP8_SWD, scr, F.lane); continue; } r -= I_DN;
        if (r < 8 * I_GU) { const int e = r / I_GU; p0_matrix_item8<1>(a.in[15] + (size_t)e * DM * DFF, DM, DFF, ws + WS_WMGU + (size_t)e * 2 * DFF * DM, r % I_GU, pg8::FP8_SWU, scr, F.lane); continue; } r -= 8 * I_GU;
        if (r < 8 * I_GU) { const int e = r / I_GU; p0_matrix_item8<2>(a.in[16] + (size_t)e * DM * DFF, DM, DFF, ws + WS_WMGU + (size_t)e * 2 * DFF * DM, r % I_GU, pg8::FP8_SWU, scr, F.lane); continue; } r -= 8 * I_GU;
        { const int e = r / I_DN; p0_matrix_item8<0>(a.in[17] + (size_t)e * DFF * DM, DFF, DM, ws + WS_WMDN + (size_t)e * DM * DFF, r % I_DN, pg8::FP8_SWD, scr, F.lane); }
    }
    { const int gt = gw * 64 + F.lane, NGT = NGW * 64; const GAS f32x4* x4 = (const GAS f32x4*)a.in[0]; GAS v4u* o4 = (GAS v4u*)(ws + WS_XB);
      for (int i = gt; i < NTOK * DM / 8; i += NGT) { const f32x4 p = x4[2 * i], q = x4[2 * i + 1]; v4u o; o.x = pk2(p[0], p[1]); o.y = pk2(p[2], p[3]); o.z = pk2(q[0], q[1]); o.w = pk2(q[2], q[3]); o4[i] = o; } }
    { const int gt = gw * 64 + F.lane; if (gt < SEQ * 32) { const int pos = gt >> 5, i = gt & 31; const float ang = (float)pos * a.invf[i];
        const double t = (double)ang * 0.15915494309189535; const float fr = (float)(t - __builtin_rint(t));
        ((float*)(ws + WS_TAB))[gt] = __builtin_amdgcn_sinf(fr); ((float*)(ws + WS_TAB + 256 * 1024))[gt] = __builtin_amdgcn_cosf(fr); } }
}
__device__ __forceinline__ void build_lut(Frame& F, const float* rel_bias) {
    LAS float* lut = (LAS float*)(F.lds + LUT_OFF);
    for (int i = F.tid; i < 18 * 129; i += NWAVES * 64) { const int hh = i / 129, d = i % 129; lut[hh * LUT_STRIDE + d] = (rel_bias[BUCKET[d] * 18 + hh] - (hh < 6 ? rel_bias[31 * 18 + hh] : 0.f)) * LOG2E; }
}
__device__ __forceinline__ void ln_stats(f32x4 (&v)[8], float& mean, float& rstd) {
    float s = 0.f;
#pragma unroll
    for (int j = 0; j < 8; ++j) s += (v[j][0] + v[j][1]) + (v[j][2] + v[j][3]);
    mean = wave_sum(s) * (1.f / DM); float s2 = 0.f;
#pragma unroll
    for (int j = 0; j < 8; ++j) { v[j] = v[j] - mean; s2 += (v[j][0] * v[j][0] + v[j][1] * v[j][1]) + (v[j][2] * v[j][2] + v[j][3] * v[j][3]); }
    rstd = 1.f / sqrtf(wave_sum(s2) * (1.f / DM) + LN_EPS);
}
__device__ __forceinline__ int expert_offsets(Frame& F, int& ntiles) {
    const unsigned c = (F.lane < 8) ? __hip_atomic_load(F.ctl + CW_CNT + 64 * F.lane, RLX_AGENT) : 0u;
    const int t = (int)((c + 255u) >> 8);
    int inc = t;
#pragma unroll
    for (int o = 1; o < 8; o <<= 1) { const int u = __shfl_up(inc, o); if (F.lane >= o) inc += u; }
    ntiles = __shfl(inc, 7);
    return (inc - t) * 256;
}
template <int MODE> __device__ __forceinline__ void ln_phase(Frame& F, const Args& a, float* T, const float* gam, const float* bet, const float* w_router) {
    unsigned char* ws = a.ws;
    bf16* XB = (bf16*)(ws + WS_XB);
    const int lane = F.lane;
    LAS float* wrT = (LAS float*)(F.lds + RING_OFF);
    LAS int* cwL = (LAS int*)(F.lds + RING_OFF + 65536);
    LAS int* baseL = (LAS int*)(F.lds + RING_OFF + 65536 + 256);
    if (MODE == 1) {
        for (int i = F.tid; i < DM * 8; i += NWAVES * 64) wrT[(i & 7) * DM + (i >> 3)] = w_router[i];
        __syncthreads();
    }
    f32x4 g4[8], b4[8];
#pragma unroll
    for (int j = 0; j < 8; ++j) { g4[j] = *(const f32x4*)(gam + 4 * lane + 256 * j); b4[j] = *(const f32x4*)(bet + 4 * lane + 256 * j); }
    int offv = 0, ntl = 0;
    if (MODE == 2) offv = expert_offsets(F, ntl);
    const int rb = (F.vcu * NWAVES + F.wave) * 8;
    unsigned long long cntp = 0ull; int me1 = 0, me2 = 0, mr1 = 0, mr2 = 0; float mg1 = 0.f, mg2 = 0.f;
    for (int r = 0; r < 8; ++r) {
        const int row = rb + r;
        float* trow = T + (size_t)row * DM;
        f32x4 v[8];
#pragma unroll
        for (int j = 0; j < 8; ++j) v[j] = *(const f32x4*)(trow + 4 * lane + 256 * j);
        if (MODE == 2) {
            const int* rt = (const int*)(ws + WS_ROUTE) + row * 8;
            const int e1 = rt[0], p1 = rt[1], e2 = rt[2], p2 = rt[3]; const float g1 = __builtin_bit_cast(float, rt[4]), g2 = __builtin_bit_cast(float, rt[5]);
            const int r1 = __shfl(offv, e1) + p1, r2 = __shfl(offv, e2) + p2;
            const bf16* y1 = (const bf16*)(ws + WS_Y) + (size_t)r1 * DM; const bf16* y2 = (const bf16*)(ws + WS_Y) + (size_t)r2 * DM;
#pragma unroll
            for (int j = 0; j < 8; ++j) { const v2u a1 = *(const v2u*)(y1 + 4 * lane + 256 * j), a2 = *(const v2u*)(y2 + 4 * lane + 256 * j);
                v[j][0] = v[j][0] * pg8::ALPHA_F + g1 * bflo(a1.x) + g2 * bflo(a2.x); v[j][1] = v[j][1] * pg8::ALPHA_F + g1 * bfhi(a1.x) + g2 * bfhi(a2.x);
                v[j][2] = v[j][2] * pg8::ALPHA_F + g1 * bflo(a1.y) + g2 * bflo(a2.y); v[j][3] = v[j][3] * pg8::ALPHA_F + g1 * bfhi(a1.y) + g2 * bfhi(a2.y); }
        }
        float mean, rstd; ln_stats(v, mean, rstd);
#pragma unroll
        for (int j = 0; j < 8; ++j) v[j] = v[j] * rstd * g4[j] + b4[j];
        if (MODE == 2) {
            float* orow = a.out + (size_t)row * DM;
#pragma unroll
            for (int j = 0; j < 8; ++j) *(f32x4*)(orow + 4 * lane + 256 * j) = v[j];
        } else {
            bf16* xrow = XB + (size_t)row * DM;
#pragma unroll
            for (int j = 0; j < 8; ++j) { *(f32x4*)(trow + 4 * lane + 256 * j) = v[j]; if (MODE == 0) { v2u o; o.x = pk2(v[j][0], v[j][1]); o.y = pk2(v[j][2], v[j][3]); *(v2u*)(xrow + 4 * lane + 256 * j) = o; }
                if (MODE == 3) { const f32x4 s = v[j] * pg8::FP8_SX; ((GAS unsigned*)(ws + WS_XG + (size_t)row * DM))[lane + 64 * j] = pg8::pack4_fp8(s[0], s[1], s[2], s[3]); } }
        }
        if (MODE == 1) {
            int i1 = -1, i2 = -1; float v1 = -3.0e38f, v2 = -3.0e38f;
#pragma unroll 1
            for (int e = 0; e < 8; ++e) { float s = 0.f;
#pragma unroll
                for (int j = 0; j < 8; ++j) { const f32x4 w = *(const LAS f32x4*)(wrT + e * DM + 4 * lane + 256 * j); s += (v[j][0] * w[0] + v[j][1] * w[1]) + (v[j][2] * w[2] + v[j][3] * w[3]); }
                const float t = wave_sum(s);
                if (t > v1) { v2 = v1; i2 = i1; v1 = t; i1 = e; } else if (t > v2) { v2 = t; i2 = e; } }
            if (i1 < 0) i1 = 0;
            if (i2 < 0) i2 = (i1 + 1) & 7;
            const float ex = __expf(v2 - v1), w1 = 1.f / (1.f + ex), w2 = ex * w1;
            const int k1 = (int)((cntp >> (8 * i1)) & 0xffull); cntp += 1ull << (8 * i1);
            const int k2 = (int)((cntp >> (8 * i2)) & 0xffull); cntp += 1ull << (8 * i2);
            if (lane == r) { me1 = i1; me2 = i2; mr1 = k1; mr2 = k2; mg1 = w1; mg2 = w2; }
        }
    }
    if (MODE == 1) {
        if (lane < 8) cwL[F.wave * 8 + lane] = (int)((cntp >> (8 * lane)) & 0xffull);
        __syncthreads();
        if (F.tid < 8) { int tot = 0;
#pragma unroll
            for (int w = 0; w < 8; ++w) tot += cwL[w * 8 + F.tid];
            baseL[F.tid] = (int)__hip_atomic_fetch_add(F.ctl + CW_CNT + 64 * F.tid, (unsigned)tot, RLX_AGENT); }
        __syncthreads();
        if (lane < 8) {
            int p1 = baseL[me1] + mr1, p2 = baseL[me2] + mr2;
            for (int w = 0; w < F.wave; ++w) { p1 += cwL[w * 8 + me1]; p2 += cwL[w * 8 + me2]; }
            int* rt = (int*)(ws + WS_ROUTE) + (rb + lane) * 8;
            rt[0] = me1; rt[1] = p1; rt[2] = me2; rt[3] = p2; rt[4] = __builtin_bit_cast(int, mg1); rt[5] = __builtin_bit_cast(int, mg2);
        }
    }
}
__device__ __forceinline__ void gather_phase(Frame& F, const Args& a, const float* T) {
    unsigned char* ws = a.ws; int ntl; const int offv = expert_offsets(F, ntl);
    const int gw = F.vcu * NWAVES + F.wave, NGW = F.G * NWAVES;
    for (int tok = gw; tok < NTOK; tok += NGW) {
        const int* rt = (const int*)(ws + WS_ROUTE) + tok * 8;
        const int d1 = __shfl(offv, rt[0]) + rt[1], d2 = __shfl(offv, rt[2]) + rt[3];
        const GAS f32x4* s = (const GAS f32x4*)(T + (size_t)tok * DM);
        GAS unsigned* o1 = (GAS unsigned*)(ws + WS_XG + (size_t)d1 * DM); GAS unsigned* o2 = (GAS unsigned*)(ws + WS_XG + (size_t)d2 * DM);
#pragma unroll
        for (int j = 0; j < 8; ++j) { const f32x4 v = s[F.lane + 64 * j] * pg8::FP8_SX; const unsigned w = pg8::pack4_fp8(v[0], v[1], v[2], v[3]); o1[F.lane + 64 * j] = w; o2[F.lane + 64 * j] = w; }
    }
}
__device__ __forceinline__ float dot8(const v4u q, const v4u k) {
    return (bflo(q.x) * bflo(k.x) + bfhi(q.x) * bfhi(k.x)) + (bflo(q.y) * bflo(k.y) + bfhi(q.y) * bfhi(k.y)) + (bflo(q.z) * bflo(k.z) + bfhi(q.z) * bfhi(k.z)) + (bflo(q.w) * bflo(k.w) + bfhi(q.w) * bfhi(k.w));
}
__device__ __forceinline__ float lambda_of(const float* lp, int lane, float lam_init) {
    const float s1 = wave_sum(lp[lane] * lp[64 + lane]), s2 = wave_sum(lp[128 + lane] * lp[192 + lane]);
    return __expf(s1) - __expf(s2) + lam_init;
}
__device__ __forceinline__ void naive_mixers(Frame& F, const Args& a, int layer) {
    unsigned char* ws = a.ws; const bf16* PROJ = (const bf16*)(ws + WS_PROJ); bf16* CAT = (bf16*)(ws + WS_CAT);
    const int lane = F.lane; const int gw = F.vcu * NWAVES + F.wave, NGW = F.G * NWAVES;
    LAS float* sc = (LAS float*)(F.lds + RING_OFF + F.wave * 16384);
    const LAS float* lut = (const LAS float*)(F.lds + LUT_OFF);
    const float lam_init = 0.8f - 0.6f * __expf(-0.3f * (float)layer);
    const float lam = lambda_of(a.in[3] + layer * 256, lane, lam_init);
    const float* subg = a.in[4] + layer * 128; const float* sinks = a.in[5] + layer * 12;
    for (int task = gw; task < NTOK * 6; task += NGW) {
        const int tok = task / 6, h = task - tok * 6, q = tok & (SEQ - 1), base = tok - q;
        v4u qv[16]; { const v4u* qp = (const v4u*)(PROJ + (size_t)tok * PWP + C_AQ + h * 128);
#pragma unroll
            for (int c = 0; c < 16; ++c) qv[c] = qp[c]; }
        float m1 = -3.0e38f, m2 = -3.0e38f;
        for (int j = lane; j <= q; j += 64) {
            const v4u* kp = (const v4u*)(PROJ + (size_t)(base + j) * PWP + C_AK + h * 128); float d1 = 0.f, d2 = 0.f;
#pragma unroll
            for (int c = 0; c < 8; ++c) { d1 += dot8(qv[c], kp[c]); d2 += dot8(qv[8 + c], kp[8 + c]); }
            const int dd = q - j; const float bias = lut[h * LUT_STRIDE + (dd < 128 ? dd : 128)];
            d1 += bias; d2 += bias; sc[j] = d1; sc[2048 + j] = d2; m1 = fmaxf(m1, d1); m2 = fmaxf(m2, d2);
        }
        m1 = wave_max(m1); m2 = wave_max(m2); float l1 = 0.f, l2 = 0.f;
        for (int j = lane; j <= q; j += 64) { const float p1 = __builtin_amdgcn_exp2f(sc[j] - m1), p2 = __builtin_amdgcn_exp2f(sc[2048 + j] - m2); sc[j] = p1; sc[2048 + j] = p2; l1 += p1; l2 += p2; }
        l1 = wave_sum(l1); l2 = wave_sum(l2); const float c1 = 1.f / l1, c2 = lam / l2;
        float o0 = 0.f, o1 = 0.f;
        for (int j = 0; j <= q; ++j) { const float w = sc[j] * c1 - sc[2048 + j] * c2; const bf16* vr = PROJ + (size_t)(base + j) * PWP + C_AV + h * 128; o0 += w * bf2f(vr[lane]); o1 += w * bf2f(vr[64 + lane]); }
        const float ss = wave_sum(o0 * o0 + o1 * o1), rr = (1.f / sqrtf(ss * (1.f / 128.f) + LN_EPS)) * (1.f - lam_init);
        bf16* orow = CAT + (size_t)tok * DM + h * 128; orow[lane] = (bf16)f2bf(o0 * rr * subg[lane]); orow[64 + lane] = (bf16)f2bf(o1 * rr * subg[64 + lane]);
    }
    for (int task = gw; task < NTOK * 12; task += NGW) {
        const int tok = task / 12, hq = task - tok * 12, kvh = hq >> 2, q = tok & (SEQ - 1), base = tok - q;
        v4u qv[8]; { const v4u* qp = (const v4u*)(PROJ + (size_t)tok * PWP + C_BQ + hq * 64);
#pragma unroll
            for (int c = 0; c < 8; ++c) qv[c] = qp[c]; }
        float s[2];
#pragma unroll
        for (int i = 0; i < 2; ++i) { const int dd = lane + 64 * i, j = q - dd; s[i] = -3.0e38f;
            if (j >= 0) { const v4u* kp = (const v4u*)(PROJ + (size_t)(base + j) * PWP + C_BK + kvh * 64); float d = 0.f;
#pragma unroll
                for (int c = 0; c < 8; ++c) d += dot8(qv[c], kp[c]);
                s[i] = d + lut[(6 + hq) * LUT_STRIDE + dd]; } }
        const float sink2 = sinks[hq] * LOG2E; const float m = fmaxf(wave_max(fmaxf(s[0], s[1])), sink2);
        const float p0 = (q - lane >= 0) ? __builtin_amdgcn_exp2f(s[0] - m) : 0.f, p1 = (q - lane - 64 >= 0) ? __builtin_amdgcn_exp2f(s[1] - m) : 0.f;
        const float l = wave_sum(p0 + p1) + __builtin_amdgcn_exp2f(sink2 - m);
        sc[lane] = p0; sc[64 + lane] = p1;
        float o = 0.f; const int nk = (q + 1 < 128) ? q + 1 : 128;
        for (int dd = 0; dd < nk; ++dd) o += sc[dd] * bf2f(PROJ[(size_t)(base + q - dd) * PWP + C_BV + kvh * 64 + lane]);
        CAT[(size_t)tok * DM + 768 + hq * 64 + lane] = (bf16)f2bf(o / l);
    }
    for (int task = gw; task < NTOK * 4; task += NGW) {
        const int tok = task >> 2, h = task & 3, q = tok & (SEQ - 1), base = tok - q;
        const float lg2 = log2f(1.f - exp2f(-5.f - (float)h));
        v4u qv[8]; { const v4u* qp = (const v4u*)(PROJ + (size_t)tok * PWP + C_CQ + h * 64);
#pragma unroll
            for (int c = 0; c < 8; ++c) qv[c] = qp[c]; }
        for (int j = lane; j <= q; j += 64) { const v4u* kp = (const v4u*)(PROJ + (size_t)(base + j) * PWP + C_CK + h * 64); float d = 0.f;
#pragma unroll
            for (int c = 0; c < 8; ++c) d += dot8(qv[c], kp[c]);
            sc[j] = d * __builtin_amdgcn_exp2f((float)(q - j) * lg2); }
        float o0 = 0.f, o1 = 0.f;
        for (int j = 0; j <= q; ++j) { const float w = sc[j]; const bf16* vr = PROJ + (size_t)(base + j) * PWP + C_CV + h * 128; o0 += w * bf2f(vr[lane]); o1 += w * bf2f(vr[64 + lane]); }
        const float mu = wave_sum(o0 + o1) * (1.f / 128.f); o0 -= mu; o1 -= mu;
        const float rs = 1.f / sqrtf(wave_sum(o0 * o0 + o1 * o1) * (1.f / 128.f) + LN_EPS);
        const bf16* gr = PROJ + (size_t)tok * PWP + C_CG + h * 128;
        bf16* orow = CAT + (size_t)tok * DM + 1536 + h * 128;
        orow[lane] = (bf16)f2bf(pg8::silu_f(bf2f(gr[lane])) * o0 * rs); orow[64 + lane] = (bf16)f2bf(pg8::silu_f(bf2f(gr[64 + lane])) * o1 * rs);
    }
}
typedef float f32x16 __attribute__((ext_vector_type(16)));
typedef short s16x4 __attribute__((ext_vector_type(4)));
typedef short v4i16_t __attribute__((ext_vector_type(4)));
typedef float f32x2_t __attribute__((ext_vector_type(2))); typedef __bf16 bf16x2_t __attribute__((ext_vector_type(2)));
__device__ __forceinline__ int crow(int r, int hi) { return (r & 3) + 8 * (r >> 2) + 4 * hi; }
__device__ __forceinline__ s16x4 vtr(const LAS unsigned char* p) { return __builtin_bit_cast(s16x4, __builtin_amdgcn_ds_read_tr16_b64_v4i16((LAS v4i16_t*)p)); }
__device__ __forceinline__ unsigned cvtpk_s(float lo, float hi) { f32x2_t v = {lo, hi}; bf16x2_t b = __builtin_convertvector(v, bf16x2_t); return __builtin_bit_cast(unsigned, b); }
__device__ __forceinline__ bf16x8 pack_p(const f32x16& p, int s2) {
    v4u w; w.x = cvtpk_s(p[8 * s2 + 0], p[8 * s2 + 1]); w.y = cvtpk_s(p[8 * s2 + 2], p[8 * s2 + 3]); w.z = cvtpk_s(p[8 * s2 + 4], p[8 * s2 + 5]); w.w = cvtpk_s(p[8 * s2 + 6], p[8 * s2 + 7]);
    return __builtin_bit_cast(bf16x8, w);
}
constexpr int MIX_WSF = 131072 + 1024 + 10240, MIX_QW = MIX_WSF + 2048;
static_assert(MIX_QW + 64 <= LDS_BYTES && LUT_OFF + 18 * LUT_STRIDE * 4 <= MIX_WSF, "mixer LDS map");
constexpr int LUTX_OFF = 98304, LUTX_STRIDE = 320;
constexpr float MIX_THR = 6.f;
__device__ __forceinline__ void glds16(const void* gsrc, unsigned lds_dst) { unsigned keep;
    asm volatile("s_mov_b32 %0, m0\n\ts_mov_b32 m0, %2\n\ts_nop 0\n\tglobal_load_lds_dwordx4 %1, off\n\ts_mov_b32 m0, %0" : "=&s"(keep) : "v"(gsrc), "s"(lds_dst) : "memory"); }
template <int MODE> __device__ __forceinline__ void mix_unit(Frame& F, const Args& a, int layer, int b, int hh, int qb, float lam, float lam_init) {
    constexpr int KW = (MODE == 0) ? 128 : 64, VW = (MODE == 1) ? 64 : 128, NEB = VW / 32, NSUB = 1;
    constexpr int KBYTES = 64 * KW * 2, VBYTES = 64 * VW * 2, BUFB = KBYTES + VBYTES, NST = 3;
    constexpr int KD = KBYTES / 1024, VD = VBYTES / 1024, PW = (KD + VD) / 8;
    static_assert(NST * BUFB <= LUTX_OFF && LUTX_OFF + 18 * LUTX_STRIDE * 4 <= RING_BYTES && (KD + VD) % 8 == 0, "mixer LDS ring");
    unsigned char* ws = a.ws; const bf16* PROJ = (const bf16*)(ws + WS_PROJ); bf16* CAT = (bf16*)(ws + WS_CAT);
    const int wave = F.wave; int lane = (int)__builtin_amdgcn_mbcnt_hi(~0u, __builtin_amdgcn_mbcnt_lo(~0u, 0u)); asm volatile("" : "+v"(lane));
    const int tid = wave * 64 + lane, r32 = lane & 31, hi = lane >> 5;
    LAS unsigned char* L = F.lds + RING_OFF;
    const unsigned Lb = (unsigned)(uintptr_t)L;
    LAS float* wsf = (LAS float*)(F.lds + MIX_WSF) + wave * 64;
    const LAS float* lut = (const LAS float*)(F.lds + LUT_OFF);
    const int rowbase = b * SEQ;
    const int q0 = (MODE == 2) ? qb * 256 : qb * 128;
    const int rg = (MODE == 2) ? wave : (wave & 3), wsel = (MODE == 2) ? 0 : (wave >> 2);
    const int qw0 = q0 + 32 * rg;
    const int kcol = (MODE == 0) ? C_AK + hh * 128 : (MODE == 1) ? C_BK + (hh >> 1) * 64 : C_CK + hh * 64;
    const int vcol = (MODE == 0) ? C_AV + hh * 128 : (MODE == 1) ? C_BV + (hh >> 1) * 64 : C_CV + hh * 128;
    const int kch0 = (MODE == 0) ? wsel * 8 : 0;
    const int t_lo = (MODE == 1) ? (qb > 0 ? 2 * qb - 2 : 0) : 0, t_hi = (MODE == 2) ? 4 * qb + 4 : 2 * qb + 2;
    bf16x8 qf[NSUB][4];
#pragma unroll
    for (int s = 0; s < NSUB; ++s) {
        const int qcol = (MODE == 0) ? C_AQ + hh * 128 + wsel * 64 : (MODE == 1) ? C_BQ + (hh * 2 + wsel) * 64 : C_CQ + hh * 64;
        const bf16* qp = PROJ + (size_t)(rowbase + qw0 + r32) * PWP + qcol + hi * 8;
#pragma unroll
        for (int d0 = 0; d0 < 4; ++d0) qf[s][d0] = *(const bf16x8*)(qp + d0 * 16);
    }
    float m_run[NSUB], l_run[NSUB]; f32x16 o[NSUB][NEB];
#pragma unroll
    for (int s = 0; s < NSUB; ++s) {
        m_run[s] = (MODE == 1) ? a.in[5][layer * 12 + hh * 2 + wsel] * LOG2E : -1.0e30f; l_run[s] = (MODE == 1) ? 1.f : 0.f;
#pragma unroll
        for (int e = 0; e < NEB; ++e) o[s][e] = f32x16{};
    }
    const float lg2 = (MODE == 2) ? log2f(1.f - exp2f(-5.f - (float)hh)) : 0.f;
    unsigned dsrc[PW]; unsigned ddst[PW];
#pragma unroll
    for (int i = 0; i < PW; ++i) {
        const int j = wave + 8 * i;
        if (j < KD) {
            int row, ch;
            if (KW == 128) { row = 4 * j + (lane >> 4); ch = (lane & 15) ^ (row & 15); }
            else { row = 8 * j + (lane >> 3); ch = (lane & 7) ^ ((row >> 1) & 7); }
            dsrc[i] = (unsigned)(((rowbase + row) * PWP + kcol + ch * 8) * 2); ddst[i] = (unsigned)(j * 1024);
        } else {
            const int jv = j - KD, eb = jv >> 2, key = 16 * (jv & 3) + 8 * (lane >> 5) + ((lane >> 2) & 7);
            dsrc[i] = (unsigned)(((rowbase + key) * PWP + vcol + eb * 32 + (lane & 3) * 8) * 2); ddst[i] = (unsigned)(KBYTES + jv * 1024);
        }
    }
#define MIX_DMA(t) do { const unsigned st_ = Lb + (unsigned)((((t) - t_lo) % NST) * BUFB); \
        _Pragma("unroll") for (int i_ = 0; i_ < PW; ++i_) glds16((const char*)PROJ + (size_t)(t) * (64 * PWP * 2) + dsrc[i_], (unsigned)__builtin_amdgcn_readfirstlane(st_ + ddst[i_])); } while (0)
    const int vlane = (4 * hi + ((lane & 15) >> 2)) * 64 + ((lane >> 4) & 1) * 32 + (lane & 3) * 8;
    asm volatile("s_waitcnt vmcnt(0)" ::: "memory");
#pragma unroll
    for (int s = 0; s < NSUB; ++s) {
        asm volatile("" : "+v"(m_run[s]));
#pragma unroll
        for (int d0 = 0; d0 < 4; ++d0) asm volatile("" : "+v"(qf[s][d0]));
    }
    MIX_DMA(t_lo);
    if (t_lo + 1 < t_hi) MIX_DMA(t_lo + 1);
#pragma unroll 1
    for (int t = t_lo; t < t_hi; ++t) {
        if (t + 1 < t_hi) { if (PW == 2) asm volatile("s_waitcnt vmcnt(2)" ::: "memory"); else if (PW == 3) asm volatile("s_waitcnt vmcnt(3)" ::: "memory"); else asm volatile("s_waitcnt vmcnt(4)" ::: "memory"); }
        else asm volatile("s_waitcnt vmcnt(0)" ::: "memory");
        asm volatile("s_waitcnt lgkmcnt(0)\n\ts_barrier" ::: "memory");
        if (t + 2 < t_hi) MIX_DMA(t + 2);
        const LAS unsigned char* Kb = L + ((t - t_lo) % NST) * BUFB; const LAS unsigned char* Vb = Kb + KBYTES;
        const int k0 = 64 * t;
        const bool active = (k0 <= qw0 + 31) && (MODE != 1 || k0 + 63 >= qw0 - 127);
        if (active) {
#pragma unroll
            for (int s = 0; s < NSUB; ++s) {
                f32x16 p0 = f32x16{}, p1 = f32x16{};
#pragma unroll
                for (int d0 = 0; d0 < 4; ++d0) {
                    const int ch = kch0 + 2 * d0 + hi;
                    const int ofs = (KW == 128) ? (r32 * 256 + ((ch ^ (r32 & 15)) << 4)) : (r32 * 128 + ((ch ^ ((r32 >> 1) & 7)) << 4));
                    const bf16x8 ka = *(const LAS bf16x8*)(Kb + ofs);
                    const bf16x8 kb2 = *(const LAS bf16x8*)(Kb + 32 * KW * 2 + ofs);
                    p0 = __builtin_amdgcn_mfma_f32_32x32x16_bf16(ka, qf[s][d0], p0, 0, 0, 0);
                    p1 = __builtin_amdgcn_mfma_f32_32x32x16_bf16(kb2, qf[s][d0], p1, 0, 0, 0);
                }
                const int qi = qw0 + r32;
                if (MODE == 2) {
#pragma unroll
                    for (int r = 0; r < 16; ++r) { const int d0_ = qi - (k0 + crow(r, hi)), d1_ = d0_ - 32;
                        p0[r] = d0_ >= 0 ? p0[r] * __builtin_amdgcn_exp2f((float)d0_ * lg2) : 0.f; p1[r] = d1_ >= 0 ? p1[r] * __builtin_amdgcn_exp2f((float)d1_ * lg2) : 0.f; }
                } else {
                    const bool nearb = (MODE == 1) || (k0 + 63 + 128 > qw0);
                    if (nearb) {
                        const LAS float* lrow = lut + ((MODE == 0) ? hh : 6 + hh * 2 + wsel) * LUT_STRIDE;
#pragma unroll
                        for (int r = 0; r < 16; ++r) { const int d0_ = qi - (k0 + crow(r, hi)), d1_ = d0_ - 32;
                            const bool ok0 = (MODE == 0) ? (d0_ >= 0) : (d0_ >= 0 && d0_ < 128), ok1 = (MODE == 0) ? (d1_ >= 0) : (d1_ >= 0 && d1_ < 128);
                            const int i0_ = d0_ < 0 ? 0 : (d0_ > 128 ? 128 : d0_), i1_ = d1_ < 0 ? 0 : (d1_ > 128 ? 128 : d1_);
                            p0[r] = ok0 ? p0[r] + lrow[i0_] : -INFINITY; p1[r] = ok1 ? p1[r] + lrow[i1_] : -INFINITY; }
                    }
                    float rm = fmaxf(p0[0], p1[0]);
#pragma unroll
                    for (int r = 1; r < 16; ++r) rm = fmaxf(rm, fmaxf(p0[r], p1[r]));
                    rm = fmaxf(rm, __shfl_xor(rm, 32));
                    if (__any(rm > m_run[s] + MIX_THR)) {
                        const float mn = fmaxf(m_run[s], rm), al = __builtin_amdgcn_exp2f(m_run[s] - mn);
                        m_run[s] = mn; l_run[s] *= al;
                        if (hi == 0) wsf[r32] = al;
                        LDS_WAIT();
#pragma unroll
                        for (int r = 0; r < 16; ++r) { const float f = wsf[crow(r, hi)];
#pragma unroll
                            for (int e = 0; e < NEB; ++e) o[s][e][r] *= f; }
                        LDS_WAIT();
                    }
                    float ls = 0.f; const float mm = m_run[s];
#pragma unroll
                    for (int r = 0; r < 16; ++r) { p0[r] = __builtin_amdgcn_exp2f(p0[r] - mm); p1[r] = __builtin_amdgcn_exp2f(p1[r] - mm); ls += p0[r] + p1[r]; }
                    l_run[s] += ls;
                }
                s16x4 vlo[2][NEB], vhi[2][NEB];
#pragma unroll
                for (int e = 0; e < NEB; ++e) { vlo[0][e] = vtr(Vb + e * 4096 + vlane); vhi[0][e] = vtr(Vb + e * 4096 + vlane + 512); }
#pragma unroll
                for (int g = 0; g < 4; ++g) {
                    if (g < 3) {
#pragma unroll
                        for (int e = 0; e < NEB; ++e) { vlo[(g + 1) & 1][e] = vtr(Vb + e * 4096 + (g + 1) * 1024 + vlane); vhi[(g + 1) & 1][e] = vtr(Vb + e * 4096 + (g + 1) * 1024 + vlane + 512); }
                    }
                    const bf16x8 pa = pack_p((g >> 1) == 0 ? p0 : p1, g & 1);
#pragma unroll
                    for (int e = 0; e < NEB; ++e) {
                        const s16x4 lo = vlo[g & 1][e], hh2 = vhi[g & 1][e];
                        const bf16x8 vb = (bf16x8){lo[0], lo[1], lo[2], lo[3], hh2[0], hh2[1], hh2[2], hh2[3]};
                        o[s][e] = __builtin_amdgcn_mfma_f32_32x32x16_bf16(pa, vb, o[s][e], 0, 0, 0);
                    }
                }
                if (NSUB > 1) __builtin_amdgcn_sched_barrier(0);
            }
        }
    }
#undef MIX_DMA
    __syncthreads();
    if (MODE == 1) {
#pragma unroll
        for (int s = 0; s < NSUB; ++s) {
            const float sink2 = a.in[5][layer * 12 + hh * 2 + wsel] * LOG2E;
            const float lt = l_run[s] + __shfl_xor(l_run[s], 32) - __builtin_amdgcn_exp2f(sink2 - m_run[s]);
            if (hi == 0) wsf[r32] = 1.f / lt;
            LDS_WAIT();
            bf16* orow = CAT + (size_t)(rowbase + qw0) * DM + 768 + (hh * 2 + wsel) * 64 + r32;
#pragma unroll
            for (int r = 0; r < 16; ++r) { const int qr = crow(r, hi); const float f = wsf[qr];
#pragma unroll
                for (int e = 0; e < NEB; ++e) orow[(size_t)qr * DM + 32 * e] = (bf16)f2bf(o[s][e][r] * f); }
            LDS_WAIT();
        }
    } else if (MODE == 2) {
        const bf16* grow = PROJ + (size_t)(rowbase + qw0) * PWP + C_CG + hh * 128 + r32;
        bf16* orow = CAT + (size_t)(rowbase + qw0) * DM + 1536 + hh * 128 + r32;
#pragma unroll
        for (int r = 0; r < 16; ++r) {
            float s1 = 0.f;
#pragma unroll
            for (int e = 0; e < NEB; ++e) s1 += o[0][e][r];
#pragma unroll
            for (int sh = 1; sh < 32; sh <<= 1) s1 += __shfl_xor(s1, sh);
            const float mu = s1 * (1.f / 128.f); float s2 = 0.f;
#pragma unroll
            for (int e = 0; e < NEB; ++e) { const float d = o[0][e][r] - mu; s2 += d * d; }
#pragma unroll
            for (int sh = 1; sh < 32; sh <<= 1) s2 += __shfl_xor(s2, sh);
            const float rs = 1.f / sqrtf(s2 * (1.f / 128.f) + LN_EPS); const int qr = crow(r, hi);
#pragma unroll
            for (int e = 0; e < NEB; ++e) orow[(size_t)qr * DM + 32 * e] = (bf16)f2bf(pg8::silu_f(bf2f(grow[(size_t)qr * PWP + 32 * e])) * (o[0][e][r] - mu) * rs);
        }
    } else {
        const float lt = l_run[0] + __shfl_xor(l_run[0], 32);
        if (hi == 0) wsf[r32] = 1.f / lt;
        LDS_WAIT();
        LAS float* xb = (LAS float*)L + rg * 4096;
        if (wsel == 1) {
#pragma unroll
            for (int r = 0; r < 16; ++r) { const float f = wsf[crow(r, hi)];
#pragma unroll
                for (int e = 0; e < NEB; ++e) xb[(e * 16 + r) * 64 + lane] = o[0][e][r] * f; }
        }
        __syncthreads();
        if (wsel == 0) {
            const float* subg = a.in[4] + layer * 128; const float post = 1.f - lam_init;
            bf16* orow = CAT + (size_t)(rowbase + qw0) * DM + hh * 128 + r32;
#pragma unroll
            for (int r = 0; r < 16; ++r) { const float f = wsf[crow(r, hi)]; float d[NEB]; float ss = 0.f;
#pragma unroll
                for (int e = 0; e < NEB; ++e) { d[e] = o[0][e][r] * f - lam * xb[(e * 16 + r) * 64 + lane]; ss += d[e] * d[e]; }
#pragma unroll
                for (int sh = 1; sh < 32; sh <<= 1) ss += __shfl_xor(ss, sh);
                const float rs = (1.f / sqrtf(ss * (1.f / 128.f) + LN_EPS)) * post; const int qr = crow(r, hi);
#pragma unroll
                for (int e = 0; e < NEB; ++e) orow[(size_t)qr * DM + 32 * e] = (bf16)f2bf(d[e] * rs * subg[32 * e + r32]); }
        }
    }
    __syncthreads();
}
template <int MODE> __device__ __forceinline__ void mixer_queue(Frame& F, const Args& a, int layer, int qword, float lam, float lam_init) {
    constexpr int NU = (MODE == 0) ? 768 : (MODE == 1) ? 768 : 256;
    LAS int* qw = (LAS int*)(F.lds + MIX_QW);
    for (;;) {
        if (F.tid == 0) *qw = (int)__hip_atomic_fetch_add(F.ctl + CW_WQ + 64 * qword, 1u, RLX_AGENT);
        __syncthreads();
        const int it = __builtin_amdgcn_readfirstlane(*qw);
        __syncthreads();
        if (it >= NU) break;
        if (MODE == 0) mix_unit<0>(F, a, layer, (it % 48) / 6, it % 6, 15 - it / 48, lam, lam_init);
        else if (MODE == 2) mix_unit<2>(F, a, layer, (it & 31) >> 2, it & 3, 7 - (it >> 5), lam, lam_init);
        else mix_unit<1>(F, a, layer, it / 96, (it % 96) / 16, it & 15, lam, lam_init);
    }
}
__device__ __forceinline__ void mixer_phase(Frame& F, const Args& a, int layer, int rep) {
    const float lam_init = 0.8f - 0.6f * __expf(-0.3f * (float)layer);
    const float lam = __builtin_bit_cast(float, __builtin_amdgcn_readfirstlane(__builtin_bit_cast(int, lambda_of(a.in[3] + layer * 256, F.lane, lam_init))));
    const int qbase = 3 * (layer + 2 * rep);
    mixer_queue<2>(F, a, layer, qbase + 0, lam, lam_init);
    mixer_queue<0>(F, a, layer, qbase + 1, lam, lam_init);
    mixer_queue<1>(F, a, layer, qbase + 2, lam, lam_init);
}
#ifndef MIXER_NAIVE
#define MIXER_NAIVE 0
#endif
#ifndef PROBE_P0
#define PROBE_P0 1
#endif
#ifndef PROBE_MIX
#define PROBE_MIX 1
#endif
#ifndef PROBE_PROJ
#define PROBE_PROJ 1
#endif
#ifndef PROBE_DUP
#define PROBE_DUP 1
#endif
#ifndef PROBE_MUP
#define PROBE_MUP 1
#endif
#ifndef PROBE_MDN
#define PROBE_MDN 1
#endif
#define REPEAT(N) for (int rep = 0; rep < (N); ++rep)
#define TWICE_IF(N, CALL) do { CALL; if ((N) == 2) { xcd_barrier(bar); CALL; } } while (0)
#define REPBAR(N) do { if (rep + 1 < (N)) xcd_barrier(bar); } while (0)
#define IN(k) (lo <= (k) && (k) < hi)
#define SEAM(k) do { if (IN(k) && IN((k) + 1)) xcd_barrier(bar); } while (0)
template <int l> __device__ __forceinline__ void run_layer(Frame& F, const Args& args, const XcdBarrier& bar, int lo, int hi) {
    unsigned char* ws = args.ws;
    bf16* XB = (bf16*)(ws + WS_XB); bf16* PROJ = (bf16*)(ws + WS_PROJ); bf16* CAT = (bf16*)(ws + WS_CAT); bf16* HB = (bf16*)(ws + WS_H);
    float* T = args.out;
        const int pb = 1 + 7 * l;
        if (IN(pb)) {
            pg8::Gemm g{XB, (const bf16*)(ws + WS_WIN) + (size_t)l * PWP * DM, NTOK, PWP, DM * 2}; pg8::StaticOrder S; S.init(NTOK, PWP, F.G, (int)blockIdx.x);
            pg8::EpiProj E{PROJ, (const float*)(ws + WS_TAB), (const float*)(ws + WS_TAB + 256 * 1024)};
            TWICE_IF(PROBE_PROJ, (pg8::gemm_phase<pg8::EpiProj, pg8::StaticOrder, true, true>(F.lds + RING_OFF, F.wave, g, S, E)));
        } SEAM(pb);
        if (IN(pb + 1)) {
#if MIXER_NAIVE
            naive_mixers(F, args, l);
#else
            REPEAT(PROBE_MIX) { mixer_phase(F, args, l, rep); REPBAR(PROBE_MIX); }
#endif
        } SEAM(pb + 1);
        if (IN(pb + 2)) {
            pg8::Gemm g{CAT, (const bf16*)(ws + WS_WOUT) + (size_t)l * DM * DM, NTOK, DM, DM * 2}; pg8::StaticOrder S; S.init(NTOK, DM, F.G, (int)blockIdx.x);
            pg8::EpiResid E{T, l == 0 ? args.in[0] : T, 1.f};
            pg8::gemm_phase<pg8::EpiResid, pg8::StaticOrder, true, true>(F.lds + RING_OFF, F.wave, g, S, E);
        } SEAM(pb + 2);
        if constexpr (l == 0) {
            if (IN(4)) { ln_phase<0>(F, args, T, args.in[7], args.in[8], nullptr); } SEAM(4);
            if (IN(5)) {
                pg8::Gemm g{XB, (const bf16*)(ws + WS_WDGU), NTOK, 2 * DFF, DM * 2}; pg8::StaticOrder S; S.init(NTOK, 2 * DFF, F.G, (int)blockIdx.x);
                pg8::EpiSwiGLU8 E{ws + WS_H, 44, 1.f};
                TWICE_IF(PROBE_DUP, (pg8::gemm_phase<pg8::EpiSwiGLU8, pg8::StaticOrder, true, true, false>(F.lds + RING_OFF, F.wave, g, S, E)));
            } SEAM(5);
            if (IN(6)) {
                pg8::Gemm g{ws + WS_H, ws + WS_WDDN, NTOK, DM, DFF}; pg8::StaticOrder S; S.init(NTOK, DM, F.G, (int)blockIdx.x);
                pg8::EpiResid E{T, T, 1.f / (pg8::FP8_SH * pg8::FP8_SWD)};
                pg8::gemm_phase<pg8::EpiResid, pg8::StaticOrder, true, true, true>(F.lds + RING_OFF, F.wave, g, S, E);
            } SEAM(6);
            if (IN(7)) { ln_phase<0>(F, args, T, args.in[9], args.in[10], nullptr); } SEAM(7);
        } else {
            if (IN(11)) { ln_phase<1>(F, args, T, args.in[7] + DM, args.in[8] + DM, args.in[14]); } SEAM(11);
            if (IN(12)) { gather_phase(F, args, T); } SEAM(12);
            if (IN(13) || IN(14)) {
                int ntl_v; const int offv = expert_offsets(F, ntl_v); const int ntl = __builtin_amdgcn_readfirstlane(ntl_v);
                pg8::GroupedOrder S; S.nM = ntl; S.G = F.G; S.c = (int)blockIdx.x;
#pragma unroll
                for (int e = 0; e < 8; ++e) S.cum[e] = (e < 7) ? __builtin_amdgcn_readfirstlane(__shfl(offv, e + 1) >> 8) : ntl;
                if (IN(13)) {
                    S.nN = 44; S.nwg = ntl * 44;
                    pg8::Gemm g{ws + WS_XG, ws + WS_WMGU, ntl * 256, 8 * 2 * DFF, DM};
                    pg8::EpiSwiGLU8 E{ws + WS_H, 44, 1.f / (pg8::FP8_SX * pg8::FP8_SWU)};
                    TWICE_IF(PROBE_MUP, (pg8::gemm_phase<pg8::EpiSwiGLU8, pg8::GroupedOrder, true, true, true>(F.lds + RING_OFF, F.wave, g, S, E)));
                } SEAM(13);
                if (IN(14)) {
                    S.nN = 8; S.nwg = ntl * 8;
                    pg8::Gemm g{ws + WS_H, ws + WS_WMDN, ntl * 256, 8 * DM, DFF};
                    pg8::EpiY E{(bf16*)(ws + WS_Y), 8, 1.f / (pg8::FP8_SH * pg8::FP8_SWD)};
                    TWICE_IF(PROBE_MDN, (pg8::gemm_phase<pg8::EpiY, pg8::GroupedOrder, true, true, true>(F.lds + RING_OFF, F.wave, g, S, E)));
                } SEAM(14);
            }
            if (IN(15)) { ln_phase<2>(F, args, T, args.in[9] + DM, args.in[10] + DM, nullptr); }
        }
}
constexpr int N_PHASES = 16;
__global__ void __launch_bounds__(NWAVES * 64, 2) hymba_fwd(Args args) {
    extern __shared__ __attribute__((aligned(16))) unsigned char lds[];
    Frame F;
    F.lds = (LAS unsigned char*)lds;
    volatile LAS unsigned* MISC = (volatile LAS unsigned*)(F.lds + MISC_OFF);
    F.wave = __builtin_amdgcn_readfirstlane((int)threadIdx.x >> 6); F.lane = (int)__builtin_amdgcn_mbcnt_hi(~0u, __builtin_amdgcn_mbcnt_lo(~0u, 0u)); F.tid = F.wave * 64 + F.lane;
    F.G = gridDim.x; { const int bx = blockIdx.x; F.vcu = (F.G % 8 == 0) ? (bx % 8) * (F.G / 8) + bx / 8 : bx; }
    unsigned char* ws = args.ws;
    F.ctl = (gu32*)(ws + WS_CTL);
    for (int u = F.tid; u < 1024 / 4; u += NWAVES * 64) ((LAS unsigned*)(F.lds + LDSCTL_OFF))[u] = 0u;
    __syncthreads();
    XcdBarrier bar = xcd_barrier_post((unsigned*)(F.ctl + CW_BAR) + args.li * 4096, MISC + 8);
    build_lut(F, args.in[2]);
    __syncthreads();
    const int lo = args.ph_lo, hi = args.ph_hi;
    if (IN(0)) { REPEAT(PROBE_P0) { p0_prologue(F, args); REPBAR(PROBE_P0); } } SEAM(0);
    run_layer<0>(F, args, bar, lo, hi);
    run_layer<1>(F, args, bar, lo, hi);
#undef IN
#undef SEAM
}

#ifndef N_LAUNCHES
#define N_LAUNCHES 1
#endif
extern "C" void kernel_launch(void* const* d_in, const int* in_sizes, int n_in, void* d_out, int out_size, void* d_ws, size_t ws_size, hipStream_t stream) {
    static int grid = 0;
    if (grid == 0) {
        if (n_in != 18 || in_sizes[0] != NTOK * DM || out_size != NTOK * DM || ws_size < WS_END) { fprintf(stderr, "kernel_launch: unexpected shapes / workspace (%d inputs, ws %zu < %zu)\n", n_in, ws_size, (size_t)WS_END); grid = -1; return; }
        int dev = 0, cus = 0, per_cu = 0;
        if (hipGetDevice(&dev) != hipSuccess || hipDeviceGetAttribute(&cus, hipDeviceAttributeMultiprocessorCount, dev) != hipSuccess) { grid = -1; return; }
        if (hipFuncSetAttribute((const void*)hymba_fwd, hipFuncAttributeMaxDynamicSharedMemorySize, LDS_BYTES) != hipSuccess) { fprintf(stderr, "kernel_launch: hipFuncSetAttribute failed\n"); grid = -1; return; }
        if (hipOccupancyMaxActiveBlocksPerMultiprocessor(&per_cu, (const void*)hymba_fwd, NWAVES * 64, LDS_BYTES) != hipSuccess || per_cu < 1) fprintf(stderr, "kernel_launch: occupancy query reports %d\n", per_cu);
        (void)hipGetLastError();
        grid = (cus == 256) ? 256 : -1;
        if (grid < 0) { fprintf(stderr, "kernel_launch: built for a 256-CU device, found %d CUs\n", cus); return; }
    }
    if (grid < 0) return;
    if (hipMemsetAsync((char*)d_ws + WS_CTL, 0, CTL_ZERO_BYTES, stream) != hipSuccess) return;
    Args a{};
    for (int i = 0; i < 18; ++i) a.in[i] = (const float*)d_in[i];
    a.out = (float*)d_out; a.ws = (unsigned char*)d_ws;
    for (int i = 0; i < 32; ++i) a.invf[i] = (float)(1.0 / pow(10000.0, (double)((float)i / 31.0f)));
#if N_LAUNCHES == 1
    const int cuts[2] = {0, N_PHASES};
#else
    int cuts[N_PHASES + 1]; for (int i = 0; i <= N_PHASES; ++i) cuts[i] = i;
#endif
    const int nl = (N_LAUNCHES == 1) ? 1 : N_PHASES;
    for (int li = 0; li < nl; ++li) {
        a.ph_lo = cuts[li]; a.ph_hi = cuts[li + 1]; a.li = li; a.pad = 0;
        hipLaunchKernelGGL(hymba_fwd, dim3(grid), dim3(NWAVES * 64), LDS_BYTES, stream, a);
        const hipError_t le = hipPeekAtLastError();
        if (le != hipSuccess) { fprintf(stderr, "kernel_launch: launch %d failed: %s\n", li, hipGetErrorName(le)); break; }
    }
}
```

```cpp
#include <hip/hip_runtime.h>
#include <cstdio>
#include <cstdint>
#include <cmath>
namespace pg8 {
#define PG8_LAS __attribute__((address_space(3)))
typedef unsigned short bf16_t;
typedef short bf16x8 __attribute__((ext_vector_type(8)));
typedef float f32x4 __attribute__((ext_vector_type(4)));
typedef unsigned u32x4 __attribute__((ext_vector_type(4)));
constexpr int BM = 256, BK = 64, HALF = 128, HTB = HALF * BK * 2  , STAGE_BYTES = 8 * HTB, NXCD = 8, WGM = 8;

__host__ __device__ __forceinline__ int lds_byte(int r, int c) { const int st = (r >> 4) * 2 + (c >> 5), rr = r & 15, cc = c & 31, ob = rr * 64 + cc * 2; return st * 1024 + (ob ^ (((ob >> 9) & 1) << 5)); }
__host__ __device__ __forceinline__ void stage_rc(int b, int& R, int& C) { const int st = b / 1024, sb = b % 1024, swz = sb ^ (((sb >> 9) & 1) << 5); R = (st >> 1) * 16 + swz / 64; C = (st & 1) * 32 + (swz % 64) / 2; }
__host__ __device__ __forceinline__ int perm32(int rho) { const int n = rho >> 4, i = rho & 15; return 8 * (i >> 2) + 4 * n + (i & 3); }

struct Unit { int pm, pn, pmo; };
struct Gemm { const void* A; const void* Bt; int M, N, KB; };
typedef int v4i_t __attribute__((ext_vector_type(4)));
typedef int v8i_t __attribute__((ext_vector_type(8)));

struct StaticOrder {
    int nM, nN, nwg, G, c;
    __host__ __device__ void init(int M, int N, int G_, int c_) { nM = M / BM; nN = N / BM; nwg = nM * nN; G = G_; c = c_; }
    __host__ __device__ bool next(int i, Unit& u) const {
        const long L = (long)i * G + c; if (L >= nwg) return false;
        int wgid = (int)L; { const int q = nwg / NXCD, r = nwg % NXCD, xcd = wgid % NXCD, off = wgid / NXCD; wgid = (xcd < r ? xcd * (q + 1) : r * (q + 1) + (xcd - r) * q) + off; }
        const int nig = WGM * nN, gid = wgid / nig, fm = gid * WGM, gsz = (nM - fm) < WGM ? (nM - fm) : WGM;
        u.pm = fm + ((wgid % nig) % gsz); u.pn = (wgid % nig) / gsz; u.pmo = u.pm; return true;
    }
    __device__ __forceinline__ void a_ready(const Unit&) const {}
    __device__ __forceinline__ void done(const Unit&) const {}
};

__device__ __forceinline__ unsigned cvt_pk_bf16(float lo, float hi) { unsigned r; asm volatile("v_cvt_pk_bf16_f32 %0, %1, %2" : "=v"(r) : "v"(lo), "v"(hi)); return r; }
typedef float f32x2 __attribute__((ext_vector_type(2)));
typedef float f32x2 __attribute__((ext_vector_type(2)));
typedef unsigned u32x2 __attribute__((ext_vector_type(2)));
constexpr float ALPHA_F = 1.41421356237309515f;
constexpr float C2_F = 0.125f * 1.4426950408889634f;
__device__ __forceinline__ u32x4 pack8(const f32x4 v0, const f32x4 v1) { u32x4 w; w.x = cvt_pk_bf16(v0[0], v0[1]); w.y = cvt_pk_bf16(v0[2], v0[3]); w.z = cvt_pk_bf16(v1[0], v1[1]); w.w = cvt_pk_bf16(v1[2], v1[3]); return w; }

struct EpiProj {
    static constexpr bool PERM = true, AFTER_DRAIN = false;
    bf16_t* O; const float* sinT; const float* cosT;
    __device__ __forceinline__ void operator()(const f32x4 (&acc)[2][2][4][2], const Unit& u, int wr, int wc, int fr, int fq) const {
        const int row0 = u.pm * BM + wr * 64 + fr;
#pragma unroll
        for (int bj = 0; bj < 2; ++bj) {
            const int cw = u.pn * BM + bj * HALF + wc * 32;
            const int c0 = cw + 8 * fq;
            float sc = 1.f; bool rope = false;
            if (cw < 768 || (cw >= 2304 && cw < 3072)) sc = C2_F;
            else if (cw >= 3456 && cw < 3968) { rope = true; if (cw >= 3712) sc = 0.125f; }
            const float klg2 = (cw >= 3712 && cw < 3968) ? -__builtin_amdgcn_logf(1.f - __builtin_amdgcn_exp2f(-5.f - (float)((cw - 3712) >> 6))) : 0.f;
            const int i0 = ((c0 - 3456) & 63) >> 1;
#pragma unroll
            for (int ai = 0; ai < 2; ++ai)
#pragma unroll
                for (int m = 0; m < 4; ++m) {
                    const int row = row0 + ai * HALF + m * 16;
                    const float scr_ = sc * __builtin_amdgcn_exp2f(klg2 * (float)(row & 127));
                    f32x4 v0 = acc[ai][bj][m][0] * scr_, v1 = acc[ai][bj][m][1] * scr_;
                    if (rope) {
                        const int pos = row & 2047;
                        const f32x4 sn = *(const f32x4*)(sinT + pos * 32 + i0), cs = *(const f32x4*)(cosT + pos * 32 + i0);
                        f32x4 w0, w1;
                        w0[0] = v0[0] * cs[0] - v0[1] * sn[0]; w0[1] = v0[1] * cs[0] + v0[0] * sn[0];
                        w0[2] = v0[2] * cs[1] - v0[3] * sn[1]; w0[3] = v0[3] * cs[1] + v0[2] * sn[1];
                        w1[0] = v1[0] * cs[2] - v1[1] * sn[2]; w1[1] = v1[1] * cs[2] + v1[0] * sn[2];
                        w1[2] = v1[2] * cs[3] - v1[3] * sn[3]; w1[3] = v1[3] * cs[3] + v1[2] * sn[3];
                        v0 = w0; v1 = w1;
                    }
                    *(u32x4*)(O + (size_t)row * 5120 + c0) = pack8(v0, v1);
                }
        }
    }
};
struct EpiResid {
    static constexpr bool PERM = true, AFTER_DRAIN = false;
    float* T; const bf16_t* R; float scale;
    __device__ __forceinline__ void operator()(const f32x4 (&acc)[2][2][4][2], const Unit& u, int wr, int wc, int fr, int fq) const {
        const int row0 = u.pm * BM + wr * 64 + fr, col0 = u.pn * BM + wc * 32 + 8 * fq;
#pragma unroll
        for (int ai = 0; ai < 2; ++ai)
#pragma unroll
            for (int m = 0; m < 4; ++m) {
                const size_t ro = (size_t)(row0 + ai * HALF + m * 16) * 2048 + col0;
#pragma unroll
                for (int bj = 0; bj < 2; ++bj) {
                    const u32x4 r = *(const u32x4*)(R + ro + bj * HALF);
                    f32x4 r0, r1;
                    r0[0] = __builtin_bit_cast(float, r.x << 16); r0[1] = __builtin_bit_cast(float, r.x & 0xffff0000u); r0[2] = __builtin_bit_cast(float, r.y << 16); r0[3] = __builtin_bit_cast(float, r.y & 0xffff0000u);
                    r1[0] = __builtin_bit_cast(float, r.z << 16); r1[1] = __builtin_bit_cast(float, r.z & 0xffff0000u); r1[2] = __builtin_bit_cast(float, r.w << 16); r1[3] = __builtin_bit_cast(float, r.w & 0xffff0000u);
                    *(f32x4*)(T + ro + bj * HALF) = r0 * ALPHA_F + acc[ai][bj][m][0] * scale;
                    *(f32x4*)(T + ro + bj * HALF + 4) = r1 * ALPHA_F + acc[ai][bj][m][1] * scale;
                }
            }
    }
};
__device__ __forceinline__ float silu_f(float x) { return x * __builtin_amdgcn_rcpf(1.f + __builtin_amdgcn_exp2f(-1.4426950408889634f * x)); }
struct EpiSwiGLU {
    static constexpr bool PERM = true, AFTER_DRAIN = false;
    bf16_t* H; int ntn;
    __device__ __forceinline__ void operator()(const f32x4 (&acc)[2][2][4][2], const Unit& u, int wr, int wc, int fr, int fq) const {
        const int row0 = u.pm * BM + wr * 64 + fr, col0 = (u.pn % ntn) * HALF + wc * 32 + 8 * fq;
#pragma unroll
        for (int ai = 0; ai < 2; ++ai)
#pragma unroll
            for (int m = 0; m < 4; ++m) {
                f32x4 h0, h1;
#pragma unroll
                for (int j = 0; j < 4; ++j) { h0[j] = silu_f(acc[ai][0][m][0][j]) * acc[ai][1][m][0][j]; h1[j] = silu_f(acc[ai][0][m][1][j]) * acc[ai][1][m][1][j]; }
                *(u32x4*)(H + (size_t)(row0 + ai * HALF + m * 16) * 5632 + col0) = pack8(h0, h1);
            }
    }
};
constexpr float FP8_SX = 16.f, FP8_SWU = 512.f, FP8_SH = 8.f, FP8_SWD = 2048.f;
__device__ __forceinline__ unsigned pack4_fp8(float a, float b, float c, float d) {
    a = __builtin_amdgcn_fmed3f(a, -448.f, 448.f); b = __builtin_amdgcn_fmed3f(b, -448.f, 448.f); c = __builtin_amdgcn_fmed3f(c, -448.f, 448.f); d = __builtin_amdgcn_fmed3f(d, -448.f, 448.f);
    int w = __builtin_amdgcn_cvt_pk_fp8_f32(a, b, 0, false); w = __builtin_amdgcn_cvt_pk_fp8_f32(c, d, w, true); return (unsigned)w;
}
struct EpiSwiGLU8 {
    static constexpr bool PERM = true, AFTER_DRAIN = false;
    unsigned char* H; int ntn; float si;
    __device__ __forceinline__ void operator()(const f32x4 (&acc)[2][2][4][2], const Unit& u, int wr, int wc, int fr, int fq) const {
        const int row0 = u.pmo * BM + wr * 64 + fr, col0 = (u.pn % ntn) * HALF + wc * 32 + 8 * fq;
#pragma unroll
        for (int ai = 0; ai < 2; ++ai)
#pragma unroll
            for (int m = 0; m < 4; ++m) {
                f32x4 h0, h1;
#pragma unroll
                for (int j = 0; j < 4; ++j) { h0[j] = silu_f(acc[ai][0][m][0][j] * si) * (acc[ai][1][m][0][j] * (si * FP8_SH)); h1[j] = silu_f(acc[ai][0][m][1][j] * si) * (acc[ai][1][m][1][j] * (si * FP8_SH)); }
                u32x2 w; w.x = pack4_fp8(h0[0], h0[1], h0[2], h0[3]); w.y = pack4_fp8(h1[0], h1[1], h1[2], h1[3]);
                *(u32x2*)(H + (size_t)(row0 + ai * HALF + m * 16) * 5632 + col0) = w;
            }
    }
};
struct EpiY {
    static constexpr bool PERM = true, AFTER_DRAIN = false;
    bf16_t* Y; int ntn; float scale;
    __device__ __forceinline__ void operator()(const f32x4 (&acc)[2][2][4][2], const Unit& u, int wr, int wc, int fr, int fq) const {
        const int row0 = u.pm * BM + wr * 64 + fr, col0 = (u.pn % ntn) * BM + wc * 32 + 8 * fq;
#pragma unroll
        for (int ai = 0; ai < 2; ++ai)
#pragma unroll
            for (int m = 0; m < 4; ++m)
#pragma unroll
                for (int bj = 0; bj < 2; ++bj)
                    *(u32x4*)(Y + (size_t)(row0 + ai * HALF + m * 16) * 2048 + col0 + bj * HALF) = pack8(acc[ai][bj][m][0] * scale, acc[ai][bj][m][1] * scale);
    }
};
struct GroupedOrder {
    int nM, nN, nwg, G, c, pm0, phys; int cum[8];
    __device__ __forceinline__ bool next(int i, Unit& u) const {
        const long L = (long)i * G + c; if (L >= nwg) return false;
        int wgid = (int)L; { const int q = nwg / NXCD, r = nwg % NXCD, xcd = wgid % NXCD, off = wgid / NXCD; wgid = (xcd < r ? xcd * (q + 1) : r * (q + 1) + (xcd - r) * q) + off; }
        const int nig = WGM * nN, gid = wgid / nig, fm = gid * WGM, gsz = (nM - fm) < WGM ? (nM - fm) : WGM;
        const int pm = pm0 + fm + ((wgid % nig) % gsz), pn = (wgid % nig) / gsz;
        int e = 0;
#pragma unroll
        for (int j = 0; j < 7; ++j) e += (pm >= cum[j]) ? 1 : 0;
        int first = 0;
#pragma unroll
        for (int j = 0; j < 7; ++j) first = (e == j + 1) ? cum[j] : first;
        u.pmo = pm; u.pm = phys ? e * 64 + (pm - first) : pm; u.pn = e * nN + pn; return true;
    }
    __device__ __forceinline__ void a_ready(const Unit&) const {}
    __device__ __forceinline__ void done(const Unit&) const {}
};
template <class Epi, class Sched, bool ALIGN_EPI = false, bool SP2 = false, bool FP8 = false>
__device__ __forceinline__ void gemm_phase(PG8_LAS unsigned char* lds, const int wid, const Gemm g, const Sched& S, const Epi& E) {
    const int lane = (int)__builtin_amdgcn_mbcnt_hi(~0u, __builtin_amdgcn_mbcnt_lo(~0u, 0u)), tid = wid * 64 + lane,
        wr = wid >> 2, wc = wid & 3, fr = lane & 15, fq = lane >> 4;
    const int KB = g.KB, nt = KB / 128;
    unsigned voffA[2], voffB[2];
#pragma unroll
    for (int i = 0; i < 2; ++i) { int R, C; stage_rc(tid * 16 + i * 8192, R, C); const int Rb = Epi::PERM ? ((R & ~31) + perm32(R & 31)) : R;
        voffA[i] = (unsigned)(R * KB + C * 2); voffB[i] = (unsigned)(Rb * KB + C * 2); }
    const size_t kstep = (size_t)128;
    const size_t hstep = (size_t)HALF * KB;
    const size_t tstep = 2 * hstep;
    const unsigned ldsw = (unsigned)wid * 1024u;
    const int aoff = lds_byte(wr * 64 + fr, fq * 8), boff = lds_byte(wc * 32 + fr, fq * 8);
#define PG8_SA(b, h) (((b) * 2 + (h)) * HTB)
#define PG8_SB(b, h) ((4 + (b) * 2 + (h)) * HTB)
#define PG8_STAGE(bufoff, gbase, voff) do { _Pragma("unroll") for (int _i = 0; _i < 2; ++_i) \
        __builtin_amdgcn_global_load_lds((const unsigned*)((const char*)(gbase) + (voff)[_i]), (PG8_LAS unsigned*)(lds + (bufoff) + ldsw + _i * 8192), 16, 0, 0); } while (0)
#define PG8_LDA(dst, b, h) do { _Pragma("unroll") for (int m = 0; m < 4; ++m) _Pragma("unroll") for (int k = 0; k < 2; ++k) dst[m][k] = *(const PG8_LAS bf16x8*)(lds + PG8_SA(b, h) + aoff + m * 2048 + k * 1024); } while (0)
#define PG8_LDB(dst, b, h) do { _Pragma("unroll") for (int n = 0; n < 2; ++n) _Pragma("unroll") for (int k = 0; k < 2; ++k) dst[n][k] = *(const PG8_LAS bf16x8*)(lds + PG8_SB(b, h) + boff + n * 2048 + k * 1024); } while (0)
#define PG8_MMA(ai, bj, At, Bt) do { __builtin_amdgcn_s_setprio(1); _Pragma("unroll") for (int m = 0; m < 4; ++m) _Pragma("unroll") for (int n = 0; n < 2; ++n) { \
        if constexpr (FP8) { const v4i_t b0_ = __builtin_bit_cast(v4i_t, Bt[n][0]), b1_ = __builtin_bit_cast(v4i_t, Bt[n][1]), a0_ = __builtin_bit_cast(v4i_t, At[m][0]), a1_ = __builtin_bit_cast(v4i_t, At[m][1]); \
            const v8i_t b8_ = __builtin_shufflevector(b0_, b1_, 0, 1, 2, 3, 4, 5, 6, 7), a8_ = __builtin_shufflevector(a0_, a1_, 0, 1, 2, 3, 4, 5, 6, 7); \
            asm volatile("v_mfma_f32_16x16x128_f8f6f4 %0, %1, %2, %0" : "+v"(acc[ai][bj][m][n]) : "v"(b8_), "v"(a8_)); } \
        else { _Pragma("unroll") for (int k = 0; k < 2; ++k) acc[ai][bj][m][n] = __builtin_amdgcn_mfma_f32_16x16x32_bf16(Bt[n][k], At[m][k], acc[ai][bj][m][n], 0, 0, 0); } } __builtin_amdgcn_s_setprio(0); } while (0)
#define PG8_WAIT_V(n) asm volatile("s_waitcnt vmcnt(" #n ")" ::: "memory")
#define PG8_WAIT_L(n) asm volatile("s_waitcnt lgkmcnt(" #n ")" ::: "memory")
#define PG8_BAR __builtin_amdgcn_s_barrier()
#define PG8_SCHED __builtin_amdgcn_sched_barrier(0)
    Unit cur, nxt; int ui = 0;
    if (!S.next(0, cur)) return;
    f32x4 acc[2][2][4][2];
#pragma unroll
    for (int a = 0; a < 2; ++a)
#pragma unroll
        for (int b = 0; b < 2; ++b)
#pragma unroll
            for (int m = 0; m < 4; ++m)
#pragma unroll
                for (int n = 0; n < 2; ++n) acc[a][b][m][n] = (f32x4){0.f, 0.f, 0.f, 0.f};
    bf16x8 At[4][2], B0[2][2], B1[2][2];
    const char* cA = (const char*)g.A + (size_t)cur.pm * tstep; const char* cB = (const char*)g.Bt + (size_t)cur.pn * tstep;
    S.a_ready(cur);
    if constexpr (SP2) {
        PG8_STAGE(PG8_SB(0, 0), cB, voffB); PG8_STAGE(PG8_SB(0, 1), cB + hstep, voffB); PG8_STAGE(PG8_SA(0, 0), cA, voffA); PG8_STAGE(PG8_SA(0, 1), cA + hstep, voffA);
        if (wr == 1) PG8_BAR;
        PG8_WAIT_V(2); PG8_BAR;
        PG8_STAGE(PG8_SB(1, 0), cB + kstep, voffB); PG8_STAGE(PG8_SA(1, 0), cA + kstep, voffA); PG8_STAGE(PG8_SB(1, 1), cB + hstep + kstep, voffB);
        PG8_WAIT_V(6); PG8_BAR;
    } else {
        PG8_STAGE(PG8_SB(0, 0), cB, voffB); PG8_STAGE(PG8_SA(0, 0), cA, voffA); PG8_STAGE(PG8_SB(0, 1), cB + hstep, voffB); PG8_STAGE(PG8_SA(0, 1), cA + hstep, voffA);
        if (wr == 1) PG8_BAR;
        PG8_WAIT_V(4); PG8_BAR;
        PG8_STAGE(PG8_SB(1, 0), cB + kstep, voffB); PG8_STAGE(PG8_SA(1, 0), cA + kstep, voffA); PG8_STAGE(PG8_SB(1, 1), cB + hstep + kstep, voffB);
        PG8_WAIT_V(6); PG8_BAR;
    }
    for (;;) {
        const bool has_next = S.next(ui + 1, nxt);
        const char* nA = has_next ? (const char*)g.A + (size_t)nxt.pm * tstep : cA; const char* nB = has_next ? (const char*)g.Bt + (size_t)nxt.pn * tstep : cB;
        for (int t = 0; t < nt; t += 2) {
            const bool last = (t == nt - 2);
            const char* a1 = cA + (size_t)(t + 1) * kstep;
            const char* a2 = last ? nA : cA + (size_t)(t + 2) * kstep; const char* b2 = last ? nB : cB + (size_t)(t + 2) * kstep;
            const char* a3 = a2 + kstep; const char* b3 = b2 + kstep;
            if (last && has_next) S.a_ready(nxt);
            if constexpr (SP2) {
            PG8_LDB(B0, 0, 0); PG8_LDB(B1, 0, 1); PG8_SCHED; PG8_LDA(At, 0, 0); PG8_STAGE(PG8_SA(1, 1), a1 + hstep, voffA);
            PG8_WAIT_V(8); PG8_WAIT_L(0); PG8_BAR; PG8_MMA(0, 0, At, B0); PG8_MMA(0, 1, At, B1); PG8_BAR; PG8_SCHED;
            PG8_LDA(At, 0, 1); PG8_STAGE(PG8_SB(0, 0), b2, voffB); PG8_STAGE(PG8_SB(0, 1), b2 + hstep, voffB); PG8_STAGE(PG8_SA(0, 0), a2, voffA);
            PG8_WAIT_V(8); PG8_WAIT_L(0); PG8_BAR; PG8_MMA(1, 0, At, B0); PG8_MMA(1, 1, At, B1); PG8_BAR; PG8_SCHED;
            PG8_LDB(B0, 1, 0); PG8_LDB(B1, 1, 1); PG8_SCHED; PG8_LDA(At, 1, 0); PG8_STAGE(PG8_SA(0, 1), a2 + hstep, voffA);
            PG8_WAIT_V(8); PG8_WAIT_L(0); PG8_BAR; PG8_MMA(0, 0, At, B0); PG8_MMA(0, 1, At, B1); PG8_BAR; PG8_SCHED;
            PG8_LDA(At, 1, 1); PG8_STAGE(PG8_SB(1, 0), b3, voffB); PG8_STAGE(PG8_SB(1, 1), b3 + hstep, voffB); PG8_STAGE(PG8_SA(1, 0), a3, voffA);
            PG8_WAIT_V(8); PG8_WAIT_L(0); PG8_BAR; PG8_MMA(1, 0, At, B0); PG8_MMA(1, 1, At, B1); PG8_BAR; PG8_SCHED;
            } else {
            PG8_LDB(B0, 0, 0); PG8_SCHED; PG8_LDA(At, 0, 0); PG8_STAGE(PG8_SA(1, 1), a1 + hstep, voffA);
            PG8_WAIT_L(8); PG8_BAR; PG8_WAIT_L(0); PG8_MMA(0, 0, At, B0); PG8_BAR; PG8_SCHED;
            PG8_LDB(B1, 0, 1); PG8_STAGE(PG8_SB(0, 0), b2, voffB);
            PG8_BAR; PG8_WAIT_L(0); PG8_MMA(0, 1, At, B1); PG8_BAR;
            PG8_LDA(At, 0, 1); PG8_STAGE(PG8_SA(0, 0), a2, voffA);
            PG8_BAR; PG8_WAIT_L(0); PG8_MMA(1, 0, At, B0); PG8_BAR; PG8_SCHED;
            PG8_STAGE(PG8_SB(0, 1), b2 + hstep, voffB);
            PG8_WAIT_V(6); PG8_BAR; PG8_MMA(1, 1, At, B1); PG8_BAR;
            PG8_LDB(B0, 1, 0); PG8_SCHED; PG8_LDA(At, 1, 0); PG8_STAGE(PG8_SA(0, 1), a2 + hstep, voffA);
            PG8_WAIT_L(8); PG8_BAR; PG8_WAIT_L(0); PG8_MMA(0, 0, At, B0); PG8_BAR; PG8_SCHED;
            PG8_LDB(B1, 1, 1); PG8_STAGE(PG8_SB(1, 0), b3, voffB);
            PG8_BAR; PG8_WAIT_L(0); PG8_MMA(0, 1, At, B1); PG8_BAR;
            PG8_LDA(At, 1, 1); PG8_STAGE(PG8_SA(1, 0), a3, voffA);
            PG8_BAR; PG8_WAIT_L(0); PG8_MMA(1, 0, At, B0); PG8_BAR; PG8_SCHED;
            PG8_STAGE(PG8_SB(1, 1), b3 + hstep, voffB);
            PG8_WAIT_V(6); PG8_BAR; PG8_MMA(1, 1, At, B1); PG8_BAR;
            }
        }
        if constexpr (ALIGN_EPI) { if (wr == 0) PG8_BAR; }
        if constexpr (FP8) asm volatile("s_nop 15\n\ts_nop 15" ::: "memory");
        if constexpr (!Epi::AFTER_DRAIN) { E(acc, cur, wr, wc, fr, fq); S.done(cur); }
        if (!has_next) break;
#pragma unroll
        for (int a = 0; a < 2; ++a)
#pragma unroll
            for (int b = 0; b < 2; ++b)
#pragma unroll
                for (int m = 0; m < 4; ++m)
#pragma unroll
                    for (int n = 0; n < 2; ++n) acc[a][b][m][n] = (f32x4){0.f, 0.f, 0.f, 0.f};
        cur = nxt; cA = nA; cB = nB; ++ui;
        if constexpr (ALIGN_EPI) { if (wr == 1) PG8_BAR; }
    }
    PG8_WAIT_V(0);
    if constexpr (!ALIGN_EPI) { if (wr == 0) PG8_BAR; }
    PG8_BAR;
    if constexpr (Epi::AFTER_DRAIN) { E.fused(acc, cur, wr, wc, fr, fq, lds, wid, lane); S.done(cur); }
#undef PG8_SA
#undef PG8_SB
#undef PG8_STAGE
#undef PG8_LDA
#undef PG8_LDB
#undef PG8_MMA
#undef PG8_WAIT_V
#undef PG8_WAIT_L
#undef PG8_BAR
#undef PG8_SCHED
}
}
constexpr int NWAVES = 8;
constexpr int NTOK = 16384, SEQ = 2048, DM = 2048, PW = 4992, PWP = 5120, DFF = 5632, NEXP = 8, MAXTILES = 136;
constexpr float LN_EPS = 1e-5f;
constexpr float LOG2E = 1.4426950408889634f;
constexpr int C_AQ = 0, C_AK = 768, C_AV = 1536, C_BQ = 2304, C_BK = 3072, C_BV = 3264, C_CQ = 3456, C_CK = 3712, C_CV = 3968, C_CG = 4480;
constexpr size_t MiB = 1u << 20;
constexpr size_t WS_CTL = 0, CTL_ZERO_BYTES = 1 * MiB;
constexpr size_t WS_TAB = 1 * MiB;
constexpr size_t WS_ROUTE = 2 * MiB;
constexpr size_t WS_WIN = 4 * MiB, WS_WOUT = 44 * MiB, WS_WDGU = 60 * MiB, WS_WDDN = 104 * MiB, WS_WMGU = 126 * MiB  , WS_WMDN = 302 * MiB  ;
constexpr size_t WS_XB = 390 * MiB, WS_XG = 454 * MiB  , WS_Y = 710 * MiB  , WS_U1 = 846 * MiB, WS_END = 1070 * MiB;
constexpr size_t WS_PROJ = WS_U1, WS_CAT = WS_U1 + 160 * MiB, WS_H = WS_U1;
constexpr int XG_CAP = 16384;
static_assert(WS_WIN + 2ull * PWP * DM * 2 <= WS_WOUT && WS_WOUT + 2ull * DM * DM * 2 <= WS_WDGU && WS_WDGU + 2ull * DFF * DM * 2 <= WS_WDDN && WS_WDDN + (size_t)DM * DFF * 2 <= WS_WMGU, "ws map 1");
static_assert(WS_WMGU + 8ull * 2 * DFF * DM <= WS_WMDN && WS_WMDN + 8ull * DM * DFF <= WS_XB && WS_XB + (size_t)NTOK * DM * 2 <= WS_XG && WS_XG + 8ull * XG_CAP * DM <= WS_Y && WS_Y + (size_t)MAXTILES * 256 * DM * 2 <= WS_U1, "ws map 2");
static_assert(WS_U1 + (size_t)MAXTILES * 256 * DFF <= WS_END && WS_PROJ + (size_t)NTOK * PWP * 2 <= WS_CAT && WS_CAT + (size_t)NTOK * DM * 2 <= WS_END, "ws map 3");
constexpr int CW_TMO = 0, CW_CODE = 1, CW_CNT = 1024  , CW_WQ = 2048  , CW_BAR = 4096  ;
constexpr int RING_OFF = 0, RING_BYTES = 131072;
constexpr int LDSCTL_OFF = RING_BYTES, MISC_OFF = LDSCTL_OFF + 320;
constexpr int LUT_OFF = LDSCTL_OFF + 1024;
constexpr int LUT_STRIDE = 132;
constexpr int LDS_BYTES = 147456;
static_assert(LUT_OFF + 18 * LUT_STRIDE * 4 <= LDS_BYTES, "LDS map");

#define GAS __attribute__((address_space(1)))
#define LAS __attribute__((address_space(3)))
typedef unsigned short bf16;
typedef unsigned v4u __attribute__((ext_vector_type(4)));
typedef unsigned v2u __attribute__((ext_vector_type(2)));
typedef float f32x4 __attribute__((ext_vector_type(4)));
typedef short bf16x8 __attribute__((ext_vector_type(8)));
typedef GAS unsigned gu32;
#define RLX_AGENT __ATOMIC_RELAXED, __HIP_MEMORY_SCOPE_AGENT
#define LDS_WAIT() asm volatile("s_waitcnt lgkmcnt(0)" ::: "memory")
#define VM_WAIT() asm volatile("s_waitcnt vmcnt(0)" ::: "memory")
__device__ __forceinline__ unsigned f2bf(float f) { unsigned u = __builtin_bit_cast(unsigned, f); return (u + 0x7fffu + ((u >> 16) & 1u)) >> 16; }
__device__ __forceinline__ unsigned pk2(float lo, float hi) { return f2bf(lo) | (f2bf(hi) << 16); }
__device__ __forceinline__ float bflo(unsigned w) { return __builtin_bit_cast(float, w << 16); }
__device__ __forceinline__ float bfhi(unsigned w) { return __builtin_bit_cast(float, w & 0xffff0000u); }
__device__ __forceinline__ float bf2f(bf16 h) { return __builtin_bit_cast(float, (unsigned)h << 16); }
__device__ const unsigned char BUCKET[129] = {0,1,2,3,4,5,6,7,8,9,10,11,12,13,14,15,16,16,16,17,17,18,18,18,19,19,19,20,20,20,20,21,21,21,21,22,22,22,22,22,23,23,23,23,23,23,24,24,24,24,24,24,25,25,25,25,25,25,25,
    26,26,26,26,26,26,26,26,27,27,27,27,27,27,27,27,27,27,28,28,28,28,28,28,28,28,28,28,29,29,29,29,29,29,29,29,29,29,29,29,30,30,30,30,30,30,30,30,30,30,30,30,30,30,31,31,31,31,31,31,31,31,31,31,31,31,31,31,31,31};
#define XB_TMO      128
#define XB_XCNT(j)  (256  + 64 * (j))
#define XB_XSUB(j)  (1280 + 64 * (j))
#define XB_XGEN(j)  (2304 + 64 * (j))
#define XB_TOP      3328
#define XB_TOPGEN   3392
#define XCD_BAR_WORDS 3456
#define XB_SPIN_CAP (1u << 18)

__device__ __forceinline__ unsigned xb_ld(unsigned* p)              { return __hip_atomic_load(p, __ATOMIC_RELAXED, __HIP_MEMORY_SCOPE_AGENT); }
__device__ __forceinline__ unsigned xb_add(unsigned* p, unsigned v) { return __hip_atomic_fetch_add(p, v, __ATOMIC_RELAXED, __HIP_MEMORY_SCOPE_AGENT); }
__device__ __forceinline__ unsigned xb_xcc_id() { return (unsigned)__builtin_amdgcn_s_getreg((3 << 11) | 20) & 0xFu; }
#define XB_SPIN(cond, bar) do { unsigned _sp = 0; while (cond) { __builtin_amdgcn_s_sleep(1); \
    if ((++_sp & 255u) == 0u) { if (xb_ld(&(bar)[XB_TMO])) break; if (_sp > XB_SPIN_CAP) { atomicAdd(&(bar)[XB_TMO], 1u); break; } } } } while (0)

struct XcdBarrier {
    unsigned* bar; unsigned x;
    volatile LAS unsigned* st;
};

__device__ __forceinline__ XcdBarrier xcd_barrier_post(unsigned* bar, volatile LAS unsigned* st) {
    XcdBarrier b; b.bar = bar; b.x = xb_xcc_id(); b.st = st;
    if (threadIdx.x == 0) (void)xb_add(&bar[XB_XCNT(b.x)], 1u);
    return b;
}
__device__ __forceinline__ void xcd_barrier_complete(unsigned* bar, unsigned x, unsigned& nloc, unsigned& nx) {
    const unsigned G = gridDim.x * gridDim.y * gridDim.z;
    unsigned sum, cnt, mine, sp = 0u;
    for (;;) {
        sum = 0u; cnt = 0u; mine = 0u;
#pragma unroll
        for (unsigned j = 0; j < 16; ++j) { const unsigned c = xb_ld(&bar[XB_XCNT(j)]); sum += c; cnt += (c > 0u) ? 1u : 0u; mine = (j == x) ? c : mine; }
        if (sum == G) break;
        __builtin_amdgcn_s_sleep(1);
        if ((++sp & 255u) == 0u) { if (xb_ld(&bar[XB_TMO])) break; if (sp > XB_SPIN_CAP) { atomicAdd(&bar[XB_TMO], 1u); break; } }
    }
    nloc = mine > 0u ? mine : 1u; nx = cnt > 0u ? cnt : 1u;
}

__device__ __forceinline__ void xcd_barrier(const XcdBarrier& b) {
    asm volatile("s_waitcnt vmcnt(0)" ::: "memory");
    __syncthreads();
    if (threadIdx.x == 0) {
        unsigned* bar = b.bar;
        __builtin_amdgcn_s_waitcnt(0);
        unsigned nloc = b.st[0], nx = b.st[1];
        if (nloc == 0u) { xcd_barrier_complete(bar, b.x, nloc, nx); b.st[0] = nloc; b.st[1] = nx; }
        const unsigned old = xb_add(&bar[XB_XSUB(b.x)], 1u);
        const unsigned gen = old / nloc;
        if (old + 1u == (gen + 1u) * nloc) {
            __builtin_amdgcn_fence(__ATOMIC_RELEASE, "agent");
            asm volatile("s_waitcnt vmcnt(0)" ::: "memory");
            const unsigned og = xb_add(&bar[XB_TOP], 1u);
            const unsigned tg = og / nx;
            if (og + 1u == (tg + 1u) * nx) xb_add(&bar[XB_TOPGEN], 1u);
            else XB_SPIN(xb_ld(&bar[XB_TOPGEN]) == tg, bar);
            __builtin_amdgcn_fence(__ATOMIC_ACQUIRE, "agent");
            xb_add(&bar[XB_XGEN(b.x)], 1u);
            asm volatile("s_waitcnt vmcnt(0)" ::: "memory");
        } else {
            XB_SPIN(xb_ld(&bar[XB_XGEN(b.x)]) == gen, bar);
            __builtin_amdgcn_fence(__ATOMIC_ACQUIRE, "agent");
            asm volatile("s_waitcnt vmcnt(0)" ::: "memory");
        }
    }
    __syncthreads();
}
struct Args { const float* in[18]; float* out; unsigned char* ws; int ph_lo, ph_hi, li, pad; float invf[32]; };
static_assert(sizeof(Args) == 20 * 8 + 16 + 128, "Args has no padding bytes");
struct Frame {
    LAS unsigned char* lds;
    gu32* ctl;
    int tid, lane, wave, vcu, G;
};
__device__ __forceinline__ float wave_sum(float v) {
#pragma unroll
    for (int o = 1; o < 64; o <<= 1) v += __shfl_xor(v, o);
    return v;
}
__device__ __forceinline__ float wave_max(float v) {
#pragma unroll
    for (int o = 1; o < 64; o <<= 1) v = fmaxf(v, __shfl_xor(v, o));
    return v;
}
__device__ __forceinline__ void p0_transpose_item(const float* W, int K, int N, bf16* WT, int k0, int n0, int drow0, LAS float* scr, int lane) {
#pragma unroll 8
    for (int i = 0; i < 32; ++i) { const int kk = 2 * i + (lane >> 5); scr[kk * 33 + (lane & 31)] = __builtin_nontemporal_load(W + (size_t)(k0 + kk) * N + n0 + (lane & 31)); }
    LDS_WAIT(); asm volatile("" ::: "memory");
    const int c = lane & 7;
#pragma unroll
    for (int j = 0; j < 4; ++j) { const int n = (lane >> 3) + 8 * j; const LAS float* s = scr + (8 * c) * 33 + n;
        v4u o; o.x = pk2(s[0 * 33], s[1 * 33]); o.y = pk2(s[2 * 33], s[3 * 33]); o.z = pk2(s[4 * 33], s[5 * 33]); o.w = pk2(s[6 * 33], s[7 * 33]);
        __builtin_nontemporal_store(o, (GAS v4u*)(WT + (size_t)(drow0 + n) * K + k0 + 8 * c)); }
    LDS_WAIT(); asm volatile("" ::: "memory");
}
template <int MODE> __device__ __forceinline__ void p0_matrix_item(const float* W, int K, int N, bf16* WT, int item, LAS float* scr, int lane) {
    const int nblk = N / 32, kb = item / nblk, nb = item % nblk, n0 = 32 * nb;
    const int drow0 = (MODE == 0) ? n0 : ((n0 >> 7) * 256 + (n0 & 127) + (MODE == 2 ? 128 : 0));
    p0_transpose_item(W, K, N, WT, 64 * kb, n0, drow0, scr, lane);
}
__device__ __forceinline__ void p0_transpose_item8(const float* W, int K, int N, unsigned char* WT, int k0, int n0, int drow0, float scale, LAS float* scr, int lane) {
#pragma unroll 8
    for (int i = 0; i < 32; ++i) { const int kk = 2 * i + (lane >> 5); scr[kk * 33 + (lane & 31)] = __builtin_nontemporal_load(W + (size_t)(k0 + kk) * N + n0 + (lane & 31)) * scale; }
    LDS_WAIT(); asm volatile("" ::: "memory");
    const int c = lane & 7;
#pragma unroll
    for (int j = 0; j < 4; ++j) { const int n = (lane >> 3) + 8 * j; const LAS float* s = scr + (8 * c) * 33 + n;
        v2u o; o.x = pg8::pack4_fp8(s[0 * 33], s[1 * 33], s[2 * 33], s[3 * 33]); o.y = pg8::pack4_fp8(s[4 * 33], s[5 * 33], s[6 * 33], s[7 * 33]);
        __builtin_nontemporal_store(o, (GAS v2u*)(WT + (size_t)(drow0 + n) * K + k0 + 8 * c)); }
    LDS_WAIT(); asm volatile("" ::: "memory");
}
template <int MODE> __device__ __forceinline__ void p0_matrix_item8(const float* W, int K, int N, unsigned char* WT, int item, float scale, LAS float* scr, int lane) {
    const int nblk = N / 32, kb = item / nblk, nb = item % nblk, n0 = 32 * nb;
    const int drow0 = (MODE == 0) ? n0 : ((n0 >> 7) * 256 + (n0 & 127) + (MODE == 2 ? 128 : 0));
    p0_transpose_item8(W, K, N, WT, 64 * kb, n0, drow0, scale, scr, lane);
}
__device__ __forceinline__ void p0_prologue(Frame& F, const Args& a) {
    LAS float* scr = (LAS float*)(F.lds + RING_OFF + F.wave * 16384);
    const int gw = F.vcu * NWAVES + F.wave, NGW = F.G * NWAVES;
    unsigned char* ws = a.ws;
    constexpr int I_IN = (DM / 64) * (PW / 32), I_OUT = (DM / 64) * (DM / 32), I_GU = (DM / 64) * (DFF / 32), I_DN = (DFF / 64) * (DM / 32);
    constexpr int NITEMS = 2 * I_IN + 2 * I_OUT + 2 * I_GU + I_DN + 8 * (2 * I_GU + I_DN);
    for (int it = gw; it < NITEMS; it += NGW) {
        int r = it;
        if (r < 2 * I_IN) { const int l = r / I_IN; p0_matrix_item<0>(a.in[1] + (size_t)l * DM * PW, DM, PW, (bf16*)(ws + WS_WIN) + (size_t)l * PWP * DM, r % I_IN, scr, F.lane); continue; } r -= 2 * I_IN;
        if (r < 2 * I_OUT) { const int l = r / I_OUT; p0_matrix_item<0>(a.in[6] + (size_t)l * DM * DM, DM, DM, (bf16*)(ws + WS_WOUT) + (size_t)l * DM * DM, r % I_OUT, scr, F.lane); continue; } r -= 2 * I_OUT;
        if (r < I_GU) { p0_matrix_item<1>(a.in[11], DM, DFF, (bf16*)(ws + WS_WDGU), r, scr, F.lane); continue; } r -= I_GU;
        if (r < I_GU) { p0_matrix_item<2>(a.in[12], DM, DFF, (bf16*)(ws + WS_WDGU), r, scr, F.lane); continue; } r -= I_GU;
        if (r < I_DN) { p0_matrix_item8<0>(a.in[13], DFF, DM, ws + WS_WDDN, r, pg8::FP8_SWD, scr, F.lane); continue; } r -= I_DN;
        if (r < 8 * I_GU) { const int e = r / I_GU; p0_matrix_item8<1>(a.in[15] + (size_t)e * DM * DFF, DM, DFF, ws + WS_WMGU + (size_t)e * 2 * DFF * DM, r % I_GU, pg8::FP8_SWU, scr, F.lane); continue; } r -= 8 * I_GU;
        if (r < 8 * I_GU) { const int e = r / I_GU; p0_matrix_item8<2>(a.in[16] + (size_t)e * DM * DFF, DM, DFF, ws + WS_WMGU + (size_t)e * 2 * DFF * DM, r % I_GU, pg8::FP8_SWU, scr, F.lane); continue; } r -= 8 * I_GU;
        { const int e = r / I_DN; p0_matrix_item8<0>(a.in[17] + (size_t)e * DFF * DM, DFF, DM, ws + WS_WMDN + (size_t)e * DM * DFF, r % I_DN, pg8::FP8_SWD, scr, F.lane); }
    }
    { const int gt = gw * 64 + F.lane, NGT = NGW * 64; const GAS f32x4* x4 = (const GAS f32x4*)a.in[0]; GAS v4u* o4 = (GAS v4u*)(ws + WS_XB);
      for (int i = gt; i < NTOK * DM / 8; i += NGT) { const f32x4 p = __builtin_nontemporal_load(x4 + 2 * i), q = __builtin_nontemporal_load(x4 + 2 * i + 1); v4u o; o.x = pk2(p[0], p[1]); o.y = pk2(p[2], p[3]); o.z = pk2(q[0], q[1]); o.w = pk2(q[2], q[3]); o4[i] = o; } }
    { const int gt = gw * 64 + F.lane; if (gt < SEQ * 32) { const int pos = gt >> 5, i = gt & 31; const float ang = (float)pos * a.invf[i];
        const double t = (double)ang * 0.15915494309189535; const float fr = (float)(t - __builtin_rint(t));
        ((float*)(ws + WS_TAB))[gt] = __builtin_amdgcn_sinf(fr); ((float*)(ws + WS_TAB + 256 * 1024))[gt] = __builtin_amdgcn_cosf(fr); } }
}
__device__ __forceinline__ void build_lut(Frame& F, const float* rel_bias) {
    LAS float* lut = (LAS float*)(F.lds + LUT_OFF);
    for (int i = F.tid; i < 18 * 129; i += NWAVES * 64) { const int hh = i / 129, d = i % 129; lut[hh * LUT_STRIDE + d] = (rel_bias[BUCKET[d] * 18 + hh] - (hh < 6 ? rel_bias[31 * 18 + hh] : 0.f)) * LOG2E; }
}
__device__ __forceinline__ void ln_stats(f32x4 (&v)[8], float& mean, float& rstd) {
    float s = 0.f;
#pragma unroll
    for (int j = 0; j < 8; ++j) s += (v[j][0] + v[j][1]) + (v[j][2] + v[j][3]);
    mean = wave_sum(s) * (1.f / DM); float s2 = 0.f;
#pragma unroll
    for (int j = 0; j < 8; ++j) { v[j] = v[j] - mean; s2 += (v[j][0] * v[j][0] + v[j][1] * v[j][1]) + (v[j][2] * v[j][2] + v[j][3] * v[j][3]); }
    rstd = 1.f / sqrtf(wave_sum(s2) * (1.f / DM) + LN_EPS);
}
__device__ __forceinline__ int expert_offsets(Frame& F, int& ntiles) {
    const unsigned c = (F.lane < 8) ? __hip_atomic_load(F.ctl + CW_CNT + 64 * F.lane, RLX_AGENT) : 0u;
    const int t = (int)((c + 255u) >> 8);
    int inc = t;
#pragma unroll
    for (int o = 1; o < 8; o <<= 1) { const int u = __shfl_up(inc, o); if (F.lane >= o) inc += u; }
    ntiles = __shfl(inc, 7);
    return (inc - t) * 256;
}
template <int MODE> __device__ __forceinline__ void ln_phase(Frame& F, const Args& a, float* T, const float* gam, const float* bet, const float* w_router, int rb_in = -1, int pass = 0) {
    unsigned char* ws = a.ws;
    bf16* XB = (bf16*)(ws + WS_XB);
    const int lane = F.lane;
    LAS float* wrT = (LAS float*)(F.lds + RING_OFF);
    LAS int* cwL = (LAS int*)(F.lds + RING_OFF + 65536);
    LAS int* baseL = (LAS int*)(F.lds + RING_OFF + 65536 + 256);
    if (MODE == 1) {
        for (int i = F.tid; i < DM * 8; i += NWAVES * 64) wrT[(i & 7) * DM + (i >> 3)] = w_router[i];
        __syncthreads();
    }
    f32x4 g4[8], b4[8];
#pragma unroll
    for (int j = 0; j < 8; ++j) { g4[j] = *(const f32x4*)(gam + 4 * lane + 256 * j); b4[j] = *(const f32x4*)(bet + 4 * lane + 256 * j); }
    int offv = 0, ntl = 0;
    if (MODE == 2) offv = expert_offsets(F, ntl);
    const int rb = (rb_in >= 0) ? rb_in : (F.vcu * NWAVES + F.wave) * 8;
    unsigned long long cntp = 0ull; int me1 = 0, me2 = 0, mr1 = 0, mr2 = 0; float mg1 = 0.f, mg2 = 0.f;
    for (int r = 0; r < 8; ++r) {
        const int row = rb + r;
        float* trow = T + (size_t)row * DM;
        if (MODE == 2 && pass != 0) {
            const int* rt = (const int*)(ws + WS_ROUTE) + row * 8;
            const bool late = (__shfl(offv, rt[0]) + rt[1] >= 32768) || (__shfl(offv, rt[2]) + rt[3] >= 32768);
            if (late != (pass == 2)) continue;
        }
        f32x4 v[8];
#pragma unroll
        for (int j = 0; j < 8; ++j) v[j] = *(const f32x4*)(trow + 4 * lane + 256 * j);
        if (MODE == 2) {
            const int* rt = (const int*)(ws + WS_ROUTE) + row * 8;
            const int e1 = rt[0], p1 = rt[1], e2 = rt[2], p2 = rt[3]; const float g1 = __builtin_bit_cast(float, rt[4]), g2 = __builtin_bit_cast(float, rt[5]);
            const int r1 = __shfl(offv, e1) + p1, r2 = __shfl(offv, e2) + p2;
            const bf16* y1 = (const bf16*)(ws + WS_Y) + (size_t)r1 * DM; const bf16* y2 = (const bf16*)(ws + WS_Y) + (size_t)r2 * DM;
#pragma unroll
            for (int j = 0; j < 8; ++j) { const v2u a1 = *(const v2u*)(y1 + 4 * lane + 256 * j), a2 = *(const v2u*)(y2 + 4 * lane + 256 * j);
                v[j][0] = v[j][0] * pg8::ALPHA_F + g1 * bflo(a1.x) + g2 * bflo(a2.x); v[j][1] = v[j][1] * pg8::ALPHA_F + g1 * bfhi(a1.x) + g2 * bfhi(a2.x);
                v[j][2] = v[j][2] * pg8::ALPHA_F + g1 * bflo(a1.y) + g2 * bflo(a2.y); v[j][3] = v[j][3] * pg8::ALPHA_F + g1 * bfhi(a1.y) + g2 * bfhi(a2.y); }
        }
        float mean, rstd; ln_stats(v, mean, rstd);
#pragma unroll
        for (int j = 0; j < 8; ++j) v[j] = v[j] * rstd * g4[j] + b4[j];
        if (MODE == 2) {
            float* orow = a.out + (size_t)row * DM;
#pragma unroll
            for (int j = 0; j < 8; ++j) *(f32x4*)(orow + 4 * lane + 256 * j) = v[j];
        } else {
            bf16* xrow = XB + (size_t)row * DM;
#pragma unroll
            for (int j = 0; j < 8; ++j) { if (MODE != 0) *(f32x4*)(trow + 4 * lane + 256 * j) = v[j]; if (MODE == 0) { v2u o; o.x = pk2(v[j][0], v[j][1]); o.y = pk2(v[j][2], v[j][3]); *(v2u*)(xrow + 4 * lane + 256 * j) = o; }
                if (MODE == 3) { const f32x4 s = v[j] * pg8::FP8_SX; ((GAS unsigned*)(ws + WS_XG + (size_t)row * DM))[lane + 64 * j] = pg8::pack4_fp8(s[0], s[1], s[2], s[3]); } }
        }
        if (MODE == 1) {
            int i1 = -1, i2 = -1; float v1 = -3.0e38f, v2 = -3.0e38f;
#pragma unroll 1
            for (int e = 0; e < 8; ++e) { float s = 0.f;
#pragma unroll
                for (int j = 0; j < 8; ++j) { const f32x4 w = *(const LAS f32x4*)(wrT + e * DM + 4 * lane + 256 * j); s += (v[j][0] * w[0] + v[j][1] * w[1]) + (v[j][2] * w[2] + v[j][3] * w[3]); }
                const float t = wave_sum(s);
                if (t > v1) { v2 = v1; i2 = i1; v1 = t; i1 = e; } else if (t > v2) { v2 = t; i2 = e; } }
            if (i1 < 0) i1 = 0;
            if (i2 < 0) i2 = (i1 + 1) & 7;
            const float ex = __expf(v2 - v1), w1 = 1.f / (1.f + ex), w2 = ex * w1;
            const int k1 = (int)((cntp >> (8 * i1)) & 0xffull); cntp += 1ull << (8 * i1);
            const int k2 = (int)((cntp >> (8 * i2)) & 0xffull); cntp += 1ull << (8 * i2);
            if (lane == r) { me1 = i1; me2 = i2; mr1 = k1; mr2 = k2; mg1 = w1; mg2 = w2; }
        }
    }
    if (MODE == 1) {
        if (lane < 8) cwL[F.wave * 8 + lane] = (int)((cntp >> (8 * lane)) & 0xffull);
        __syncthreads();
        if (F.tid < 8) { int tot = 0;
#pragma unroll
            for (int w = 0; w < 8; ++w) tot += cwL[w * 8 + F.tid];
            baseL[F.tid] = (int)__hip_atomic_fetch_add(F.ctl + CW_CNT + 64 * F.tid, (unsigned)tot, RLX_AGENT); }
        __syncthreads();
        if (lane < 8) {
            int p1 = baseL[me1] + mr1, p2 = baseL[me2] + mr2;
            for (int w = 0; w < F.wave; ++w) { p1 += cwL[w * 8 + me1]; p2 += cwL[w * 8 + me2]; }
            int* rt = (int*)(ws + WS_ROUTE) + (rb + lane) * 8;
            rt[0] = me1; rt[1] = p1; rt[2] = me2; rt[3] = p2; rt[4] = __builtin_bit_cast(int, mg1); rt[5] = __builtin_bit_cast(int, mg2);
            mr1 = p1; mr2 = p2;
        }
        asm volatile("s_waitcnt vmcnt(0)" ::: "memory");
        for (int r = 0; r < 8; ++r) {
            const int e1 = __shfl(me1, r), e2 = __shfl(me2, r), q1 = __shfl(mr1, r), q2 = __shfl(mr2, r);
            const GAS f32x4* p0 = (const GAS f32x4*)(T + (size_t)(rb + r) * DM) + lane; const GAS f32x4* p1 = p0 + 256;
            f32x4 x0, x1, x2, x3, x4, x5, x6, x7;
            asm volatile("global_load_dwordx4 %0, %8, off sc0 sc1\n\tglobal_load_dwordx4 %1, %8, off offset:1024 sc0 sc1\n\tglobal_load_dwordx4 %2, %8, off offset:2048 sc0 sc1\n\tglobal_load_dwordx4 %3, %8, off offset:3072 sc0 sc1\n\t"
                         "global_load_dwordx4 %4, %9, off sc0 sc1\n\tglobal_load_dwordx4 %5, %9, off offset:1024 sc0 sc1\n\tglobal_load_dwordx4 %6, %9, off offset:2048 sc0 sc1\n\tglobal_load_dwordx4 %7, %9, off offset:3072 sc0 sc1\n\ts_waitcnt vmcnt(0)"
                         : "=&v"(x0), "=&v"(x1), "=&v"(x2), "=&v"(x3), "=&v"(x4), "=&v"(x5), "=&v"(x6), "=&v"(x7) : "v"(p0), "v"(p1) : "memory");
            GAS unsigned* o1 = (GAS unsigned*)(ws + WS_XG + ((size_t)e1 * XG_CAP + q1) * DM); GAS unsigned* o2 = (GAS unsigned*)(ws + WS_XG + ((size_t)e2 * XG_CAP + q2) * DM);
#define LN_PUT(j, x) do { const f32x4 v_ = (x) * pg8::FP8_SX; const unsigned w_ = pg8::pack4_fp8(v_[0], v_[1], v_[2], v_[3]); o1[lane + 64 * (j)] = w_; o2[lane + 64 * (j)] = w_; } while (0)
            LN_PUT(0, x0); LN_PUT(1, x1); LN_PUT(2, x2); LN_PUT(3, x3); LN_PUT(4, x4); LN_PUT(5, x5); LN_PUT(6, x6); LN_PUT(7, x7);
#undef LN_PUT
        }
    }
}
__device__ __forceinline__ void gather_phase(Frame& F, const Args& a, const float* T) {
    unsigned char* ws = a.ws; int ntl; const int offv = expert_offsets(F, ntl);
    const int gw = F.vcu * NWAVES + F.wave, NGW = F.G * NWAVES;
    for (int tok = gw; tok < NTOK; tok += NGW) {
        const int* rt = (const int*)(ws + WS_ROUTE) + tok * 8;
        const int d1 = __shfl(offv, rt[0]) + rt[1], d2 = __shfl(offv, rt[2]) + rt[3];
        const GAS f32x4* s = (const GAS f32x4*)(T + (size_t)tok * DM);
        GAS unsigned* o1 = (GAS unsigned*)(ws + WS_XG + (size_t)d1 * DM); GAS unsigned* o2 = (GAS unsigned*)(ws + WS_XG + (size_t)d2 * DM);
#pragma unroll
        for (int j = 0; j < 8; ++j) { const f32x4 v = s[F.lane + 64 * j] * pg8::FP8_SX; const unsigned w = pg8::pack4_fp8(v[0], v[1], v[2], v[3]); o1[F.lane + 64 * j] = w; o2[F.lane + 64 * j] = w; }
    }
}
__device__ __forceinline__ float dot8(const v4u q, const v4u k) {
    return (bflo(q.x) * bflo(k.x) + bfhi(q.x) * bfhi(k.x)) + (bflo(q.y) * bflo(k.y) + bfhi(q.y) * bfhi(k.y)) + (bflo(q.z) * bflo(k.z) + bfhi(q.z) * bfhi(k.z)) + (bflo(q.w) * bflo(k.w) + bfhi(q.w) * bfhi(k.w));
}
__device__ __forceinline__ float lambda_of(const float* lp, int lane, float lam_init) {
    const float s1 = wave_sum(lp[lane] * lp[64 + lane]), s2 = wave_sum(lp[128 + lane] * lp[192 + lane]);
    return __expf(s1) - __expf(s2) + lam_init;
}
__device__ __forceinline__ void naive_mixers(Frame& F, const Args& a, int layer) {
    unsigned char* ws = a.ws; const bf16* PROJ = (const bf16*)(ws + WS_PROJ); bf16* CAT = (bf16*)(ws + WS_CAT);
    const int lane = F.lane; const int gw = F.vcu * NWAVES + F.wave, NGW = F.G * NWAVES;
    LAS float* sc = (LAS float*)(F.lds + RING_OFF + F.wave * 16384);
    const LAS float* lut = (const LAS float*)(F.lds + LUT_OFF);
    const float lam_init = 0.8f - 0.6f * __expf(-0.3f * (float)layer);
    const float lam = lambda_of(a.in[3] + layer * 256, lane, lam_init);
    const float* subg = a.in[4] + layer * 128; const float* sinks = a.in[5] + layer * 12;
    for (int task = gw; task < NTOK * 6; task += NGW) {
        const int tok = task / 6, h = task - tok * 6, q = tok & (SEQ - 1), base = tok - q;
        v4u qv[16]; { const v4u* qp = (const v4u*)(PROJ + (size_t)tok * PWP + C_AQ + h * 128);
#pragma unroll
            for (int c = 0; c < 16; ++c) qv[c] = qp[c]; }
        float m1 = -3.0e38f, m2 = -3.0e38f;
        for (int j = lane; j <= q; j += 64) {
            const v4u* kp = (const v4u*)(PROJ + (size_t)(base + j) * PWP + C_AK + h * 128); float d1 = 0.f, d2 = 0.f;
#pragma unroll
            for (int c = 0; c < 8; ++c) { d1 += dot8(qv[c], kp[c]); d2 += dot8(qv[8 + c], kp[8 + c]); }
            const int dd = q - j; const float bias = lut[h * LUT_STRIDE + (dd < 128 ? dd : 128)];
            d1 += bias; d2 += bias; sc[j] = d1; sc[2048 + j] = d2; m1 = fmaxf(m1, d1); m2 = fmaxf(m2, d2);
        }
        m1 = wave_max(m1); m2 = wave_max(m2); float l1 = 0.f, l2 = 0.f;
        for (int j = lane; j <= q; j += 64) { const float p1 = __builtin_amdgcn_exp2f(sc[j] - m1), p2 = __builtin_amdgcn_exp2f(sc[2048 + j] - m2); sc[j] = p1; sc[2048 + j] = p2; l1 += p1; l2 += p2; }
        l1 = wave_sum(l1); l2 = wave_sum(l2); const float c1 = 1.f / l1, c2 = lam / l2;
        float o0 = 0.f, o1 = 0.f;
        for (int j = 0; j <= q; ++j) { const float w = sc[j] * c1 - sc[2048 + j] * c2; const bf16* vr = PROJ + (size_t)(base + j) * PWP + C_AV + h * 128; o0 += w * bf2f(vr[lane]); o1 += w * bf2f(vr[64 + lane]); }
        const float ss = wave_sum(o0 * o0 + o1 * o1), rr = (1.f / sqrtf(ss * (1.f / 128.f) + LN_EPS)) * (1.f - lam_init);
        bf16* orow = CAT + (size_t)tok * DM + h * 128; orow[lane] = (bf16)f2bf(o0 * rr * subg[lane]); orow[64 + lane] = (bf16)f2bf(o1 * rr * subg[64 + lane]);
    }
    for (int task = gw; task < NTOK * 12; task += NGW) {
        const int tok = task / 12, hq = task - tok * 12, kvh = hq >> 2, q = tok & (SEQ - 1), base = tok - q;
        v4u qv[8]; { const v4u* qp = (const v4u*)(PROJ + (size_t)tok * PWP + C_BQ + hq * 64);
#pragma unroll
            for (int c = 0; c < 8; ++c) qv[c] = qp[c]; }
        float s[2];
#pragma unroll
        for (int i = 0; i < 2; ++i) { const int dd = lane + 64 * i, j = q - dd; s[i] = -3.0e38f;
            if (j >= 0) { const v4u* kp = (const v4u*)(PROJ + (size_t)(base + j) * PWP + C_BK + kvh * 64); float d = 0.f;
#pragma unroll
                for (int c = 0; c < 8; ++c) d += dot8(qv[c], kp[c]);
                s[i] = d + lut[(6 + hq) * LUT_STRIDE + dd]; } }
        const float sink2 = sinks[hq] * LOG2E; const float m = fmaxf(wave_max(fmaxf(s[0], s[1])), sink2);
        const float p0 = (q - lane >= 0) ? __builtin_amdgcn_exp2f(s[0] - m) : 0.f, p1 = (q - lane - 64 >= 0) ? __builtin_amdgcn_exp2f(s[1] - m) : 0.f;
        const float l = wave_sum(p0 + p1) + __builtin_amdgcn_exp2f(sink2 - m);
        sc[lane] = p0; sc[64 + lane] = p1;
        float o = 0.f; const int nk = (q + 1 < 128) ? q + 1 : 128;
        for (int dd = 0; dd < nk; ++dd) o += sc[dd] * bf2f(PROJ[(size_t)(base + q - dd) * PWP + C_BV + kvh * 64 + lane]);
        CAT[(size_t)tok * DM + 768 + hq * 64 + lane] = (bf16)f2bf(o / l);
    }
    for (int task = gw; task < NTOK * 4; task += NGW) {
        const int tok = task >> 2, h = task & 3, q = tok & (SEQ - 1), base = tok - q;
        const float lg2 = log2f(1.f - exp2f(-5.f - (float)h));
        v4u qv[8]; { const v4u* qp = (const v4u*)(PROJ + (size_t)tok * PWP + C_CQ + h * 64);
#pragma unroll
            for (int c = 0; c < 8; ++c) qv[c] = qp[c]; }
        for (int j = lane; j <= q; j += 64) { const v4u* kp = (const v4u*)(PROJ + (size_t)(base + j) * PWP + C_CK + h * 64); float d = 0.f;
#pragma unroll
            for (int c = 0; c < 8; ++c) d += dot8(qv[c], kp[c]);
            sc[j] = d * __builtin_amdgcn_exp2f((float)(q - j) * lg2); }
        float o0 = 0.f, o1 = 0.f;
        for (int j = 0; j <= q; ++j) { const float w = sc[j]; const bf16* vr = PROJ + (size_t)(base + j) * PWP + C_CV + h * 128; o0 += w * bf2f(vr[lane]); o1 += w * bf2f(vr[64 + lane]); }
        const float mu = wave_sum(o0 + o1) * (1.f / 128.f); o0 -= mu; o1 -= mu;
        const float rs = 1.f / sqrtf(wave_sum(o0 * o0 + o1 * o1) * (1.f / 128.f) + LN_EPS);
        const bf16* gr = PROJ + (size_t)tok * PWP + C_CG + h * 128;
        bf16* orow = CAT + (size_t)tok * DM + 1536 + h * 128;
        orow[lane] = (bf16)f2bf(pg8::silu_f(bf2f(gr[lane])) * o0 * rs); orow[64 + lane] = (bf16)f2bf(pg8::silu_f(bf2f(gr[64 + lane])) * o1 * rs);
    }
}
typedef float f32x16 __attribute__((ext_vector_type(16)));
typedef short s16x4 __attribute__((ext_vector_type(4)));
typedef short v4i16_t __attribute__((ext_vector_type(4)));
typedef float f32x2_t __attribute__((ext_vector_type(2))); typedef __bf16 bf16x2_t __attribute__((ext_vector_type(2)));
__device__ __forceinline__ int crow(int r, int hi) { return (r & 3) + 8 * (r >> 2) + 4 * hi; }
__device__ __forceinline__ s16x4 vtr(const LAS unsigned char* p) { return __builtin_bit_cast(s16x4, __builtin_amdgcn_ds_read_tr16_b64_v4i16((LAS v4i16_t*)p)); }
__device__ __forceinline__ unsigned cvtpk_s(float lo, float hi) { f32x2_t v = {lo, hi}; bf16x2_t b = __builtin_convertvector(v, bf16x2_t); return __builtin_bit_cast(unsigned, b); }
__device__ __forceinline__ bf16x8 pack_p(const f32x16& p, int s2) {
    v4u w; w.x = cvtpk_s(p[8 * s2 + 0], p[8 * s2 + 1]); w.y = cvtpk_s(p[8 * s2 + 2], p[8 * s2 + 3]); w.z = cvtpk_s(p[8 * s2 + 4], p[8 * s2 + 5]); w.w = cvtpk_s(p[8 * s2 + 6], p[8 * s2 + 7]);
    return __builtin_bit_cast(bf16x8, w);
}
constexpr int MIX_WSF = 131072 + 1024 + 10240, MIX_QW = MIX_WSF + 2048;
static_assert(MIX_QW + 64 <= LDS_BYTES && LUT_OFF + 18 * LUT_STRIDE * 4 <= MIX_WSF, "mixer LDS map");
constexpr int LUTX_OFF = 98304, LUTX_STRIDE = 320;
constexpr float MIX_THR = 6.f;
__device__ __forceinline__ void glds16(const void* gsrc, unsigned lds_dst) { unsigned keep;
    asm volatile("s_mov_b32 %0, m0\n\ts_mov_b32 m0, %2\n\ts_nop 0\n\tglobal_load_lds_dwordx4 %1, off\n\ts_mov_b32 m0, %0" : "=&s"(keep) : "v"(gsrc), "s"(lds_dst) : "memory"); }
template <int IMM> __device__ __forceinline__ void glds16s(const void* sbase, unsigned voff, unsigned lds_dst) { unsigned keep;
    lds_dst -= (unsigned)IMM;
    asm volatile("s_mov_b32 %0, m0\n\ts_mov_b32 m0, %3\n\ts_nop 0\n\tglobal_load_lds_dwordx4 %1, %2 offset:%c4\n\ts_mov_b32 m0, %0" : "=&s"(keep) : "v"(voff), "s"(sbase), "s"(lds_dst), "i"(IMM) : "memory"); }
template <int MODE> __device__ __forceinline__ void mix_unit(Frame& F, const Args& a, int layer, int b, int hh, int qb, float lam, float lam_init) {
    constexpr int KW = (MODE == 0) ? 128 : 64, VW = (MODE == 1) ? 64 : 128, NEB = VW / 32, NSUB = 1;
    constexpr int KBYTES = 64 * KW * 2, VBYTES = 64 * VW * 2, BUFB = KBYTES + VBYTES, NST = 3;
    constexpr int KD = KBYTES / 1024, VD = VBYTES / 1024, PW = (KD + VD) / 8;
    static_assert(NST * BUFB <= LUTX_OFF && LUTX_OFF + 18 * LUTX_STRIDE * 4 <= RING_BYTES && (KD + VD) % 8 == 0, "mixer LDS ring");
    unsigned char* ws = a.ws; const bf16* PROJ = (const bf16*)(ws + WS_PROJ); bf16* CAT = (bf16*)(ws + WS_CAT);
    const int wave = F.wave; int lane = (int)__builtin_amdgcn_mbcnt_hi(~0u, __builtin_amdgcn_mbcnt_lo(~0u, 0u)); asm volatile("" : "+v"(lane));
    const int tid = wave * 64 + lane, r32 = lane & 31, hi = lane >> 5;
    LAS unsigned char* L = F.lds + RING_OFF;
    const unsigned Lb = (unsigned)(uintptr_t)L;
    LAS float* wsf = (LAS float*)(F.lds + MIX_WSF) + wave * 64;
    const LAS float* lut = (const LAS float*)(F.lds + LUT_OFF);
    const int rowbase = b * SEQ;
    const int q0 = (MODE == 2) ? qb * 256 : qb * 128;
    const int rg = (MODE == 2) ? wave : (wave & 3), wsel = (MODE == 2) ? 0 : (wave >> 2);
    const int qw0 = q0 + 32 * rg;
    const int kcol = (MODE == 0) ? C_AK + hh * 128 : (MODE == 1) ? C_BK + (hh >> 1) * 64 : C_CK + hh * 64;
    const int vcol = (MODE == 0) ? C_AV + hh * 128 : (MODE == 1) ? C_BV + (hh >> 1) * 64 : C_CV + hh * 128;
    const int kch0 = (MODE == 0) ? wsel * 8 : 0;
    const int t_lo = (MODE == 1) ? (qb > 0 ? 2 * qb - 2 : 0) : 0, t_hi = (MODE == 2) ? 4 * qb + 4 : 2 * qb + 2;
    bf16x8 qf[NSUB][4];
#pragma unroll
    for (int s = 0; s < NSUB; ++s) {
        const int qcol = (MODE == 0) ? C_AQ + hh * 128 + wsel * 64 : (MODE == 1) ? C_BQ + (hh * 2 + wsel) * 64 : C_CQ + hh * 64;
        const bf16* qp = PROJ + (size_t)(rowbase + qw0 + r32) * PWP + qcol + hi * 8;
#pragma unroll
        for (int d0 = 0; d0 < 4; ++d0) qf[s][d0] = *(const bf16x8*)(qp + d0 * 16);
    }
    float m_run[NSUB], l_run[NSUB]; f32x16 o[NSUB][NEB];
#pragma unroll
    for (int s = 0; s < NSUB; ++s) {
        m_run[s] = (MODE == 1) ? a.in[5][layer * 12 + hh * 2 + wsel] * LOG2E : -1.0e30f; l_run[s] = (MODE == 1) ? 1.f : 0.f;
#pragma unroll
        for (int e = 0; e < NEB; ++e) o[s][e] = f32x16{};
    }
    const float lg2 = (MODE == 2) ? log2f(1.f - exp2f(-5.f - (float)hh)) : 0.f;
    unsigned dsrc[PW]; unsigned ddst[PW];
#pragma unroll
    for (int i = 0; i < PW; ++i) {
        const int j = wave + 8 * i;
        if (j < KD) {
            int row, ch;
            if (KW == 128) { row = 4 * j + (lane >> 4); ch = (lane & 15) ^ (row & 15); }
            else { row = 8 * j + (lane >> 3); ch = (lane & 7) ^ ((row >> 1) & 7); }
            dsrc[i] = (unsigned)(((rowbase + row) * PWP + kcol + ch * 8) * 2); ddst[i] = (unsigned)(j * 1024);
        } else {
            const int jv = j - KD, eb = jv >> 2, key = 16 * (jv & 3) + 8 * (lane >> 5) + ((lane >> 2) & 7);
            dsrc[i] = (unsigned)(((rowbase + key) * PWP + vcol + eb * 32 + (lane & 3) * 8) * 2); ddst[i] = (unsigned)(KBYTES + jv * 1024);
        }
    }
#define MIX_DMA(t) do { const unsigned st_ = Lb + (unsigned)((((t) - t_lo) % NST) * BUFB); \
        _Pragma("unroll") for (int i_ = 0; i_ < PW; ++i_) glds16((const char*)PROJ + (size_t)(t) * (64 * PWP * 2) + dsrc[i_], (unsigned)__builtin_amdgcn_readfirstlane(st_ + ddst[i_])); } while (0)
    const int vlane = (4 * hi + ((lane & 15) >> 2)) * 64 + ((lane >> 4) & 1) * 32 + (lane & 3) * 8;
    asm volatile("s_waitcnt vmcnt(0)" ::: "memory");
#pragma unroll
    for (int s = 0; s < NSUB; ++s) {
        asm volatile("" : "+v"(m_run[s]));
#pragma unroll
        for (int d0 = 0; d0 < 4; ++d0) asm volatile("" : "+v"(qf[s][d0]));
    }
    MIX_DMA(t_lo);
    if (t_lo + 1 < t_hi) MIX_DMA(t_lo + 1);
#pragma unroll 1
    for (int t = t_lo; t < t_hi; ++t) {
        if (t + 1 < t_hi) { if (PW == 2) asm volatile("s_waitcnt vmcnt(2)" ::: "memory"); else if (PW == 3) asm volatile("s_waitcnt vmcnt(3)" ::: "memory"); else asm volatile("s_waitcnt vmcnt(4)" ::: "memory"); }
        else asm volatile("s_waitcnt vmcnt(0)" ::: "memory");
        asm volatile("s_waitcnt lgkmcnt(0)\n\ts_barrier" ::: "memory");
        if (t + 2 < t_hi) MIX_DMA(t + 2);
        const LAS unsigned char* Kb = L + ((t - t_lo) % NST) * BUFB; const LAS unsigned char* Vb = Kb + KBYTES;
        const int k0 = 64 * t;
        const bool active = (k0 <= qw0 + 31) && (MODE != 1 || k0 + 63 >= qw0 - 127);
        if (active) {
#pragma unroll
            for (int s = 0; s < NSUB; ++s) {
                f32x16 p0 = f32x16{}, p1 = f32x16{};
#pragma unroll
                for (int d0 = 0; d0 < 4; ++d0) {
                    const int ch = kch0 + 2 * d0 + hi;
                    const int ofs = (KW == 128) ? (r32 * 256 + ((ch ^ (r32 & 15)) << 4)) : (r32 * 128 + ((ch ^ ((r32 >> 1) & 7)) << 4));
                    const bf16x8 ka = *(const LAS bf16x8*)(Kb + ofs);
                    const bf16x8 kb2 = *(const LAS bf16x8*)(Kb + 32 * KW * 2 + ofs);
                    p0 = __builtin_amdgcn_mfma_f32_32x32x16_bf16(ka, qf[s][d0], p0, 0, 0, 0);
                    p1 = __builtin_amdgcn_mfma_f32_32x32x16_bf16(kb2, qf[s][d0], p1, 0, 0, 0);
                }
                const int qi = qw0 + r32;
                if (MODE == 2) {
#pragma unroll
                    for (int r = 0; r < 16; ++r) { const int d0_ = qi - (k0 + crow(r, hi)), d1_ = d0_ - 32;
                        const float dec = __builtin_amdgcn_exp2f((float)(qi - (k0 & ~127)) * lg2);
                        p0[r] = d0_ >= 0 ? p0[r] * dec : 0.f; p1[r] = d1_ >= 0 ? p1[r] * dec : 0.f; }
                } else {
                    const bool nearb = (MODE == 1) || (k0 + 63 + 128 > qw0);
                    if (nearb) {
                        const LAS float* lrow = lut + ((MODE == 0) ? hh : 6 + hh * 2 + wsel) * LUT_STRIDE;
#pragma unroll
                        for (int r = 0; r < 16; ++r) { const int d0_ = qi - (k0 + crow(r, hi)), d1_ = d0_ - 32;
                            const bool ok0 = (MODE == 0) ? (d0_ >= 0) : (d0_ >= 0 && d0_ < 128), ok1 = (MODE == 0) ? (d1_ >= 0) : (d1_ >= 0 && d1_ < 128);
                            const int i0_ = d0_ < 0 ? 0 : (d0_ > 128 ? 128 : d0_), i1_ = d1_ < 0 ? 0 : (d1_ > 128 ? 128 : d1_);
                            p0[r] = ok0 ? p0[r] + lrow[i0_] : -INFINITY; p1[r] = ok1 ? p1[r] + lrow[i1_] : -INFINITY; }
                    }
                    float rm = fmaxf(p0[0], p1[0]);
#pragma unroll
                    for (int r = 1; r < 16; ++r) rm = fmaxf(rm, fmaxf(p0[r], p1[r]));
                    rm = fmaxf(rm, __shfl_xor(rm, 32));
                    if (__any(rm > m_run[s] + MIX_THR)) {
                        const float mn = fmaxf(m_run[s], rm), al = __builtin_amdgcn_exp2f(m_run[s] - mn);
                        m_run[s] = mn; l_run[s] *= al;
                        if (hi == 0) wsf[r32] = al;
                        LDS_WAIT();
#pragma unroll
                        for (int r = 0; r < 16; ++r) { const float f = wsf[crow(r, hi)];
#pragma unroll
                            for (int e = 0; e < NEB; ++e) o[s][e][r] *= f; }
                        LDS_WAIT();
                    }
                    float ls = 0.f; const float mm = m_run[s];
#pragma unroll
                    for (int r = 0; r < 16; ++r) { p0[r] = __builtin_amdgcn_exp2f(p0[r] - mm); p1[r] = __builtin_amdgcn_exp2f(p1[r] - mm); ls += p0[r] + p1[r]; }
                    l_run[s] += ls;
                }
                s16x4 vlo[2][NEB], vhi[2][NEB];
#pragma unroll
                for (int e = 0; e < NEB; ++e) { vlo[0][e] = vtr(Vb + e * 4096 + vlane); vhi[0][e] = vtr(Vb + e * 4096 + vlane + 512); }
#pragma unroll
                for (int g = 0; g < 4; ++g) {
                    if (g < 3) {
#pragma unroll
                        for (int e = 0; e < NEB; ++e) { vlo[(g + 1) & 1][e] = vtr(Vb + e * 4096 + (g + 1) * 1024 + vlane); vhi[(g + 1) & 1][e] = vtr(Vb + e * 4096 + (g + 1) * 1024 + vlane + 512); }
                    }
                    const bf16x8 pa = pack_p((g >> 1) == 0 ? p0 : p1, g & 1);
#pragma unroll
                    for (int e = 0; e < NEB; ++e) {
                        const s16x4 lo = vlo[g & 1][e], hh2 = vhi[g & 1][e];
                        const bf16x8 vb = (bf16x8){lo[0], lo[1], lo[2], lo[3], hh2[0], hh2[1], hh2[2], hh2[3]};
                        o[s][e] = __builtin_amdgcn_mfma_f32_32x32x16_bf16(pa, vb, o[s][e], 0, 0, 0);
                    }
                }
                if (NSUB > 1) __builtin_amdgcn_sched_barrier(0);
            }
        }
    }
#undef MIX_DMA
    __syncthreads();
    if (MODE == 1) {
#pragma unroll
        for (int s = 0; s < NSUB; ++s) {
            const float sink2 = a.in[5][layer * 12 + hh * 2 + wsel] * LOG2E;
            const float lt = l_run[s] + __shfl_xor(l_run[s], 32) - __builtin_amdgcn_exp2f(sink2 - m_run[s]);
            if (hi == 0) wsf[r32] = 1.f / lt;
            LDS_WAIT();
            bf16* orow = CAT + (size_t)(rowbase + qw0) * DM + 768 + (hh * 2 + wsel) * 64 + r32;
#pragma unroll
            for (int r = 0; r < 16; ++r) { const int qr = crow(r, hi); const float f = wsf[qr];
#pragma unroll
                for (int e = 0; e < NEB; ++e) orow[(size_t)qr * DM + 32 * e] = (bf16)f2bf(o[s][e][r] * f); }
            LDS_WAIT();
        }
    } else if (MODE == 2) {
        const bf16* grow = PROJ + (size_t)(rowbase + qw0) * PWP + C_CG + hh * 128 + r32;
        bf16* orow = CAT + (size_t)(rowbase + qw0) * DM + 1536 + hh * 128 + r32;
#pragma unroll
        for (int r = 0; r < 16; ++r) {
            float s1 = 0.f;
#pragma unroll
            for (int e = 0; e < NEB; ++e) s1 += o[0][e][r];
#pragma unroll
            for (int sh = 1; sh < 32; sh <<= 1) s1 += __shfl_xor(s1, sh);
            const float mu = s1 * (1.f / 128.f); float s2 = 0.f;
#pragma unroll
            for (int e = 0; e < NEB; ++e) { const float d = o[0][e][r] - mu; s2 += d * d; }
#pragma unroll
            for (int sh = 1; sh < 32; sh <<= 1) s2 += __shfl_xor(s2, sh);
            const float rs = 1.f / sqrtf(s2 * (1.f / 128.f) + LN_EPS); const int qr = crow(r, hi);
#pragma unroll
            for (int e = 0; e < NEB; ++e) orow[(size_t)qr * DM + 32 * e] = (bf16)f2bf(pg8::silu_f(bf2f(grow[(size_t)qr * PWP + 32 * e])) * (o[0][e][r] - mu) * rs);
        }
    } else {
        const float lt = l_run[0] + __shfl_xor(l_run[0], 32);
        if (hi == 0) wsf[r32] = 1.f / lt;
        LDS_WAIT();
        LAS float* xb = (LAS float*)L + rg * 4096;
        if (wsel == 1) {
#pragma unroll
            for (int r = 0; r < 16; ++r) { const float f = wsf[crow(r, hi)];
#pragma unroll
                for (int e = 0; e < NEB; ++e) xb[(e * 16 + r) * 64 + lane] = o[0][e][r] * f; }
        }
        __syncthreads();
        if (wsel == 0) {
            const float* subg = a.in[4] + layer * 128; const float post = 1.f - lam_init;
            bf16* orow = CAT + (size_t)(rowbase + qw0) * DM + hh * 128 + r32;
#pragma unroll
            for (int r = 0; r < 16; ++r) { const float f = wsf[crow(r, hi)]; float d[NEB]; float ss = 0.f;
#pragma unroll
                for (int e = 0; e < NEB; ++e) { d[e] = o[0][e][r] * f - lam * xb[(e * 16 + r) * 64 + lane]; ss += d[e] * d[e]; }
#pragma unroll
                for (int sh = 1; sh < 32; sh <<= 1) ss += __shfl_xor(ss, sh);
                const float rs = (1.f / sqrtf(ss * (1.f / 128.f) + LN_EPS)) * post; const int qr = crow(r, hi);
#pragma unroll
                for (int e = 0; e < NEB; ++e) orow[(size_t)qr * DM + 32 * e] = (bf16)f2bf(d[e] * rs * subg[32 * e + r32]); }
        }
    }
    __syncthreads();
}
constexpr int C2_KR = 0, C2_KT = 16384, C2_VT = 32768, C2_ST = 65536, C2_STATS = 81920, C2_G = 83968;
static_assert(C2_G + 32768 <= RING_BYTES, "chunkwise retention LDS map");
__device__ __forceinline__ void retention_unit(Frame& F, const Args& a, int b, int hh) {
    unsigned char* ws = a.ws; const bf16* PROJ = (const bf16*)(ws + WS_PROJ); bf16* CAT = (bf16*)(ws + WS_CAT);
    const int wave = F.wave; int lane = (int)__builtin_amdgcn_mbcnt_hi(~0u, __builtin_amdgcn_mbcnt_lo(~0u, 0u)); asm volatile("" : "+v"(lane));
    const int r32 = lane & 31, hi = lane >> 5;
    LAS unsigned char* L = F.lds + RING_OFF; const unsigned Lb = (unsigned)(uintptr_t)L;
    const int rowbase = b * SEQ, rg = wave & 3, eh = wave >> 2, dh = wave & 1, eq = wave >> 1;
    const float lg2 = log2f(1.f - exp2f(-5.f - (float)hh));
    const float gq = __builtin_amdgcn_exp2f(lg2 * (float)(32 * rg + r32));
    const float gC = __builtin_amdgcn_exp2f(lg2 * 128.f), gC1 = __builtin_amdgcn_exp2f(lg2 * 127.f);
    unsigned srcKr, srcKt, srcVt;
    { const int row = 8 * wave + (lane >> 3), ch = (lane & 7) ^ ((row >> 1) & 7); srcKr = (unsigned)(((rowbase + row) * PWP + C_CK + hh * 64 + ch * 8) * 2);
      const int key = 16 * wave + 8 * (lane >> 5) + ((lane >> 2) & 7);
      srcKt = (unsigned)(((rowbase + key) * PWP + C_CK + hh * 64 + (lane & 3) * 8) * 2); srcVt = (unsigned)(((rowbase + key) * PWP + C_CV + hh * 128 + (lane & 3) * 8) * 2); }
    const unsigned srcG = (unsigned)(((rowbase + 4 * wave + (lane >> 4)) * PWP + C_CG + hh * 128 + (lane & 15) * 8) * 2);
#define C2_GDMA(n) do { const char* gb_ = (const char*)PROJ + (size_t)(n) * (128 * PWP * 2); const unsigned wg_ = (unsigned)__builtin_amdgcn_readfirstlane(Lb + C2_G + wave * 1024); \
        glds16s<0>(gb_, srcG, wg_); glds16s<0>(gb_ + 32 * PWP * 2, srcG, wg_ + 8192); glds16s<0>(gb_ + 64 * PWP * 2, srcG, wg_ + 16384); glds16s<0>(gb_ + 96 * PWP * 2, srcG, wg_ + 24576); } while (0)
#define C2_DMA(n) do { const char* cb_ = (const char*)PROJ + (size_t)(n) * (128 * PWP * 2); const char* cb2_ = cb_ + 64 * PWP * 2; const unsigned w1k_ = (unsigned)__builtin_amdgcn_readfirstlane(Lb + wave * 1024); \
        glds16s<0>(cb_, srcKr, w1k_ + C2_KR); glds16s<0>(cb2_, srcKr, w1k_ + C2_KR + 8192); \
        glds16s<0>(cb_, srcKt, w1k_ + C2_KT); glds16s<64>(cb_, srcKt, w1k_ + C2_KT + 8192); \
        glds16s<0>(cb_, srcVt, w1k_ + C2_VT); glds16s<64>(cb_, srcVt, w1k_ + C2_VT + 8192); glds16s<128>(cb_, srcVt, w1k_ + C2_VT + 16384); glds16s<192>(cb_, srcVt, w1k_ + C2_VT + 24576); } while (0)
    const int vlane = (4 * hi + ((lane & 15) >> 2)) * 64 + ((lane >> 4) & 1) * 32 + (lane & 3) * 8;
    const int krow = r32 * 128, kkey = (r32 >> 1) & 7;
    f32x16 Sb = f32x16{};
    bf16x8 qf[4];
    { const bf16* qbase = PROJ + (size_t)(rowbase + 32 * rg + r32) * PWP + C_CQ + hh * 64 + hi * 8;
#pragma unroll
      for (int d0 = 0; d0 < 4; ++d0) qf[d0] = *(const bf16x8*)(qbase + d0 * 16); }
    asm volatile("s_waitcnt vmcnt(0)" ::: "memory");
#pragma unroll
    for (int d0 = 0; d0 < 4; ++d0) asm volatile("" : "+v"(qf[d0]));
    C2_DMA(0);
#pragma unroll 1
    for (int n = 0; n < 16; ++n) {
        asm volatile("s_waitcnt vmcnt(0) lgkmcnt(0)\n\ts_barrier" ::: "memory");
        C2_GDMA(n);
        f32x16 o[2]; o[0] = f32x16{}; o[1] = f32x16{};
        for (int kb = 0; kb <= rg; ++kb) {
            f32x16 T = f32x16{};
#pragma unroll
            for (int d0 = 0; d0 < 4; ++d0) {
                const bf16x8 ka = *(const LAS bf16x8*)(L + C2_KR + kb * 4096 + krow + (((2 * d0 + hi) ^ kkey) << 4));
                T = __builtin_amdgcn_mfma_f32_32x32x16_bf16(ka, qf[d0], T, 0, 0, 0);
            }
#pragma unroll
            for (int r = 0; r < 16; ++r) T[r] = (kb == rg && crow(r, hi) > r32) ? 0.f : T[r] * gq;
#pragma unroll
            for (int s2 = 0; s2 < 2; ++s2) {
                const bf16x8 pa = pack_p(T, s2);
#pragma unroll
                for (int e = 0; e < 2; ++e) {
                    const LAS unsigned char* vp = L + C2_VT + (2 * eh + e) * 8192 + (4 * kb + 2 * s2) * 512 + vlane;
                    const s16x4 lo = vtr(vp), h2 = vtr(vp + 512);
                    const bf16x8 vb = (bf16x8){lo[0], lo[1], lo[2], lo[3], h2[0], h2[1], h2[2], h2[3]};
                    o[e] = __builtin_amdgcn_mfma_f32_32x32x16_bf16(pa, vb, o[e], 0, 0, 0);
                }
                __builtin_amdgcn_sched_barrier(0);
            }
        }
        __builtin_amdgcn_sched_barrier(0);
        if (n > 0) {
            f32x16 oc[2]; oc[0] = f32x16{}; oc[1] = f32x16{};
#pragma unroll
            for (int d0 = 0; d0 < 4; ++d0)
#pragma unroll
                for (int e = 0; e < 2; ++e) {
                    const bf16x8 sb = *(const LAS bf16x8*)(L + C2_ST + (2 * eh + e) * 4096 + krow + (((2 * d0 + hi) ^ kkey) << 4));
                    oc[e] = __builtin_amdgcn_mfma_f32_32x32x16_bf16(qf[d0], sb, oc[e], 0, 0, 0);
                }
#pragma unroll
            for (int r = 0; r < 16; ++r) { const float xi = __builtin_amdgcn_exp2f(lg2 * (float)(32 * rg + crow(r, hi) + 1)); o[0][r] += xi * oc[0][r]; o[1][r] += xi * oc[1][r]; }
        }
        __builtin_amdgcn_sched_barrier(0);
        {
            f32x16 kv = f32x16{};
#pragma unroll
            for (int g = 0; g < 8; ++g) {
                const LAS unsigned char* kp = L + C2_KT + dh * 8192 + (2 * g) * 512 + vlane; const LAS unsigned char* vp = L + C2_VT + eq * 8192 + (2 * g) * 512 + vlane;
                const s16x4 kl = vtr(kp), kh2 = vtr(kp + 512), vl = vtr(vp), vh2 = vtr(vp + 512);
                const bf16x8 ka = (bf16x8){kl[0], kl[1], kl[2], kl[3], kh2[0], kh2[1], kh2[2], kh2[3]}, vb = (bf16x8){vl[0], vl[1], vl[2], vl[3], vh2[0], vh2[1], vh2[2], vh2[3]};
                kv = __builtin_amdgcn_mfma_f32_32x32x16_bf16(ka, vb, kv, 0, 0, 0);
                if (g & 1) __builtin_amdgcn_sched_barrier(0);
            }
#pragma unroll
            for (int r = 0; r < 16; ++r) Sb[r] = gC * Sb[r] + gC1 * kv[r];
        }
        __builtin_amdgcn_sched_barrier(0);
        if (n + 1 < 16) {
            int l2 = lane; asm volatile("" : "+v"(l2));
            const bf16* qn = PROJ + (size_t)(rowbase + 128 * (n + 1) + 32 * rg + (l2 & 31)) * PWP + C_CQ + hh * 64 + (l2 >> 5) * 8;
#pragma unroll
            for (int d0 = 0; d0 < 4; ++d0) qf[d0] = *(const bf16x8*)(qn + d0 * 16);
        }
        LAS float* st = (LAS float*)(L + C2_STATS);
#pragma unroll
        for (int r4 = 0; r4 < 4; ++r4) {
            float s1[4], s2[4];
#pragma unroll
            for (int i = 0; i < 4; ++i) { const int r = 4 * r4 + i; s1[i] = o[0][r] + o[1][r]; s2[i] = o[0][r] * o[0][r] + o[1][r] * o[1][r]; }
#pragma unroll
            for (int sh = 1; sh < 32; sh <<= 1)
#pragma unroll
                for (int i = 0; i < 4; ++i) { s1[i] += __shfl_xor(s1[i], sh); s2[i] += __shfl_xor(s2[i], sh); }
            if (r32 == 0) {
#pragma unroll
                for (int i = 0; i < 4; ++i) { const int qr = crow(4 * r4 + i, hi); st[((rg * 2 + eh) * 32 + qr) * 2 + 0] = s1[i]; st[((rg * 2 + eh) * 32 + qr) * 2 + 1] = s2[i]; }
            }
            __builtin_amdgcn_sched_barrier(0);
        }
        __builtin_amdgcn_sched_barrier(0);
        asm volatile("s_waitcnt vmcnt(0) lgkmcnt(0)\n\ts_barrier" ::: "memory");
        if (n + 1 < 16) C2_DMA(n + 1);
        {
            const int e_ = 32 * eq + r32;
#pragma unroll
            for (int q4 = 0; q4 < 4; ++q4) { v2u w; w.x = cvtpk_s(Sb[4 * q4 + 0], Sb[4 * q4 + 1]); w.y = cvtpk_s(Sb[4 * q4 + 2], Sb[4 * q4 + 3]);
                *(LAS v2u*)(L + C2_ST + e_ * 128 + (((4 * dh + q4) ^ ((e_ >> 1) & 7)) << 4) + 8 * hi) = w; }
        }
        asm volatile("s_waitcnt lgkmcnt(0)\n\ts_barrier" ::: "memory");
        {
            const LAS bf16* grow = (const LAS bf16*)(L + C2_G) + (32 * rg) * 128 + 64 * eh + r32;
            bf16* orow = CAT + (size_t)(rowbase + 128 * n + 32 * rg) * DM + 1536 + hh * 128 + 64 * eh + r32;
#pragma unroll
            for (int r = 0; r < 16; ++r) {
                const int qr = crow(r, hi);
                const float t1 = st[((rg * 2) * 32 + qr) * 2 + 0] + st[((rg * 2 + 1) * 32 + qr) * 2 + 0], t2 = st[((rg * 2) * 32 + qr) * 2 + 1] + st[((rg * 2 + 1) * 32 + qr) * 2 + 1];
                const float mu = t1 * (1.f / 128.f), var = fmaxf(t2 * (1.f / 128.f) - mu * mu, 0.f), rs = 1.f / sqrtf(var + LN_EPS);
#pragma unroll
                for (int e = 0; e < 2; ++e) orow[(size_t)qr * DM + 32 * e] = (bf16)f2bf(pg8::silu_f(bf2f(grow[qr * 128 + 32 * e])) * (o[e][r] - mu) * rs);
                if ((r & 3) == 3) __builtin_amdgcn_sched_barrier(0);
            }
        }
    }
#undef C2_DMA
#undef C2_GDMA
    __syncthreads();
}
template <int MODE> __device__ __forceinline__ void mixer_queue(Frame& F, const Args& a, int layer, int qword, float lam, float lam_init) {
    constexpr int NU = (MODE == 0) ? 768 : (MODE == 1) ? 768 : (MODE == 3) ? 32 : 256;
    LAS int* qw = (LAS int*)(F.lds + MIX_QW);
    for (;;) {
        if (F.tid == 0) *qw = (int)__hip_atomic_fetch_add(F.ctl + CW_WQ + 64 * qword, 1u, RLX_AGENT);
        __syncthreads();
        const int it = __builtin_amdgcn_readfirstlane(*qw);
        __syncthreads();
        if (it >= NU) break;
        if (MODE == 3) retention_unit(F, a, it >> 2, it & 3);
        else if (MODE == 0) mix_unit<0>(F, a, layer, (it % 48) / 6, it % 6, 15 - it / 48, lam, lam_init);
        else if (MODE == 2) mix_unit<2>(F, a, layer, (it & 31) >> 2, it & 3, 7 - (it >> 5), lam, lam_init);
        else mix_unit<1>(F, a, layer, it / 96, (it % 96) / 16, it & 15, lam, lam_init);
    }
}
__device__ __forceinline__ void mixer_phase(Frame& F, const Args& a, int layer, int rep) {
    const int qbase = 3 * (layer + 2 * rep);
    mixer_queue<3>(F, a, layer, qbase + 0, 0.f, 0.f);
    asm volatile("" ::: "memory");
    const float lam_init = 0.8f - 0.6f * __expf(-0.3f * (float)layer);
    const float lam = __builtin_bit_cast(float, __builtin_amdgcn_readfirstlane(__builtin_bit_cast(int, lambda_of(a.in[3] + layer * 256, F.lane, lam_init))));
    mixer_queue<0>(F, a, layer, qbase + 1, lam, lam_init);
    mixer_queue<1>(F, a, layer, qbase + 2, lam, lam_init);
}
#ifndef MIXER_NAIVE
#define MIXER_NAIVE 0
#endif
#ifndef PROBE_P0
#define PROBE_P0 1
#endif
#ifndef PROBE_MIX
#define PROBE_MIX 1
#endif
#ifndef PROBE_PROJ
#define PROBE_PROJ 1
#endif
#ifndef PROBE_DUP
#define PROBE_DUP 1
#endif
#ifndef PROBE_MUP
#define PROBE_MUP 1
#endif
#ifndef PROBE_MDN
#define PROBE_MDN 1
#endif
#ifndef PROBE_SPIN_PHASE
#define PROBE_SPIN_PHASE -1
#endif
#define PH_BEGIN(k) do { if (PROBE_SPIN_PHASE == (k)) spin_t0 = __builtin_amdgcn_s_memrealtime(); } while (0)
#define PH_END(k) do { if (PROBE_SPIN_PHASE == (k)) spin_dt = __builtin_amdgcn_s_memrealtime() - spin_t0; } while (0)
#define REPEAT(N) for (int rep = 0; rep < (N); ++rep)
#define TWICE_IF(N, CALL) do { CALL; if ((N) == 2) { xcd_barrier(bar); CALL; } } while (0)
#define REPBAR(N) do { if (rep + 1 < (N)) xcd_barrier(bar); } while (0)
#define IN(k) (lo <= (k) && (k) < hi)
#define SEAM(k) do { if (IN(k) && IN((k) + 1)) xcd_barrier(bar); } while (0)
template <int l> __device__ __forceinline__ void run_layer(Frame& F, const Args& args, const XcdBarrier& bar, int lo, int hi, unsigned long long& spin_t0, unsigned long long& spin_dt) {
    unsigned char* ws = args.ws;
    bf16* XB = (bf16*)(ws + WS_XB); bf16* PROJ = (bf16*)(ws + WS_PROJ); bf16* CAT = (bf16*)(ws + WS_CAT); bf16* HB = (bf16*)(ws + WS_H);
    float* T = args.out;
        const int pb = 1 + 7 * l;
        PH_BEGIN(pb); if (IN(pb)) {
            pg8::Gemm g{XB, (const bf16*)(ws + WS_WIN) + (size_t)l * PWP * DM, NTOK, PWP, DM * 2}; pg8::StaticOrder S; S.init(NTOK, PWP, F.G, (int)blockIdx.x);
            pg8::EpiProj E{PROJ, (const float*)(ws + WS_TAB), (const float*)(ws + WS_TAB + 256 * 1024)};
            TWICE_IF(PROBE_PROJ, (pg8::gemm_phase<pg8::EpiProj, pg8::StaticOrder, true, true>(F.lds + RING_OFF, F.wave, g, S, E)));
        } SEAM(pb); PH_END(pb);
        PH_BEGIN(pb + 1); if (IN(pb + 1)) {
#if MIXER_NAIVE
            naive_mixers(F, args, l);
#else
            REPEAT(PROBE_MIX) { mixer_phase(F, args, l, rep); REPBAR(PROBE_MIX); }
#endif
        } SEAM(pb + 1); PH_END(pb + 1);
        PH_BEGIN(pb + 2); if (IN(pb + 2)) {
            pg8::Gemm g{CAT, (const bf16*)(ws + WS_WOUT) + (size_t)l * DM * DM, NTOK, DM, DM * 2}; pg8::StaticOrder S; S.init(NTOK, DM, F.G, (int)blockIdx.x);
            pg8::EpiResid E{T, XB, 1.f};
            pg8::gemm_phase<pg8::EpiResid, pg8::StaticOrder, true, true>(F.lds + RING_OFF, F.wave, g, S, E);
        } SEAM(pb + 2); PH_END(pb + 2);
        if constexpr (l == 0) {
            PH_BEGIN(4); if (IN(4)) { ln_phase<0>(F, args, T, args.in[7], args.in[8], nullptr); } SEAM(4); PH_END(4);
            PH_BEGIN(5); if (IN(5)) {
                pg8::Gemm g{XB, (const bf16*)(ws + WS_WDGU), NTOK, 2 * DFF, DM * 2}; pg8::StaticOrder S; S.init(NTOK, 2 * DFF, F.G, (int)blockIdx.x);
                pg8::EpiSwiGLU8 E{ws + WS_H, 44, 1.f};
                TWICE_IF(PROBE_DUP, (pg8::gemm_phase<pg8::EpiSwiGLU8, pg8::StaticOrder, true, true, false>(F.lds + RING_OFF, F.wave, g, S, E)));
            } SEAM(5); PH_END(5);
            PH_BEGIN(6); if (IN(6)) {
                pg8::Gemm g{ws + WS_H, ws + WS_WDDN, NTOK, DM, DFF}; pg8::StaticOrder S; S.init(NTOK, DM, F.G, (int)blockIdx.x);
                pg8::EpiResid E{T, XB, 1.f / (pg8::FP8_SH * pg8::FP8_SWD)};
                pg8::gemm_phase<pg8::EpiResid, pg8::StaticOrder, true, true, true>(F.lds + RING_OFF, F.wave, g, S, E);
            } SEAM(6); PH_END(6);
            PH_BEGIN(7); if (IN(7)) { ln_phase<0>(F, args, T, args.in[9], args.in[10], nullptr); } SEAM(7); PH_END(7);
        } else {
            PH_BEGIN(11); if (IN(11)) { ln_phase<1>(F, args, T, args.in[7] + DM, args.in[8] + DM, args.in[14]); } SEAM(11); PH_END(11);
            if (IN(13) || IN(14) || IN(15)) {
                int ntl_v; const int offv = expert_offsets(F, ntl_v); const int ntl = __builtin_amdgcn_readfirstlane(ntl_v);
                pg8::GroupedOrder S; S.nM = ntl; S.pm0 = 0; S.phys = 0; S.G = F.G; S.c = (int)blockIdx.x;
#pragma unroll
                for (int e = 0; e < 8; ++e) S.cum[e] = (e < 7) ? __builtin_amdgcn_readfirstlane(__shfl(offv, e + 1) >> 8) : ntl;
                PH_BEGIN(13); if (IN(13)) {
                    S.nN = 44; S.nwg = ntl * 44; S.phys = 1;
                    pg8::Gemm g{ws + WS_XG, ws + WS_WMGU, 8 * XG_CAP, 8 * 2 * DFF, DM};
                    pg8::EpiSwiGLU8 E{ws + WS_H, 44, 1.f / (pg8::FP8_SX * pg8::FP8_SWU)};
                    TWICE_IF(PROBE_MUP, (pg8::gemm_phase<pg8::EpiSwiGLU8, pg8::GroupedOrder, true, true, true>(F.lds + RING_OFF, F.wave, g, S, E)));
                } SEAM(13); PH_END(13);
                PH_BEGIN(14); if (IN(14)) {
                    S.nN = 8; S.pm0 = 0; S.phys = 0; S.nM = ntl < 128 ? ntl : 128; S.nwg = S.nM * 8;
                    pg8::Gemm g{ws + WS_H, ws + WS_WMDN, ntl * 256, 8 * DM, DFF};
                    pg8::EpiY E{(bf16*)(ws + WS_Y), 8, 1.f / (pg8::FP8_SH * pg8::FP8_SWD)};
                    TWICE_IF(PROBE_MDN, (pg8::gemm_phase<pg8::EpiY, pg8::GroupedOrder, true, true, true>(F.lds + RING_OFF, F.wave, g, S, E)));
                } SEAM(14); PH_END(14);
                PH_BEGIN(15); if (IN(15)) {
                    S.nN = 8; S.pm0 = 128; S.nM = ntl > 128 ? ntl - 128 : 0; S.nwg = S.nM * 8;
                    if (S.nwg > 0) {
                        pg8::Gemm g{ws + WS_H, ws + WS_WMDN, ntl * 256, 8 * DM, DFF};
                        pg8::EpiY E{(bf16*)(ws + WS_Y), 8, 1.f / (pg8::FP8_SH * pg8::FP8_SWD)};
                        pg8::gemm_phase<pg8::EpiY, pg8::GroupedOrder, true, true, true>(F.lds + RING_OFF, F.wave, g, S, E);
                    }
                    {
                        LAS int* qw = (LAS int*)(F.lds + MIX_QW);
                        for (;;) {
                            if (F.tid == 0) *qw = (int)__hip_atomic_fetch_add(F.ctl + CW_WQ + 64 * 12, 1u, RLX_AGENT);
                            __syncthreads();
                            const int grp64 = __builtin_amdgcn_readfirstlane(*qw);
                            __syncthreads();
                            if (grp64 >= NTOK / 64) break;
                            ln_phase<2>(F, args, T, args.in[9] + DM, args.in[10] + DM, nullptr, grp64 * 64 + F.wave * 8, 1);
                        }
                    }
                    xcd_barrier(bar);
                    ln_phase<2>(F, args, T, args.in[9] + DM, args.in[10] + DM, nullptr, -1, 2);
                } PH_END(15);
            }
        }
}
constexpr int N_PHASES = 16;
__global__ void __launch_bounds__(NWAVES * 64, 2) hymba_fwd(Args args) {
    extern __shared__ __attribute__((aligned(16))) unsigned char lds[];
    Frame F;
    F.lds = (LAS unsigned char*)lds;
    volatile LAS unsigned* MISC = (volatile LAS unsigned*)(F.lds + MISC_OFF);
    F.wave = __builtin_amdgcn_readfirstlane((int)threadIdx.x >> 6); F.lane = (int)__builtin_amdgcn_mbcnt_hi(~0u, __builtin_amdgcn_mbcnt_lo(~0u, 0u)); F.tid = F.wave * 64 + F.lane;
    F.G = gridDim.x; { const int bx = blockIdx.x; F.vcu = (F.G % 8 == 0) ? (bx % 8) * (F.G / 8) + bx / 8 : bx; }
    unsigned char* ws = args.ws;
    F.ctl = (gu32*)(ws + WS_CTL);
    for (int u = F.tid; u < 1024 / 4; u += NWAVES * 64) ((LAS unsigned*)(F.lds + LDSCTL_OFF))[u] = 0u;
    __syncthreads();
    XcdBarrier bar = xcd_barrier_post((unsigned*)(F.ctl + CW_BAR) + args.li * 4096, MISC + 8);
    build_lut(F, args.in[2]);
    __syncthreads();
    const int lo = args.ph_lo, hi = args.ph_hi;
    unsigned long long spin_t0 = 0ull, spin_dt = 0ull;
    PH_BEGIN(0); if (IN(0)) { REPEAT(PROBE_P0) { p0_prologue(F, args); REPBAR(PROBE_P0); } } SEAM(0); PH_END(0);
    run_layer<0>(F, args, bar, lo, hi, spin_t0, spin_dt);
    run_layer<1>(F, args, bar, lo, hi, spin_t0, spin_dt);
    if (PROBE_SPIN_PHASE >= 0 && blockIdx.x == 0) { const unsigned long long te = __builtin_amdgcn_s_memrealtime() + 10ull * spin_dt; while (__builtin_amdgcn_s_memrealtime() < te) __builtin_amdgcn_s_sleep(16); }
#undef IN
#undef SEAM
}

#ifndef N_LAUNCHES
#define N_LAUNCHES 1
#endif
extern "C" void kernel_launch(void* const* d_in, const int* in_sizes, int n_in, void* d_out, int out_size, void* d_ws, size_t ws_size, hipStream_t stream) {
    static int grid = 0;
    if (grid == 0) {
        if (n_in != 18 || in_sizes[0] != NTOK * DM || out_size != NTOK * DM || ws_size < WS_END) { fprintf(stderr, "kernel_launch: unexpected shapes / workspace (%d inputs, ws %zu < %zu)\n", n_in, ws_size, (size_t)WS_END); grid = -1; return; }
        int dev = 0, cus = 0, per_cu = 0;
        if (hipGetDevice(&dev) != hipSuccess || hipDeviceGetAttribute(&cus, hipDeviceAttributeMultiprocessorCount, dev) != hipSuccess) { grid = -1; return; }
        if (hipFuncSetAttribute((const void*)hymba_fwd, hipFuncAttributeMaxDynamicSharedMemorySize, LDS_BYTES) != hipSuccess) { fprintf(stderr, "kernel_launch: hipFuncSetAttribute failed\n"); grid = -1; return; }
        if (hipOccupancyMaxActiveBlocksPerMultiprocessor(&per_cu, (const void*)hymba_fwd, NWAVES * 64, LDS_BYTES) != hipSuccess || per_cu < 1) fprintf(stderr, "kernel_launch: occupancy query reports %d\n", per_cu);
        (void)hipGetLastError();
        grid = (cus == 256) ? 256 : -1;
        if (grid < 0) { fprintf(stderr, "kernel_launch: built for a 256-CU device, found %d CUs\n", cus); return; }
    }
    if (grid < 0) return;
    if (hipMemsetAsync((char*)d_ws + WS_CTL, 0, CTL_ZERO_BYTES, stream) != hipSuccess) return;
    Args a{};
    for (int i = 0; i < 18; ++i) a.in[i] = (const float*)d_in[i];
    a.out = (float*)d_out; a.ws = (unsigned char*)d_ws;
    for (int i = 0; i < 32; ++i) a.invf[i] = (float)(1.0 / pow(10000.0, (double)((float)i / 31.0f)));
#if N_LAUNCHES == 1
    const int cuts[2] = {0, N_PHASES};
#else
    int cuts[N_PHASES + 1]; for (int i = 0; i <= N_PHASES; ++i) cuts[i] = i;
#endif
    const int nl = (N_LAUNCHES == 1) ? 1 : N_PHASES;
    for (int li = 0; li < nl; ++li) {
        a.ph_lo = cuts[li]; a.ph_hi = cuts[li + 1]; a.li = li; a.pad = 0;
        hipLaunchKernelGGL(hymba_fwd, dim3(grid), dim3(NWAVES * 64), LDS_BYTES, stream, a);
        const hipError_t le = hipPeekAtLastError();
        if (le != hipSuccess) { fprintf(stderr, "kernel_launch: launch %d failed: %s\n", li, hipGetErrorName(le)); break; }
    }
}
```

```cpp
#include <hip/hip_runtime.h>
#include <cstdio>
#include <cstdint>
#include <cmath>
namespace pg8 {
#define PG8_LAS __attribute__((address_space(3)))
typedef unsigned short bf16_t;
typedef short bf16x8 __attribute__((ext_vector_type(8)));
typedef float f32x4 __attribute__((ext_vector_type(4)));
typedef unsigned u32x4 __attribute__((ext_vector_type(4)));
constexpr int BM = 256, BK = 64, HALF = 128, HTB = HALF * BK * 2  , STAGE_BYTES = 8 * HTB, NXCD = 8, WGM = 8;

__host__ __device__ __forceinline__ int lds_byte(int r, int c) { const int st = (r >> 4) * 2 + (c >> 5), rr = r & 15, cc = c & 31, ob = rr * 64 + cc * 2; return st * 1024 + (ob ^ (((ob >> 9) & 1) << 5)); }
__host__ __device__ __forceinline__ void stage_rc(int b, int& R, int& C) { const int st = b / 1024, sb = b % 1024, swz = sb ^ (((sb >> 9) & 1) << 5); R = (st >> 1) * 16 + swz / 64; C = (st & 1) * 32 + (swz % 64) / 2; }
__host__ __device__ __forceinline__ int perm32(int rho) { const int n = rho >> 4, i = rho & 15; return 8 * (i >> 2) + 4 * n + (i & 3); }

struct Unit { int pm, pn; };
struct Gemm { const void* A; const void* Bt; int M, N, KB; };
typedef int v4i_t __attribute__((ext_vector_type(4)));
typedef int v8i_t __attribute__((ext_vector_type(8)));

struct StaticOrder {
    int nM, nN, nwg, G, c;
    __host__ __device__ void init(int M, int N, int G_, int c_) { nM = M / BM; nN = N / BM; nwg = nM * nN; G = G_; c = c_; }
    __host__ __device__ bool next(int i, Unit& u) const {
        const long L = (long)i * G + c; if (L >= nwg) return false;
        int wgid = (int)L; { const int q = nwg / NXCD, r = nwg % NXCD, xcd = wgid % NXCD, off = wgid / NXCD; wgid = (xcd < r ? xcd * (q + 1) : r * (q + 1) + (xcd - r) * q) + off; }
        const int nig = WGM * nN, gid = wgid / nig, fm = gid * WGM, gsz = (nM - fm) < WGM ? (nM - fm) : WGM;
        u.pm = fm + ((wgid % nig) % gsz); u.pn = (wgid % nig) / gsz; return true;
    }
    __device__ __forceinline__ void a_ready(const Unit&) const {}
    __device__ __forceinline__ void done(const Unit&) const {}
};

__device__ __forceinline__ unsigned cvt_pk_bf16(float lo, float hi) { unsigned r; asm volatile("v_cvt_pk_bf16_f32 %0, %1, %2" : "=v"(r) : "v"(lo), "v"(hi)); return r; }
typedef float f32x2 __attribute__((ext_vector_type(2)));
typedef float f32x2 __attribute__((ext_vector_type(2)));
typedef unsigned u32x2 __attribute__((ext_vector_type(2)));
constexpr float ALPHA_F = 1.41421356237309515f;
constexpr float C2_F = 0.125f * 1.4426950408889634f;
__device__ __forceinline__ u32x4 pack8(const f32x4 v0, const f32x4 v1) { u32x4 w; w.x = cvt_pk_bf16(v0[0], v0[1]); w.y = cvt_pk_bf16(v0[2], v0[3]); w.z = cvt_pk_bf16(v1[0], v1[1]); w.w = cvt_pk_bf16(v1[2], v1[3]); return w; }

struct EpiProj {
    static constexpr bool PERM = true, AFTER_DRAIN = false;
    bf16_t* O; const float* sinT; const float* cosT;
    __device__ __forceinline__ void operator()(const f32x4 (&acc)[2][2][4][2], const Unit& u, int wr, int wc, int fr, int fq) const {
        const int row0 = u.pm * BM + wr * 64 + fr;
#pragma unroll
        for (int bj = 0; bj < 2; ++bj) {
            const int cw = u.pn * BM + bj * HALF + wc * 32;
            const int c0 = cw + 8 * fq;
            float sc = 1.f; bool rope = false;
            if (cw < 768 || (cw >= 2304 && cw < 3072)) sc = C2_F;
            else if (cw >= 3456 && cw < 3968) { rope = true; if (cw >= 3712) sc = 0.125f; }
            const float klg2 = (cw >= 3712 && cw < 3968) ? -__builtin_amdgcn_logf(1.f - __builtin_amdgcn_exp2f(-5.f - (float)((cw - 3712) >> 6))) : 0.f;
            const int i0 = ((c0 - 3456) & 63) >> 1;
#pragma unroll
            for (int ai = 0; ai < 2; ++ai)
#pragma unroll
                for (int m = 0; m < 4; ++m) {
                    const int row = row0 + ai * HALF + m * 16;
                    const float scr_ = sc * __builtin_amdgcn_exp2f(klg2 * (float)(row & 127));
                    f32x4 v0 = acc[ai][bj][m][0] * scr_, v1 = acc[ai][bj][m][1] * scr_;
                    if (rope) {
                        const int pos = row & 2047;
                        const f32x4 sn = *(const f32x4*)(sinT + pos * 32 + i0), cs = *(const f32x4*)(cosT + pos * 32 + i0);
                        f32x4 w0, w1;
                        w0[0] = v0[0] * cs[0] - v0[1] * sn[0]; w0[1] = v0[1] * cs[0] + v0[0] * sn[0];
                        w0[2] = v0[2] * cs[1] - v0[3] * sn[1]; w0[3] = v0[3] * cs[1] + v0[2] * sn[1];
                        w1[0] = v1[0] * cs[2] - v1[1] * sn[2]; w1[1] = v1[1] * cs[2] + v1[0] * sn[2];
                        w1[2] = v1[2] * cs[3] - v1[3] * sn[3]; w1[3] = v1[3] * cs[3] + v1[2] * sn[3];
                        v0 = w0; v1 = w1;
                    }
                    *(u32x4*)(O + (size_t)row * 5120 + c0) = pack8(v0, v1);
                }
        }
    }
};
struct EpiResid {
    static constexpr bool PERM = true, AFTER_DRAIN = false;
    float* T; const bf16_t* R; float scale;
    __device__ __forceinline__ void operator()(const f32x4 (&acc)[2][2][4][2], const Unit& u, int wr, int wc, int fr, int fq) const {
        const int row0 = u.pm * BM + wr * 64 + fr, col0 = u.pn * BM + wc * 32 + 8 * fq;
#pragma unroll
        for (int ai = 0; ai < 2; ++ai)
#pragma unroll
            for (int m = 0; m < 4; ++m) {
                const size_t ro = (size_t)(row0 + ai * HALF + m * 16) * 2048 + col0;
#pragma unroll
                for (int bj = 0; bj < 2; ++bj) {
                    const u32x4 r = *(const u32x4*)(R + ro + bj * HALF);
                    f32x4 r0, r1;
                    r0[0] = __builtin_bit_cast(float, r.x << 16); r0[1] = __builtin_bit_cast(float, r.x & 0xffff0000u); r0[2] = __builtin_bit_cast(float, r.y << 16); r0[3] = __builtin_bit_cast(float, r.y & 0xffff0000u);
                    r1[0] = __builtin_bit_cast(float, r.z << 16); r1[1] = __builtin_bit_cast(float, r.z & 0xffff0000u); r1[2] = __builtin_bit_cast(float, r.w << 16); r1[3] = __builtin_bit_cast(float, r.w & 0xffff0000u);
                    *(f32x4*)(T + ro + bj * HALF) = r0 * ALPHA_F + acc[ai][bj][m][0] * scale;
                    *(f32x4*)(T + ro + bj * HALF + 4) = r1 * ALPHA_F + acc[ai][bj][m][1] * scale;
                }
            }
    }
};
__device__ __forceinline__ float silu_f(float x) { return x * __builtin_amdgcn_rcpf(1.f + __builtin_amdgcn_exp2f(-1.4426950408889634f * x)); }
struct EpiSwiGLU {
    static constexpr bool PERM = true, AFTER_DRAIN = false;
    bf16_t* H; int ntn;
    __device__ __forceinline__ void operator()(const f32x4 (&acc)[2][2][4][2], const Unit& u, int wr, int wc, int fr, int fq) const {
        const int row0 = u.pm * BM + wr * 64 + fr, col0 = (u.pn % ntn) * HALF + wc * 32 + 8 * fq;
#pragma unroll
        for (int ai = 0; ai < 2; ++ai)
#pragma unroll
            for (int m = 0; m < 4; ++m) {
                f32x4 h0, h1;
#pragma unroll
                for (int j = 0; j < 4; ++j) { h0[j] = silu_f(acc[ai][0][m][0][j]) * acc[ai][1][m][0][j]; h1[j] = silu_f(acc[ai][0][m][1][j]) * acc[ai][1][m][1][j]; }
                *(u32x4*)(H + (size_t)(row0 + ai * HALF + m * 16) * 5632 + col0) = pack8(h0, h1);
            }
    }
};
constexpr float FP8_SX = 16.f, FP8_SWU = 512.f, FP8_SH = 8.f, FP8_SWD = 2048.f;
__device__ __forceinline__ unsigned pack4_fp8(float a, float b, float c, float d) {
    a = __builtin_amdgcn_fmed3f(a, -448.f, 448.f); b = __builtin_amdgcn_fmed3f(b, -448.f, 448.f); c = __builtin_amdgcn_fmed3f(c, -448.f, 448.f); d = __builtin_amdgcn_fmed3f(d, -448.f, 448.f);
    int w = __builtin_amdgcn_cvt_pk_fp8_f32(a, b, 0, false); w = __builtin_amdgcn_cvt_pk_fp8_f32(c, d, w, true); return (unsigned)w;
}
struct EpiSwiGLU8 {
    static constexpr bool PERM = true, AFTER_DRAIN = false;
    unsigned char* H; int ntn; float si;
    __device__ __forceinline__ void operator()(const f32x4 (&acc)[2][2][4][2], const Unit& u, int wr, int wc, int fr, int fq) const {
        const int row0 = u.pm * BM + wr * 64 + fr, col0 = (u.pn % ntn) * HALF + wc * 32 + 8 * fq;
#pragma unroll
        for (int ai = 0; ai < 2; ++ai)
#pragma unroll
            for (int m = 0; m < 4; ++m) {
                f32x4 h0, h1;
#pragma unroll
                for (int j = 0; j < 4; ++j) { h0[j] = silu_f(acc[ai][0][m][0][j] * si) * (acc[ai][1][m][0][j] * (si * FP8_SH)); h1[j] = silu_f(acc[ai][0][m][1][j] * si) * (acc[ai][1][m][1][j] * (si * FP8_SH)); }
                u32x2 w; w.x = pack4_fp8(h0[0], h0[1], h0[2], h0[3]); w.y = pack4_fp8(h1[0], h1[1], h1[2], h1[3]);
                *(u32x2*)(H + (size_t)(row0 + ai * HALF + m * 16) * 5632 + col0) = w;
            }
    }
};
struct EpiY {
    static constexpr bool PERM = true, AFTER_DRAIN = false;
    bf16_t* Y; int ntn; float scale;
    __device__ __forceinline__ void operator()(const f32x4 (&acc)[2][2][4][2], const Unit& u, int wr, int wc, int fr, int fq) const {
        const int row0 = u.pm * BM + wr * 64 + fr, col0 = (u.pn % ntn) * BM + wc * 32 + 8 * fq;
#pragma unroll
        for (int ai = 0; ai < 2; ++ai)
#pragma unroll
            for (int m = 0; m < 4; ++m)
#pragma unroll
                for (int bj = 0; bj < 2; ++bj)
                    *(u32x4*)(Y + (size_t)(row0 + ai * HALF + m * 16) * 2048 + col0 + bj * HALF) = pack8(acc[ai][bj][m][0] * scale, acc[ai][bj][m][1] * scale);
    }
};
struct GroupedOrder {
    int nM, nN, nwg, G, c, pm0; int cum[8];
    __device__ __forceinline__ bool next(int i, Unit& u) const {
        const long L = (long)i * G + c; if (L >= nwg) return false;
        int wgid = (int)L; { const int q = nwg / NXCD, r = nwg % NXCD, xcd = wgid % NXCD, off = wgid / NXCD; wgid = (xcd < r ? xcd * (q + 1) : r * (q + 1) + (xcd - r) * q) + off; }
        const int nig = WGM * nN, gid = wgid / nig, fm = gid * WGM, gsz = (nM - fm) < WGM ? (nM - fm) : WGM;
        const int pm = pm0 + fm + ((wgid % nig) % gsz), pn = (wgid % nig) / gsz;
        int e = 0;
#pragma unroll
        for (int j = 0; j < 7; ++j) e += (pm >= cum[j]) ? 1 : 0;
        u.pm = pm; u.pn = e * nN + pn; return true;
    }
    __device__ __forceinline__ void a_ready(const Unit&) const {}
    __device__ __forceinline__ void done(const Unit&) const {}
};
template <class Epi, class Sched, bool ALIGN_EPI = false, bool SP2 = false, bool FP8 = false>
__device__ __forceinline__ void gemm_phase(PG8_LAS unsigned char* lds, const int wid, const Gemm g, const Sched& S, const Epi& E) {
    const int lane = (int)__builtin_amdgcn_mbcnt_hi(~0u, __builtin_amdgcn_mbcnt_lo(~0u, 0u)), tid = wid * 64 + lane,
        wr = wid >> 2, wc = wid & 3, fr = lane & 15, fq = lane >> 4;
    const int KB = g.KB, nt = KB / 128;
    unsigned voffA[2], voffB[2];
#pragma unroll
    for (int i = 0; i < 2; ++i) { int R, C; stage_rc(tid * 16 + i * 8192, R, C); const int Rb = Epi::PERM ? ((R & ~31) + perm32(R & 31)) : R;
        voffA[i] = (unsigned)(R * KB + C * 2); voffB[i] = (unsigned)(Rb * KB + C * 2); }
    const size_t kstep = (size_t)128;
    const size_t hstep = (size_t)HALF * KB;
    const size_t tstep = 2 * hstep;
    const unsigned ldsw = (unsigned)wid * 1024u;
    const int aoff = lds_byte(wr * 64 + fr, fq * 8), boff = lds_byte(wc * 32 + fr, fq * 8);
#define PG8_SA(b, h) (((b) * 2 + (h)) * HTB)
#define PG8_SB(b, h) ((4 + (b) * 2 + (h)) * HTB)
#define PG8_STAGE(bufoff, gbase, voff) do { _Pragma("unroll") for (int _i = 0; _i < 2; ++_i) \
        __builtin_amdgcn_global_load_lds((const unsigned*)((const char*)(gbase) + (voff)[_i]), (PG8_LAS unsigned*)(lds + (bufoff) + ldsw + _i * 8192), 16, 0, 0); } while (0)
#define PG8_LDA(dst, b, h) do { _Pragma("unroll") for (int m = 0; m < 4; ++m) _Pragma("unroll") for (int k = 0; k < 2; ++k) dst[m][k] = *(const PG8_LAS bf16x8*)(lds + PG8_SA(b, h) + aoff + m * 2048 + k * 1024); } while (0)
#define PG8_LDB(dst, b, h) do { _Pragma("unroll") for (int n = 0; n < 2; ++n) _Pragma("unroll") for (int k = 0; k < 2; ++k) dst[n][k] = *(const PG8_LAS bf16x8*)(lds + PG8_SB(b, h) + boff + n * 2048 + k * 1024); } while (0)
#define PG8_MMA(ai, bj, At, Bt) do { __builtin_amdgcn_s_setprio(1); _Pragma("unroll") for (int m = 0; m < 4; ++m) _Pragma("unroll") for (int n = 0; n < 2; ++n) { \
        if constexpr (FP8) { const v4i_t b0_ = __builtin_bit_cast(v4i_t, Bt[n][0]), b1_ = __builtin_bit_cast(v4i_t, Bt[n][1]), a0_ = __builtin_bit_cast(v4i_t, At[m][0]), a1_ = __builtin_bit_cast(v4i_t, At[m][1]); \
            const v8i_t b8_ = __builtin_shufflevector(b0_, b1_, 0, 1, 2, 3, 4, 5, 6, 7), a8_ = __builtin_shufflevector(a0_, a1_, 0, 1, 2, 3, 4, 5, 6, 7); \
            asm volatile("v_mfma_f32_16x16x128_f8f6f4 %0, %1, %2, %0" : "+v"(acc[ai][bj][m][n]) : "v"(b8_), "v"(a8_)); } \
        else { _Pragma("unroll") for (int k = 0; k < 2; ++k) acc[ai][bj][m][n] = __builtin_amdgcn_mfma_f32_16x16x32_bf16(Bt[n][k], At[m][k], acc[ai][bj][m][n], 0, 0, 0); } } __builtin_amdgcn_s_setprio(0); } while (0)
#define PG8_WAIT_V(n) asm volatile("s_waitcnt vmcnt(" #n ")" ::: "memory")
#define PG8_WAIT_L(n) asm volatile("s_waitcnt lgkmcnt(" #n ")" ::: "memory")
#define PG8_BAR __builtin_amdgcn_s_barrier()
#define PG8_SCHED __builtin_amdgcn_sched_barrier(0)
    Unit cur, nxt; int ui = 0;
    if (!S.next(0, cur)) return;
    f32x4 acc[2][2][4][2];
#pragma unroll
    for (int a = 0; a < 2; ++a)
#pragma unroll
        for (int b = 0; b < 2; ++b)
#pragma unroll
            for (int m = 0; m < 4; ++m)
#pragma unroll
                for (int n = 0; n < 2; ++n) acc[a][b][m][n] = (f32x4){0.f, 0.f, 0.f, 0.f};
    bf16x8 At[4][2], B0[2][2], B1[2][2];
    const char* cA = (const char*)g.A + (size_t)cur.pm * tstep; const char* cB = (const char*)g.Bt + (size_t)cur.pn * tstep;
    S.a_ready(cur);
    if constexpr (SP2) {
        PG8_STAGE(PG8_SB(0, 0), cB, voffB); PG8_STAGE(PG8_SB(0, 1), cB + hstep, voffB); PG8_STAGE(PG8_SA(0, 0), cA, voffA); PG8_STAGE(PG8_SA(0, 1), cA + hstep, voffA);
        if (wr == 1) PG8_BAR;
        PG8_WAIT_V(2); PG8_BAR;
        PG8_STAGE(PG8_SB(1, 0), cB + kstep, voffB); PG8_STAGE(PG8_SA(1, 0), cA + kstep, voffA); PG8_STAGE(PG8_SB(1, 1), cB + hstep + kstep, voffB);
        PG8_WAIT_V(6); PG8_BAR;
    } else {
        PG8_STAGE(PG8_SB(0, 0), cB, voffB); PG8_STAGE(PG8_SA(0, 0), cA, voffA); PG8_STAGE(PG8_SB(0, 1), cB + hstep, voffB); PG8_STAGE(PG8_SA(0, 1), cA + hstep, voffA);
        if (wr == 1) PG8_BAR;
        PG8_WAIT_V(4); PG8_BAR;
        PG8_STAGE(PG8_SB(1, 0), cB + kstep, voffB); PG8_STAGE(PG8_SA(1, 0), cA + kstep, voffA); PG8_STAGE(PG8_SB(1, 1), cB + hstep + kstep, voffB);
        PG8_WAIT_V(6); PG8_BAR;
    }
    for (;;) {
        const bool has_next = S.next(ui + 1, nxt);
        const char* nA = has_next ? (const char*)g.A + (size_t)nxt.pm * tstep : cA; const char* nB = has_next ? (const char*)g.Bt + (size_t)nxt.pn * tstep : cB;
        for (int t = 0; t < nt; t += 2) {
            const bool last = (t == nt - 2);
            const char* a1 = cA + (size_t)(t + 1) * kstep;
            const char* a2 = last ? nA : cA + (size_t)(t + 2) * kstep; const char* b2 = last ? nB : cB + (size_t)(t + 2) * kstep;
            const char* a3 = a2 + kstep; const char* b3 = b2 + kstep;
            if (last && has_next) S.a_ready(nxt);
            if constexpr (SP2) {
            PG8_LDB(B0, 0, 0); PG8_LDB(B1, 0, 1); PG8_SCHED; PG8_LDA(At, 0, 0); PG8_STAGE(PG8_SA(1, 1), a1 + hstep, voffA);
            PG8_WAIT_V(8); PG8_WAIT_L(0); PG8_BAR; PG8_MMA(0, 0, At, B0); PG8_MMA(0, 1, At, B1); PG8_BAR; PG8_SCHED;
            PG8_LDA(At, 0, 1); PG8_STAGE(PG8_SB(0, 0), b2, voffB); PG8_STAGE(PG8_SB(0, 1), b2 + hstep, voffB); PG8_STAGE(PG8_SA(0, 0), a2, voffA);
            PG8_WAIT_V(8); PG8_WAIT_L(0); PG8_BAR; PG8_MMA(1, 0, At, B0); PG8_MMA(1, 1, At, B1); PG8_BAR; PG8_SCHED;
            PG8_LDB(B0, 1, 0); PG8_LDB(B1, 1, 1); PG8_SCHED; PG8_LDA(At, 1, 0); PG8_STAGE(PG8_SA(0, 1), a2 + hstep, voffA);
            PG8_WAIT_V(8); PG8_WAIT_L(0); PG8_BAR; PG8_MMA(0, 0, At, B0); PG8_MMA(0, 1, At, B1); PG8_BAR; PG8_SCHED;
            PG8_LDA(At, 1, 1); PG8_STAGE(PG8_SB(1, 0), b3, voffB); PG8_STAGE(PG8_SB(1, 1), b3 + hstep, voffB); PG8_STAGE(PG8_SA(1, 0), a3, voffA);
            PG8_WAIT_V(8); PG8_WAIT_L(0); PG8_BAR; PG8_MMA(1, 0, At, B0); PG8_MMA(1, 1, At, B1); PG8_BAR; PG8_SCHED;
            } else {
            PG8_LDB(B0, 0, 0); PG8_SCHED; PG8_LDA(At, 0, 0); PG8_STAGE(PG8_SA(1, 1), a1 + hstep, voffA);
            PG8_WAIT_L(8); PG8_BAR; PG8_WAIT_L(0); PG8_MMA(0, 0, At, B0); PG8_BAR; PG8_SCHED;
            PG8_LDB(B1, 0, 1); PG8_STAGE(PG8_SB(0, 0), b2, voffB);
            PG8_BAR; PG8_WAIT_L(0); PG8_MMA(0, 1, At, B1); PG8_BAR;
            PG8_LDA(At, 0, 1); PG8_STAGE(PG8_SA(0, 0), a2, voffA);
            PG8_BAR; PG8_WAIT_L(0); PG8_MMA(1, 0, At, B0); PG8_BAR; PG8_SCHED;
            PG8_STAGE(PG8_SB(0, 1), b2 + hstep, voffB);
            PG8_WAIT_V(6); PG8_BAR; PG8_MMA(1, 1, At, B1); PG8_BAR;
            PG8_LDB(B0, 1, 0); PG8_SCHED; PG8_LDA(At, 1, 0); PG8_STAGE(PG8_SA(0, 1), a2 + hstep, voffA);
            PG8_WAIT_L(8); PG8_BAR; PG8_WAIT_L(0); PG8_MMA(0, 0, At, B0); PG8_BAR; PG8_SCHED;
            PG8_LDB(B1, 1, 1); PG8_STAGE(PG8_SB(1, 0), b3, voffB);
            PG8_BAR; PG8_WAIT_L(0); PG8_MMA(0, 1, At, B1); PG8_BAR;
            PG8_LDA(At, 1, 1); PG8_STAGE(PG8_SA(1, 0), a3, voffA);
            PG8_BAR; PG8_WAIT_L(0); PG8_MMA(1, 0, At, B0); PG8_BAR; PG8_SCHED;
            PG8_STAGE(PG8_SB(1, 1), b3 + hstep, voffB);
            PG8_WAIT_V(6); PG8_BAR; PG8_MMA(1, 1, At, B1); PG8_BAR;
            }
        }
        if constexpr (ALIGN_EPI) { if (wr == 0) PG8_BAR; }
        if constexpr (FP8) asm volatile("s_nop 15\n\ts_nop 15" ::: "memory");
        if constexpr (!Epi::AFTER_DRAIN) { E(acc, cur, wr, wc, fr, fq); S.done(cur); }
        if (!has_next) break;
#pragma unroll
        for (int a = 0; a < 2; ++a)
#pragma unroll
            for (int b = 0; b < 2; ++b)
#pragma unroll
                for (int m = 0; m < 4; ++m)
#pragma unroll
                    for (int n = 0; n < 2; ++n) acc[a][b][m][n] = (f32x4){0.f, 0.f, 0.f, 0.f};
        cur = nxt; cA = nA; cB = nB; ++ui;
        if constexpr (ALIGN_EPI) { if (wr == 1) PG8_BAR; }
    }
    PG8_WAIT_V(0);
    if constexpr (!ALIGN_EPI) { if (wr == 0) PG8_BAR; }
    PG8_BAR;
    if constexpr (Epi::AFTER_DRAIN) { E.fused(acc, cur, wr, wc, fr, fq, lds, wid, lane); S.done(cur); }
#undef PG8_SA
#undef PG8_SB
#undef PG8_STAGE
#undef PG8_LDA
#undef PG8_LDB
#undef PG8_MMA
#undef PG8_WAIT_V
#undef PG8_WAIT_L
#undef PG8_BAR
#undef PG8_SCHED
}
}
constexpr int NWAVES = 8;
constexpr int NTOK = 16384, SEQ = 2048, DM = 2048, PW = 4992, PWP = 5120, DFF = 5632, NEXP = 8, MAXTILES = 136;
constexpr float LN_EPS = 1e-5f;
constexpr float LOG2E = 1.4426950408889634f;
constexpr int C_AQ = 0, C_AK = 768, C_AV = 1536, C_BQ = 2304, C_BK = 3072, C_BV = 3264, C_CQ = 3456, C_CK = 3712, C_CV = 3968, C_CG = 4480;
constexpr size_t MiB = 1u << 20;
constexpr size_t WS_CTL = 0, CTL_ZERO_BYTES = 1 * MiB;
constexpr size_t WS_TAB = 1 * MiB;
constexpr size_t WS_ROUTE = 2 * MiB;
constexpr size_t WS_WIN = 4 * MiB, WS_WOUT = 44 * MiB, WS_WDGU = 60 * MiB, WS_WDDN = 104 * MiB, WS_WMGU = 126 * MiB, WS_WMDN = 478 * MiB;
constexpr size_t WS_XB = 654 * MiB, WS_XG = 718 * MiB, WS_U1 = 854 * MiB, WS_END = 1228 * MiB;
constexpr size_t WS_PROJ = WS_U1, WS_CAT = WS_U1 + 160 * MiB, WS_H = WS_U1, WS_Y = WS_XG;
static_assert(WS_WIN + 2ull * PWP * DM * 2 <= WS_WOUT && WS_WOUT + 2ull * DM * DM * 2 <= WS_WDGU && WS_WDGU + 2ull * DFF * DM * 2 <= WS_WDDN && WS_WDDN + (size_t)DM * DFF * 2 <= WS_WMGU, "ws map 1");
static_assert(WS_WMGU + 8ull * 2 * DFF * DM * 2 <= WS_WMDN && WS_WMDN + 8ull * DM * DFF * 2 <= WS_XB && WS_XB + (size_t)NTOK * DM * 2 <= WS_XG && WS_XG + (size_t)MAXTILES * 256 * DM * 2 <= WS_U1, "ws map 2");
static_assert(WS_U1 + (size_t)MAXTILES * 256 * DFF * 2 <= WS_END && WS_PROJ + (size_t)NTOK * PWP * 2 <= WS_CAT && WS_CAT + (size_t)NTOK * DM * 2 <= WS_END, "ws map 3");
constexpr int CW_TMO = 0, CW_CODE = 1, CW_CNT = 1024  , CW_WQ = 2048  , CW_BAR = 4096  ;
constexpr int RING_OFF = 0, RING_BYTES = 131072;
constexpr int LDSCTL_OFF = RING_BYTES, MISC_OFF = LDSCTL_OFF + 320;
constexpr int LUT_OFF = LDSCTL_OFF + 1024;
constexpr int LUT_STRIDE = 132;
constexpr int LDS_BYTES = 147456;
static_assert(LUT_OFF + 18 * LUT_STRIDE * 4 <= LDS_BYTES, "LDS map");

#define GAS __attribute__((address_space(1)))
#define LAS __attribute__((address_space(3)))
typedef unsigned short bf16;
typedef unsigned v4u __attribute__((ext_vector_type(4)));
typedef unsigned v2u __attribute__((ext_vector_type(2)));
typedef float f32x4 __attribute__((ext_vector_type(4)));
typedef short bf16x8 __attribute__((ext_vector_type(8)));
typedef GAS unsigned gu32;
#define RLX_AGENT __ATOMIC_RELAXED, __HIP_MEMORY_SCOPE_AGENT
#define LDS_WAIT() asm volatile("s_waitcnt lgkmcnt(0)" ::: "memory")
#define VM_WAIT() asm volatile("s_waitcnt vmcnt(0)" ::: "memory")
__device__ __forceinline__ unsigned f2bf(float f) { unsigned u = __builtin_bit_cast(unsigned, f); return (u + 0x7fffu + ((u >> 16) & 1u)) >> 16; }
__device__ __forceinline__ unsigned pk2(float lo, float hi) { return f2bf(lo) | (f2bf(hi) << 16); }
__device__ __forceinline__ float bflo(unsigned w) { return __builtin_bit_cast(float, w << 16); }
__device__ __forceinline__ float bfhi(unsigned w) { return __builtin_bit_cast(float, w & 0xffff0000u); }
__device__ __forceinline__ float bf2f(bf16 h) { return __builtin_bit_cast(float, (unsigned)h << 16); }
__device__ const unsigned char BUCKET[129] = {0,1,2,3,4,5,6,7,8,9,10,11,12,13,14,15,16,16,16,17,17,18,18,18,19,19,19,20,20,20,20,21,21,21,21,22,22,22,22,22,23,23,23,23,23,23,24,24,24,24,24,24,25,25,25,25,25,25,25,
    26,26,26,26,26,26,26,26,27,27,27,27,27,27,27,27,27,27,28,28,28,28,28,28,28,28,28,28,29,29,29,29,29,29,29,29,29,29,29,29,30,30,30,30,30,30,30,30,30,30,30,30,30,30,31,31,31,31,31,31,31,31,31,31,31,31,31,31,31,31};
#define XB_TMO      128
#define XB_XCNT(j)  (256  + 64 * (j))
#define XB_XSUB(j)  (1280 + 64 * (j))
#define XB_XGEN(j)  (2304 + 64 * (j))
#define XB_TOP      3328
#define XB_TOPGEN   3392
#define XCD_BAR_WORDS 3456
#define XB_SPIN_CAP (1u << 18)

__device__ __forceinline__ unsigned xb_ld(unsigned* p)              { return __hip_atomic_load(p, __ATOMIC_RELAXED, __HIP_MEMORY_SCOPE_AGENT); }
__device__ __forceinline__ unsigned xb_add(unsigned* p, unsigned v) { return __hip_atomic_fetch_add(p, v, __ATOMIC_RELAXED, __HIP_MEMORY_SCOPE_AGENT); }
__device__ __forceinline__ unsigned xb_xcc_id() { return (unsigned)__builtin_amdgcn_s_getreg((3 << 11) | 20) & 0xFu; }
#define XB_SPIN(cond, bar) do { unsigned _sp = 0; while (cond) { __builtin_amdgcn_s_sleep(1); \
    if ((++_sp & 255u) == 0u) { if (xb_ld(&(bar)[XB_TMO])) break; if (_sp > XB_SPIN_CAP) { atomicAdd(&(bar)[XB_TMO], 1u); break; } } } } while (0)

struct XcdBarrier {
    unsigned* bar; unsigned x;
    volatile LAS unsigned* st;
};

__device__ __forceinline__ XcdBarrier xcd_barrier_post(unsigned* bar, volatile LAS unsigned* st) {
    XcdBarrier b; b.bar = bar; b.x = xb_xcc_id(); b.st = st;
    if (threadIdx.x == 0) (void)xb_add(&bar[XB_XCNT(b.x)], 1u);
    return b;
}
__device__ __forceinline__ void xcd_barrier_complete(unsigned* bar, unsigned x, unsigned& nloc, unsigned& nx) {
    const unsigned G = gridDim.x * gridDim.y * gridDim.z;
    unsigned sum, cnt, mine, sp = 0u;
    for (;;) {
        sum = 0u; cnt = 0u; mine = 0u;
#pragma unroll
        for (unsigned j = 0; j < 16; ++j) { const unsigned c = xb_ld(&bar[XB_XCNT(j)]); sum += c; cnt += (c > 0u) ? 1u : 0u; mine = (j == x) ? c : mine; }
        if (sum == G) break;
        __builtin_amdgcn_s_sleep(1);
        if ((++sp & 255u) == 0u) { if (xb_ld(&bar[XB_TMO])) break; if (sp > XB_SPIN_CAP) { atomicAdd(&bar[XB_TMO], 1u); break; } }
    }
    nloc = mine > 0u ? mine : 1u; nx = cnt > 0u ? cnt : 1u;
}

__device__ __forceinline__ void xcd_barrier(const XcdBarrier& b) {
    asm volatile("s_waitcnt vmcnt(0)" ::: "memory");
    __syncthreads();
    if (threadIdx.x == 0) {
        unsigned* bar = b.bar;
        __builtin_amdgcn_s_waitcnt(0);
        unsigned nloc = b.st[0], nx = b.st[1];
        if (nloc == 0u) { xcd_barrier_complete(bar, b.x, nloc, nx); b.st[0] = nloc; b.st[1] = nx; }
        const unsigned old = xb_add(&bar[XB_XSUB(b.x)], 1u);
        const unsigned gen = old / nloc;
        if (old + 1u == (gen + 1u) * nloc) {
            __builtin_amdgcn_fence(__ATOMIC_RELEASE, "agent");
            asm volatile("s_waitcnt vmcnt(0)" ::: "memory");
            const unsigned og = xb_add(&bar[XB_TOP], 1u);
            const unsigned tg = og / nx;
            if (og + 1u == (tg + 1u) * nx) xb_add(&bar[XB_TOPGEN], 1u);
            else XB_SPIN(xb_ld(&bar[XB_TOPGEN]) == tg, bar);
            __builtin_amdgcn_fence(__ATOMIC_ACQUIRE, "agent");
            xb_add(&bar[XB_XGEN(b.x)], 1u);
            asm volatile("s_waitcnt vmcnt(0)" ::: "memory");
        } else {
            XB_SPIN(xb_ld(&bar[XB_XGEN(b.x)]) == gen, bar);
            __builtin_amdgcn_fence(__ATOMIC_ACQUIRE, "agent");
            asm volatile("s_waitcnt vmcnt(0)" ::: "memory");
        }
    }
    __syncthreads();
}
struct Args { const float* in[18]; float* out; unsigned char* ws; int ph_lo, ph_hi, li, pad; float invf[32]; };
static_assert(sizeof(Args) == 20 * 8 + 16 + 128, "Args has no padding bytes");
struct Frame {
    LAS unsigned char* lds;
    gu32* ctl;
    int tid, lane, wave, vcu, G;
};
__device__ __forceinline__ float wave_sum(float v) {
#pragma unroll
    for (int o = 1; o < 64; o <<= 1) v += __shfl_xor(v, o);
    return v;
}
__device__ __forceinline__ float wave_max(float v) {
#pragma unroll
    for (int o = 1; o < 64; o <<= 1) v = fmaxf(v, __shfl_xor(v, o));
    return v;
}
__device__ __forceinline__ void p0_transpose_item(const float* W, int K, int N, bf16* WT, int k0, int n0, int drow0, LAS float* scr, int lane) {
#pragma unroll 8
    for (int i = 0; i < 32; ++i) { const int kk = 2 * i + (lane >> 5); scr[kk * 33 + (lane & 31)] = __builtin_nontemporal_load(W + (size_t)(k0 + kk) * N + n0 + (lane & 31)); }
    LDS_WAIT(); asm volatile("" ::: "memory");
    const int c = lane & 7;
#pragma unroll
    for (int j = 0; j < 4; ++j) { const int n = (lane >> 3) + 8 * j; const LAS float* s = scr + (8 * c) * 33 + n;
        v4u o; o.x = pk2(s[0 * 33], s[1 * 33]); o.y = pk2(s[2 * 33], s[3 * 33]); o.z = pk2(s[4 * 33], s[5 * 33]); o.w = pk2(s[6 * 33], s[7 * 33]);
        __builtin_nontemporal_store(o, (GAS v4u*)(WT + (size_t)(drow0 + n) * K + k0 + 8 * c)); }
    LDS_WAIT(); asm volatile("" ::: "memory");
}
template <int MODE> __device__ __forceinline__ void p0_matrix_item(const float* W, int K, int N, bf16* WT, int item, LAS float* scr, int lane) {
    const int nblk = N / 32, kb = item / nblk, nb = item % nblk, n0 = 32 * nb;
    const int drow0 = (MODE == 0) ? n0 : ((n0 >> 7) * 256 + (n0 & 127) + (MODE == 2 ? 128 : 0));
    p0_transpose_item(W, K, N, WT, 64 * kb, n0, drow0, scr, lane);
}
__device__ __forceinline__ void p0_transpose_item8(const float* W, int K, int N, unsigned char* WT, int k0, int n0, int drow0, float scale, LAS float* scr, int lane) {
#pragma unroll 8
    for (int i = 0; i < 32; ++i) { const int kk = 2 * i + (lane >> 5); scr[kk * 33 + (lane & 31)] = __builtin_nontemporal_load(W + (size_t)(k0 + kk) * N + n0 + (lane & 31)) * scale; }
    LDS_WAIT(); asm volatile("" ::: "memory");
    const int c = lane & 7;
#pragma unroll
    for (int j = 0; j < 4; ++j) { const int n = (lane >> 3) + 8 * j; const LAS float* s = scr + (8 * c) * 33 + n;
        v2u o; o.x = pg8::pack4_fp8(s[0 * 33], s[1 * 33], s[2 * 33], s[3 * 33]); o.y = pg8::pack4_fp8(s[4 * 33], s[5 * 33], s[6 * 33], s[7 * 33]);
        __builtin_nontemporal_store(o, (GAS v2u*)(WT + (size_t)(drow0 + n) * K + k0 + 8 * c)); }
    LDS_WAIT(); asm volatile("" ::: "memory");
}
template <int MODE> __device__ __forceinline__ void p0_matrix_item8(const float* W, int K, int N, unsigned char* WT, int item, float scale, LAS float* scr, int lane) {
    const int nblk = N / 32, kb = item / nblk, nb = item % nblk, n0 = 32 * nb;
    const int drow0 = (MODE == 0) ? n0 : ((n0 >> 7) * 256 + (n0 & 127) + (MODE == 2 ? 128 : 0));
    p0_transpose_item8(W, K, N, WT, 64 * kb, n0, drow0, scale, scr, lane);
}
__device__ __forceinline__ void p0_prologue(Frame& F, const Args& a) {
    LAS float* scr = (LAS float*)(F.lds + RING_OFF + F.wave * 16384);
    const int gw = F.vcu * NWAVES + F.wave, NGW = F.G * NWAVES;
    unsigned char* ws = a.ws;
    constexpr int I_IN = (DM / 64) * (PW / 32), I_OUT = (DM / 64) * (DM / 32), I_GU = (DM / 64) * (DFF / 32), I_DN = (DFF / 64) * (DM / 32);
    constexpr int NITEMS = 2 * I_IN + 2 * I_OUT + 2 * I_GU + I_DN + 8 * (2 * I_GU + I_DN);
    for (int it = gw; it < NITEMS; it += NGW) {
        int r = it;
        if (r < 2 * I_IN) { const int l = r / I_IN; p0_matrix_item<0>(a.in[1] + (size_t)l * DM * PW, DM, PW, (bf16*)(ws + WS_WIN) + (size_t)l * PWP * DM, r % I_IN, scr, F.lane); continue; } r -= 2 * I_IN;
        if (r < 2 * I_OUT) { const int l = r / I_OUT; p0_matrix_item<0>(a.in[6] + (size_t)l * DM * DM, DM, DM, (bf16*)(ws + WS_WOUT) + (size_t)l * DM * DM, r % I_OUT, scr, F.lane); continue; } r -= 2 * I_OUT;
        if (r < I_GU) { p0_matrix_item<1>(a.in[11], DM, DFF, (bf16*)(ws + WS_WDGU), r, scr, F.lane); continue; } r -= I_GU;
        if (r < I_GU) { p0_matrix_item<2>(a.in[12], DM, DFF, (bf16*)(ws + WS_WDGU), r, scr, F.lane); continue; } r -= I_GU;
        if (r < I_DN) { p0_matrix_item8<0>(a.in[13], DFF, DM, ws + WS_WDDN, r, pg8::FP8_SWD, scr, F.lane); continue; } r -= I_DN;
        if (r < 8 * I_GU) { const int e = r / I_GU; p0_matrix_item8<1>(a.in[15] + (size_t)e * DM * DFF, DM, DFF, ws + WS_WMGU + (size_t)e * 2 * DFF * DM, r % I_GU, pg8::FP8_SWU, scr, F.lane); continue; } r -= 8 * I_GU;
        if (r < 8 * I_GU) { const int e = r / I_GU; p0_matrix_item8<2>(a.in[16] + (size_t)e * DM * DFF, DM, DFF, ws + WS_WMGU + (size_t)e * 2 * DFF * DM, r % I_GU, pg8::FP8_SWU, scr, F.lane); continue; } r -= 8 * I_GU;
        { const int e = r / I_DN; p0_matrix_item8<0>(a.in[17] + (size_t)e * DFF * DM, DFF, DM, ws + WS_WMDN + (size_t)e * DM * DFF, r % I_DN, pg8::FP8_SWD, scr, F.lane); }
    }
    { const int gt = gw * 64 + F.lane, NGT = NGW * 64; const GAS f32x4* x4 = (const GAS f32x4*)a.in[0]; GAS v4u* o4 = (GAS v4u*)(ws + WS_XB);
      for (int i = gt; i < NTOK * DM / 8; i += NGT) { const f32x4 p = __builtin_nontemporal_load(x4 + 2 * i), q = __builtin_nontemporal_load(x4 + 2 * i + 1); v4u o; o.x = pk2(p[0], p[1]); o.y = pk2(p[2], p[3]); o.z = pk2(q[0], q[1]); o.w = pk2(q[2], q[3]); o4[i] = o; } }
    { const int gt = gw * 64 + F.lane; if (gt < SEQ * 32) { const int pos = gt >> 5, i = gt & 31; const float ang = (float)pos * a.invf[i];
        const double t = (double)ang * 0.15915494309189535; const float fr = (float)(t - __builtin_rint(t));
        ((float*)(ws + WS_TAB))[gt] = __builtin_amdgcn_sinf(fr); ((float*)(ws + WS_TAB + 256 * 1024))[gt] = __builtin_amdgcn_cosf(fr); } }
}
__device__ __forceinline__ void build_lut(Frame& F, const float* rel_bias) {
    LAS float* lut = (LAS float*)(F.lds + LUT_OFF);
    for (int i = F.tid; i < 18 * 129; i += NWAVES * 64) { const int hh = i / 129, d = i % 129; lut[hh * LUT_STRIDE + d] = (rel_bias[BUCKET[d] * 18 + hh] - (hh < 6 ? rel_bias[31 * 18 + hh] : 0.f)) * LOG2E; }
}
__device__ __forceinline__ void ln_stats(f32x4 (&v)[8], float& mean, float& rstd) {
    float s = 0.f;
#pragma unroll
    for (int j = 0; j < 8; ++j) s += (v[j][0] + v[j][1]) + (v[j][2] + v[j][3]);
    mean = wave_sum(s) * (1.f / DM); float s2 = 0.f;
#pragma unroll
    for (int j = 0; j < 8; ++j) { v[j] = v[j] - mean; s2 += (v[j][0] * v[j][0] + v[j][1] * v[j][1]) + (v[j][2] * v[j][2] + v[j][3] * v[j][3]); }
    rstd = 1.f / sqrtf(wave_sum(s2) * (1.f / DM) + LN_EPS);
}
__device__ __forceinline__ int expert_offsets(Frame& F, int& ntiles) {
    const unsigned c = (F.lane < 8) ? __hip_atomic_load(F.ctl + CW_CNT + 64 * F.lane, RLX_AGENT) : 0u;
    const int t = (int)((c + 255u) >> 8);
    int inc = t;
#pragma unroll
    for (int o = 1; o < 8; o <<= 1) { const int u = __shfl_up(inc, o); if (F.lane >= o) inc += u; }
    ntiles = __shfl(inc, 7);
    return (inc - t) * 256;
}
template <int MODE> __device__ __forceinline__ void ln_phase(Frame& F, const Args& a, float* T, const float* gam, const float* bet, const float* w_router, int rb_in = -1, int pass = 0) {
    unsigned char* ws = a.ws;
    bf16* XB = (bf16*)(ws + WS_XB);
    const int lane = F.lane;
    LAS float* wrT = (LAS float*)(F.lds + RING_OFF);
    LAS int* cwL = (LAS int*)(F.lds + RING_OFF + 65536);
    LAS int* baseL = (LAS int*)(F.lds + RING_OFF + 65536 + 256);
    if (MODE == 1) {
        for (int i = F.tid; i < DM * 8; i += NWAVES * 64) wrT[(i & 7) * DM + (i >> 3)] = w_router[i];
        __syncthreads();
    }
    f32x4 g4[8], b4[8];
#pragma unroll
    for (int j = 0; j < 8; ++j) { g4[j] = *(const f32x4*)(gam + 4 * lane + 256 * j); b4[j] = *(const f32x4*)(bet + 4 * lane + 256 * j); }
    int offv = 0, ntl = 0;
    if (MODE == 2) offv = expert_offsets(F, ntl);
    const int rb = (rb_in >= 0) ? rb_in : (F.vcu * NWAVES + F.wave) * 8;
    unsigned long long cntp = 0ull; int me1 = 0, me2 = 0, mr1 = 0, mr2 = 0; float mg1 = 0.f, mg2 = 0.f;
    for (int r = 0; r < 8; ++r) {
        const int row = rb + r;
        float* trow = T + (size_t)row * DM;
        if (MODE == 2 && pass != 0) {
            const int* rt = (const int*)(ws + WS_ROUTE) + row * 8;
            const bool late = (__shfl(offv, rt[0]) + rt[1] >= 32768) || (__shfl(offv, rt[2]) + rt[3] >= 32768);
            if (late != (pass == 2)) continue;
        }
        f32x4 v[8];
#pragma unroll
        for (int j = 0; j < 8; ++j) v[j] = *(const f32x4*)(trow + 4 * lane + 256 * j);
        if (MODE == 2) {
            const int* rt = (const int*)(ws + WS_ROUTE) + row * 8;
            const int e1 = rt[0], p1 = rt[1], e2 = rt[2], p2 = rt[3]; const float g1 = __builtin_bit_cast(float, rt[4]), g2 = __builtin_bit_cast(float, rt[5]);
            const int r1 = __shfl(offv, e1) + p1, r2 = __shfl(offv, e2) + p2;
            const bf16* y1 = (const bf16*)(ws + WS_Y) + (size_t)r1 * DM; const bf16* y2 = (const bf16*)(ws + WS_Y) + (size_t)r2 * DM;
#pragma unroll
            for (int j = 0; j < 8; ++j) { const v2u a1 = *(const v2u*)(y1 + 4 * lane + 256 * j), a2 = *(const v2u*)(y2 + 4 * lane + 256 * j);
                v[j][0] = v[j][0] * pg8::ALPHA_F + g1 * bflo(a1.x) + g2 * bflo(a2.x); v[j][1] = v[j][1] * pg8::ALPHA_F + g1 * bfhi(a1.x) + g2 * bfhi(a2.x);
                v[j][2] = v[j][2] * pg8::ALPHA_F + g1 * bflo(a1.y) + g2 * bflo(a2.y); v[j][3] = v[j][3] * pg8::ALPHA_F + g1 * bfhi(a1.y) + g2 * bfhi(a2.y); }
        }
        float mean, rstd; ln_stats(v, mean, rstd);
#pragma unroll
        for (int j = 0; j < 8; ++j) v[j] = v[j] * rstd * g4[j] + b4[j];
        if (MODE == 2) {
            float* orow = a.out + (size_t)row * DM;
#pragma unroll
            for (int j = 0; j < 8; ++j) *(f32x4*)(orow + 4 * lane + 256 * j) = v[j];
        } else {
            bf16* xrow = XB + (size_t)row * DM;
#pragma unroll
            for (int j = 0; j < 8; ++j) { if (MODE != 0) *(f32x4*)(trow + 4 * lane + 256 * j) = v[j]; if (MODE == 0) { v2u o; o.x = pk2(v[j][0], v[j][1]); o.y = pk2(v[j][2], v[j][3]); *(v2u*)(xrow + 4 * lane + 256 * j) = o; }
                if (MODE == 3) { const f32x4 s = v[j] * pg8::FP8_SX; ((GAS unsigned*)(ws + WS_XG + (size_t)row * DM))[lane + 64 * j] = pg8::pack4_fp8(s[0], s[1], s[2], s[3]); } }
        }
        if (MODE == 1) {
            int i1 = -1, i2 = -1; float v1 = -3.0e38f, v2 = -3.0e38f;
#pragma unroll 1
            for (int e = 0; e < 8; ++e) { float s = 0.f;
#pragma unroll
                for (int j = 0; j < 8; ++j) { const f32x4 w = *(const LAS f32x4*)(wrT + e * DM + 4 * lane + 256 * j); s += (v[j][0] * w[0] + v[j][1] * w[1]) + (v[j][2] * w[2] + v[j][3] * w[3]); }
                const float t = wave_sum(s);
                if (t > v1) { v2 = v1; i2 = i1; v1 = t; i1 = e; } else if (t > v2) { v2 = t; i2 = e; } }
            if (i1 < 0) i1 = 0;
            if (i2 < 0) i2 = (i1 + 1) & 7;
            const float ex = __expf(v2 - v1), w1 = 1.f / (1.f + ex), w2 = ex * w1;
            const int k1 = (int)((cntp >> (8 * i1)) & 0xffull); cntp += 1ull << (8 * i1);
            const int k2 = (int)((cntp >> (8 * i2)) & 0xffull); cntp += 1ull << (8 * i2);
            if (lane == r) { me1 = i1; me2 = i2; mr1 = k1; mr2 = k2; mg1 = w1; mg2 = w2; }
        }
    }
    if (MODE == 1) {
        if (lane < 8) cwL[F.wave * 8 + lane] = (int)((cntp >> (8 * lane)) & 0xffull);
        __syncthreads();
        if (F.tid < 8) { int tot = 0;
#pragma unroll
            for (int w = 0; w < 8; ++w) tot += cwL[w * 8 + F.tid];
            baseL[F.tid] = (int)__hip_atomic_fetch_add(F.ctl + CW_CNT + 64 * F.tid, (unsigned)tot, RLX_AGENT); }
        __syncthreads();
        if (lane < 8) {
            int p1 = baseL[me1] + mr1, p2 = baseL[me2] + mr2;
            for (int w = 0; w < F.wave; ++w) { p1 += cwL[w * 8 + me1]; p2 += cwL[w * 8 + me2]; }
            int* rt = (int*)(ws + WS_ROUTE) + (rb + lane) * 8;
            rt[0] = me1; rt[1] = p1; rt[2] = me2; rt[3] = p2; rt[4] = __builtin_bit_cast(int, mg1); rt[5] = __builtin_bit_cast(int, mg2);
        }
    }
}
__device__ __forceinline__ void gather_phase(Frame& F, const Args& a, const float* T) {
    unsigned char* ws = a.ws; int ntl; const int offv = expert_offsets(F, ntl);
    const int gw = F.vcu * NWAVES + F.wave, NGW = F.G * NWAVES;
    for (int tok = gw; tok < NTOK; tok += NGW) {
        const int* rt = (const int*)(ws + WS_ROUTE) + tok * 8;
        const int d1 = __shfl(offv, rt[0]) + rt[1], d2 = __shfl(offv, rt[2]) + rt[3];
        const GAS f32x4* s = (const GAS f32x4*)(T + (size_t)tok * DM);
        GAS unsigned* o1 = (GAS unsigned*)(ws + WS_XG + (size_t)d1 * DM); GAS unsigned* o2 = (GAS unsigned*)(ws + WS_XG + (size_t)d2 * DM);
#pragma unroll
        for (int j = 0; j < 8; ++j) { const f32x4 v = s[F.lane + 64 * j] * pg8::FP8_SX; const unsigned w = pg8::pack4_fp8(v[0], v[1], v[2], v[3]); o1[F.lane + 64 * j] = w; o2[F.lane + 64 * j] = w; }
    }
}
__device__ __forceinline__ float dot8(const v4u q, const v4u k) {
    return (bflo(q.x) * bflo(k.x) + bfhi(q.x) * bfhi(k.x)) + (bflo(q.y) * bflo(k.y) + bfhi(q.y) * bfhi(k.y)) + (bflo(q.z) * bflo(k.z) + bfhi(q.z) * bfhi(k.z)) + (bflo(q.w) * bflo(k.w) + bfhi(q.w) * bfhi(k.w));
}
__device__ __forceinline__ float lambda_of(const float* lp, int lane, float lam_init) {
    const float s1 = wave_sum(lp[lane] * lp[64 + lane]), s2 = wave_sum(lp[128 + lane] * lp[192 + lane]);
    return __expf(s1) - __expf(s2) + lam_init;
}
__device__ __forceinline__ void naive_mixers(Frame& F, const Args& a, int layer) {
    unsigned char* ws = a.ws; const bf16* PROJ = (const bf16*)(ws + WS_PROJ); bf16* CAT = (bf16*)(ws + WS_CAT);
    const int lane = F.lane; const int gw = F.vcu * NWAVES + F.wave, NGW = F.G * NWAVES;
    LAS float* sc = (LAS float*)(F.lds + RING_OFF + F.wave * 16384);
    const LAS float* lut = (const LAS float*)(F.lds + LUT_OFF);
    const float lam_init = 0.8f - 0.6f * __expf(-0.3f * (float)layer);
    const float lam = lambda_of(a.in[3] + layer * 256, lane, lam_init);
    const float* subg = a.in[4] + layer * 128; const float* sinks = a.in[5] + layer * 12;
    for (int task = gw; task < NTOK * 6; task += NGW) {
        const int tok = task / 6, h = task - tok * 6, q = tok & (SEQ - 1), base = tok - q;
        v4u qv[16]; { const v4u* qp = (const v4u*)(PROJ + (size_t)tok * PWP + C_AQ + h * 128);
#pragma unroll
            for (int c = 0; c < 16; ++c) qv[c] = qp[c]; }
        float m1 = -3.0e38f, m2 = -3.0e38f;
        for (int j = lane; j <= q; j += 64) {
            const v4u* kp = (const v4u*)(PROJ + (size_t)(base + j) * PWP + C_AK + h * 128); float d1 = 0.f, d2 = 0.f;
#pragma unroll
            for (int c = 0; c < 8; ++c) { d1 += dot8(qv[c], kp[c]); d2 += dot8(qv[8 + c], kp[8 + c]); }
            const int dd = q - j; const float bias = lut[h * LUT_STRIDE + (dd < 128 ? dd : 128)];
            d1 += bias; d2 += bias; sc[j] = d1; sc[2048 + j] = d2; m1 = fmaxf(m1, d1); m2 = fmaxf(m2, d2);
        }
        m1 = wave_max(m1); m2 = wave_max(m2); float l1 = 0.f, l2 = 0.f;
        for (int j = lane; j <= q; j += 64) { const float p1 = __builtin_amdgcn_exp2f(sc[j] - m1), p2 = __builtin_amdgcn_exp2f(sc[2048 + j] - m2); sc[j] = p1; sc[2048 + j] = p2; l1 += p1; l2 += p2; }
        l1 = wave_sum(l1); l2 = wave_sum(l2); const float c1 = 1.f / l1, c2 = lam / l2;
        float o0 = 0.f, o1 = 0.f;
        for (int j = 0; j <= q; ++j) { const float w = sc[j] * c1 - sc[2048 + j] * c2; const bf16* vr = PROJ + (size_t)(base + j) * PWP + C_AV + h * 128; o0 += w * bf2f(vr[lane]); o1 += w * bf2f(vr[64 + lane]); }
        const float ss = wave_sum(o0 * o0 + o1 * o1), rr = (1.f / sqrtf(ss * (1.f / 128.f) + LN_EPS)) * (1.f - lam_init);
        bf16* orow = CAT + (size_t)tok * DM + h * 128; orow[lane] = (bf16)f2bf(o0 * rr * subg[lane]); orow[64 + lane] = (bf16)f2bf(o1 * rr * subg[64 + lane]);
    }
    for (int task = gw; task < NTOK * 12; task += NGW) {
        const int tok = task / 12, hq = task - tok * 12, kvh = hq >> 2, q = tok & (SEQ - 1), base = tok - q;
        v4u qv[8]; { const v4u* qp = (const v4u*)(PROJ + (size_t)tok * PWP + C_BQ + hq * 64);
#pragma unroll
            for (int c = 0; c < 8; ++c) qv[c] = qp[c]; }
        float s[2];
#pragma unroll
        for (int i = 0; i < 2; ++i) { const int dd = lane + 64 * i, j = q - dd; s[i] = -3.0e38f;
            if (j >= 0) { const v4u* kp = (const v4u*)(PROJ + (size_t)(base + j) * PWP + C_BK + kvh * 64); float d = 0.f;
#pragma unroll
                for (int c = 0; c < 8; ++c) d += dot8(qv[c], kp[c]);
                s[i] = d + lut[(6 + hq) * LUT_STRIDE + dd]; } }
        const float sink2 = sinks[hq] * LOG2E; const float m = fmaxf(wave_max(fmaxf(s[0], s[1])), sink2);
        const float p0 = (q - lane >= 0) ? __builtin_amdgcn_exp2f(s[0] - m) : 0.f, p1 = (q - lane - 64 >= 0) ? __builtin_amdgcn_exp2f(s[1] - m) : 0.f;
        const float l = wave_sum(p0 + p1) + __builtin_amdgcn_exp2f(sink2 - m);
        sc[lane] = p0; sc[64 + lane] = p1;
        float o = 0.f; const int nk = (q + 1 < 128) ? q + 1 : 128;
        for (int dd = 0; dd < nk; ++dd) o += sc[dd] * bf2f(PROJ[(size_t)(base + q - dd) * PWP + C_BV + kvh * 64 + lane]);
        CAT[(size_t)tok * DM + 768 + hq * 64 + lane] = (bf16)f2bf(o / l);
    }
    for (int task = gw; task < NTOK * 4; task += NGW) {
        const int tok = task >> 2, h = task & 3, q = tok & (SEQ - 1), base = tok - q;
        const float lg2 = log2f(1.f - exp2f(-5.f - (float)h));
        v4u qv[8]; { const v4u* qp = (const v4u*)(PROJ + (size_t)tok * PWP + C_CQ + h * 64);
#pragma unroll
            for (int c = 0; c < 8; ++c) qv[c] = qp[c]; }
        for (int j = lane; j <= q; j += 64) { const v4u* kp = (const v4u*)(PROJ + (size_t)(base + j) * PWP + C_CK + h * 64); float d = 0.f;
#pragma unroll
            for (int c = 0; c < 8; ++c) d += dot8(qv[c], kp[c]);
            sc[j] = d * __builtin_amdgcn_exp2f((float)(q - j) * lg2); }
        float o0 = 0.f, o1 = 0.f;
        for (int j = 0; j <= q; ++j) { const float w = sc[j]; const bf16* vr = PROJ + (size_t)(base + j) * PWP + C_CV + h * 128; o0 += w * bf2f(vr[lane]); o1 += w * bf2f(vr[64 + lane]); }
        const float mu = wave_sum(o0 + o1) * (1.f / 128.f); o0 -= mu; o1 -= mu;
        const float rs = 1.f / sqrtf(wave_sum(o0 * o0 + o1 * o1) * (1.f / 128.f) + LN_EPS);
        const bf16* gr = PROJ + (size_t)tok * PWP + C_CG + h * 128;
        bf16* orow = CAT + (size_t)tok * DM + 1536 + h * 128;
        orow[lane] = (bf16)f2bf(pg8::silu_f(bf2f(gr[lane])) * o0 * rs); orow[64 + lane] = (bf16)f2bf(pg8::silu_f(bf2f(gr[64 + lane])) * o1 * rs);
    }
}
typedef float f32x16 __attribute__((ext_vector_type(16)));
typedef short s16x4 __attribute__((ext_vector_type(4)));
typedef short v4i16_t __attribute__((ext_vector_type(4)));
typedef float f32x2_t __attribute__((ext_vector_type(2))); typedef __bf16 bf16x2_t __attribute__((ext_vector_type(2)));
__device__ __forceinline__ int crow(int r, int hi) { return (r & 3) + 8 * (r >> 2) + 4 * hi; }
__device__ __forceinline__ s16x4 vtr(const LAS unsigned char* p) { return __builtin_bit_cast(s16x4, __builtin_amdgcn_ds_read_tr16_b64_v4i16((LAS v4i16_t*)p)); }
__device__ __forceinline__ unsigned cvtpk_s(float lo, float hi) { f32x2_t v = {lo, hi}; bf16x2_t b = __builtin_convertvector(v, bf16x2_t); return __builtin_bit_cast(unsigned, b); }
__device__ __forceinline__ bf16x8 pack_p(const f32x16& p, int s2) {
    v4u w; w.x = cvtpk_s(p[8 * s2 + 0], p[8 * s2 + 1]); w.y = cvtpk_s(p[8 * s2 + 2], p[8 * s2 + 3]); w.z = cvtpk_s(p[8 * s2 + 4], p[8 * s2 + 5]); w.w = cvtpk_s(p[8 * s2 + 6], p[8 * s2 + 7]);
    return __builtin_bit_cast(bf16x8, w);
}
constexpr int MIX_WSF = 131072 + 1024 + 10240, MIX_QW = MIX_WSF + 2048;
static_assert(MIX_QW + 64 <= LDS_BYTES && LUT_OFF + 18 * LUT_STRIDE * 4 <= MIX_WSF, "mixer LDS map");
constexpr int LUTX_OFF = 98304, LUTX_STRIDE = 320;
constexpr float MIX_THR = 6.f;
__device__ __forceinline__ void glds16(const void* gsrc, unsigned lds_dst) { unsigned keep;
    asm volatile("s_mov_b32 %0, m0\n\ts_mov_b32 m0, %2\n\ts_nop 0\n\tglobal_load_lds_dwordx4 %1, off\n\ts_mov_b32 m0, %0" : "=&s"(keep) : "v"(gsrc), "s"(lds_dst) : "memory"); }
template <int IMM> __device__ __forceinline__ void glds16s(const void* sbase, unsigned voff, unsigned lds_dst) { unsigned keep;
    lds_dst -= (unsigned)IMM;
    asm volatile("s_mov_b32 %0, m0\n\ts_mov_b32 m0, %3\n\ts_nop 0\n\tglobal_load_lds_dwordx4 %1, %2 offset:%c4\n\ts_mov_b32 m0, %0" : "=&s"(keep) : "v"(voff), "s"(sbase), "s"(lds_dst), "i"(IMM) : "memory"); }
template <int MODE> __device__ __forceinline__ void mix_unit(Frame& F, const Args& a, int layer, int b, int hh, int qb, float lam, float lam_init) {
    constexpr int KW = (MODE == 0) ? 128 : 64, VW = (MODE == 1) ? 64 : 128, NEB = VW / 32, NSUB = 1;
    constexpr int KBYTES = 64 * KW * 2, VBYTES = 64 * VW * 2, BUFB = KBYTES + VBYTES, NST = 3;
    constexpr int KD = KBYTES / 1024, VD = VBYTES / 1024, PW = (KD + VD) / 8;
    static_assert(NST * BUFB <= LUTX_OFF && LUTX_OFF + 18 * LUTX_STRIDE * 4 <= RING_BYTES && (KD + VD) % 8 == 0, "mixer LDS ring");
    unsigned char* ws = a.ws; const bf16* PROJ = (const bf16*)(ws + WS_PROJ); bf16* CAT = (bf16*)(ws + WS_CAT);
    const int wave = F.wave; int lane = (int)__builtin_amdgcn_mbcnt_hi(~0u, __builtin_amdgcn_mbcnt_lo(~0u, 0u)); asm volatile("" : "+v"(lane));
    const int tid = wave * 64 + lane, r32 = lane & 31, hi = lane >> 5;
    LAS unsigned char* L = F.lds + RING_OFF;
    const unsigned Lb = (unsigned)(uintptr_t)L;
    LAS float* wsf = (LAS float*)(F.lds + MIX_WSF) + wave * 64;
    const LAS float* lut = (const LAS float*)(F.lds + LUT_OFF);
    const int rowbase = b * SEQ;
    const int q0 = (MODE == 2) ? qb * 256 : qb * 128;
    const int rg = (MODE == 2) ? wave : (wave & 3), wsel = (MODE == 2) ? 0 : (wave >> 2);
    const int qw0 = q0 + 32 * rg;
    const int kcol = (MODE == 0) ? C_AK + hh * 128 : (MODE == 1) ? C_BK + (hh >> 1) * 64 : C_CK + hh * 64;
    const int vcol = (MODE == 0) ? C_AV + hh * 128 : (MODE == 1) ? C_BV + (hh >> 1) * 64 : C_CV + hh * 128;
    const int kch0 = (MODE == 0) ? wsel * 8 : 0;
    const int t_lo = (MODE == 1) ? (qb > 0 ? 2 * qb - 2 : 0) : 0, t_hi = (MODE == 2) ? 4 * qb + 4 : 2 * qb + 2;
    bf16x8 qf[NSUB][4];
#pragma unroll
    for (int s = 0; s < NSUB; ++s) {
        const int qcol = (MODE == 0) ? C_AQ + hh * 128 + wsel * 64 : (MODE == 1) ? C_BQ + (hh * 2 + wsel) * 64 : C_CQ + hh * 64;
        const bf16* qp = PROJ + (size_t)(rowbase + qw0 + r32) * PWP + qcol + hi * 8;
#pragma unroll
        for (int d0 = 0; d0 < 4; ++d0) qf[s][d0] = *(const bf16x8*)(qp + d0 * 16);
    }
    float m_run[NSUB], l_run[NSUB]; f32x16 o[NSUB][NEB];
#pragma unroll
    for (int s = 0; s < NSUB; ++s) {
        m_run[s] = (MODE == 1) ? a.in[5][layer * 12 + hh * 2 + wsel] * LOG2E : -1.0e30f; l_run[s] = (MODE == 1) ? 1.f : 0.f;
#pragma unroll
        for (int e = 0; e < NEB; ++e) o[s][e] = f32x16{};
    }
    const float lg2 = (MODE == 2) ? log2f(1.f - exp2f(-5.f - (float)hh)) : 0.f;
    unsigned dsrc[PW]; unsigned ddst[PW];
#pragma unroll
    for (int i = 0; i < PW; ++i) {
        const int j = wave + 8 * i;
        if (j < KD) {
            int row, ch;
            if (KW == 128) { row = 4 * j + (lane >> 4); ch = (lane & 15) ^ (row & 15); }
            else { row = 8 * j + (lane >> 3); ch = (lane & 7) ^ ((row >> 1) & 7); }
            dsrc[i] = (unsigned)(((rowbase + row) * PWP + kcol + ch * 8) * 2); ddst[i] = (unsigned)(j * 1024);
        } else {
            const int jv = j - KD, eb = jv >> 2, key = 16 * (jv & 3) + 8 * (lane >> 5) + ((lane >> 2) & 7);
            dsrc[i] = (unsigned)(((rowbase + key) * PWP + vcol + eb * 32 + (lane & 3) * 8) * 2); ddst[i] = (unsigned)(KBYTES + jv * 1024);
        }
    }
#define MIX_DMA(t) do { const unsigned st_ = Lb + (unsigned)((((t) - t_lo) % NST) * BUFB); \
        _Pragma("unroll") for (int i_ = 0; i_ < PW; ++i_) glds16((const char*)PROJ + (size_t)(t) * (64 * PWP * 2) + dsrc[i_], (unsigned)__builtin_amdgcn_readfirstlane(st_ + ddst[i_])); } while (0)
    const int vlane = (4 * hi + ((lane & 15) >> 2)) * 64 + ((lane >> 4) & 1) * 32 + (lane & 3) * 8;
    asm volatile("s_waitcnt vmcnt(0)" ::: "memory");
#pragma unroll
    for (int s = 0; s < NSUB; ++s) {
        asm volatile("" : "+v"(m_run[s]));
#pragma unroll
        for (int d0 = 0; d0 < 4; ++d0) asm volatile("" : "+v"(qf[s][d0]));
    }
    MIX_DMA(t_lo);
    if (t_lo + 1 < t_hi) MIX_DMA(t_lo + 1);
#pragma unroll 1
    for (int t = t_lo; t < t_hi; ++t) {
        if (t + 1 < t_hi) { if (PW == 2) asm volatile("s_waitcnt vmcnt(2)" ::: "memory"); else if (PW == 3) asm volatile("s_waitcnt vmcnt(3)" ::: "memory"); else asm volatile("s_waitcnt vmcnt(4)" ::: "memory"); }
        else asm volatile("s_waitcnt vmcnt(0)" ::: "memory");
        asm volatile("s_waitcnt lgkmcnt(0)\n\ts_barrier" ::: "memory");
        if (t + 2 < t_hi) MIX_DMA(t + 2);
        const LAS unsigned char* Kb = L + ((t - t_lo) % NST) * BUFB; const LAS unsigned char* Vb = Kb + KBYTES;
        const int k0 = 64 * t;
        const bool active = (k0 <= qw0 + 31) && (MODE != 1 || k0 + 63 >= qw0 - 127);
        if (active) {
#pragma unroll
            for (int s = 0; s < NSUB; ++s) {
                f32x16 p0 = f32x16{}, p1 = f32x16{};
#pragma unroll
                for (int d0 = 0; d0 < 4; ++d0) {
                    const int ch = kch0 + 2 * d0 + hi;
                    const int ofs = (KW == 128) ? (r32 * 256 + ((ch ^ (r32 & 15)) << 4)) : (r32 * 128 + ((ch ^ ((r32 >> 1) & 7)) << 4));
                    const bf16x8 ka = *(const LAS bf16x8*)(Kb + ofs);
                    const bf16x8 kb2 = *(const LAS bf16x8*)(Kb + 32 * KW * 2 + ofs);
                    p0 = __builtin_amdgcn_mfma_f32_32x32x16_bf16(ka, qf[s][d0], p0, 0, 0, 0);
                    p1 = __builtin_amdgcn_mfma_f32_32x32x16_bf16(kb2, qf[s][d0], p1, 0, 0, 0);
                }
                const int qi = qw0 + r32;
                if (MODE == 2) {
#pragma unroll
                    for (int r = 0; r < 16; ++r) { const int d0_ = qi - (k0 + crow(r, hi)), d1_ = d0_ - 32;
                        const float dec = __builtin_amdgcn_exp2f((float)(qi - (k0 & ~127)) * lg2);
                        p0[r] = d0_ >= 0 ? p0[r] * dec : 0.f; p1[r] = d1_ >= 0 ? p1[r] * dec : 0.f; }
                } else {
                    const bool nearb = (MODE == 1) || (k0 + 63 + 128 > qw0);
                    if (nearb) {
                        const LAS float* lrow = lut + ((MODE == 0) ? hh : 6 + hh * 2 + wsel) * LUT_STRIDE;
#pragma unroll
                        for (int r = 0; r < 16; ++r) { const int d0_ = qi - (k0 + crow(r, hi)), d1_ = d0_ - 32;
                            const bool ok0 = (MODE == 0) ? (d0_ >= 0) : (d0_ >= 0 && d0_ < 128), ok1 = (MODE == 0) ? (d1_ >= 0) : (d1_ >= 0 && d1_ < 128);
                            const int i0_ = d0_ < 0 ? 0 : (d0_ > 128 ? 128 : d0_), i1_ = d1_ < 0 ? 0 : (d1_ > 128 ? 128 : d1_);
                            p0[r] = ok0 ? p0[r] + lrow[i0_] : -INFINITY; p1[r] = ok1 ? p1[r] + lrow[i1_] : -INFINITY; }
                    }
                    float rm = fmaxf(p0[0], p1[0]);
#pragma unroll
                    for (int r = 1; r < 16; ++r) rm = fmaxf(rm, fmaxf(p0[r], p1[r]));
                    rm = fmaxf(rm, __shfl_xor(rm, 32));
                    if (__any(rm > m_run[s] + MIX_THR)) {
                        const float mn = fmaxf(m_run[s], rm), al = __builtin_amdgcn_exp2f(m_run[s] - mn);
                        m_run[s] = mn; l_run[s] *= al;
                        if (hi == 0) wsf[r32] = al;
                        LDS_WAIT();
#pragma unroll
                        for (int r = 0; r < 16; ++r) { const float f = wsf[crow(r, hi)];
#pragma unroll
                            for (int e = 0; e < NEB; ++e) o[s][e][r] *= f; }
                        LDS_WAIT();
                    }
                    float ls = 0.f; const float mm = m_run[s];
#pragma unroll
                    for (int r = 0; r < 16; ++r) { p0[r] = __builtin_amdgcn_exp2f(p0[r] - mm); p1[r] = __builtin_amdgcn_exp2f(p1[r] - mm); ls += p0[r] + p1[r]; }
                    l_run[s] += ls;
                }
                s16x4 vlo[2][NEB], vhi[2][NEB];
#pragma unroll
                for (int e = 0; e < NEB; ++e) { vlo[0][e] = vtr(Vb + e * 4096 + vlane); vhi[0][e] = vtr(Vb + e * 4096 + vlane + 512); }
#pragma unroll
                for (int g = 0; g < 4; ++g) {
                    if (g < 3) {
#pragma unroll
                        for (int e = 0; e < NEB; ++e) { vlo[(g + 1) & 1][e] = vtr(Vb + e * 4096 + (g + 1) * 1024 + vlane); vhi[(g + 1) & 1][e] = vtr(Vb + e * 4096 + (g + 1) * 1024 + vlane + 512); }
                    }
                    const bf16x8 pa = pack_p((g >> 1) == 0 ? p0 : p1, g & 1);
#pragma unroll
                    for (int e = 0; e < NEB; ++e) {
                        const s16x4 lo = vlo[g & 1][e], hh2 = vhi[g & 1][e];
                        const bf16x8 vb = (bf16x8){lo[0], lo[1], lo[2], lo[3], hh2[0], hh2[1], hh2[2], hh2[3]};
                        o[s][e] = __builtin_amdgcn_mfma_f32_32x32x16_bf16(pa, vb, o[s][e], 0, 0, 0);
                    }
                }
                if (NSUB > 1) __builtin_amdgcn_sched_barrier(0);
            }
        }
    }
#undef MIX_DMA
    __syncthreads();
    if (MODE == 1) {
#pragma unroll
        for (int s = 0; s < NSUB; ++s) {
            const float sink2 = a.in[5][layer * 12 + hh * 2 + wsel] * LOG2E;
            const float lt = l_run[s] + __shfl_xor(l_run[s], 32) - __builtin_amdgcn_exp2f(sink2 - m_run[s]);
            if (hi == 0) wsf[r32] = 1.f / lt;
            LDS_WAIT();
            bf16* orow = CAT + (size_t)(rowbase + qw0) * DM + 768 + (hh * 2 + wsel) * 64 + r32;
#pragma unroll
            for (int r = 0; r < 16; ++r) { const int qr = crow(r, hi); const float f = wsf[qr];
#pragma unroll
                for (int e = 0; e < NEB; ++e) orow[(size_t)qr * DM + 32 * e] = (bf16)f2bf(o[s][e][r] * f); }
            LDS_WAIT();
        }
    } else if (MODE == 2) {
        const bf16* grow = PROJ + (size_t)(rowbase + qw0) * PWP + C_CG + hh * 128 + r32;
        bf16* orow = CAT + (size_t)(rowbase + qw0) * DM + 1536 + hh * 128 + r32;
#pragma unroll
        for (int r = 0; r < 16; ++r) {
            float s1 = 0.f;
#pragma unroll
            for (int e = 0; e < NEB; ++e) s1 += o[0][e][r];
#pragma unroll
            for (int sh = 1; sh < 32; sh <<= 1) s1 += __shfl_xor(s1, sh);
            const float mu = s1 * (1.f / 128.f); float s2 = 0.f;
#pragma unroll
            for (int e = 0; e < NEB; ++e) { const float d = o[0][e][r] - mu; s2 += d * d; }
#pragma unroll
            for (int sh = 1; sh < 32; sh <<= 1) s2 += __shfl_xor(s2, sh);
            const float rs = 1.f / sqrtf(s2 * (1.f / 128.f) + LN_EPS); const int qr = crow(r, hi);
#pragma unroll
            for (int e = 0; e < NEB; ++e) orow[(size_t)qr * DM + 32 * e] = (bf16)f2bf(pg8::silu_f(bf2f(grow[(size_t)qr * PWP + 32 * e])) * (o[0][e][r] - mu) * rs);
        }
    } else {
        const float lt = l_run[0] + __shfl_xor(l_run[0], 32);
        if (hi == 0) wsf[r32] = 1.f / lt;
        LDS_WAIT();
        LAS float* xb = (LAS float*)L + rg * 4096;
        if (wsel == 1) {
#pragma unroll
            for (int r = 0; r < 16; ++r) { const float f = wsf[crow(r, hi)];
#pragma unroll
                for (int e = 0; e < NEB; ++e) xb[(e * 16 + r) * 64 + lane] = o[0][e][r] * f; }
        }
        __syncthreads();
        if (wsel == 0) {
            const float* subg = a.in[4] + layer * 128; const float post = 1.f - lam_init;
            bf16* orow = CAT + (size_t)(rowbase + qw0) * DM + hh * 128 + r32;
#pragma unroll
            for (int r = 0; r < 16; ++r) { const float f = wsf[crow(r, hi)]; float d[NEB]; float ss = 0.f;
#pragma unroll
                for (int e = 0; e < NEB; ++e) { d[e] = o[0][e][r] * f - lam * xb[(e * 16 + r) * 64 + lane]; ss += d[e] * d[e]; }
#pragma unroll
                for (int sh = 1; sh < 32; sh <<= 1) ss += __shfl_xor(ss, sh);
                const float rs = (1.f / sqrtf(ss * (1.f / 128.f) + LN_EPS)) * post; const int qr = crow(r, hi);
#pragma unroll
                for (int e = 0; e < NEB; ++e) orow[(size_t)qr * DM + 32 * e] = (bf16)f2bf(d[e] * rs * subg[32 * e + r32]); }
        }
    }
    __syncthreads();
}
constexpr int C2_KR = 0, C2_KT = 16384, C2_VT = 32768, C2_ST = 65536, C2_STATS = 81920, C2_G = 83968;
static_assert(C2_G + 32768 <= RING_BYTES, "chunkwise retention LDS map");
__device__ __forceinline__ void retention_unit(Frame& F, const Args& a, int b, int hh) {
    unsigned char* ws = a.ws; const bf16* PROJ = (const bf16*)(ws + WS_PROJ); bf16* CAT = (bf16*)(ws + WS_CAT);
    const int wave = F.wave; int lane = (int)__builtin_amdgcn_mbcnt_hi(~0u, __builtin_amdgcn_mbcnt_lo(~0u, 0u)); asm volatile("" : "+v"(lane));
    const int r32 = lane & 31, hi = lane >> 5;
    LAS unsigned char* L = F.lds + RING_OFF; const unsigned Lb = (unsigned)(uintptr_t)L;
    const int rowbase = b * SEQ, rg = wave & 3, eh = wave >> 2, dh = wave & 1, eq = wave >> 1;
    const float lg2 = log2f(1.f - exp2f(-5.f - (float)hh));
    const float gq = __builtin_amdgcn_exp2f(lg2 * (float)(32 * rg + r32));
    const float gC = __builtin_amdgcn_exp2f(lg2 * 128.f), gC1 = __builtin_amdgcn_exp2f(lg2 * 127.f);
    unsigned srcKr, srcKt, srcVt;
    { const int row = 8 * wave + (lane >> 3), ch = (lane & 7) ^ ((row >> 1) & 7); srcKr = (unsigned)(((rowbase + row) * PWP + C_CK + hh * 64 + ch * 8) * 2);
      const int key = 16 * wave + 8 * (lane >> 5) + ((lane >> 2) & 7);
      srcKt = (unsigned)(((rowbase + key) * PWP + C_CK + hh * 64 + (lane & 3) * 8) * 2); srcVt = (unsigned)(((rowbase + key) * PWP + C_CV + hh * 128 + (lane & 3) * 8) * 2); }
    const unsigned srcG = (unsigned)(((rowbase + 4 * wave + (lane >> 4)) * PWP + C_CG + hh * 128 + (lane & 15) * 8) * 2);
#define C2_GDMA(n) do { const char* gb_ = (const char*)PROJ + (size_t)(n) * (128 * PWP * 2); const unsigned wg_ = (unsigned)__builtin_amdgcn_readfirstlane(Lb + C2_G + wave * 1024); \
        glds16s<0>(gb_, srcG, wg_); glds16s<0>(gb_ + 32 * PWP * 2, srcG, wg_ + 8192); glds16s<0>(gb_ + 64 * PWP * 2, srcG, wg_ + 16384); glds16s<0>(gb_ + 96 * PWP * 2, srcG, wg_ + 24576); } while (0)
#define C2_DMA(n) do { const char* cb_ = (const char*)PROJ + (size_t)(n) * (128 * PWP * 2); const char* cb2_ = cb_ + 64 * PWP * 2; const unsigned w1k_ = (unsigned)__builtin_amdgcn_readfirstlane(Lb + wave * 1024); \
        glds16s<0>(cb_, srcKr, w1k_ + C2_KR); glds16s<0>(cb2_, srcKr, w1k_ + C2_KR + 8192); \
        glds16s<0>(cb_, srcKt, w1k_ + C2_KT); glds16s<64>(cb_, srcKt, w1k_ + C2_KT + 8192); \
        glds16s<0>(cb_, srcVt, w1k_ + C2_VT); glds16s<64>(cb_, srcVt, w1k_ + C2_VT + 8192); glds16s<128>(cb_, srcVt, w1k_ + C2_VT + 16384); glds16s<192>(cb_, srcVt, w1k_ + C2_VT + 24576); } while (0)
    const int vlane = (4 * hi + ((lane & 15) >> 2)) * 64 + ((lane >> 4) & 1) * 32 + (lane & 3) * 8;
    const int krow = r32 * 128, kkey = (r32 >> 1) & 7;
    f32x16 Sb = f32x16{};
    bf16x8 qf[4];
    { const bf16* qbase = PROJ + (size_t)(rowbase + 32 * rg + r32) * PWP + C_CQ + hh * 64 + hi * 8;
#pragma unroll
      for (int d0 = 0; d0 < 4; ++d0) qf[d0] = *(const bf16x8*)(qbase + d0 * 16); }
    asm volatile("s_waitcnt vmcnt(0)" ::: "memory");
#pragma unroll
    for (int d0 = 0; d0 < 4; ++d0) asm volatile("" : "+v"(qf[d0]));
    C2_DMA(0);
#pragma unroll 1
    for (int n = 0; n < 16; ++n) {
        asm volatile("s_waitcnt vmcnt(0) lgkmcnt(0)\n\ts_barrier" ::: "memory");
        C2_GDMA(n);
        f32x16 o[2]; o[0] = f32x16{}; o[1] = f32x16{};
        for (int kb = 0; kb <= rg; ++kb) {
            f32x16 T = f32x16{};
#pragma unroll
            for (int d0 = 0; d0 < 4; ++d0) {
                const bf16x8 ka = *(const LAS bf16x8*)(L + C2_KR + kb * 4096 + krow + (((2 * d0 + hi) ^ kkey) << 4));
                T = __builtin_amdgcn_mfma_f32_32x32x16_bf16(ka, qf[d0], T, 0, 0, 0);
            }
#pragma unroll
            for (int r = 0; r < 16; ++r) T[r] = (kb == rg && crow(r, hi) > r32) ? 0.f : T[r] * gq;
#pragma unroll
            for (int s2 = 0; s2 < 2; ++s2) {
                const bf16x8 pa = pack_p(T, s2);
#pragma unroll
                for (int e = 0; e < 2; ++e) {
                    const LAS unsigned char* vp = L + C2_VT + (2 * eh + e) * 8192 + (4 * kb + 2 * s2) * 512 + vlane;
                    const s16x4 lo = vtr(vp), h2 = vtr(vp + 512);
                    const bf16x8 vb = (bf16x8){lo[0], lo[1], lo[2], lo[3], h2[0], h2[1], h2[2], h2[3]};
                    o[e] = __builtin_amdgcn_mfma_f32_32x32x16_bf16(pa, vb, o[e], 0, 0, 0);
                }
                __builtin_amdgcn_sched_barrier(0);
            }
        }
        __builtin_amdgcn_sched_barrier(0);
        if (n > 0) {
            f32x16 oc[2]; oc[0] = f32x16{}; oc[1] = f32x16{};
#pragma unroll
            for (int d0 = 0; d0 < 4; ++d0)
#pragma unroll
                for (int e = 0; e < 2; ++e) {
                    const bf16x8 sb = *(const LAS bf16x8*)(L + C2_ST + (2 * eh + e) * 4096 + krow + (((2 * d0 + hi) ^ kkey) << 4));
                    oc[e] = __builtin_amdgcn_mfma_f32_32x32x16_bf16(qf[d0], sb, oc[e], 0, 0, 0);
                }
#pragma unroll
            for (int r = 0; r < 16; ++r) { const float xi = __builtin_amdgcn_exp2f(lg2 * (float)(32 * rg + crow(r, hi) + 1)); o[0][r] += xi * oc[0][r]; o[1][r] += xi * oc[1][r]; }
        }
        __builtin_amdgcn_sched_barrier(0);
        {
            f32x16 kv = f32x16{};
#pragma unroll
            for (int g = 0; g < 8; ++g) {
                const LAS unsigned char* kp = L + C2_KT + dh * 8192 + (2 * g) * 512 + vlane; const LAS unsigned char* vp = L + C2_VT + eq * 8192 + (2 * g) * 512 + vlane;
                const s16x4 kl = vtr(kp), kh2 = vtr(kp + 512), vl = vtr(vp), vh2 = vtr(vp + 512);
                const bf16x8 ka = (bf16x8){kl[0], kl[1], kl[2], kl[3], kh2[0], kh2[1], kh2[2], kh2[3]}, vb = (bf16x8){vl[0], vl[1], vl[2], vl[3], vh2[0], vh2[1], vh2[2], vh2[3]};
                kv = __builtin_amdgcn_mfma_f32_32x32x16_bf16(ka, vb, kv, 0, 0, 0);
                if (g & 1) __builtin_amdgcn_sched_barrier(0);
            }
#pragma unroll
            for (int r = 0; r < 16; ++r) Sb[r] = gC * Sb[r] + gC1 * kv[r];
        }
        __builtin_amdgcn_sched_barrier(0);
        if (n + 1 < 16) {
            int l2 = lane; asm volatile("" : "+v"(l2));
            const bf16* qn = PROJ + (size_t)(rowbase + 128 * (n + 1) + 32 * rg + (l2 & 31)) * PWP + C_CQ + hh * 64 + (l2 >> 5) * 8;
#pragma unroll
            for (int d0 = 0; d0 < 4; ++d0) qf[d0] = *(const bf16x8*)(qn + d0 * 16);
        }
        LAS float* st = (LAS float*)(L + C2_STATS);
#pragma unroll
        for (int r4 = 0; r4 < 4; ++r4) {
            float s1[4], s2[4];
#pragma unroll
            for (int i = 0; i < 4; ++i) { const int r = 4 * r4 + i; s1[i] = o[0][r] + o[1][r]; s2[i] = o[0][r] * o[0][r] + o[1][r] * o[1][r]; }
#pragma unroll
            for (int sh = 1; sh < 32; sh <<= 1)
#pragma unroll
                for (int i = 0; i < 4; ++i) { s1[i] += __shfl_xor(s1[i], sh); s2[i] += __shfl_xor(s2[i], sh); }
            if (r32 == 0) {
#pragma unroll
                for (int i = 0; i < 4; ++i) { const int qr = crow(4 * r4 + i, hi); st[((rg * 2 + eh) * 32 + qr) * 2 + 0] = s1[i]; st[((rg * 2 + eh) * 32 + qr) * 2 + 1] = s2[i]; }
            }
            __builtin_amdgcn_sched_barrier(0);
        }
        __builtin_amdgcn_sched_barrier(0);
        asm volatile("s_waitcnt vmcnt(0) lgkmcnt(0)\n\ts_barrier" ::: "memory");
        if (n + 1 < 16) C2_DMA(n + 1);
        {
            const int e_ = 32 * eq + r32;
#pragma unroll
            for (int q4 = 0; q4 < 4; ++q4) { v2u w; w.x = cvtpk_s(Sb[4 * q4 + 0], Sb[4 * q4 + 1]); w.y = cvtpk_s(Sb[4 * q4 + 2], Sb[4 * q4 + 3]);
                *(LAS v2u*)(L + C2_ST + e_ * 128 + (((4 * dh + q4) ^ ((e_ >> 1) & 7)) << 4) + 8 * hi) = w; }
        }
        asm volatile("s_waitcnt lgkmcnt(0)\n\ts_barrier" ::: "memory");
        {
            const LAS bf16* grow = (const LAS bf16*)(L + C2_G) + (32 * rg) * 128 + 64 * eh + r32;
            bf16* orow = CAT + (size_t)(rowbase + 128 * n + 32 * rg) * DM + 1536 + hh * 128 + 64 * eh + r32;
#pragma unroll
            for (int r = 0; r < 16; ++r) {
                const int qr = crow(r, hi);
                const float t1 = st[((rg * 2) * 32 + qr) * 2 + 0] + st[((rg * 2 + 1) * 32 + qr) * 2 + 0], t2 = st[((rg * 2) * 32 + qr) * 2 + 1] + st[((rg * 2 + 1) * 32 + qr) * 2 + 1];
                const float mu = t1 * (1.f / 128.f), var = fmaxf(t2 * (1.f / 128.f) - mu * mu, 0.f), rs = 1.f / sqrtf(var + LN_EPS);
#pragma unroll
                for (int e = 0; e < 2; ++e) orow[(size_t)qr * DM + 32 * e] = (bf16)f2bf(pg8::silu_f(bf2f(grow[qr * 128 + 32 * e])) * (o[e][r] - mu) * rs);
                if ((r & 3) == 3) __builtin_amdgcn_sched_barrier(0);
            }
        }
    }
#undef C2_DMA
#undef C2_GDMA
    __syncthreads();
}
constexpr int B2_K = 0, B2_V = 32768;
__device__ __forceinline__ void swa_unit(Frame& F, const Args& a, int layer, int b, int kvh, int qb) {
    unsigned char* ws = a.ws; const bf16* PROJ = (const bf16*)(ws + WS_PROJ); bf16* CAT = (bf16*)(ws + WS_CAT);
    const int wave = F.wave; int lane = (int)__builtin_amdgcn_mbcnt_hi(~0u, __builtin_amdgcn_mbcnt_lo(~0u, 0u)); asm volatile("" : "+v"(lane));
    const int r32 = lane & 31, hi = lane >> 5;
    LAS unsigned char* L = F.lds + RING_OFF; const unsigned Lb = (unsigned)(uintptr_t)L;
    LAS float* wsf = (LAS float*)(F.lds + MIX_WSF) + wave * 64;
    const LAS float* lut = (const LAS float*)(F.lds + LUT_OFF);
    const int rowbase = b * SEQ, q0 = qb * 128;
    const int tl0 = (qb == 0) ? 2 : 0;
    unsigned srcK, srcV;
    { const int row = 8 * wave + (lane >> 3), ch = (lane & 7) ^ ((row >> 1) & 7); srcK = (unsigned)(((rowbase + q0 + row) * PWP + C_BK + kvh * 64 + ch * 8) * 2);
      const int key = 16 * (wave & 3) + 8 * (lane >> 5) + ((lane >> 2) & 7); srcV = (unsigned)(((rowbase + q0 + key) * PWP + C_BV + kvh * 64 + (wave >> 2) * 32 + (lane & 3) * 8) * 2); }
    {
        const unsigned wk = (unsigned)__builtin_amdgcn_readfirstlane(Lb + wave * 1024);
        for (int tl = tl0; tl < 4; ++tl) {
            const char* tb = (const char*)PROJ + (long)(tl - 2) * (64 * PWP * 2);
            glds16s<0>(tb, srcK, wk + B2_K + tl * 8192); glds16s<0>(tb, srcV, wk + B2_V + tl * 8192);
        }
    }
    const int vlane = (4 * hi + ((lane & 15) >> 2)) * 64 + ((lane >> 4) & 1) * 32 + (lane & 3) * 8;
    const int kofs0 = r32 * 128, kkey = (r32 >> 1) & 7;
    const int rg = wave & 3, qw0 = q0 + 32 * rg;
    bf16x8 qf[2][4]; float sink2[2], m_run[2], l_run[2]; f32x16 o[2][2]; const LAS float* lrow[2];
#pragma unroll
    for (int s = 0; s < 2; ++s) {
        const int hq = kvh * 4 + (wave >> 2) + 2 * s;
        const bf16* qp = PROJ + (size_t)(rowbase + qw0 + r32) * PWP + C_BQ + hq * 64 + hi * 8;
#pragma unroll
        for (int d0 = 0; d0 < 4; ++d0) qf[s][d0] = *(const bf16x8*)(qp + d0 * 16);
        sink2[s] = a.in[5][layer * 12 + hq] * LOG2E; m_run[s] = sink2[s]; l_run[s] = 1.f; o[s][0] = f32x16{}; o[s][1] = f32x16{};
        lrow[s] = lut + (6 + hq) * LUT_STRIDE;
    }
    asm volatile("s_waitcnt vmcnt(0)" ::: "memory"); __syncthreads();
    const int t_a = (rg < 2) ? 0 : 1;
    for (int tl = (t_a < tl0 ? tl0 : t_a); tl < t_a + 3; ++tl) {
        const LAS unsigned char* Kb = L + B2_K + tl * 8192; const LAS unsigned char* Vb = L + B2_V + tl * 8192;
        const int k0 = q0 - 128 + 64 * tl;
        f32x16 p0[2], p1[2]; p0[0] = f32x16{}; p0[1] = f32x16{}; p1[0] = f32x16{}; p1[1] = f32x16{};
#pragma unroll
        for (int d0 = 0; d0 < 4; ++d0) {
            const int ofs = kofs0 + (((2 * d0 + hi) ^ kkey) << 4);
            const bf16x8 ka = *(const LAS bf16x8*)(Kb + ofs), kb2 = *(const LAS bf16x8*)(Kb + 4096 + ofs);
#pragma unroll
            for (int s = 0; s < 2; ++s) { p0[s] = __builtin_amdgcn_mfma_f32_32x32x16_bf16(ka, qf[s][d0], p0[s], 0, 0, 0); p1[s] = __builtin_amdgcn_mfma_f32_32x32x16_bf16(kb2, qf[s][d0], p1[s], 0, 0, 0); }
        }
        const int qi = qw0 + r32;
#pragma unroll
        for (int r = 0; r < 16; ++r) { const int d0_ = qi - (k0 + crow(r, hi)), d1_ = d0_ - 32;
            const bool ok0 = (d0_ >= 0 && d0_ < 128), ok1 = (d1_ >= 0 && d1_ < 128);
            const int i0_ = d0_ < 0 ? 0 : (d0_ > 128 ? 128 : d0_), i1_ = d1_ < 0 ? 0 : (d1_ > 128 ? 128 : d1_);
#pragma unroll
            for (int s = 0; s < 2; ++s) { p0[s][r] = ok0 ? p0[s][r] + lrow[s][i0_] : -INFINITY; p1[s][r] = ok1 ? p1[s][r] + lrow[s][i1_] : -INFINITY; } }
#pragma unroll
        for (int s = 0; s < 2; ++s) {
            float rm = fmaxf(p0[s][0], p1[s][0]);
#pragma unroll
            for (int r = 1; r < 16; ++r) rm = fmaxf(rm, fmaxf(p0[s][r], p1[s][r]));
            rm = fmaxf(rm, __shfl_xor(rm, 32));
            if (__any(rm > m_run[s] + MIX_THR)) {
                const float mn = fmaxf(m_run[s], rm), al = __builtin_amdgcn_exp2f(m_run[s] - mn);
                m_run[s] = mn; l_run[s] *= al;
                if (hi == 0) wsf[r32] = al;
                LDS_WAIT();
#pragma unroll
                for (int r = 0; r < 16; ++r) { const float f = wsf[crow(r, hi)]; o[s][0][r] *= f; o[s][1][r] *= f; }
                LDS_WAIT();
            }
            float ls = 0.f;
#pragma unroll
            for (int r = 0; r < 16; ++r) { p0[s][r] = __builtin_amdgcn_exp2f(p0[s][r] - m_run[s]); p1[s][r] = __builtin_amdgcn_exp2f(p1[s][r] - m_run[s]); ls += p0[s][r] + p1[s][r]; }
            l_run[s] += ls;
        }
#pragma unroll
        for (int gq = 0; gq < 4; ++gq) {
            bf16x8 pa[2];
#pragma unroll
            for (int s = 0; s < 2; ++s) pa[s] = pack_p((gq >> 1) == 0 ? p0[s] : p1[s], gq & 1);
#pragma unroll
            for (int e = 0; e < 2; ++e) {
                const LAS unsigned char* vp = Vb + e * 4096 + gq * 1024 + vlane;
                const s16x4 lo = vtr(vp), h2 = vtr(vp + 512);
                const bf16x8 vb = (bf16x8){lo[0], lo[1], lo[2], lo[3], h2[0], h2[1], h2[2], h2[3]};
#pragma unroll
                for (int s = 0; s < 2; ++s) o[s][e] = __builtin_amdgcn_mfma_f32_32x32x16_bf16(pa[s], vb, o[s][e], 0, 0, 0);
            }
        }
    }
#pragma unroll
    for (int s = 0; s < 2; ++s) {
        const int hq = kvh * 4 + (wave >> 2) + 2 * s;
        const float lt = l_run[s] + __shfl_xor(l_run[s], 32) - __builtin_amdgcn_exp2f(sink2[s] - m_run[s]);
        if (hi == 0) wsf[r32] = 1.f / lt;
        LDS_WAIT();
        bf16* orow = CAT + (size_t)(rowbase + qw0) * DM + 768 + hq * 64 + r32;
#pragma unroll
        for (int r = 0; r < 16; ++r) { const int qr = crow(r, hi); const float f = wsf[qr]; orow[(size_t)qr * DM] = (bf16)f2bf(o[s][0][r] * f); orow[(size_t)qr * DM + 32] = (bf16)f2bf(o[s][1][r] * f); }
        LDS_WAIT();
    }
    __syncthreads();
}
template <int MODE> __device__ __forceinline__ void mixer_queue(Frame& F, const Args& a, int layer, int qword, float lam, float lam_init) {
    constexpr int NU = (MODE == 0) ? 768 : (MODE == 1) ? 384 : (MODE == 3) ? 32 : 256;
    LAS int* qw = (LAS int*)(F.lds + MIX_QW);
    for (;;) {
        if (F.tid == 0) *qw = (int)__hip_atomic_fetch_add(F.ctl + CW_WQ + 64 * qword, 1u, RLX_AGENT);
        __syncthreads();
        const int it = __builtin_amdgcn_readfirstlane(*qw);
        __syncthreads();
        if (it >= NU) break;
        if (MODE == 3) retention_unit(F, a, it >> 2, it & 3);
        else if (MODE == 0) mix_unit<0>(F, a, layer, (it % 48) / 6, it % 6, 15 - it / 48, lam, lam_init);
        else if (MODE == 2) mix_unit<2>(F, a, layer, (it & 31) >> 2, it & 3, 7 - (it >> 5), lam, lam_init);
        else swa_unit(F, a, layer, it / 48, (it % 48) / 16, it & 15);
    }
}
__device__ __forceinline__ void mixer_phase(Frame& F, const Args& a, int layer, int rep) {
    const int qbase = 3 * (layer + 2 * rep);
    mixer_queue<3>(F, a, layer, qbase + 0, 0.f, 0.f);
    asm volatile("" ::: "memory");
    const float lam_init = 0.8f - 0.6f * __expf(-0.3f * (float)layer);
    const float lam = __builtin_bit_cast(float, __builtin_amdgcn_readfirstlane(__builtin_bit_cast(int, lambda_of(a.in[3] + layer * 256, F.lane, lam_init))));
    mixer_queue<0>(F, a, layer, qbase + 1, lam, lam_init);
    mixer_queue<1>(F, a, layer, qbase + 2, lam, lam_init);
}
#ifndef MIXER_NAIVE
#define MIXER_NAIVE 0
#endif
#ifndef PROBE_P0
#define PROBE_P0 1
#endif
#ifndef PROBE_MIX
#define PROBE_MIX 1
#endif
#ifndef PROBE_PROJ
#define PROBE_PROJ 1
#endif
#ifndef PROBE_DUP
#define PROBE_DUP 1
#endif
#ifndef PROBE_MUP
#define PROBE_MUP 1
#endif
#ifndef PROBE_MDN
#define PROBE_MDN 1
#endif
#ifndef PROBE_SPIN_PHASE
#define PROBE_SPIN_PHASE -1
#endif
#define PH_BEGIN(k) do { if (PROBE_SPIN_PHASE == (k)) spin_t0 = __builtin_amdgcn_s_memrealtime(); } while (0)
#define PH_END(k) do { if (PROBE_SPIN_PHASE == (k)) spin_dt = __builtin_amdgcn_s_memrealtime() - spin_t0; } while (0)
#define REPEAT(N) for (int rep = 0; rep < (N); ++rep)
#define TWICE_IF(N, CALL) do { CALL; if ((N) == 2) { xcd_barrier(bar); CALL; } } while (0)
#define REPBAR(N) do { if (rep + 1 < (N)) xcd_barrier(bar); } while (0)
#define IN(k) (lo <= (k) && (k) < hi)
#define SEAM(k) do { if (IN(k) && IN((k) + 1)) xcd_barrier(bar); } while (0)
template <int l> __device__ __forceinline__ void run_layer(Frame& F, const Args& args, const XcdBarrier& bar, int lo, int hi, unsigned long long& spin_t0, unsigned long long& spin_dt) {
    unsigned char* ws = args.ws;
    bf16* XB = (bf16*)(ws + WS_XB); bf16* PROJ = (bf16*)(ws + WS_PROJ); bf16* CAT = (bf16*)(ws + WS_CAT); bf16* HB = (bf16*)(ws + WS_H);
    float* T = args.out;
        const int pb = 1 + 7 * l;
        PH_BEGIN(pb); if (IN(pb)) {
            pg8::Gemm g{XB, (const bf16*)(ws + WS_WIN) + (size_t)l * PWP * DM, NTOK, PWP, DM * 2}; pg8::StaticOrder S; S.init(NTOK, PWP, F.G, (int)blockIdx.x);
            pg8::EpiProj E{PROJ, (const float*)(ws + WS_TAB), (const float*)(ws + WS_TAB + 256 * 1024)};
            TWICE_IF(PROBE_PROJ, (pg8::gemm_phase<pg8::EpiProj, pg8::StaticOrder, true, true>(F.lds + RING_OFF, F.wave, g, S, E)));
        } SEAM(pb); PH_END(pb);
        PH_BEGIN(pb + 1); if (IN(pb + 1)) {
#if MIXER_NAIVE
            naive_mixers(F, args, l);
#else
            REPEAT(PROBE_MIX) { mixer_phase(F, args, l, rep); REPBAR(PROBE_MIX); }
#endif
        } SEAM(pb + 1); PH_END(pb + 1);
        PH_BEGIN(pb + 2); if (IN(pb + 2)) {
            pg8::Gemm g{CAT, (const bf16*)(ws + WS_WOUT) + (size_t)l * DM * DM, NTOK, DM, DM * 2}; pg8::StaticOrder S; S.init(NTOK, DM, F.G, (int)blockIdx.x);
            pg8::EpiResid E{T, XB, 1.f};
            pg8::gemm_phase<pg8::EpiResid, pg8::StaticOrder, true, true>(F.lds + RING_OFF, F.wave, g, S, E);
        } SEAM(pb + 2); PH_END(pb + 2);
        if constexpr (l == 0) {
            PH_BEGIN(4); if (IN(4)) { ln_phase<0>(F, args, T, args.in[7], args.in[8], nullptr); } SEAM(4); PH_END(4);
            PH_BEGIN(5); if (IN(5)) {
                pg8::Gemm g{XB, (const bf16*)(ws + WS_WDGU), NTOK, 2 * DFF, DM * 2}; pg8::StaticOrder S; S.init(NTOK, 2 * DFF, F.G, (int)blockIdx.x);
                pg8::EpiSwiGLU8 E{ws + WS_H, 44, 1.f};
                TWICE_IF(PROBE_DUP, (pg8::gemm_phase<pg8::EpiSwiGLU8, pg8::StaticOrder, true, true, false>(F.lds + RING_OFF, F.wave, g, S, E)));
            } SEAM(5); PH_END(5);
            PH_BEGIN(6); if (IN(6)) {
                pg8::Gemm g{ws + WS_H, ws + WS_WDDN, NTOK, DM, DFF}; pg8::StaticOrder S; S.init(NTOK, DM, F.G, (int)blockIdx.x);
                pg8::EpiResid E{T, XB, 1.f / (pg8::FP8_SH * pg8::FP8_SWD)};
                pg8::gemm_phase<pg8::EpiResid, pg8::StaticOrder, true, true, true>(F.lds + RING_OFF, F.wave, g, S, E);
            } SEAM(6); PH_END(6);
            PH_BEGIN(7); if (IN(7)) { ln_phase<0>(F, args, T, args.in[9], args.in[10], nullptr); } SEAM(7); PH_END(7);
        } else {
            PH_BEGIN(11); if (IN(11)) { ln_phase<1>(F, args, T, args.in[7] + DM, args.in[8] + DM, args.in[14]); } SEAM(11); PH_END(11);
            PH_BEGIN(12); if (IN(12)) { gather_phase(F, args, T); } SEAM(12); PH_END(12);
            if (IN(13) || IN(14) || IN(15)) {
                int ntl_v; const int offv = expert_offsets(F, ntl_v); const int ntl = __builtin_amdgcn_readfirstlane(ntl_v);
                pg8::GroupedOrder S; S.nM = ntl; S.pm0 = 0; S.G = F.G; S.c = (int)blockIdx.x;
#pragma unroll
                for (int e = 0; e < 8; ++e) S.cum[e] = (e < 7) ? __builtin_amdgcn_readfirstlane(__shfl(offv, e + 1) >> 8) : ntl;
                PH_BEGIN(13); if (IN(13)) {
                    S.nN = 44; S.nwg = ntl * 44;
                    pg8::Gemm g{ws + WS_XG, ws + WS_WMGU, ntl * 256, 8 * 2 * DFF, DM};
                    pg8::EpiSwiGLU8 E{ws + WS_H, 44, 1.f / (pg8::FP8_SX * pg8::FP8_SWU)};
                    TWICE_IF(PROBE_MUP, (pg8::gemm_phase<pg8::EpiSwiGLU8, pg8::GroupedOrder, true, true, true>(F.lds + RING_OFF, F.wave, g, S, E)));
                } SEAM(13); PH_END(13);
                PH_BEGIN(14); if (IN(14)) {
                    S.nN = 8; S.pm0 = 0; S.nM = ntl < 128 ? ntl : 128; S.nwg = S.nM * 8;
                    pg8::Gemm g{ws + WS_H, ws + WS_WMDN, ntl * 256, 8 * DM, DFF};
                    pg8::EpiY E{(bf16*)(ws + WS_Y), 8, 1.f / (pg8::FP8_SH * pg8::FP8_SWD)};
                    TWICE_IF(PROBE_MDN, (pg8::gemm_phase<pg8::EpiY, pg8::GroupedOrder, true, true, true>(F.lds + RING_OFF, F.wave, g, S, E)));
                } SEAM(14); PH_END(14);
                PH_BEGIN(15); if (IN(15)) {
                    S.nN = 8; S.pm0 = 128; S.nM = ntl > 128 ? ntl - 128 : 0; S.nwg = S.nM * 8;
                    if (S.nwg > 0) {
                        pg8::Gemm g{ws + WS_H, ws + WS_WMDN, ntl * 256, 8 * DM, DFF};
                        pg8::EpiY E{(bf16*)(ws + WS_Y), 8, 1.f / (pg8::FP8_SH * pg8::FP8_SWD)};
                        pg8::gemm_phase<pg8::EpiY, pg8::GroupedOrder, true, true, true>(F.lds + RING_OFF, F.wave, g, S, E);
                    }
                    {
                        LAS int* qw = (LAS int*)(F.lds + MIX_QW);
                        for (;;) {
                            if (F.tid == 0) *qw = (int)__hip_atomic_fetch_add(F.ctl + CW_WQ + 64 * 12, 1u, RLX_AGENT);
                            __syncthreads();
                            const int grp64 = __builtin_amdgcn_readfirstlane(*qw);
                            __syncthreads();
                            if (grp64 >= NTOK / 64) break;
                            ln_phase<2>(F, args, T, args.in[9] + DM, args.in[10] + DM, nullptr, grp64 * 64 + F.wave * 8, 1);
                        }
                    }
                    xcd_barrier(bar);
                    ln_phase<2>(F, args, T, args.in[9] + DM, args.in[10] + DM, nullptr, -1, 2);
                } PH_END(15);
            }
        }
}
constexpr int N_PHASES = 16;
__global__ void __launch_bounds__(NWAVES * 64, 2) hymba_fwd(Args args) {
    extern __shared__ __attribute__((aligned(16))) unsigned char lds[];
    Frame F;
    F.lds = (LAS unsigned char*)lds;
    volatile LAS unsigned* MISC = (volatile LAS unsigned*)(F.lds + MISC_OFF);
    F.wave = __builtin_amdgcn_readfirstlane((int)threadIdx.x >> 6); F.lane = (int)__builtin_amdgcn_mbcnt_hi(~0u, __builtin_amdgcn_mbcnt_lo(~0u, 0u)); F.tid = F.wave * 64 + F.lane;
    F.G = gridDim.x; { const int bx = blockIdx.x; F.vcu = (F.G % 8 == 0) ? (bx % 8) * (F.G / 8) + bx / 8 : bx; }
    unsigned char* ws = args.ws;
    F.ctl = (gu32*)(ws + WS_CTL);
    for (int u = F.tid; u < 1024 / 4; u += NWAVES * 64) ((LAS unsigned*)(F.lds + LDSCTL_OFF))[u] = 0u;
    __syncthreads();
    XcdBarrier bar = xcd_barrier_post((unsigned*)(F.ctl + CW_BAR) + args.li * 4096, MISC + 8);
    build_lut(F, args.in[2]);
    __syncthreads();
    const int lo = args.ph_lo, hi = args.ph_hi;
    unsigned long long spin_t0 = 0ull, spin_dt = 0ull;
    PH_BEGIN(0); if (IN(0)) { REPEAT(PROBE_P0) { p0_prologue(F, args); REPBAR(PROBE_P0); } } SEAM(0); PH_END(0);
    run_layer<0>(F, args, bar, lo, hi, spin_t0, spin_dt);
    run_layer<1>(F, args, bar, lo, hi, spin_t0, spin_dt);
    if (PROBE_SPIN_PHASE >= 0 && blockIdx.x == 0) { const unsigned long long te = __builtin_amdgcn_s_memrealtime() + 10ull * spin_dt; while (__builtin_amdgcn_s_memrealtime() < te) __builtin_amdgcn_s_sleep(16); }
#undef IN
#undef SEAM
}

#ifndef N_LAUNCHES
#define N_LAUNCHES 1
#endif
extern "C" void kernel_launch(void* const* d_in, const int* in_sizes, int n_in, void* d_out, int out_size, void* d_ws, size_t ws_size, hipStream_t stream) {
    static int grid = 0;
    if (grid == 0) {
        if (n_in != 18 || in_sizes[0] != NTOK * DM || out_size != NTOK * DM || ws_size < WS_END) { fprintf(stderr, "kernel_launch: unexpected shapes / workspace (%d inputs, ws %zu < %zu)\n", n_in, ws_size, (size_t)WS_END); grid = -1; return; }
        int dev = 0, cus = 0, per_cu = 0;
        if (hipGetDevice(&dev) != hipSuccess || hipDeviceGetAttribute(&cus, hipDeviceAttributeMultiprocessorCount, dev) != hipSuccess) { grid = -1; return; }
        if (hipFuncSetAttribute((const void*)hymba_fwd, hipFuncAttributeMaxDynamicSharedMemorySize, LDS_BYTES) != hipSuccess) { fprintf(stderr, "kernel_launch: hipFuncSetAttribute failed\n"); grid = -1; return; }
        if (hipOccupancyMaxActiveBlocksPerMultiprocessor(&per_cu, (const void*)hymba_fwd, NWAVES * 64, LDS_BYTES) != hipSuccess || per_cu < 1) fprintf(stderr, "kernel_launch: occupancy query reports %d\n", per_cu);
        (void)hipGetLastError();
        grid = (cus == 256) ? 256 : -1;
        if (grid < 0) { fprintf(stderr, "kernel_launch: built for a 256-CU device, found %d CUs\n", cus); return; }
    }
    if (grid < 0) return;
    if (hipMemsetAsync((char*)d_ws + WS_CTL, 0, CTL_ZERO_BYTES, stream) != hipSuccess) return;
    Args a{};
    for (int i = 0; i < 18; ++i) a.in[i] = (const float*)d_in[i];
    a.out = (float*)d_out; a.ws = (unsigned char*)d_ws;
    for (int i = 0; i < 32; ++i) a.invf[i] = (float)(1.0 / pow(10000.0, (double)((float)i / 31.0f)));
#if N_LAUNCHES == 1
    const int cuts[2] = {0, N_PHASES};
#else
    int cuts[N_PHASES + 1]; for (int i = 0; i <= N_PHASES; ++i) cuts[i] = i;
#endif
    const int nl = (N_LAUNCHES == 1) ? 1 : N_PHASES;
    for (int li = 0; li < nl; ++li) {
        a.ph_lo = cuts[li]; a.ph_hi = cuts[li + 1]; a.li = li; a.pad = 0;
        hipLaunchKernelGGL(hymba_fwd, dim3(grid), dim3(NWAVES * 64), LDS_BYTES, stream, a);
        const hipError_t le = hipPeekAtLastError();
        if (le != hipSuccess) { fprintf(stderr, "kernel_launch: launch %d failed: %s\n", li, hipGetErrorName(le)); break; }
    }
}
```

```cpp
#include <hip/hip_runtime.h>
#include <cstdio>
#include <cstdint>
#include <cmath>
namespace pg8 {
#define PG8_LAS __attribute__((address_space(3)))
typedef unsigned short bf16_t;
typedef short bf16x8 __attribute__((ext_vector_type(8)));
typedef float f32x4 __attribute__((ext_vector_type(4)));
typedef unsigned u32x4 __attribute__((ext_vector_type(4)));
constexpr int BM = 256, BK = 64, HALF = 128, HTB = HALF * BK * 2  , STAGE_BYTES = 8 * HTB, NXCD = 8, WGM = 8;

__host__ __device__ __forceinline__ int lds_byte(int r, int c) { const int st = (r >> 4) * 2 + (c >> 5), rr = r & 15, cc = c & 31, ob = rr * 64 + cc * 2; return st * 1024 + (ob ^ (((ob >> 9) & 1) << 5)); }
__host__ __device__ __forceinline__ void stage_rc(int b, int& R, int& C) { const int st = b / 1024, sb = b % 1024, swz = sb ^ (((sb >> 9) & 1) << 5); R = (st >> 1) * 16 + swz / 64; C = (st & 1) * 32 + (swz % 64) / 2; }
__host__ __device__ __forceinline__ int perm32(int rho) { const int n = rho >> 4, i = rho & 15; return 8 * (i >> 2) + 4 * n + (i & 3); }

struct Unit { int pm, pn; };
struct Gemm { const void* A; const void* Bt; int M, N, KB; };
typedef int v4i_t __attribute__((ext_vector_type(4)));
typedef int v8i_t __attribute__((ext_vector_type(8)));

struct StaticOrder {
    int nM, nN, nwg, G, c;
    __host__ __device__ void init(int M, int N, int G_, int c_) { nM = M / BM; nN = N / BM; nwg = nM * nN; G = G_; c = c_; }
    __host__ __device__ bool next(int i, Unit& u) const {
        const long L = (long)i * G + c; if (L >= nwg) return false;
        int wgid = (int)L; { const int q = nwg / NXCD, r = nwg % NXCD, xcd = wgid % NXCD, off = wgid / NXCD; wgid = (xcd < r ? xcd * (q + 1) : r * (q + 1) + (xcd - r) * q) + off; }
        const int nig = WGM * nN, gid = wgid / nig, fm = gid * WGM, gsz = (nM - fm) < WGM ? (nM - fm) : WGM;
        u.pm = fm + ((wgid % nig) % gsz); u.pn = (wgid % nig) / gsz; return true;
    }
    __device__ __forceinline__ void a_ready(const Unit&) const {}
    __device__ __forceinline__ void done(const Unit&) const {}
};

__device__ __forceinline__ unsigned cvt_pk_bf16(float lo, float hi) { unsigned r; asm volatile("v_cvt_pk_bf16_f32 %0, %1, %2" : "=v"(r) : "v"(lo), "v"(hi)); return r; }
typedef float f32x2 __attribute__((ext_vector_type(2)));
typedef float f32x2 __attribute__((ext_vector_type(2)));
typedef unsigned u32x2 __attribute__((ext_vector_type(2)));
constexpr float ALPHA_F = 1.41421356237309515f;
constexpr float C2_F = 0.125f * 1.4426950408889634f;
__device__ __forceinline__ u32x4 pack8(const f32x4 v0, const f32x4 v1) { u32x4 w; w.x = cvt_pk_bf16(v0[0], v0[1]); w.y = cvt_pk_bf16(v0[2], v0[3]); w.z = cvt_pk_bf16(v1[0], v1[1]); w.w = cvt_pk_bf16(v1[2], v1[3]); return w; }

struct EpiProj {
    static constexpr bool PERM = true, AFTER_DRAIN = false;
    bf16_t* O; const float* sinT; const float* cosT;
    __device__ __forceinline__ void operator()(const f32x4 (&acc)[2][2][4][2], const Unit& u, int wr, int wc, int fr, int fq) const {
        const int row0 = u.pm * BM + wr * 64 + fr;
#pragma unroll
        for (int bj = 0; bj < 2; ++bj) {
            const int cw = u.pn * BM + bj * HALF + wc * 32;
            const int c0 = cw + 8 * fq;
            float sc = 1.f; bool rope = false;
            if (cw < 768 || (cw >= 2304 && cw < 3072)) sc = C2_F;
            else if (cw >= 3456 && cw < 3968) { rope = true; if (cw >= 3712) sc = 0.125f; }
            const float klg2 = (cw >= 3712 && cw < 3968) ? -__builtin_amdgcn_logf(1.f - __builtin_amdgcn_exp2f(-5.f - (float)((cw - 3712) >> 6))) : 0.f;
            const int i0 = ((c0 - 3456) & 63) >> 1;
#pragma unroll
            for (int ai = 0; ai < 2; ++ai)
#pragma unroll
                for (int m = 0; m < 4; ++m) {
                    const int row = row0 + ai * HALF + m * 16;
                    const float scr_ = sc * __builtin_amdgcn_exp2f(klg2 * (float)(row & 127));
                    f32x4 v0 = acc[ai][bj][m][0] * scr_, v1 = acc[ai][bj][m][1] * scr_;
                    if (rope) {
                        const int pos = row & 2047;
                        const f32x4 sn = *(const f32x4*)(sinT + pos * 32 + i0), cs = *(const f32x4*)(cosT + pos * 32 + i0);
                        f32x4 w0, w1;
                        w0[0] = v0[0] * cs[0] - v0[1] * sn[0]; w0[1] = v0[1] * cs[0] + v0[0] * sn[0];
                        w0[2] = v0[2] * cs[1] - v0[3] * sn[1]; w0[3] = v0[3] * cs[1] + v0[2] * sn[1];
                        w1[0] = v1[0] * cs[2] - v1[1] * sn[2]; w1[1] = v1[1] * cs[2] + v1[0] * sn[2];
                        w1[2] = v1[2] * cs[3] - v1[3] * sn[3]; w1[3] = v1[3] * cs[3] + v1[2] * sn[3];
                        v0 = w0; v1 = w1;
                    }
                    *(u32x4*)(O + (size_t)row * 5120 + c0) = pack8(v0, v1);
                }
        }
    }
};
struct EpiResid {
    static constexpr bool PERM = true, AFTER_DRAIN = false;
    float* T; const bf16_t* R; float scale;
    __device__ __forceinline__ void operator()(const f32x4 (&acc)[2][2][4][2], const Unit& u, int wr, int wc, int fr, int fq) const {
        const int row0 = u.pm * BM + wr * 64 + fr, col0 = u.pn * BM + wc * 32 + 8 * fq;
#pragma unroll
        for (int ai = 0; ai < 2; ++ai)
#pragma unroll
            for (int m = 0; m < 4; ++m) {
                const size_t ro = (size_t)(row0 + ai * HALF + m * 16) * 2048 + col0;
#pragma unroll
                for (int bj = 0; bj < 2; ++bj) {
                    const u32x4 r = *(const u32x4*)(R + ro + bj * HALF);
                    f32x4 r0, r1;
                    r0[0] = __builtin_bit_cast(float, r.x << 16); r0[1] = __builtin_bit_cast(float, r.x & 0xffff0000u); r0[2] = __builtin_bit_cast(float, r.y << 16); r0[3] = __builtin_bit_cast(float, r.y & 0xffff0000u);
                    r1[0] = __builtin_bit_cast(float, r.z << 16); r1[1] = __builtin_bit_cast(float, r.z & 0xffff0000u); r1[2] = __builtin_bit_cast(float, r.w << 16); r1[3] = __builtin_bit_cast(float, r.w & 0xffff0000u);
                    *(f32x4*)(T + ro + bj * HALF) = r0 * ALPHA_F + acc[ai][bj][m][0] * scale;
                    *(f32x4*)(T + ro + bj * HALF + 4) = r1 * ALPHA_F + acc[ai][bj][m][1] * scale;
                }
            }
    }
};
__device__ __forceinline__ float silu_f(float x) { return x * __builtin_amdgcn_rcpf(1.f + __builtin_amdgcn_exp2f(-1.4426950408889634f * x)); }
struct EpiSwiGLU {
    static constexpr bool PERM = true, AFTER_DRAIN = false;
    bf16_t* H; int ntn;
    __device__ __forceinline__ void operator()(const f32x4 (&acc)[2][2][4][2], const Unit& u, int wr, int wc, int fr, int fq) const {
        const int row0 = u.pm * BM + wr * 64 + fr, col0 = (u.pn % ntn) * HALF + wc * 32 + 8 * fq;
#pragma unroll
        for (int ai = 0; ai < 2; ++ai)
#pragma unroll
            for (int m = 0; m < 4; ++m) {
                f32x4 h0, h1;
#pragma unroll
                for (int j = 0; j < 4; ++j) { h0[j] = silu_f(acc[ai][0][m][0][j]) * acc[ai][1][m][0][j]; h1[j] = silu_f(acc[ai][0][m][1][j]) * acc[ai][1][m][1][j]; }
                *(u32x4*)(H + (size_t)(row0 + ai * HALF + m * 16) * 5632 + col0) = pack8(h0, h1);
            }
    }
};
constexpr float FP8_SX = 16.f, FP8_SWU = 512.f, FP8_SH = 8.f, FP8_SWD = 2048.f;
__device__ __forceinline__ unsigned pack4_fp8(float a, float b, float c, float d) {
    a = __builtin_amdgcn_fmed3f(a, -448.f, 448.f); b = __builtin_amdgcn_fmed3f(b, -448.f, 448.f); c = __builtin_amdgcn_fmed3f(c, -448.f, 448.f); d = __builtin_amdgcn_fmed3f(d, -448.f, 448.f);
    int w = __builtin_amdgcn_cvt_pk_fp8_f32(a, b, 0, false); w = __builtin_amdgcn_cvt_pk_fp8_f32(c, d, w, true); return (unsigned)w;
}
struct EpiSwiGLU8 {
    static constexpr bool PERM = true, AFTER_DRAIN = false;
    unsigned char* H; int ntn; float si;
    __device__ __forceinline__ void operator()(const f32x4 (&acc)[2][2][4][2], const Unit& u, int wr, int wc, int fr, int fq) const {
        const int row0 = u.pm * BM + wr * 64 + fr, col0 = (u.pn % ntn) * HALF + wc * 32 + 8 * fq;
#pragma unroll
        for (int ai = 0; ai < 2; ++ai)
#pragma unroll
            for (int m = 0; m < 4; ++m) {
                f32x4 h0, h1;
#pragma unroll
                for (int j = 0; j < 4; ++j) { h0[j] = silu_f(acc[ai][0][m][0][j] * si) * (acc[ai][1][m][0][j] * (si * FP8_SH)); h1[j] = silu_f(acc[ai][0][m][1][j] * si) * (acc[ai][1][m][1][j] * (si * FP8_SH)); }
                u32x2 w; w.x = pack4_fp8(h0[0], h0[1], h0[2], h0[3]); w.y = pack4_fp8(h1[0], h1[1], h1[2], h1[3]);
                *(u32x2*)(H + (size_t)(row0 + ai * HALF + m * 16) * 5632 + col0) = w;
            }
    }
};
struct EpiY {
    static constexpr bool PERM = true, AFTER_DRAIN = false;
    bf16_t* Y; int ntn; float scale;
    __device__ __forceinline__ void operator()(const f32x4 (&acc)[2][2][4][2], const Unit& u, int wr, int wc, int fr, int fq) const {
        const int row0 = u.pm * BM + wr * 64 + fr, col0 = (u.pn % ntn) * BM + wc * 32 + 8 * fq;
#pragma unroll
        for (int ai = 0; ai < 2; ++ai)
#pragma unroll
            for (int m = 0; m < 4; ++m)
#pragma unroll
                for (int bj = 0; bj < 2; ++bj)
                    *(u32x4*)(Y + (size_t)(row0 + ai * HALF + m * 16) * 2048 + col0 + bj * HALF) = pack8(acc[ai][bj][m][0] * scale, acc[ai][bj][m][1] * scale);
    }
};
struct GroupedOrder {
    int nM, nN, nwg, G, c, pm0; int cum[8];
    __device__ __forceinline__ bool next(int i, Unit& u) const {
        const long L = (long)i * G + c; if (L >= nwg) return false;
        int wgid = (int)L; { const int q = nwg / NXCD, r = nwg % NXCD, xcd = wgid % NXCD, off = wgid / NXCD; wgid = (xcd < r ? xcd * (q + 1) : r * (q + 1) + (xcd - r) * q) + off; }
        const int nig = WGM * nN, gid = wgid / nig, fm = gid * WGM, gsz = (nM - fm) < WGM ? (nM - fm) : WGM;
        const int pm = pm0 + fm + ((wgid % nig) % gsz), pn = (wgid % nig) / gsz;
        int e = 0;
#pragma unroll
        for (int j = 0; j < 7; ++j) e += (pm >= cum[j]) ? 1 : 0;
        u.pm = pm; u.pn = e * nN + pn; return true;
    }
    __device__ __forceinline__ void a_ready(const Unit&) const {}
    __device__ __forceinline__ void done(const Unit&) const {}
};
template <class Epi, class Sched, bool ALIGN_EPI = false, bool SP2 = false, bool FP8 = false>
__device__ __forceinline__ void gemm_phase(PG8_LAS unsigned char* lds, const int wid, const Gemm g, const Sched& S, const Epi& E) {
    const int lane = (int)__builtin_amdgcn_mbcnt_hi(~0u, __builtin_amdgcn_mbcnt_lo(~0u, 0u)), tid = wid * 64 + lane,
        wr = wid >> 2, wc = wid & 3, fr = lane & 15, fq = lane >> 4;
    const int KB = g.KB, nt = KB / 128;
    unsigned voffA[2], voffB[2];
#pragma unroll
    for (int i = 0; i < 2; ++i) { int R, C; stage_rc(tid * 16 + i * 8192, R, C); const int Rb = Epi::PERM ? ((R & ~31) + perm32(R & 31)) : R;
        voffA[i] = (unsigned)(R * KB + C * 2); voffB[i] = (unsigned)(Rb * KB + C * 2); }
    const size_t kstep = (size_t)128;
    const size_t hstep = (size_t)HALF * KB;
    const size_t tstep = 2 * hstep;
    const unsigned ldsw = (unsigned)wid * 1024u;
    const int aoff = lds_byte(wr * 64 + fr, fq * 8), boff = lds_byte(wc * 32 + fr, fq * 8);
#define PG8_SA(b, h) (((b) * 2 + (h)) * HTB)
#define PG8_SB(b, h) ((4 + (b) * 2 + (h)) * HTB)
#define PG8_STAGE(bufoff, gbase, voff) do { _Pragma("unroll") for (int _i = 0; _i < 2; ++_i) \
        __builtin_amdgcn_global_load_lds((const unsigned*)((const char*)(gbase) + (voff)[_i]), (PG8_LAS unsigned*)(lds + (bufoff) + ldsw + _i * 8192), 16, 0, 0); } while (0)
#define PG8_LDA(dst, b, h) do { _Pragma("unroll") for (int m = 0; m < 4; ++m) _Pragma("unroll") for (int k = 0; k < 2; ++k) dst[m][k] = *(const PG8_LAS bf16x8*)(lds + PG8_SA(b, h) + aoff + m * 2048 + k * 1024); } while (0)
#define PG8_LDB(dst, b, h) do { _Pragma("unroll") for (int n = 0; n < 2; ++n) _Pragma("unroll") for (int k = 0; k < 2; ++k) dst[n][k] = *(const PG8_LAS bf16x8*)(lds + PG8_SB(b, h) + boff + n * 2048 + k * 1024); } while (0)
#define PG8_MMA(ai, bj, At, Bt) do { __builtin_amdgcn_s_setprio(1); _Pragma("unroll") for (int m = 0; m < 4; ++m) _Pragma("unroll") for (int n = 0; n < 2; ++n) { \
        if constexpr (FP8) { const v4i_t b0_ = __builtin_bit_cast(v4i_t, Bt[n][0]), b1_ = __builtin_bit_cast(v4i_t, Bt[n][1]), a0_ = __builtin_bit_cast(v4i_t, At[m][0]), a1_ = __builtin_bit_cast(v4i_t, At[m][1]); \
            const v8i_t b8_ = __builtin_shufflevector(b0_, b1_, 0, 1, 2, 3, 4, 5, 6, 7), a8_ = __builtin_shufflevector(a0_, a1_, 0, 1, 2, 3, 4, 5, 6, 7); \
            asm volatile("v_mfma_f32_16x16x128_f8f6f4 %0, %1, %2, %0" : "+v"(acc[ai][bj][m][n]) : "v"(b8_), "v"(a8_)); } \
        else { _Pragma("unroll") for (int k = 0; k < 2; ++k) acc[ai][bj][m][n] = __builtin_amdgcn_mfma_f32_16x16x32_bf16(Bt[n][k], At[m][k], acc[ai][bj][m][n], 0, 0, 0); } } __builtin_amdgcn_s_setprio(0); } while (0)
#define PG8_WAIT_V(n) asm volatile("s_waitcnt vmcnt(" #n ")" ::: "memory")
#define PG8_WAIT_L(n) asm volatile("s_waitcnt lgkmcnt(" #n ")" ::: "memory")
#define PG8_BAR __builtin_amdgcn_s_barrier()
#define PG8_SCHED __builtin_amdgcn_sched_barrier(0)
    Unit cur, nxt; int ui = 0;
    if (!S.next(0, cur)) return;
    f32x4 acc[2][2][4][2];
#pragma unroll
    for (int a = 0; a < 2; ++a)
#pragma unroll
        for (int b = 0; b < 2; ++b)
#pragma unroll
            for (int m = 0; m < 4; ++m)
#pragma unroll
                for (int n = 0; n < 2; ++n) acc[a][b][m][n] = (f32x4){0.f, 0.f, 0.f, 0.f};
    bf16x8 At[4][2], B0[2][2], B1[2][2];
    const char* cA = (const char*)g.A + (size_t)cur.pm * tstep; const char* cB = (const char*)g.Bt + (size_t)cur.pn * tstep;
    S.a_ready(cur);
    if constexpr (SP2) {
        PG8_STAGE(PG8_SB(0, 0), cB, voffB); PG8_STAGE(PG8_SB(0, 1), cB + hstep, voffB); PG8_STAGE(PG8_SA(0, 0), cA, voffA); PG8_STAGE(PG8_SA(0, 1), cA + hstep, voffA);
        if (wr == 1) PG8_BAR;
        PG8_WAIT_V(2); PG8_BAR;
        PG8_STAGE(PG8_SB(1, 0), cB + kstep, voffB); PG8_STAGE(PG8_SA(1, 0), cA + kstep, voffA); PG8_STAGE(PG8_SB(1, 1), cB + hstep + kstep, voffB);
        PG8_WAIT_V(6); PG8_BAR;
    } else {
        PG8_STAGE(PG8_SB(0, 0), cB, voffB); PG8_STAGE(PG8_SA(0, 0), cA, voffA); PG8_STAGE(PG8_SB(0, 1), cB + hstep, voffB); PG8_STAGE(PG8_SA(0, 1), cA + hstep, voffA);
        if (wr == 1) PG8_BAR;
        PG8_WAIT_V(4); PG8_BAR;
        PG8_STAGE(PG8_SB(1, 0), cB + kstep, voffB); PG8_STAGE(PG8_SA(1, 0), cA + kstep, voffA); PG8_STAGE(PG8_SB(1, 1), cB + hstep + kstep, voffB);
        PG8_WAIT_V(6); PG8_BAR;
    }
    for (;;) {
        const bool has_next = S.next(ui + 1, nxt);
        const char* nA = has_next ? (const char*)g.A + (size_t)nxt.pm * tstep : cA; const char* nB = has_next ? (const char*)g.Bt + (size_t)nxt.pn * tstep : cB;
        for (int t = 0; t < nt; t += 2) {
            const bool last = (t == nt - 2);
            const char* a1 = cA + (size_t)(t + 1) * kstep;
            const char* a2 = last ? nA : cA + (size_t)(t + 2) * kstep; const char* b2 = last ? nB : cB + (size_t)(t + 2) * kstep;
            const char* a3 = a2 + kstep; const char* b3 = b2 + kstep;
            if (last && has_next) S.a_ready(nxt);
            if constexpr (SP2) {
            PG8_LDB(B0, 0, 0); PG8_LDB(B1, 0, 1); PG8_SCHED; PG8_LDA(At, 0, 0); PG8_STAGE(PG8_SA(1, 1), a1 + hstep, voffA);
            PG8_WAIT_V(8); PG8_WAIT_L(0); PG8_BAR; PG8_MMA(0, 0, At, B0); PG8_MMA(0, 1, At, B1); PG8_BAR; PG8_SCHED;
            PG8_LDA(At, 0, 1); PG8_STAGE(PG8_SB(0, 0), b2, voffB); PG8_STAGE(PG8_SB(0, 1), b2 + hstep, voffB); PG8_STAGE(PG8_SA(0, 0), a2, voffA);
            PG8_WAIT_V(8); PG8_WAIT_L(0); PG8_BAR; PG8_MMA(1, 0, At, B0); PG8_MMA(1, 1, At, B1); PG8_BAR; PG8_SCHED;
            PG8_LDB(B0, 1, 0); PG8_LDB(B1, 1, 1); PG8_SCHED; PG8_LDA(At, 1, 0); PG8_STAGE(PG8_SA(0, 1), a2 + hstep, voffA);
            PG8_WAIT_V(8); PG8_WAIT_L(0); PG8_BAR; PG8_MMA(0, 0, At, B0); PG8_MMA(0, 1, At, B1); PG8_BAR; PG8_SCHED;
            PG8_LDA(At, 1, 1); PG8_STAGE(PG8_SB(1, 0), b3, voffB); PG8_STAGE(PG8_SB(1, 1), b3 + hstep, voffB); PG8_STAGE(PG8_SA(1, 0), a3, voffA);
            PG8_WAIT_V(8); PG8_WAIT_L(0); PG8_BAR; PG8_MMA(1, 0, At, B0); PG8_MMA(1, 1, At, B1); PG8_BAR; PG8_SCHED;
            } else {
            PG8_LDB(B0, 0, 0); PG8_SCHED; PG8_LDA(At, 0, 0); PG8_STAGE(PG8_SA(1, 1), a1 + hstep, voffA);
            PG8_WAIT_L(8); PG8_BAR; PG8_WAIT_L(0); PG8_MMA(0, 0, At, B0); PG8_BAR; PG8_SCHED;
            PG8_LDB(B1, 0, 1); PG8_STAGE(PG8_SB(0, 0), b2, voffB);
            PG8_BAR; PG8_WAIT_L(0); PG8_MMA(0, 1, At, B1); PG8_BAR;
            PG8_LDA(At, 0, 1); PG8_STAGE(PG8_SA(0, 0), a2, voffA);
            PG8_BAR; PG8_WAIT_L(0); PG8_MMA(1, 0, At, B0); PG8_BAR; PG8_SCHED;
            PG8_STAGE(PG8_SB(0, 1), b2 + hstep, voffB);
            PG8_WAIT_V(6); PG8_BAR; PG8_MMA(1, 1, At, B1); PG8_BAR;
            PG8_LDB(B0, 1, 0); PG8_SCHED; PG8_LDA(At, 1, 0); PG8_STAGE(PG8_SA(0, 1), a2 + hstep, voffA);
            PG8_WAIT_L(8); PG8_BAR; PG8_WAIT_L(0); PG8_MMA(0, 0, At, B0); PG8_BAR; PG8_SCHED;
            PG8_LDB(B1, 1, 1); PG8_STAGE(PG8_SB(1, 0), b3, voffB);
            PG8_BAR; PG8_WAIT_L(0); PG8_MMA(0, 1, At, B1); PG8_BAR;
            PG8_LDA(At, 1, 1); PG8_STAGE(PG8_SA(1, 0), a3, voffA);
            PG8_BAR; PG8_WAIT_L(0); PG8_MMA(1, 0, At, B0); PG8_BAR; PG8_SCHED;
            PG8_STAGE(PG8_SB(1, 1), b3 + hstep, voffB);
            PG8_WAIT_V(6); PG8_BAR; PG8_MMA(1, 1, At, B1); PG8_BAR;
            }
        }
        if constexpr (ALIGN_EPI) { if (wr == 0) PG8_BAR; }
        if constexpr (FP8) asm volatile("s_nop 15\n\ts_nop 15" ::: "memory");
        if constexpr (!Epi::AFTER_DRAIN) { E(acc, cur, wr, wc, fr, fq); S.done(cur); }
        if (!has_next) break;
#pragma unroll
        for (int a = 0; a < 2; ++a)
#pragma unroll
            for (int b = 0; b < 2; ++b)
#pragma unroll
                for (int m = 0; m < 4; ++m)
#pragma unroll
                    for (int n = 0; n < 2; ++n) acc[a][b][m][n] = (f32x4){0.f, 0.f, 0.f, 0.f};
        cur = nxt; cA = nA; cB = nB; ++ui;
        if constexpr (ALIGN_EPI) { if (wr == 1) PG8_BAR; }
    }
    PG8_WAIT_V(0);
    if constexpr (!ALIGN_EPI) { if (wr == 0) PG8_BAR; }
    PG8_BAR;
    if constexpr (Epi::AFTER_DRAIN) { E.fused(acc, cur, wr, wc, fr, fq, lds, wid, lane); S.done(cur); }
#undef PG8_SA
#undef PG8_SB
#undef PG8_STAGE
#undef PG8_LDA
#undef PG8_LDB
#undef PG8_MMA
#undef PG8_WAIT_V
#undef PG8_WAIT_L
#undef PG8_BAR
#undef PG8_SCHED
}
}
constexpr int NWAVES = 8;
constexpr int NTOK = 16384, SEQ = 2048, DM = 2048, PW = 4992, PWP = 5120, DFF = 5632, NEXP = 8, MAXTILES = 136;
constexpr float LN_EPS = 1e-5f;
constexpr float LOG2E = 1.4426950408889634f;
constexpr int C_AQ = 0, C_AK = 768, C_AV = 1536, C_BQ = 2304, C_BK = 3072, C_BV = 3264, C_CQ = 3456, C_CK = 3712, C_CV = 3968, C_CG = 4480;
constexpr size_t MiB = 1u << 20;
constexpr size_t WS_CTL = 0, CTL_ZERO_BYTES = 1 * MiB;
constexpr size_t WS_TAB = 1 * MiB;
constexpr size_t WS_ROUTE = 2 * MiB;
constexpr size_t WS_WIN = 4 * MiB, WS_WOUT = 44 * MiB, WS_WDGU = 60 * MiB, WS_WDDN = 104 * MiB, WS_WMGU = 126 * MiB, WS_WMDN = 478 * MiB;
constexpr size_t WS_XB = 654 * MiB, WS_XG = 718 * MiB, WS_U1 = 854 * MiB, WS_END = 1228 * MiB;
constexpr size_t WS_PROJ = WS_U1, WS_CAT = WS_U1 + 160 * MiB, WS_H = WS_U1, WS_Y = WS_XG;
static_assert(WS_WIN + 2ull * PWP * DM * 2 <= WS_WOUT && WS_WOUT + 2ull * DM * DM * 2 <= WS_WDGU && WS_WDGU + 2ull * DFF * DM * 2 <= WS_WDDN && WS_WDDN + (size_t)DM * DFF * 2 <= WS_WMGU, "ws map 1");
static_assert(WS_WMGU + 8ull * 2 * DFF * DM * 2 <= WS_WMDN && WS_WMDN + 8ull * DM * DFF * 2 <= WS_XB && WS_XB + (size_t)NTOK * DM * 2 <= WS_XG && WS_XG + (size_t)MAXTILES * 256 * DM * 2 <= WS_U1, "ws map 2");
static_assert(WS_U1 + (size_t)MAXTILES * 256 * DFF * 2 <= WS_END && WS_PROJ + (size_t)NTOK * PWP * 2 <= WS_CAT && WS_CAT + (size_t)NTOK * DM * 2 <= WS_END, "ws map 3");
constexpr int CW_TMO = 0, CW_CODE = 1, CW_CNT = 1024  , CW_WQ = 2048  , CW_BAR = 4096  ;
constexpr int RING_OFF = 0, RING_BYTES = 131072;
constexpr int LDSCTL_OFF = RING_BYTES, MISC_OFF = LDSCTL_OFF + 320;
constexpr int LUT_OFF = LDSCTL_OFF + 1024;
constexpr int LUT_STRIDE = 132;
constexpr int LDS_BYTES = 147456;
static_assert(LUT_OFF + 18 * LUT_STRIDE * 4 <= LDS_BYTES, "LDS map");

#define GAS __attribute__((address_space(1)))
#define LAS __attribute__((address_space(3)))
typedef unsigned short bf16;
typedef unsigned v4u __attribute__((ext_vector_type(4)));
typedef unsigned v2u __attribute__((ext_vector_type(2)));
typedef float f32x4 __attribute__((ext_vector_type(4)));
typedef short bf16x8 __attribute__((ext_vector_type(8)));
typedef GAS unsigned gu32;
#define RLX_AGENT __ATOMIC_RELAXED, __HIP_MEMORY_SCOPE_AGENT
#define LDS_WAIT() asm volatile("s_waitcnt lgkmcnt(0)" ::: "memory")
#define VM_WAIT() asm volatile("s_waitcnt vmcnt(0)" ::: "memory")
__device__ __forceinline__ unsigned f2bf(float f) { unsigned u = __builtin_bit_cast(unsigned, f); return (u + 0x7fffu + ((u >> 16) & 1u)) >> 16; }
__device__ __forceinline__ unsigned pk2(float lo, float hi) { return f2bf(lo) | (f2bf(hi) << 16); }
__device__ __forceinline__ float bflo(unsigned w) { return __builtin_bit_cast(float, w << 16); }
__device__ __forceinline__ float bfhi(unsigned w) { return __builtin_bit_cast(float, w & 0xffff0000u); }
__device__ __forceinline__ float bf2f(bf16 h) { return __builtin_bit_cast(float, (unsigned)h << 16); }
__device__ const unsigned char BUCKET[129] = {0,1,2,3,4,5,6,7,8,9,10,11,12,13,14,15,16,16,16,17,17,18,18,18,19,19,19,20,20,20,20,21,21,21,21,22,22,22,22,22,23,23,23,23,23,23,24,24,24,24,24,24,25,25,25,25,25,25,25,
    26,26,26,26,26,26,26,26,27,27,27,27,27,27,27,27,27,27,28,28,28,28,28,28,28,28,28,28,29,29,29,29,29,29,29,29,29,29,29,29,30,30,30,30,30,30,30,30,30,30,30,30,30,30,31,31,31,31,31,31,31,31,31,31,31,31,31,31,31,31};
#define XB_TMO      128
#define XB_XCNT(j)  (256  + 64 * (j))
#define XB_XSUB(j)  (1280 + 64 * (j))
#define XB_XGEN(j)  (2304 + 64 * (j))
#define XB_TOP      3328
#define XB_TOPGEN   3392
#define XCD_BAR_WORDS 3456
#define XB_SPIN_CAP (1u << 18)

__device__ __forceinline__ unsigned xb_ld(unsigned* p)              { return __hip_atomic_load(p, __ATOMIC_RELAXED, __HIP_MEMORY_SCOPE_AGENT); }
__device__ __forceinline__ unsigned xb_add(unsigned* p, unsigned v) { return __hip_atomic_fetch_add(p, v, __ATOMIC_RELAXED, __HIP_MEMORY_SCOPE_AGENT); }
__device__ __forceinline__ unsigned xb_xcc_id() { return (unsigned)__builtin_amdgcn_s_getreg((3 << 11) | 20) & 0xFu; }
#define XB_SPIN(cond, bar) do { unsigned _sp = 0; while (cond) { __builtin_amdgcn_s_sleep(1); \
    if ((++_sp & 255u) == 0u) { if (xb_ld(&(bar)[XB_TMO])) break; if (_sp > XB_SPIN_CAP) { atomicAdd(&(bar)[XB_TMO], 1u); break; } } } } while (0)

struct XcdBarrier {
    unsigned* bar; unsigned x;
    volatile LAS unsigned* st;
};

__device__ __forceinline__ XcdBarrier xcd_barrier_post(unsigned* bar, volatile LAS unsigned* st) {
    XcdBarrier b; b.bar = bar; b.x = xb_xcc_id(); b.st = st;
    if (threadIdx.x == 0) (void)xb_add(&bar[XB_XCNT(b.x)], 1u);
    return b;
}
__device__ __forceinline__ void xcd_barrier_complete(unsigned* bar, unsigned x, unsigned& nloc, unsigned& nx) {
    const unsigned G = gridDim.x * gridDim.y * gridDim.z;
    unsigned sum, cnt, mine, sp = 0u;
    for (;;) {
        sum = 0u; cnt = 0u; mine = 0u;
#pragma unroll
        for (unsigned j = 0; j < 16; ++j) { const unsigned c = xb_ld(&bar[XB_XCNT(j)]); sum += c; cnt += (c > 0u) ? 1u : 0u; mine = (j == x) ? c : mine; }
        if (sum == G) break;
        __builtin_amdgcn_s_sleep(1);
        if ((++sp & 255u) == 0u) { if (xb_ld(&bar[XB_TMO])) break; if (sp > XB_SPIN_CAP) { atomicAdd(&bar[XB_TMO], 1u); break; } }
    }
    nloc = mine > 0u ? mine : 1u; nx = cnt > 0u ? cnt : 1u;
}

__device__ __forceinline__ void xcd_barrier(const XcdBarrier& b) {
    asm volatile("s_waitcnt vmcnt(0)" ::: "memory");
    __syncthreads();
    if (threadIdx.x == 0) {
        unsigned* bar = b.bar;
        __builtin_amdgcn_s_waitcnt(0);
        unsigned nloc = b.st[0], nx = b.st[1];
        if (nloc == 0u) { xcd_barrier_complete(bar, b.x, nloc, nx); b.st[0] = nloc; b.st[1] = nx; }
        const unsigned old = xb_add(&bar[XB_XSUB(b.x)], 1u);
        const unsigned gen = old / nloc;
        if (old + 1u == (gen + 1u) * nloc) {
            __builtin_amdgcn_fence(__ATOMIC_RELEASE, "agent");
            asm volatile("s_waitcnt vmcnt(0)" ::: "memory");
            const unsigned og = xb_add(&bar[XB_TOP], 1u);
            const unsigned tg = og / nx;
            if (og + 1u == (tg + 1u) * nx) xb_add(&bar[XB_TOPGEN], 1u);
            else XB_SPIN(xb_ld(&bar[XB_TOPGEN]) == tg, bar);
            __builtin_amdgcn_fence(__ATOMIC_ACQUIRE, "agent");
            xb_add(&bar[XB_XGEN(b.x)], 1u);
            asm volatile("s_waitcnt vmcnt(0)" ::: "memory");
        } else {
            XB_SPIN(xb_ld(&bar[XB_XGEN(b.x)]) == gen, bar);
            __builtin_amdgcn_fence(__ATOMIC_ACQUIRE, "agent");
            asm volatile("s_waitcnt vmcnt(0)" ::: "memory");
        }
    }
    __syncthreads();
}
struct Args { const float* in[18]; float* out; unsigned char* ws; int ph_lo, ph_hi, li, pad; float invf[32]; };
static_assert(sizeof(Args) == 20 * 8 + 16 + 128, "Args has no padding bytes");
struct Frame {
    LAS unsigned char* lds;
    gu32* ctl;
    int tid, lane, wave, vcu, G;
};
__device__ __forceinline__ float wave_sum(float v) {
#pragma unroll
    for (int o = 1; o < 64; o <<= 1) v += __shfl_xor(v, o);
    return v;
}
__device__ __forceinline__ float wave_max(float v) {
#pragma unroll
    for (int o = 1; o < 64; o <<= 1) v = fmaxf(v, __shfl_xor(v, o));
    return v;
}
__device__ __forceinline__ void p0_transpose_item(const float* W, int K, int N, bf16* WT, int k0, int n0, int drow0, LAS float* scr, int lane) {
#pragma unroll 8
    for (int i = 0; i < 32; ++i) { const int kk = 2 * i + (lane >> 5); scr[kk * 33 + (lane & 31)] = __builtin_nontemporal_load(W + (size_t)(k0 + kk) * N + n0 + (lane & 31)); }
    LDS_WAIT(); asm volatile("" ::: "memory");
    const int c = lane & 7;
#pragma unroll
    for (int j = 0; j < 4; ++j) { const int n = (lane >> 3) + 8 * j; const LAS float* s = scr + (8 * c) * 33 + n;
        v4u o; o.x = pk2(s[0 * 33], s[1 * 33]); o.y = pk2(s[2 * 33], s[3 * 33]); o.z = pk2(s[4 * 33], s[5 * 33]); o.w = pk2(s[6 * 33], s[7 * 33]);
        __builtin_nontemporal_store(o, (GAS v4u*)(WT + (size_t)(drow0 + n) * K + k0 + 8 * c)); }
    LDS_WAIT(); asm volatile("" ::: "memory");
}
template <int MODE> __device__ __forceinline__ void p0_matrix_item(const float* W, int K, int N, bf16* WT, int item, LAS float* scr, int lane) {
    const int nblk = N / 32, kb = item / nblk, nb = item % nblk, n0 = 32 * nb;
    const int drow0 = (MODE == 0) ? n0 : ((n0 >> 7) * 256 + (n0 & 127) + (MODE == 2 ? 128 : 0));
    p0_transpose_item(W, K, N, WT, 64 * kb, n0, drow0, scr, lane);
}
__device__ __forceinline__ void p0_transpose_item8(const float* W, int K, int N, unsigned char* WT, int k0, int n0, int drow0, float scale, LAS float* scr, int lane) {
#pragma unroll 8
    for (int i = 0; i < 32; ++i) { const int kk = 2 * i + (lane >> 5); scr[kk * 33 + (lane & 31)] = __builtin_nontemporal_load(W + (size_t)(k0 + kk) * N + n0 + (lane & 31)) * scale; }
    LDS_WAIT(); asm volatile("" ::: "memory");
    const int c = lane & 7;
#pragma unroll
    for (int j = 0; j < 4; ++j) { const int n = (lane >> 3) + 8 * j; const LAS float* s = scr + (8 * c) * 33 + n;
        v2u o; o.x = pg8::pack4_fp8(s[0 * 33], s[1 * 33], s[2 * 33], s[3 * 33]); o.y = pg8::pack4_fp8(s[4 * 33], s[5 * 33], s[6 * 33], s[7 * 33]);
        __builtin_nontemporal_store(o, (GAS v2u*)(WT + (size_t)(drow0 + n) * K + k0 + 8 * c)); }
    LDS_WAIT(); asm volatile("" ::: "memory");
}
template <int MODE> __device__ __forceinline__ void p0_matrix_item8(const float* W, int K, int N, unsigned char* WT, int item, float scale, LAS float* scr, int lane) {
    const int nblk = N / 32, kb = item / nblk, nb = item % nblk, n0 = 32 * nb;
    const int drow0 = (MODE == 0) ? n0 : ((n0 >> 7) * 256 + (n0 & 127) + (MODE == 2 ? 128 : 0));
    p0_transpose_item8(W, K, N, WT, 64 * kb, n0, drow0, scale, scr, lane);
}
__device__ __forceinline__ void p0_prologue(Frame& F, const Args& a) {
    LAS float* scr = (LAS float*)(F.lds + RING_OFF + F.wave * 16384);
    const int gw = F.vcu * NWAVES + F.wave, NGW = F.G * NWAVES;
    unsigned char* ws = a.ws;
    constexpr int I_IN = (DM / 64) * (PW / 32), I_OUT = (DM / 64) * (DM / 32), I_GU = (DM / 64) * (DFF / 32), I_DN = (DFF / 64) * (DM / 32);
    constexpr int NITEMS = 2 * I_IN + 2 * I_OUT + 2 * I_GU + I_DN + 8 * (2 * I_GU + I_DN);
    for (int it = gw; it < NITEMS; it += NGW) {
        int r = it;
        if (r < 2 * I_IN) { const int l = r / I_IN; p0_matrix_item<0>(a.in[1] + (size_t)l * DM * PW, DM, PW, (bf16*)(ws + WS_WIN) + (size_t)l * PWP * DM, r % I_IN, scr, F.lane); continue; } r -= 2 * I_IN;
        if (r < 2 * I_OUT) { const int l = r / I_OUT; p0_matrix_item<0>(a.in[6] + (size_t)l * DM * DM, DM, DM, (bf16*)(ws + WS_WOUT) + (size_t)l * DM * DM, r % I_OUT, scr, F.lane); continue; } r -= 2 * I_OUT;
        if (r < I_GU) { p0_matrix_item<1>(a.in[11], DM, DFF, (bf16*)(ws + WS_WDGU), r, scr, F.lane); continue; } r -= I_GU;
        if (r < I_GU) { p0_matrix_item<2>(a.in[12], DM, DFF, (bf16*)(ws + WS_WDGU), r, scr, F.lane); continue; } r -= I_GU;
        if (r < I_DN) { p0_matrix_item8<0>(a.in[13], DFF, DM, ws + WS_WDDN, r, pg8::FP8_SWD, scr, F.lane); continue; } r -= I_DN;
        if (r < 8 * I_GU) { const int e = r / I_GU; p0_matrix_item8<1>(a.in[15] + (size_t)e * DM * DFF, DM, DFF, ws + WS_WMGU + (size_t)e * 2 * DFF * DM, r % I_GU, pg8::FP8_SWU, scr, F.lane); continue; } r -= 8 * I_GU;
        if (r < 8 * I_GU) { const int e = r / I_GU; p0_matrix_item8<2>(a.in[16] + (size_t)e * DM * DFF, DM, DFF, ws + WS_WMGU + (size_t)e * 2 * DFF * DM, r % I_GU, pg8::FP8_SWU, scr, F.lane); continue; } r -= 8 * I_GU;
        { const int e = r / I_DN; p0_matrix_item8<0>(a.in[17] + (size_t)e * DFF * DM, DFF, DM, ws + WS_WMDN + (size_t)e * DM * DFF, r % I_DN, pg8::FP8_SWD, scr, F.lane); }
    }
    { const int gt = gw * 64 + F.lane, NGT = NGW * 64; const GAS f32x4* x4 = (const GAS f32x4*)a.in[0]; GAS v4u* o4 = (GAS v4u*)(ws + WS_XB);
      for (int i = gt; i < NTOK * DM / 8; i += NGT) { const f32x4 p = __builtin_nontemporal_load(x4 + 2 * i), q = __builtin_nontemporal_load(x4 + 2 * i + 1); v4u o; o.x = pk2(p[0], p[1]); o.y = pk2(p[2], p[3]); o.z = pk2(q[0], q[1]); o.w = pk2(q[2], q[3]); o4[i] = o; } }
    { const int gt = gw * 64 + F.lane; if (gt < SEQ * 32) { const int pos = gt >> 5, i = gt & 31; const float ang = (float)pos * a.invf[i];
        const double t = (double)ang * 0.15915494309189535; const float fr = (float)(t - __builtin_rint(t));
        ((float*)(ws + WS_TAB))[gt] = __builtin_amdgcn_sinf(fr); ((float*)(ws + WS_TAB + 256 * 1024))[gt] = __builtin_amdgcn_cosf(fr); } }
}
__device__ __forceinline__ void build_lut(Frame& F, const float* rel_bias) {
    LAS float* lut = (LAS float*)(F.lds + LUT_OFF);
    for (int i = F.tid; i < 18 * 129; i += NWAVES * 64) { const int hh = i / 129, d = i % 129; lut[hh * LUT_STRIDE + d] = (rel_bias[BUCKET[d] * 18 + hh] - (hh < 6 ? rel_bias[31 * 18 + hh] : 0.f)) * LOG2E; }
}
__device__ __forceinline__ void ln_stats(f32x4 (&v)[8], float& mean, float& rstd) {
    float s = 0.f;
#pragma unroll
    for (int j = 0; j < 8; ++j) s += (v[j][0] + v[j][1]) + (v[j][2] + v[j][3]);
    mean = wave_sum(s) * (1.f / DM); float s2 = 0.f;
#pragma unroll
    for (int j = 0; j < 8; ++j) { v[j] = v[j] - mean; s2 += (v[j][0] * v[j][0] + v[j][1] * v[j][1]) + (v[j][2] * v[j][2] + v[j][3] * v[j][3]); }
    rstd = 1.f / sqrtf(wave_sum(s2) * (1.f / DM) + LN_EPS);
}
__device__ __forceinline__ int expert_offsets(Frame& F, int& ntiles) {
    const unsigned c = (F.lane < 8) ? __hip_atomic_load(F.ctl + CW_CNT + 64 * F.lane, RLX_AGENT) : 0u;
    const int t = (int)((c + 255u) >> 8);
    int inc = t;
#pragma unroll
    for (int o = 1; o < 8; o <<= 1) { const int u = __shfl_up(inc, o); if (F.lane >= o) inc += u; }
    ntiles = __shfl(inc, 7);
    return (inc - t) * 256;
}
template <int MODE> __device__ __forceinline__ void ln_phase(Frame& F, const Args& a, float* T, const float* gam, const float* bet, const float* w_router, int rb_in = -1, int pass = 0) {
    unsigned char* ws = a.ws;
    bf16* XB = (bf16*)(ws + WS_XB);
    const int lane = F.lane;
    LAS float* wrT = (LAS float*)(F.lds + RING_OFF);
    LAS int* cwL = (LAS int*)(F.lds + RING_OFF + 65536);
    LAS int* baseL = (LAS int*)(F.lds + RING_OFF + 65536 + 256);
    if (MODE == 1) {
        for (int i = F.tid; i < DM * 8; i += NWAVES * 64) wrT[(i & 7) * DM + (i >> 3)] = w_router[i];
        __syncthreads();
    }
    f32x4 g4[8], b4[8];
#pragma unroll
    for (int j = 0; j < 8; ++j) { g4[j] = *(const f32x4*)(gam + 4 * lane + 256 * j); b4[j] = *(const f32x4*)(bet + 4 * lane + 256 * j); }
    int offv = 0, ntl = 0;
    if (MODE == 2) offv = expert_offsets(F, ntl);
    const int rb = (rb_in >= 0) ? rb_in : (F.vcu * NWAVES + F.wave) * 8;
    unsigned long long cntp = 0ull; int me1 = 0, me2 = 0, mr1 = 0, mr2 = 0; float mg1 = 0.f, mg2 = 0.f;
    for (int r = 0; r < 8; ++r) {
        const int row = rb + r;
        float* trow = T + (size_t)row * DM;
        if (MODE == 2 && pass != 0) {
            const int* rt = (const int*)(ws + WS_ROUTE) + row * 8;
            const bool late = (__shfl(offv, rt[0]) + rt[1] >= 32768) || (__shfl(offv, rt[2]) + rt[3] >= 32768);
            if (late != (pass == 2)) continue;
        }
        f32x4 v[8];
#pragma unroll
        for (int j = 0; j < 8; ++j) v[j] = *(const f32x4*)(trow + 4 * lane + 256 * j);
        if (MODE == 2) {
            const int* rt = (const int*)(ws + WS_ROUTE) + row * 8;
            const int e1 = rt[0], p1 = rt[1], e2 = rt[2], p2 = rt[3]; const float g1 = __builtin_bit_cast(float, rt[4]), g2 = __builtin_bit_cast(float, rt[5]);
            const int r1 = __shfl(offv, e1) + p1, r2 = __shfl(offv, e2) + p2;
            const bf16* y1 = (const bf16*)(ws + WS_Y) + (size_t)r1 * DM; const bf16* y2 = (const bf16*)(ws + WS_Y) + (size_t)r2 * DM;
#pragma unroll
            for (int j = 0; j < 8; ++j) { const v2u a1 = *(const v2u*)(y1 + 4 * lane + 256 * j), a2 = *(const v2u*)(y2 + 4 * lane + 256 * j);
                v[j][0] = v[j][0] * pg8::ALPHA_F + g1 * bflo(a1.x) + g2 * bflo(a2.x); v[j][1] = v[j][1] * pg8::ALPHA_F + g1 * bfhi(a1.x) + g2 * bfhi(a2.x);
                v[j][2] = v[j][2] * pg8::ALPHA_F + g1 * bflo(a1.y) + g2 * bflo(a2.y); v[j][3] = v[j][3] * pg8::ALPHA_F + g1 * bfhi(a1.y) + g2 * bfhi(a2.y); }
        }
        float mean, rstd; ln_stats(v, mean, rstd);
#pragma unroll
        for (int j = 0; j < 8; ++j) v[j] = v[j] * rstd * g4[j] + b4[j];
        if (MODE == 2) {
            float* orow = a.out + (size_t)row * DM;
#pragma unroll
            for (int j = 0; j < 8; ++j) *(f32x4*)(orow + 4 * lane + 256 * j) = v[j];
        } else {
            bf16* xrow = XB + (size_t)row * DM;
#pragma unroll
            for (int j = 0; j < 8; ++j) { if (MODE != 0) *(f32x4*)(trow + 4 * lane + 256 * j) = v[j]; if (MODE == 0) { v2u o; o.x = pk2(v[j][0], v[j][1]); o.y = pk2(v[j][2], v[j][3]); *(v2u*)(xrow + 4 * lane + 256 * j) = o; }
                if (MODE == 3) { const f32x4 s = v[j] * pg8::FP8_SX; ((GAS unsigned*)(ws + WS_XG + (size_t)row * DM))[lane + 64 * j] = pg8::pack4_fp8(s[0], s[1], s[2], s[3]); } }
        }
        if (MODE == 1) {
            int i1 = -1, i2 = -1; float v1 = -3.0e38f, v2 = -3.0e38f;
#pragma unroll 1
            for (int e = 0; e < 8; ++e) { float s = 0.f;
#pragma unroll
                for (int j = 0; j < 8; ++j) { const f32x4 w = *(const LAS f32x4*)(wrT + e * DM + 4 * lane + 256 * j); s += (v[j][0] * w[0] + v[j][1] * w[1]) + (v[j][2] * w[2] + v[j][3] * w[3]); }
                const float t = wave_sum(s);
                if (t > v1) { v2 = v1; i2 = i1; v1 = t; i1 = e; } else if (t > v2) { v2 = t; i2 = e; } }
            if (i1 < 0) i1 = 0;
            if (i2 < 0) i2 = (i1 + 1) & 7;
            const float ex = __expf(v2 - v1), w1 = 1.f / (1.f + ex), w2 = ex * w1;
            const int k1 = (int)((cntp >> (8 * i1)) & 0xffull); cntp += 1ull << (8 * i1);
            const int k2 = (int)((cntp >> (8 * i2)) & 0xffull); cntp += 1ull << (8 * i2);
            if (lane == r) { me1 = i1; me2 = i2; mr1 = k1; mr2 = k2; mg1 = w1; mg2 = w2; }
        }
    }
    if (MODE == 1) {
        if (lane < 8) cwL[F.wave * 8 + lane] = (int)((cntp >> (8 * lane)) & 0xffull);
        __syncthreads();
        if (F.tid < 8) { int tot = 0;
#pragma unroll
            for (int w = 0; w < 8; ++w) tot += cwL[w * 8 + F.tid];
            baseL[F.tid] = (int)__hip_atomic_fetch_add(F.ctl + CW_CNT + 64 * F.tid, (unsigned)tot, RLX_AGENT); }
        __syncthreads();
        if (lane < 8) {
            int p1 = baseL[me1] + mr1, p2 = baseL[me2] + mr2;
            for (int w = 0; w < F.wave; ++w) { p1 += cwL[w * 8 + me1]; p2 += cwL[w * 8 + me2]; }
            int* rt = (int*)(ws + WS_ROUTE) + (rb + lane) * 8;
            rt[0] = me1; rt[1] = p1; rt[2] = me2; rt[3] = p2; rt[4] = __builtin_bit_cast(int, mg1); rt[5] = __builtin_bit_cast(int, mg2);
        }
    }
}
__device__ __forceinline__ void gather_phase(Frame& F, const Args& a, const float* T) {
    unsigned char* ws = a.ws; int ntl; const int offv = expert_offsets(F, ntl);
    const int gw = F.vcu * NWAVES + F.wave, NGW = F.G * NWAVES;
    for (int tok = gw; tok < NTOK; tok += NGW) {
        const int* rt = (const int*)(ws + WS_ROUTE) + tok * 8;
        const int d1 = __shfl(offv, rt[0]) + rt[1], d2 = __shfl(offv, rt[2]) + rt[3];
        const GAS f32x4* s = (const GAS f32x4*)(T + (size_t)tok * DM);
        GAS unsigned* o1 = (GAS unsigned*)(ws + WS_XG + (size_t)d1 * DM); GAS unsigned* o2 = (GAS unsigned*)(ws + WS_XG + (size_t)d2 * DM);
#pragma unroll
        for (int j = 0; j < 8; ++j) { const f32x4 v = s[F.lane + 64 * j] * pg8::FP8_SX; const unsigned w = pg8::pack4_fp8(v[0], v[1], v[2], v[3]); o1[F.lane + 64 * j] = w; o2[F.lane + 64 * j] = w; }
    }
}
__device__ __forceinline__ float dot8(const v4u q, const v4u k) {
    return (bflo(q.x) * bflo(k.x) + bfhi(q.x) * bfhi(k.x)) + (bflo(q.y) * bflo(k.y) + bfhi(q.y) * bfhi(k.y)) + (bflo(q.z) * bflo(k.z) + bfhi(q.z) * bfhi(k.z)) + (bflo(q.w) * bflo(k.w) + bfhi(q.w) * bfhi(k.w));
}
__device__ __forceinline__ float lambda_of(const float* lp, int lane, float lam_init) {
    const float s1 = wave_sum(lp[lane] * lp[64 + lane]), s2 = wave_sum(lp[128 + lane] * lp[192 + lane]);
    return __expf(s1) - __expf(s2) + lam_init;
}
__device__ __forceinline__ void naive_mixers(Frame& F, const Args& a, int layer) {
    unsigned char* ws = a.ws; const bf16* PROJ = (const bf16*)(ws + WS_PROJ); bf16* CAT = (bf16*)(ws + WS_CAT);
    const int lane = F.lane; const int gw = F.vcu * NWAVES + F.wave, NGW = F.G * NWAVES;
    LAS float* sc = (LAS float*)(F.lds + RING_OFF + F.wave * 16384);
    const LAS float* lut = (const LAS float*)(F.lds + LUT_OFF);
    const float lam_init = 0.8f - 0.6f * __expf(-0.3f * (float)layer);
    const float lam = lambda_of(a.in[3] + layer * 256, lane, lam_init);
    const float* subg = a.in[4] + layer * 128; const float* sinks = a.in[5] + layer * 12;
    for (int task = gw; task < NTOK * 6; task += NGW) {
        const int tok = task / 6, h = task - tok * 6, q = tok & (SEQ - 1), base = tok - q;
        v4u qv[16]; { const v4u* qp = (const v4u*)(PROJ + (size_t)tok * PWP + C_AQ + h * 128);
#pragma unroll
            for (int c = 0; c < 16; ++c) qv[c] = qp[c]; }
        float m1 = -3.0e38f, m2 = -3.0e38f;
        for (int j = lane; j <= q; j += 64) {
            const v4u* kp = (const v4u*)(PROJ + (size_t)(base + j) * PWP + C_AK + h * 128); float d1 = 0.f, d2 = 0.f;
#pragma unroll
            for (int c = 0; c < 8; ++c) { d1 += dot8(qv[c], kp[c]); d2 += dot8(qv[8 + c], kp[8 + c]); }
            const int dd = q - j; const float bias = lut[h * LUT_STRIDE + (dd < 128 ? dd : 128)];
            d1 += bias; d2 += bias; sc[j] = d1; sc[2048 + j] = d2; m1 = fmaxf(m1, d1); m2 = fmaxf(m2, d2);
        }
        m1 = wave_max(m1); m2 = wave_max(m2); float l1 = 0.f, l2 = 0.f;
        for (int j = lane; j <= q; j += 64) { const float p1 = __builtin_amdgcn_exp2f(sc[j] - m1), p2 = __builtin_amdgcn_exp2f(sc[2048 + j] - m2); sc[j] = p1; sc[2048 + j] = p2; l1 += p1; l2 += p2; }
        l1 = wave_sum(l1); l2 = wave_sum(l2); const float c1 = 1.f / l1, c2 = lam / l2;
        float o0 = 0.f, o1 = 0.f;
        for (int j = 0; j <= q; ++j) { const float w = sc[j] * c1 - sc[2048 + j] * c2; const bf16* vr = PROJ + (size_t)(base + j) * PWP + C_AV + h * 128; o0 += w * bf2f(vr[lane]); o1 += w * bf2f(vr[64 + lane]); }
        const float ss = wave_sum(o0 * o0 + o1 * o1), rr = (1.f / sqrtf(ss * (1.f / 128.f) + LN_EPS)) * (1.f - lam_init);
        bf16* orow = CAT + (size_t)tok * DM + h * 128; orow[lane] = (bf16)f2bf(o0 * rr * subg[lane]); orow[64 + lane] = (bf16)f2bf(o1 * rr * subg[64 + lane]);
    }
    for (int task = gw; task < NTOK * 12; task += NGW) {
        const int tok = task / 12, hq = task - tok * 12, kvh = hq >> 2, q = tok & (SEQ - 1), base = tok - q;
        v4u qv[8]; { const v4u* qp = (const v4u*)(PROJ + (size_t)tok * PWP + C_BQ + hq * 64);
#pragma unroll
            for (int c = 0; c < 8; ++c) qv[c] = qp[c]; }
        float s[2];
#pragma unroll
        for (int i = 0; i < 2; ++i) { const int dd = lane + 64 * i, j = q - dd; s[i] = -3.0e38f;
            if (j >= 0) { const v4u* kp = (const v4u*)(PROJ + (size_t)(base + j) * PWP + C_BK + kvh * 64); float d = 0.f;
#pragma unroll
                for (int c = 0; c < 8; ++c) d += dot8(qv[c], kp[c]);
                s[i] = d + lut[(6 + hq) * LUT_STRIDE + dd]; } }
        const float sink2 = sinks[hq] * LOG2E; const float m = fmaxf(wave_max(fmaxf(s[0], s[1])), sink2);
        const float p0 = (q - lane >= 0) ? __builtin_amdgcn_exp2f(s[0] - m) : 0.f, p1 = (q - lane - 64 >= 0) ? __builtin_amdgcn_exp2f(s[1] - m) : 0.f;
        const float l = wave_sum(p0 + p1) + __builtin_amdgcn_exp2f(sink2 - m);
        sc[lane] = p0; sc[64 + lane] = p1;
        float o = 0.f; const int nk = (q + 1 < 128) ? q + 1 : 128;
        for (int dd = 0; dd < nk; ++dd) o += sc[dd] * bf2f(PROJ[(size_t)(base + q - dd) * PWP + C_BV + kvh * 64 + lane]);
        CAT[(size_t)tok * DM + 768 + hq * 64 + lane] = (bf16)f2bf(o / l);
    }
    for (int task = gw; task < NTOK * 4; task += NGW) {
        const int tok = task >> 2, h = task & 3, q = tok & (SEQ - 1), base = tok - q;
        const float lg2 = log2f(1.f - exp2f(-5.f - (float)h));
        v4u qv[8]; { const v4u* qp = (const v4u*)(PROJ + (size_t)tok * PWP + C_CQ + h * 64);
#pragma unroll
            for (int c = 0; c < 8; ++c) qv[c] = qp[c]; }
        for (int j = lane; j <= q; j += 64) { const v4u* kp = (const v4u*)(PROJ + (size_t)(base + j) * PWP + C_CK + h * 64); float d = 0.f;
#pragma unroll
            for (int c = 0; c < 8; ++c) d += dot8(qv[c], kp[c]);
            sc[j] = d * __builtin_amdgcn_exp2f((float)(q - j) * lg2); }
        float o0 = 0.f, o1 = 0.f;
        for (int j = 0; j <= q; ++j) { const float w = sc[j]; const bf16* vr = PROJ + (size_t)(base + j) * PWP + C_CV + h * 128; o0 += w * bf2f(vr[lane]); o1 += w * bf2f(vr[64 + lane]); }
        const float mu = wave_sum(o0 + o1) * (1.f / 128.f); o0 -= mu; o1 -= mu;
        const float rs = 1.f / sqrtf(wave_sum(o0 * o0 + o1 * o1) * (1.f / 128.f) + LN_EPS);
        const bf16* gr = PROJ + (size_t)tok * PWP + C_CG + h * 128;
        bf16* orow = CAT + (size_t)tok * DM + 1536 + h * 128;
        orow[lane] = (bf16)f2bf(pg8::silu_f(bf2f(gr[lane])) * o0 * rs); orow[64 + lane] = (bf16)f2bf(pg8::silu_f(bf2f(gr[64 + lane])) * o1 * rs);
    }
}
typedef float f32x16 __attribute__((ext_vector_type(16)));
typedef short s16x4 __attribute__((ext_vector_type(4)));
typedef short v4i16_t __attribute__((ext_vector_type(4)));
typedef float f32x2_t __attribute__((ext_vector_type(2))); typedef __bf16 bf16x2_t __attribute__((ext_vector_type(2)));
__device__ __forceinline__ int crow(int r, int hi) { return (r & 3) + 8 * (r >> 2) + 4 * hi; }
__device__ __forceinline__ s16x4 vtr(const LAS unsigned char* p) { return __builtin_bit_cast(s16x4, __builtin_amdgcn_ds_read_tr16_b64_v4i16((LAS v4i16_t*)p)); }
__device__ __forceinline__ unsigned cvtpk_s(float lo, float hi) { f32x2_t v = {lo, hi}; bf16x2_t b = __builtin_convertvector(v, bf16x2_t); return __builtin_bit_cast(unsigned, b); }
__device__ __forceinline__ bf16x8 pack_p(const f32x16& p, int s2) {
    v4u w; w.x = cvtpk_s(p[8 * s2 + 0], p[8 * s2 + 1]); w.y = cvtpk_s(p[8 * s2 + 2], p[8 * s2 + 3]); w.z = cvtpk_s(p[8 * s2 + 4], p[8 * s2 + 5]); w.w = cvtpk_s(p[8 * s2 + 6], p[8 * s2 + 7]);
    return __builtin_bit_cast(bf16x8, w);
}
constexpr int MIX_WSF = 131072 + 1024 + 10240, MIX_QW = MIX_WSF + 2048;
static_assert(MIX_QW + 64 <= LDS_BYTES && LUT_OFF + 18 * LUT_STRIDE * 4 <= MIX_WSF, "mixer LDS map");
constexpr int LUTX_OFF = 98304, LUTX_STRIDE = 320;
constexpr float MIX_THR = 6.f;
__device__ __forceinline__ void glds16(const void* gsrc, unsigned lds_dst) { unsigned keep;
    asm volatile("s_mov_b32 %0, m0\n\ts_mov_b32 m0, %2\n\ts_nop 0\n\tglobal_load_lds_dwordx4 %1, off\n\ts_mov_b32 m0, %0" : "=&s"(keep) : "v"(gsrc), "s"(lds_dst) : "memory"); }
template <int IMM> __device__ __forceinline__ void glds16s(const void* sbase, unsigned voff, unsigned lds_dst) { unsigned keep;
    lds_dst -= (unsigned)IMM;
    asm volatile("s_mov_b32 %0, m0\n\ts_mov_b32 m0, %3\n\ts_nop 0\n\tglobal_load_lds_dwordx4 %1, %2 offset:%c4\n\ts_mov_b32 m0, %0" : "=&s"(keep) : "v"(voff), "s"(sbase), "s"(lds_dst), "i"(IMM) : "memory"); }
template <int MODE> __device__ __forceinline__ void mix_unit(Frame& F, const Args& a, int layer, int b, int hh, int qb, float lam, float lam_init) {
    constexpr int KW = (MODE == 0) ? 128 : 64, VW = (MODE == 1) ? 64 : 128, NEB = VW / 32, NSUB = 1;
    constexpr int KBYTES = 64 * KW * 2, VBYTES = 64 * VW * 2, BUFB = KBYTES + VBYTES, NST = 3;
    constexpr int KD = KBYTES / 1024, VD = VBYTES / 1024, PW = (KD + VD) / 8;
    static_assert(NST * BUFB <= LUTX_OFF && LUTX_OFF + 18 * LUTX_STRIDE * 4 <= RING_BYTES && (KD + VD) % 8 == 0, "mixer LDS ring");
    unsigned char* ws = a.ws; const bf16* PROJ = (const bf16*)(ws + WS_PROJ); bf16* CAT = (bf16*)(ws + WS_CAT);
    const int wave = F.wave; int lane = (int)__builtin_amdgcn_mbcnt_hi(~0u, __builtin_amdgcn_mbcnt_lo(~0u, 0u)); asm volatile("" : "+v"(lane));
    const int tid = wave * 64 + lane, r32 = lane & 31, hi = lane >> 5;
    LAS unsigned char* L = F.lds + RING_OFF;
    const unsigned Lb = (unsigned)(uintptr_t)L;
    LAS float* wsf = (LAS float*)(F.lds + MIX_WSF) + wave * 64;
    const LAS float* lut = (const LAS float*)(F.lds + LUT_OFF);
    const int rowbase = b * SEQ;
    const int q0 = (MODE == 2) ? qb * 256 : qb * 128;
    const int rg = (MODE == 2) ? wave : (wave & 3), wsel = (MODE == 2) ? 0 : (wave >> 2);
    const int qw0 = q0 + 32 * rg;
    const int kcol = (MODE == 0) ? C_AK + hh * 128 : (MODE == 1) ? C_BK + (hh >> 1) * 64 : C_CK + hh * 64;
    const int vcol = (MODE == 0) ? C_AV + hh * 128 : (MODE == 1) ? C_BV + (hh >> 1) * 64 : C_CV + hh * 128;
    const int kch0 = (MODE == 0) ? wsel * 8 : 0;
    const int t_lo = (MODE == 1) ? (qb > 0 ? 2 * qb - 2 : 0) : 0, t_hi = (MODE == 2) ? 4 * qb + 4 : 2 * qb + 2;
    bf16x8 qf[NSUB][4];
#pragma unroll
    for (int s = 0; s < NSUB; ++s) {
        const int qcol = (MODE == 0) ? C_AQ + hh * 128 + wsel * 64 : (MODE == 1) ? C_BQ + (hh * 2 + wsel) * 64 : C_CQ + hh * 64;
        const bf16* qp = PROJ + (size_t)(rowbase + qw0 + r32) * PWP + qcol + hi * 8;
#pragma unroll
        for (int d0 = 0; d0 < 4; ++d0) qf[s][d0] = *(const bf16x8*)(qp + d0 * 16);
    }
    float m_run[NSUB], l_run[NSUB]; f32x16 o[NSUB][NEB];
#pragma unroll
    for (int s = 0; s < NSUB; ++s) {
        m_run[s] = (MODE == 1) ? a.in[5][layer * 12 + hh * 2 + wsel] * LOG2E : -1.0e30f; l_run[s] = (MODE == 1) ? 1.f : 0.f;
#pragma unroll
        for (int e = 0; e < NEB; ++e) o[s][e] = f32x16{};
    }
    const float lg2 = (MODE == 2) ? log2f(1.f - exp2f(-5.f - (float)hh)) : 0.f;
    unsigned dsrc[PW]; unsigned ddst[PW];
#pragma unroll
    for (int i = 0; i < PW; ++i) {
        const int j = wave + 8 * i;
        if (j < KD) {
            int row, ch;
            if (KW == 128) { row = 4 * j + (lane >> 4); ch = (lane & 15) ^ (row & 15); }
            else { row = 8 * j + (lane >> 3); ch = (lane & 7) ^ ((row >> 1) & 7); }
            dsrc[i] = (unsigned)(((rowbase + row) * PWP + kcol + ch * 8) * 2); ddst[i] = (unsigned)(j * 1024);
        } else {
            const int jv = j - KD, eb = jv >> 2, key = 16 * (jv & 3) + 8 * (lane >> 5) + ((lane >> 2) & 7);
            dsrc[i] = (unsigned)(((rowbase + key) * PWP + vcol + eb * 32 + (lane & 3) * 8) * 2); ddst[i] = (unsigned)(KBYTES + jv * 1024);
        }
    }
#define MIX_DMA(t) do { const unsigned st_ = Lb + (unsigned)((((t) - t_lo) % NST) * BUFB); \
        _Pragma("unroll") for (int i_ = 0; i_ < PW; ++i_) glds16((const char*)PROJ + (size_t)(t) * (64 * PWP * 2) + dsrc[i_], (unsigned)__builtin_amdgcn_readfirstlane(st_ + ddst[i_])); } while (0)
    const int vlane = (4 * hi + ((lane & 15) >> 2)) * 64 + ((lane >> 4) & 1) * 32 + (lane & 3) * 8;
    asm volatile("s_waitcnt vmcnt(0)" ::: "memory");
#pragma unroll
    for (int s = 0; s < NSUB; ++s) {
        asm volatile("" : "+v"(m_run[s]));
#pragma unroll
        for (int d0 = 0; d0 < 4; ++d0) asm volatile("" : "+v"(qf[s][d0]));
    }
    MIX_DMA(t_lo);
    if (t_lo + 1 < t_hi) MIX_DMA(t_lo + 1);
#pragma unroll 1
    for (int t = t_lo; t < t_hi; ++t) {
        if (t + 1 < t_hi) { if (PW == 2) asm volatile("s_waitcnt vmcnt(2)" ::: "memory"); else if (PW == 3) asm volatile("s_waitcnt vmcnt(3)" ::: "memory"); else asm volatile("s_waitcnt vmcnt(4)" ::: "memory"); }
        else asm volatile("s_waitcnt vmcnt(0)" ::: "memory");
        asm volatile("s_waitcnt lgkmcnt(0)\n\ts_barrier" ::: "memory");
        if (t + 2 < t_hi) MIX_DMA(t + 2);
        const LAS unsigned char* Kb = L + ((t - t_lo) % NST) * BUFB; const LAS unsigned char* Vb = Kb + KBYTES;
        const int k0 = 64 * t;
        const bool active = (k0 <= qw0 + 31) && (MODE != 1 || k0 + 63 >= qw0 - 127);
        if (active) {
#pragma unroll
            for (int s = 0; s < NSUB; ++s) {
                f32x16 p0 = f32x16{}, p1 = f32x16{};
#pragma unroll
                for (int d0 = 0; d0 < 4; ++d0) {
                    const int ch = kch0 + 2 * d0 + hi;
                    const int ofs = (KW == 128) ? (r32 * 256 + ((ch ^ (r32 & 15)) << 4)) : (r32 * 128 + ((ch ^ ((r32 >> 1) & 7)) << 4));
                    const bf16x8 ka = *(const LAS bf16x8*)(Kb + ofs);
                    const bf16x8 kb2 = *(const LAS bf16x8*)(Kb + 32 * KW * 2 + ofs);
                    p0 = __builtin_amdgcn_mfma_f32_32x32x16_bf16(ka, qf[s][d0], p0, 0, 0, 0);
                    p1 = __builtin_amdgcn_mfma_f32_32x32x16_bf16(kb2, qf[s][d0], p1, 0, 0, 0);
                }
                const int qi = qw0 + r32;
                if (MODE == 2) {
#pragma unroll
                    for (int r = 0; r < 16; ++r) { const int d0_ = qi - (k0 + crow(r, hi)), d1_ = d0_ - 32;
                        const float dec = __builtin_amdgcn_exp2f((float)(qi - (k0 & ~127)) * lg2);
                        p0[r] = d0_ >= 0 ? p0[r] * dec : 0.f; p1[r] = d1_ >= 0 ? p1[r] * dec : 0.f; }
                } else {
                    const bool nearb = (MODE == 1) || (k0 + 63 + 128 > qw0);
                    if (nearb) {
                        const LAS float* lrow = lut + ((MODE == 0) ? hh : 6 + hh * 2 + wsel) * LUT_STRIDE;
#pragma unroll
                        for (int r = 0; r < 16; ++r) { const int d0_ = qi - (k0 + crow(r, hi)), d1_ = d0_ - 32;
                            const bool ok0 = (MODE == 0) ? (d0_ >= 0) : (d0_ >= 0 && d0_ < 128), ok1 = (MODE == 0) ? (d1_ >= 0) : (d1_ >= 0 && d1_ < 128);
                            const int i0_ = d0_ < 0 ? 0 : (d0_ > 128 ? 128 : d0_), i1_ = d1_ < 0 ? 0 : (d1_ > 128 ? 128 : d1_);
                            p0[r] = ok0 ? p0[r] + lrow[i0_] : -INFINITY; p1[r] = ok1 ? p1[r] + lrow[i1_] : -INFINITY; }
                    }
                    float rm = fmaxf(p0[0], p1[0]);
#pragma unroll
                    for (int r = 1; r < 16; ++r) rm = fmaxf(rm, fmaxf(p0[r], p1[r]));
                    rm = fmaxf(rm, __shfl_xor(rm, 32));
                    if (__any(rm > m_run[s] + MIX_THR)) {
                        const float mn = fmaxf(m_run[s], rm), al = __builtin_amdgcn_exp2f(m_run[s] - mn);
                        m_run[s] = mn; l_run[s] *= al;
                        if (hi == 0) wsf[r32] = al;
                        LDS_WAIT();
#pragma unroll
                        for (int r = 0; r < 16; ++r) { const float f = wsf[crow(r, hi)];
#pragma unroll
                            for (int e = 0; e < NEB; ++e) o[s][e][r] *= f; }
                        LDS_WAIT();
                    }
                    float ls = 0.f; const float mm = m_run[s];
#pragma unroll
                    for (int r = 0; r < 16; ++r) { p0[r] = __builtin_amdgcn_exp2f(p0[r] - mm); p1[r] = __builtin_amdgcn_exp2f(p1[r] - mm); ls += p0[r] + p1[r]; }
                    l_run[s] += ls;
                }
                s16x4 vlo[2][NEB], vhi[2][NEB];
#pragma unroll
                for (int e = 0; e < NEB; ++e) { vlo[0][e] = vtr(Vb + e * 4096 + vlane); vhi[0][e] = vtr(Vb + e * 4096 + vlane + 512); }
#pragma unroll
                for (int g = 0; g < 4; ++g) {
                    if (g < 3) {
#pragma unroll
                        for (int e = 0; e < NEB; ++e) { vlo[(g + 1) & 1][e] = vtr(Vb + e * 4096 + (g + 1) * 1024 + vlane); vhi[(g + 1) & 1][e] = vtr(Vb + e * 4096 + (g + 1) * 1024 + vlane + 512); }
                    }
                    const bf16x8 pa = pack_p((g >> 1) == 0 ? p0 : p1, g & 1);
#pragma unroll
                    for (int e = 0; e < NEB; ++e) {
                        const s16x4 lo = vlo[g & 1][e], hh2 = vhi[g & 1][e];
                        const bf16x8 vb = (bf16x8){lo[0], lo[1], lo[2], lo[3], hh2[0], hh2[1], hh2[2], hh2[3]};
                        o[s][e] = __builtin_amdgcn_mfma_f32_32x32x16_bf16(pa, vb, o[s][e], 0, 0, 0);
                    }
                }
                if (NSUB > 1) __builtin_amdgcn_sched_barrier(0);
            }
        }
    }
#undef MIX_DMA
    __syncthreads();
    if (MODE == 1) {
#pragma unroll
        for (int s = 0; s < NSUB; ++s) {
            const float sink2 = a.in[5][layer * 12 + hh * 2 + wsel] * LOG2E;
            const float lt = l_run[s] + __shfl_xor(l_run[s], 32) - __builtin_amdgcn_exp2f(sink2 - m_run[s]);
            if (hi == 0) wsf[r32] = 1.f / lt;
            LDS_WAIT();
            bf16* orow = CAT + (size_t)(rowbase + qw0) * DM + 768 + (hh * 2 + wsel) * 64 + r32;
#pragma unroll
            for (int r = 0; r < 16; ++r) { const int qr = crow(r, hi); const float f = wsf[qr];
#pragma unroll
                for (int e = 0; e < NEB; ++e) orow[(size_t)qr * DM + 32 * e] = (bf16)f2bf(o[s][e][r] * f); }
            LDS_WAIT();
        }
    } else if (MODE == 2) {
        const bf16* grow = PROJ + (size_t)(rowbase + qw0) * PWP + C_CG + hh * 128 + r32;
        bf16* orow = CAT + (size_t)(rowbase + qw0) * DM + 1536 + hh * 128 + r32;
#pragma unroll
        for (int r = 0; r < 16; ++r) {
            float s1 = 0.f;
#pragma unroll
            for (int e = 0; e < NEB; ++e) s1 += o[0][e][r];
#pragma unroll
            for (int sh = 1; sh < 32; sh <<= 1) s1 += __shfl_xor(s1, sh);
            const float mu = s1 * (1.f / 128.f); float s2 = 0.f;
#pragma unroll
            for (int e = 0; e < NEB; ++e) { const float d = o[0][e][r] - mu; s2 += d * d; }
#pragma unroll
            for (int sh = 1; sh < 32; sh <<= 1) s2 += __shfl_xor(s2, sh);
            const float rs = 1.f / sqrtf(s2 * (1.f / 128.f) + LN_EPS); const int qr = crow(r, hi);
#pragma unroll
            for (int e = 0; e < NEB; ++e) orow[(size_t)qr * DM + 32 * e] = (bf16)f2bf(pg8::silu_f(bf2f(grow[(size_t)qr * PWP + 32 * e])) * (o[0][e][r] - mu) * rs);
        }
    } else {
        const float lt = l_run[0] + __shfl_xor(l_run[0], 32);
        if (hi == 0) wsf[r32] = 1.f / lt;
        LDS_WAIT();
        LAS float* xb = (LAS float*)L + rg * 4096;
        if (wsel == 1) {
#pragma unroll
            for (int r = 0; r < 16; ++r) { const float f = wsf[crow(r, hi)];
#pragma unroll
                for (int e = 0; e < NEB; ++e) xb[(e * 16 + r) * 64 + lane] = o[0][e][r] * f; }
        }
        __syncthreads();
        if (wsel == 0) {
            const float* subg = a.in[4] + layer * 128; const float post = 1.f - lam_init;
            bf16* orow = CAT + (size_t)(rowbase + qw0) * DM + hh * 128 + r32;
#pragma unroll
            for (int r = 0; r < 16; ++r) { const float f = wsf[crow(r, hi)]; float d[NEB]; float ss = 0.f;
#pragma unroll
                for (int e = 0; e < NEB; ++e) { d[e] = o[0][e][r] * f - lam * xb[(e * 16 + r) * 64 + lane]; ss += d[e] * d[e]; }
#pragma unroll
                for (int sh = 1; sh < 32; sh <<= 1) ss += __shfl_xor(ss, sh);
                const float rs = (1.f / sqrtf(ss * (1.f / 128.f) + LN_EPS)) * post; const int qr = crow(r, hi);
#pragma unroll
                for (int e = 0; e < NEB; ++e) orow[(size_t)qr * DM + 32 * e] = (bf16)f2bf(d[e] * rs * subg[32 * e + r32]); }
        }
    }
    __syncthreads();
}
__device__ __forceinline__ void attn3_unit(Frame& F, const Args& a, int layer, int b, int hh, int qb, float lam, float lam_init) {
    constexpr int KBYTES = 128 * 256, VBYTES = 128 * 256, BUFB = KBYTES + VBYTES;
    static_assert(2 * BUFB <= RING_BYTES, "attn3 LDS ring");
    unsigned char* ws = a.ws; const bf16* PROJ = (const bf16*)(ws + WS_PROJ); bf16* CAT = (bf16*)(ws + WS_CAT);
    const int wave = F.wave; int lane = (int)__builtin_amdgcn_mbcnt_hi(~0u, __builtin_amdgcn_mbcnt_lo(~0u, 0u)); asm volatile("" : "+v"(lane));
    const int r32 = lane & 31, hi = lane >> 5;
    LAS unsigned char* L = F.lds + RING_OFF; const unsigned Lb = (unsigned)(uintptr_t)L;
    LAS float* wsf = (LAS float*)(F.lds + MIX_WSF) + wave * 64;
    const LAS float* lrow = (const LAS float*)(F.lds + LUT_OFF) + hh * LUT_STRIDE;
    const int rowbase = b * SEQ, q0 = qb * 128, rg = wave & 3, wsel = wave >> 2, qw0 = q0 + 32 * rg, t_hi = qb + 1;
    unsigned srcK, srcV;
    { const int row = 4 * wave + (lane >> 4), ch = (lane & 15) ^ (row & 15); srcK = (unsigned)(((rowbase + row) * PWP + C_AK + hh * 128 + ch * 8) * 2);
      const int key = 16 * wave + 8 * (lane >> 5) + ((lane >> 2) & 7); srcV = (unsigned)(((rowbase + key) * PWP + C_AV + hh * 128 + (lane & 3) * 8) * 2); }
#define A3_DMA(t) do { const char* tb_ = (const char*)PROJ + (size_t)(t) * (128 * PWP * 2); const unsigned st_ = (unsigned)__builtin_amdgcn_readfirstlane(Lb + (unsigned)(((t) & 1) * BUFB) + wave * 1024); \
        glds16s<0>(tb_, srcK, st_); glds16s<0>(tb_ + 32 * PWP * 2, srcK, st_ + 8192); glds16s<0>(tb_ + 64 * PWP * 2, srcK, st_ + 16384); glds16s<0>(tb_ + 96 * PWP * 2, srcK, st_ + 24576); \
        glds16s<0>(tb_, srcV, st_ + KBYTES); glds16s<64>(tb_, srcV, st_ + KBYTES + 8192); glds16s<128>(tb_, srcV, st_ + KBYTES + 16384); glds16s<192>(tb_, srcV, st_ + KBYTES + 24576); } while (0)
    const int vlane = (4 * hi + ((lane & 15) >> 2)) * 64 + ((lane >> 4) & 1) * 32 + (lane & 3) * 8;
    A3_DMA(0);
    bf16x8 qf[4];
    { const bf16* qp = PROJ + (size_t)(rowbase + qw0 + r32) * PWP + C_AQ + hh * 128 + wsel * 64 + hi * 8;
#pragma unroll
      for (int d0 = 0; d0 < 4; ++d0) qf[d0] = *(const bf16x8*)(qp + d0 * 16); }
    float m_run = -1.0e30f, l_run = 0.f; f32x16 o[4];
#pragma unroll
    for (int e = 0; e < 4; ++e) o[e] = f32x16{};
    asm volatile("s_waitcnt vmcnt(0)" ::: "memory");
#pragma unroll
    for (int d0 = 0; d0 < 4; ++d0) asm volatile("" : "+v"(qf[d0]));
    asm volatile("s_waitcnt lgkmcnt(0)\n\ts_barrier" ::: "memory");
#pragma unroll 1
    for (int t = 0; t < t_hi; ++t) {
        if (t + 1 < t_hi) A3_DMA(t + 1);
        const LAS unsigned char* Kb = L + (t & 1) * BUFB; const LAS unsigned char* Vb = Kb + KBYTES;
        const int k0 = 128 * t;
        if (k0 <= qw0 + 31) {
            f32x16 p[4];
#pragma unroll
            for (int j = 0; j < 4; ++j) p[j] = f32x16{};
#pragma unroll
            for (int d0 = 0; d0 < 4; ++d0) {
                const int ofs = r32 * 256 + (((8 * wsel + 2 * d0 + hi) ^ (r32 & 15)) << 4);
#pragma unroll
                for (int j = 0; j < 4; ++j) p[j] = __builtin_amdgcn_mfma_f32_32x32x16_bf16(*(const LAS bf16x8*)(Kb + j * 8192 + ofs), qf[d0], p[j], 0, 0, 0);
            }
            const int qi = qw0 + r32;
            if (k0 + 127 + 128 > qw0) {
#pragma unroll
                for (int r = 0; r < 16; ++r) { const int dd = qi - (k0 + crow(r, hi));
#pragma unroll
                    for (int j = 0; j < 4; ++j) { const int dj = dd - 32 * j; const int ij = dj < 0 ? 0 : (dj > 128 ? 128 : dj); p[j][r] = dj >= 0 ? p[j][r] + lrow[ij] : -INFINITY; } }
            }
            float rm = fmaxf(fmaxf(p[0][0], p[1][0]), fmaxf(p[2][0], p[3][0]));
#pragma unroll
            for (int r = 1; r < 16; ++r) rm = fmaxf(rm, fmaxf(fmaxf(p[0][r], p[1][r]), fmaxf(p[2][r], p[3][r])));
            rm = fmaxf(rm, __shfl_xor(rm, 32));
            if (__any(rm > m_run + MIX_THR)) {
                const float mn = fmaxf(m_run, rm), al = __builtin_amdgcn_exp2f(m_run - mn);
                m_run = mn; l_run *= al;
                if (hi == 0) wsf[r32] = al;
                LDS_WAIT();
#pragma unroll
                for (int r = 0; r < 16; ++r) { const float f = wsf[crow(r, hi)];
#pragma unroll
                    for (int e = 0; e < 4; ++e) o[e][r] *= f; }
                LDS_WAIT();
            }
            float ls0 = 0.f, ls1 = 0.f;
#pragma unroll
            for (int r = 0; r < 16; ++r) { p[0][r] = __builtin_amdgcn_exp2f(p[0][r] - m_run); p[1][r] = __builtin_amdgcn_exp2f(p[1][r] - m_run); p[2][r] = __builtin_amdgcn_exp2f(p[2][r] - m_run); p[3][r] = __builtin_amdgcn_exp2f(p[3][r] - m_run);
                ls0 += p[0][r] + p[1][r]; ls1 += p[2][r] + p[3][r]; }
            l_run += ls0 + ls1;
#pragma unroll
            for (int g = 0; g < 8; ++g) {
                const bf16x8 pa = pack_p(p[g >> 1], g & 1);
#pragma unroll
                for (int e = 0; e < 4; ++e) {
                    const LAS unsigned char* vp = Vb + e * 8192 + g * 1024 + vlane;
                    const s16x4 lo = vtr(vp), h2 = vtr(vp + 512);
                    const bf16x8 vb = (bf16x8){lo[0], lo[1], lo[2], lo[3], h2[0], h2[1], h2[2], h2[3]};
                    o[e] = __builtin_amdgcn_mfma_f32_32x32x16_bf16(pa, vb, o[e], 0, 0, 0);
                }
            }
        }
        asm volatile("s_waitcnt vmcnt(0) lgkmcnt(0)\n\ts_barrier" ::: "memory");
    }
#undef A3_DMA
    {
        const float lt = l_run + __shfl_xor(l_run, 32);
        if (hi == 0) wsf[r32] = 1.f / lt;
        LDS_WAIT();
        LAS float* xb = (LAS float*)L + rg * 4096;
        if (wsel == 1) {
#pragma unroll
            for (int r = 0; r < 16; ++r) { const float f = wsf[crow(r, hi)];
#pragma unroll
                for (int e = 0; e < 4; ++e) xb[(e * 16 + r) * 64 + lane] = o[e][r] * f; }
        }
        __syncthreads();
        if (wsel == 0) {
            const float* subg = a.in[4] + layer * 128; const float post = 1.f - lam_init;
            bf16* orow = CAT + (size_t)(rowbase + qw0) * DM + hh * 128 + r32;
#pragma unroll
            for (int r = 0; r < 16; ++r) { const float f = wsf[crow(r, hi)]; float d[4]; float ss = 0.f;
#pragma unroll
                for (int e = 0; e < 4; ++e) { d[e] = o[e][r] * f - lam * xb[(e * 16 + r) * 64 + lane]; ss += d[e] * d[e]; }
#pragma unroll
                for (int sh = 1; sh < 32; sh <<= 1) ss += __shfl_xor(ss, sh);
                const float rs = (1.f / sqrtf(ss * (1.f / 128.f) + LN_EPS)) * post; const int qr = crow(r, hi);
#pragma unroll
                for (int e = 0; e < 4; ++e) orow[(size_t)qr * DM + 32 * e] = (bf16)f2bf(d[e] * rs * subg[32 * e + r32]); }
        }
    }
    __syncthreads();
}
constexpr int C2_KR = 0, C2_KT = 16384, C2_VT = 32768, C2_ST = 65536, C2_STATS = 81920, C2_G = 83968;
static_assert(C2_G + 32768 <= RING_BYTES, "chunkwise retention LDS map");
__device__ __forceinline__ void retention_unit(Frame& F, const Args& a, int b, int hh) {
    unsigned char* ws = a.ws; const bf16* PROJ = (const bf16*)(ws + WS_PROJ); bf16* CAT = (bf16*)(ws + WS_CAT);
    const int wave = F.wave; int lane = (int)__builtin_amdgcn_mbcnt_hi(~0u, __builtin_amdgcn_mbcnt_lo(~0u, 0u)); asm volatile("" : "+v"(lane));
    const int r32 = lane & 31, hi = lane >> 5;
    LAS unsigned char* L = F.lds + RING_OFF; const unsigned Lb = (unsigned)(uintptr_t)L;
    const int rowbase = b * SEQ, rg = wave & 3, eh = wave >> 2, dh = wave & 1, eq = wave >> 1;
    const float lg2 = log2f(1.f - exp2f(-5.f - (float)hh));
    const float gq = __builtin_amdgcn_exp2f(lg2 * (float)(32 * rg + r32));
    const float gC = __builtin_amdgcn_exp2f(lg2 * 128.f), gC1 = __builtin_amdgcn_exp2f(lg2 * 127.f);
    unsigned srcKr, srcKt, srcVt;
    { const int row = 8 * wave + (lane >> 3), ch = (lane & 7) ^ ((row >> 1) & 7); srcKr = (unsigned)(((rowbase + row) * PWP + C_CK + hh * 64 + ch * 8) * 2);
      const int key = 16 * wave + 8 * (lane >> 5) + ((lane >> 2) & 7);
      srcKt = (unsigned)(((rowbase + key) * PWP + C_CK + hh * 64 + (lane & 3) * 8) * 2); srcVt = (unsigned)(((rowbase + key) * PWP + C_CV + hh * 128 + (lane & 3) * 8) * 2); }
    const unsigned srcG = (unsigned)(((rowbase + 4 * wave + (lane >> 4)) * PWP + C_CG + hh * 128 + (lane & 15) * 8) * 2);
#define C2_GDMA(n) do { const char* gb_ = (const char*)PROJ + (size_t)(n) * (128 * PWP * 2); const unsigned wg_ = (unsigned)__builtin_amdgcn_readfirstlane(Lb + C2_G + wave * 1024); \
        glds16s<0>(gb_, srcG, wg_); glds16s<0>(gb_ + 32 * PWP * 2, srcG, wg_ + 8192); glds16s<0>(gb_ + 64 * PWP * 2, srcG, wg_ + 16384); glds16s<0>(gb_ + 96 * PWP * 2, srcG, wg_ + 24576); } while (0)
#define C2_DMA(n) do { const char* cb_ = (const char*)PROJ + (size_t)(n) * (128 * PWP * 2); const char* cb2_ = cb_ + 64 * PWP * 2; const unsigned w1k_ = (unsigned)__builtin_amdgcn_readfirstlane(Lb + wave * 1024); \
        glds16s<0>(cb_, srcKr, w1k_ + C2_KR); glds16s<0>(cb2_, srcKr, w1k_ + C2_KR + 8192); \
        glds16s<0>(cb_, srcKt, w1k_ + C2_KT); glds16s<64>(cb_, srcKt, w1k_ + C2_KT + 8192); \
        glds16s<0>(cb_, srcVt, w1k_ + C2_VT); glds16s<64>(cb_, srcVt, w1k_ + C2_VT + 8192); glds16s<128>(cb_, srcVt, w1k_ + C2_VT + 16384); glds16s<192>(cb_, srcVt, w1k_ + C2_VT + 24576); } while (0)
    const int vlane = (4 * hi + ((lane & 15) >> 2)) * 64 + ((lane >> 4) & 1) * 32 + (lane & 3) * 8;
    const int krow = r32 * 128, kkey = (r32 >> 1) & 7;
    f32x16 Sb = f32x16{};
    bf16x8 qf[4];
    { const bf16* qbase = PROJ + (size_t)(rowbase + 32 * rg + r32) * PWP + C_CQ + hh * 64 + hi * 8;
#pragma unroll
      for (int d0 = 0; d0 < 4; ++d0) qf[d0] = *(const bf16x8*)(qbase + d0 * 16); }
    asm volatile("s_waitcnt vmcnt(0)" ::: "memory");
#pragma unroll
    for (int d0 = 0; d0 < 4; ++d0) asm volatile("" : "+v"(qf[d0]));
    C2_DMA(0);
#pragma unroll 1
    for (int n = 0; n < 16; ++n) {
        asm volatile("s_waitcnt vmcnt(0) lgkmcnt(0)\n\ts_barrier" ::: "memory");
        C2_GDMA(n);
        f32x16 o[2]; o[0] = f32x16{}; o[1] = f32x16{};
        for (int kb = 0; kb <= rg; ++kb) {
            f32x16 T = f32x16{};
#pragma unroll
            for (int d0 = 0; d0 < 4; ++d0) {
                const bf16x8 ka = *(const LAS bf16x8*)(L + C2_KR + kb * 4096 + krow + (((2 * d0 + hi) ^ kkey) << 4));
                T = __builtin_amdgcn_mfma_f32_32x32x16_bf16(ka, qf[d0], T, 0, 0, 0);
            }
#pragma unroll
            for (int r = 0; r < 16; ++r) T[r] = (kb == rg && crow(r, hi) > r32) ? 0.f : T[r] * gq;
#pragma unroll
            for (int s2 = 0; s2 < 2; ++s2) {
                const bf16x8 pa = pack_p(T, s2);
#pragma unroll
                for (int e = 0; e < 2; ++e) {
                    const LAS unsigned char* vp = L + C2_VT + (2 * eh + e) * 8192 + (4 * kb + 2 * s2) * 512 + vlane;
                    const s16x4 lo = vtr(vp), h2 = vtr(vp + 512);
                    const bf16x8 vb = (bf16x8){lo[0], lo[1], lo[2], lo[3], h2[0], h2[1], h2[2], h2[3]};
                    o[e] = __builtin_amdgcn_mfma_f32_32x32x16_bf16(pa, vb, o[e], 0, 0, 0);
                }
                __builtin_amdgcn_sched_barrier(0);
            }
        }
        __builtin_amdgcn_sched_barrier(0);
        if (n > 0) {
            f32x16 oc[2]; oc[0] = f32x16{}; oc[1] = f32x16{};
#pragma unroll
            for (int d0 = 0; d0 < 4; ++d0)
#pragma unroll
                for (int e = 0; e < 2; ++e) {
                    const bf16x8 sb = *(const LAS bf16x8*)(L + C2_ST + (2 * eh + e) * 4096 + krow + (((2 * d0 + hi) ^ kkey) << 4));
                    oc[e] = __builtin_amdgcn_mfma_f32_32x32x16_bf16(qf[d0], sb, oc[e], 0, 0, 0);
                }
#pragma unroll
            for (int r = 0; r < 16; ++r) { const float xi = __builtin_amdgcn_exp2f(lg2 * (float)(32 * rg + crow(r, hi) + 1)); o[0][r] += xi * oc[0][r]; o[1][r] += xi * oc[1][r]; }
        }
        __builtin_amdgcn_sched_barrier(0);
        {
            f32x16 kv = f32x16{};
#pragma unroll
            for (int g = 0; g < 8; ++g) {
                const LAS unsigned char* kp = L + C2_KT + dh * 8192 + (2 * g) * 512 + vlane; const LAS unsigned char* vp = L + C2_VT + eq * 8192 + (2 * g) * 512 + vlane;
                const s16x4 kl = vtr(kp), kh2 = vtr(kp + 512), vl = vtr(vp), vh2 = vtr(vp + 512);
                const bf16x8 ka = (bf16x8){kl[0], kl[1], kl[2], kl[3], kh2[0], kh2[1], kh2[2], kh2[3]}, vb = (bf16x8){vl[0], vl[1], vl[2], vl[3], vh2[0], vh2[1], vh2[2], vh2[3]};
                kv = __builtin_amdgcn_mfma_f32_32x32x16_bf16(ka, vb, kv, 0, 0, 0);
                if (g & 1) __builtin_amdgcn_sched_barrier(0);
            }
#pragma unroll
            for (int r = 0; r < 16; ++r) Sb[r] = gC * Sb[r] + gC1 * kv[r];
        }
        __builtin_amdgcn_sched_barrier(0);
        if (n + 1 < 16) {
            int l2 = lane; asm volatile("" : "+v"(l2));
            const bf16* qn = PROJ + (size_t)(rowbase + 128 * (n + 1) + 32 * rg + (l2 & 31)) * PWP + C_CQ + hh * 64 + (l2 >> 5) * 8;
#pragma unroll
            for (int d0 = 0; d0 < 4; ++d0) qf[d0] = *(const bf16x8*)(qn + d0 * 16);
        }
        LAS float* st = (LAS float*)(L + C2_STATS);
#pragma unroll
        for (int r4 = 0; r4 < 4; ++r4) {
            float s1[4], s2[4];
#pragma unroll
            for (int i = 0; i < 4; ++i) { const int r = 4 * r4 + i; s1[i] = o[0][r] + o[1][r]; s2[i] = o[0][r] * o[0][r] + o[1][r] * o[1][r]; }
#pragma unroll
            for (int sh = 1; sh < 32; sh <<= 1)
#pragma unroll
                for (int i = 0; i < 4; ++i) { s1[i] += __shfl_xor(s1[i], sh); s2[i] += __shfl_xor(s2[i], sh); }
            if (r32 == 0) {
#pragma unroll
                for (int i = 0; i < 4; ++i) { const int qr = crow(4 * r4 + i, hi); st[((rg * 2 + eh) * 32 + qr) * 2 + 0] = s1[i]; st[((rg * 2 + eh) * 32 + qr) * 2 + 1] = s2[i]; }
            }
            __builtin_amdgcn_sched_barrier(0);
        }
        __builtin_amdgcn_sched_barrier(0);
        asm volatile("s_waitcnt vmcnt(0) lgkmcnt(0)\n\ts_barrier" ::: "memory");
        if (n + 1 < 16) C2_DMA(n + 1);
        {
            const int e_ = 32 * eq + r32;
#pragma unroll
            for (int q4 = 0; q4 < 4; ++q4) { v2u w; w.x = cvtpk_s(Sb[4 * q4 + 0], Sb[4 * q4 + 1]); w.y = cvtpk_s(Sb[4 * q4 + 2], Sb[4 * q4 + 3]);
                *(LAS v2u*)(L + C2_ST + e_ * 128 + (((4 * dh + q4) ^ ((e_ >> 1) & 7)) << 4) + 8 * hi) = w; }
        }
        asm volatile("s_waitcnt lgkmcnt(0)\n\ts_barrier" ::: "memory");
        {
            const LAS bf16* grow = (const LAS bf16*)(L + C2_G) + (32 * rg) * 128 + 64 * eh + r32;
            bf16* orow = CAT + (size_t)(rowbase + 128 * n + 32 * rg) * DM + 1536 + hh * 128 + 64 * eh + r32;
#pragma unroll
            for (int r = 0; r < 16; ++r) {
                const int qr = crow(r, hi);
                const float t1 = st[((rg * 2) * 32 + qr) * 2 + 0] + st[((rg * 2 + 1) * 32 + qr) * 2 + 0], t2 = st[((rg * 2) * 32 + qr) * 2 + 1] + st[((rg * 2 + 1) * 32 + qr) * 2 + 1];
                const float mu = t1 * (1.f / 128.f), var = fmaxf(t2 * (1.f / 128.f) - mu * mu, 0.f), rs = 1.f / sqrtf(var + LN_EPS);
#pragma unroll
                for (int e = 0; e < 2; ++e) orow[(size_t)qr * DM + 32 * e] = (bf16)f2bf(pg8::silu_f(bf2f(grow[qr * 128 + 32 * e])) * (o[e][r] - mu) * rs);
                if ((r & 3) == 3) __builtin_amdgcn_sched_barrier(0);
            }
        }
    }
#undef C2_DMA
#undef C2_GDMA
    __syncthreads();
}
constexpr int B2_K = 0, B2_V = 32768;
__device__ __forceinline__ void swa_unit(Frame& F, const Args& a, int layer, int b, int kvh, int qb) {
    unsigned char* ws = a.ws; const bf16* PROJ = (const bf16*)(ws + WS_PROJ); bf16* CAT = (bf16*)(ws + WS_CAT);
    const int wave = F.wave; int lane = (int)__builtin_amdgcn_mbcnt_hi(~0u, __builtin_amdgcn_mbcnt_lo(~0u, 0u)); asm volatile("" : "+v"(lane));
    const int r32 = lane & 31, hi = lane >> 5;
    LAS unsigned char* L = F.lds + RING_OFF; const unsigned Lb = (unsigned)(uintptr_t)L;
    LAS float* wsf = (LAS float*)(F.lds + MIX_WSF) + wave * 64;
    const LAS float* lut = (const LAS float*)(F.lds + LUT_OFF);
    const int rowbase = b * SEQ, q0 = qb * 128;
    const int tl0 = (qb == 0) ? 2 : 0;
    unsigned srcK, srcV;
    { const int row = 8 * wave + (lane >> 3), ch = (lane & 7) ^ ((row >> 1) & 7); srcK = (unsigned)(((rowbase + q0 + row) * PWP + C_BK + kvh * 64 + ch * 8) * 2);
      const int key = 16 * (wave & 3) + 8 * (lane >> 5) + ((lane >> 2) & 7); srcV = (unsigned)(((rowbase + q0 + key) * PWP + C_BV + kvh * 64 + (wave >> 2) * 32 + (lane & 3) * 8) * 2); }
    {
        const unsigned wk = (unsigned)__builtin_amdgcn_readfirstlane(Lb + wave * 1024);
        for (int tl = tl0; tl < 4; ++tl) {
            const char* tb = (const char*)PROJ + (long)(tl - 2) * (64 * PWP * 2);
            glds16s<0>(tb, srcK, wk + B2_K + tl * 8192); glds16s<0>(tb, srcV, wk + B2_V + tl * 8192);
        }
    }
    const int vlane = (4 * hi + ((lane & 15) >> 2)) * 64 + ((lane >> 4) & 1) * 32 + (lane & 3) * 8;
    const int kofs0 = r32 * 128, kkey = (r32 >> 1) & 7;
    const int rg = wave & 3, qw0 = q0 + 32 * rg;
    bf16x8 qf[2][4]; float sink2[2], m_run[2], l_run[2]; f32x16 o[2][2]; const LAS float* lrow[2];
#pragma unroll
    for (int s = 0; s < 2; ++s) {
        const int hq = kvh * 4 + (wave >> 2) + 2 * s;
        const bf16* qp = PROJ + (size_t)(rowbase + qw0 + r32) * PWP + C_BQ + hq * 64 + hi * 8;
#pragma unroll
        for (int d0 = 0; d0 < 4; ++d0) qf[s][d0] = *(const bf16x8*)(qp + d0 * 16);
        sink2[s] = a.in[5][layer * 12 + hq] * LOG2E; m_run[s] = sink2[s]; l_run[s] = 1.f; o[s][0] = f32x16{}; o[s][1] = f32x16{};
        lrow[s] = lut + (6 + hq) * LUT_STRIDE;
    }
    asm volatile("s_waitcnt vmcnt(0)" ::: "memory"); __syncthreads();
    const int t_a = (rg < 2) ? 0 : 1;
    for (int tl = (t_a < tl0 ? tl0 : t_a); tl < t_a + 3; ++tl) {
        const LAS unsigned char* Kb = L + B2_K + tl * 8192; const LAS unsigned char* Vb = L + B2_V + tl * 8192;
        const int k0 = q0 - 128 + 64 * tl;
        f32x16 p0[2], p1[2]; p0[0] = f32x16{}; p0[1] = f32x16{}; p1[0] = f32x16{}; p1[1] = f32x16{};
#pragma unroll
        for (int d0 = 0; d0 < 4; ++d0) {
            const int ofs = kofs0 + (((2 * d0 + hi) ^ kkey) << 4);
            const bf16x8 ka = *(const LAS bf16x8*)(Kb + ofs), kb2 = *(const LAS bf16x8*)(Kb + 4096 + ofs);
#pragma unroll
            for (int s = 0; s < 2; ++s) { p0[s] = __builtin_amdgcn_mfma_f32_32x32x16_bf16(ka, qf[s][d0], p0[s], 0, 0, 0); p1[s] = __builtin_amdgcn_mfma_f32_32x32x16_bf16(kb2, qf[s][d0], p1[s], 0, 0, 0); }
        }
        const int qi = qw0 + r32;
#pragma unroll
        for (int r = 0; r < 16; ++r) { const int d0_ = qi - (k0 + crow(r, hi)), d1_ = d0_ - 32;
            const bool ok0 = (d0_ >= 0 && d0_ < 128), ok1 = (d1_ >= 0 && d1_ < 128);
            const int i0_ = d0_ < 0 ? 0 : (d0_ > 128 ? 128 : d0_), i1_ = d1_ < 0 ? 0 : (d1_ > 128 ? 128 : d1_);
#pragma unroll
            for (int s = 0; s < 2; ++s) { p0[s][r] = ok0 ? p0[s][r] + lrow[s][i0_] : -INFINITY; p1[s][r] = ok1 ? p1[s][r] + lrow[s][i1_] : -INFINITY; } }
#pragma unroll
        for (int s = 0; s < 2; ++s) {
            float rm = fmaxf(p0[s][0], p1[s][0]);
#pragma unroll
            for (int r = 1; r < 16; ++r) rm = fmaxf(rm, fmaxf(p0[s][r], p1[s][r]));
            rm = fmaxf(rm, __shfl_xor(rm, 32));
            if (__any(rm > m_run[s] + MIX_THR)) {
                const float mn = fmaxf(m_run[s], rm), al = __builtin_amdgcn_exp2f(m_run[s] - mn);
                m_run[s] = mn; l_run[s] *= al;
                if (hi == 0) wsf[r32] = al;
                LDS_WAIT();
#pragma unroll
                for (int r = 0; r < 16; ++r) { const float f = wsf[crow(r, hi)]; o[s][0][r] *= f; o[s][1][r] *= f; }
                LDS_WAIT();
            }
            float ls = 0.f;
#pragma unroll
            for (int r = 0; r < 16; ++r) { p0[s][r] = __builtin_amdgcn_exp2f(p0[s][r] - m_run[s]); p1[s][r] = __builtin_amdgcn_exp2f(p1[s][r] - m_run[s]); ls += p0[s][r] + p1[s][r]; }
            l_run[s] += ls;
        }
#pragma unroll
        for (int gq = 0; gq < 4; ++gq) {
            bf16x8 pa[2];
#pragma unroll
            for (int s = 0; s < 2; ++s) pa[s] = pack_p((gq >> 1) == 0 ? p0[s] : p1[s], gq & 1);
#pragma unroll
            for (int e = 0; e < 2; ++e) {
                const LAS unsigned char* vp = Vb + e * 4096 + gq * 1024 + vlane;
                const s16x4 lo = vtr(vp), h2 = vtr(vp + 512);
                const bf16x8 vb = (bf16x8){lo[0], lo[1], lo[2], lo[3], h2[0], h2[1], h2[2], h2[3]};
#pragma unroll
                for (int s = 0; s < 2; ++s) o[s][e] = __builtin_amdgcn_mfma_f32_32x32x16_bf16(pa[s], vb, o[s][e], 0, 0, 0);
            }
        }
    }
#pragma unroll
    for (int s = 0; s < 2; ++s) {
        const int hq = kvh * 4 + (wave >> 2) + 2 * s;
        const float lt = l_run[s] + __shfl_xor(l_run[s], 32) - __builtin_amdgcn_exp2f(sink2[s] - m_run[s]);
        if (hi == 0) wsf[r32] = 1.f / lt;
        LDS_WAIT();
        bf16* orow = CAT + (size_t)(rowbase + qw0) * DM + 768 + hq * 64 + r32;
#pragma unroll
        for (int r = 0; r < 16; ++r) { const int qr = crow(r, hi); const float f = wsf[qr]; orow[(size_t)qr * DM] = (bf16)f2bf(o[s][0][r] * f); orow[(size_t)qr * DM + 32] = (bf16)f2bf(o[s][1][r] * f); }
        LDS_WAIT();
    }
    __syncthreads();
}
template <int MODE> __device__ __forceinline__ void mixer_queue(Frame& F, const Args& a, int layer, int qword, float lam, float lam_init) {
    constexpr int NU = (MODE == 0) ? 768 : (MODE == 1) ? 384 : (MODE == 3) ? 32 : 256;
    LAS int* qw = (LAS int*)(F.lds + MIX_QW);
    for (;;) {
        if (F.tid == 0) *qw = (int)__hip_atomic_fetch_add(F.ctl + CW_WQ + 64 * qword, 1u, RLX_AGENT);
        __syncthreads();
        const int it = __builtin_amdgcn_readfirstlane(*qw);
        __syncthreads();
        if (it >= NU) break;
        if (MODE == 3) retention_unit(F, a, it >> 2, it & 3);
        else if (MODE == 0) attn3_unit(F, a, layer, (it % 48) / 6, it % 6, 15 - it / 48, lam, lam_init);
        else if (MODE == 2) mix_unit<2>(F, a, layer, (it & 31) >> 2, it & 3, 7 - (it >> 5), lam, lam_init);
        else swa_unit(F, a, layer, it / 48, (it % 48) / 16, it & 15);
    }
}
__device__ __forceinline__ void mixer_phase(Frame& F, const Args& a, int layer, int rep) {
    const int qbase = 3 * (layer + 2 * rep);
    mixer_queue<3>(F, a, layer, qbase + 0, 0.f, 0.f);
    asm volatile("" ::: "memory");
    const float lam_init = 0.8f - 0.6f * __expf(-0.3f * (float)layer);
    const float lam = __builtin_bit_cast(float, __builtin_amdgcn_readfirstlane(__builtin_bit_cast(int, lambda_of(a.in[3] + layer * 256, F.lane, lam_init))));
    mixer_queue<0>(F, a, layer, qbase + 1, lam, lam_init);
    mixer_queue<1>(F, a, layer, qbase + 2, lam, lam_init);
}
#ifndef MIXER_NAIVE
#define MIXER_NAIVE 0
#endif
#ifndef PROBE_P0
#define PROBE_P0 1
#endif
#ifndef PROBE_MIX
#define PROBE_MIX 1
#endif
#ifndef PROBE_PROJ
#define PROBE_PROJ 1
#endif
#ifndef PROBE_DUP
#define PROBE_DUP 1
#endif
#ifndef PROBE_MUP
#define PROBE_MUP 1
#endif
#ifndef PROBE_MDN
#define PROBE_MDN 1
#endif
#ifndef PROBE_SPIN_PHASE
#define PROBE_SPIN_PHASE -1
#endif
#define PH_BEGIN(k) do { if (PROBE_SPIN_PHASE == (k)) spin_t0 = __builtin_amdgcn_s_memrealtime(); } while (0)
#define PH_END(k) do { if (PROBE_SPIN_PHASE == (k)) spin_dt = __builtin_amdgcn_s_memrealtime() - spin_t0; } while (0)
#define REPEAT(N) for (int rep = 0; rep < (N); ++rep)
#define TWICE_IF(N, CALL) do { CALL; if ((N) == 2) { xcd_barrier(bar); CALL; } } while (0)
#define REPBAR(N) do { if (rep + 1 < (N)) xcd_barrier(bar); } while (0)
#define IN(k) (lo <= (k) && (k) < hi)
#define SEAM(k) do { if (IN(k) && IN((k) + 1)) xcd_barrier(bar); } while (0)
template <int l> __device__ __forceinline__ void run_layer(Frame& F, const Args& args, const XcdBarrier& bar, int lo, int hi, unsigned long long& spin_t0, unsigned long long& spin_dt) {
    unsigned char* ws = args.ws;
    bf16* XB = (bf16*)(ws + WS_XB); bf16* PROJ = (bf16*)(ws + WS_PROJ); bf16* CAT = (bf16*)(ws + WS_CAT); bf16* HB = (bf16*)(ws + WS_H);
    float* T = args.out;
        const int pb = 1 + 7 * l;
        PH_BEGIN(pb); if (IN(pb)) {
            pg8::Gemm g{XB, (const bf16*)(ws + WS_WIN) + (size_t)l * PWP * DM, NTOK, PWP, DM * 2}; pg8::StaticOrder S; S.init(NTOK, PWP, F.G, (int)blockIdx.x);
            pg8::EpiProj E{PROJ, (const float*)(ws + WS_TAB), (const float*)(ws + WS_TAB + 256 * 1024)};
            TWICE_IF(PROBE_PROJ, (pg8::gemm_phase<pg8::EpiProj, pg8::StaticOrder, true, true>(F.lds + RING_OFF, F.wave, g, S, E)));
        } SEAM(pb); PH_END(pb);
        PH_BEGIN(pb + 1); if (IN(pb + 1)) {
#if MIXER_NAIVE
            naive_mixers(F, args, l);
#else
            REPEAT(PROBE_MIX) { mixer_phase(F, args, l, rep); REPBAR(PROBE_MIX); }
#endif
        } SEAM(pb + 1); PH_END(pb + 1);
        PH_BEGIN(pb + 2); if (IN(pb + 2)) {
            pg8::Gemm g{CAT, (const bf16*)(ws + WS_WOUT) + (size_t)l * DM * DM, NTOK, DM, DM * 2}; pg8::StaticOrder S; S.init(NTOK, DM, F.G, (int)blockIdx.x);
            pg8::EpiResid E{T, XB, 1.f};
            pg8::gemm_phase<pg8::EpiResid, pg8::StaticOrder, true, true>(F.lds + RING_OFF, F.wave, g, S, E);
        } SEAM(pb + 2); PH_END(pb + 2);
        if constexpr (l == 0) {
            PH_BEGIN(4); if (IN(4)) { ln_phase<0>(F, args, T, args.in[7], args.in[8], nullptr); } SEAM(4); PH_END(4);
            PH_BEGIN(5); if (IN(5)) {
                pg8::Gemm g{XB, (const bf16*)(ws + WS_WDGU), NTOK, 2 * DFF, DM * 2}; pg8::StaticOrder S; S.init(NTOK, 2 * DFF, F.G, (int)blockIdx.x);
                pg8::EpiSwiGLU8 E{ws + WS_H, 44, 1.f};
                TWICE_IF(PROBE_DUP, (pg8::gemm_phase<pg8::EpiSwiGLU8, pg8::StaticOrder, true, true, false>(F.lds + RING_OFF, F.wave, g, S, E)));
            } SEAM(5); PH_END(5);
            PH_BEGIN(6); if (IN(6)) {
                pg8::Gemm g{ws + WS_H, ws + WS_WDDN, NTOK, DM, DFF}; pg8::StaticOrder S; S.init(NTOK, DM, F.G, (int)blockIdx.x);
                pg8::EpiResid E{T, XB, 1.f / (pg8::FP8_SH * pg8::FP8_SWD)};
                pg8::gemm_phase<pg8::EpiResid, pg8::StaticOrder, true, true, true>(F.lds + RING_OFF, F.wave, g, S, E);
            } SEAM(6); PH_END(6);
            PH_BEGIN(7); if (IN(7)) { ln_phase<0>(F, args, T, args.in[9], args.in[10], nullptr); } SEAM(7); PH_END(7);
        } else {
            PH_BEGIN(11); if (IN(11)) { ln_phase<1>(F, args, T, args.in[7] + DM, args.in[8] + DM, args.in[14]); } SEAM(11); PH_END(11);
            PH_BEGIN(12); if (IN(12)) { gather_phase(F, args, T); } SEAM(12); PH_END(12);
            if (IN(13) || IN(14) || IN(15)) {
                int ntl_v; const int offv = expert_offsets(F, ntl_v); const int ntl = __builtin_amdgcn_readfirstlane(ntl_v);
                pg8::GroupedOrder S; S.nM = ntl; S.pm0 = 0; S.G = F.G; S.c = (int)blockIdx.x;
#pragma unroll
                for (int e = 0; e < 8; ++e) S.cum[e] = (e < 7) ? __builtin_amdgcn_readfirstlane(__shfl(offv, e + 1) >> 8) : ntl;
                PH_BEGIN(13); if (IN(13)) {
                    S.nN = 44; S.nwg = ntl * 44;
                    pg8::Gemm g{ws + WS_XG, ws + WS_WMGU, ntl * 256, 8 * 2 * DFF, DM};
                    pg8::EpiSwiGLU8 E{ws + WS_H, 44, 1.f / (pg8::FP8_SX * pg8::FP8_SWU)};
                    TWICE_IF(PROBE_MUP, (pg8::gemm_phase<pg8::EpiSwiGLU8, pg8::GroupedOrder, true, true, true>(F.lds + RING_OFF, F.wave, g, S, E)));
                } SEAM(13); PH_END(13);
                PH_BEGIN(14); if (IN(14)) {
                    S.nN = 8; S.pm0 = 0; S.nM = ntl < 128 ? ntl : 128; S.nwg = S.nM * 8;
                    pg8::Gemm g{ws + WS_H, ws + WS_WMDN, ntl * 256, 8 * DM, DFF};
                    pg8::EpiY E{(bf16*)(ws + WS_Y), 8, 1.f / (pg8::FP8_SH * pg8::FP8_SWD)};
                    TWICE_IF(PROBE_MDN, (pg8::gemm_phase<pg8::EpiY, pg8::GroupedOrder, true, true, true>(F.lds + RING_OFF, F.wave, g, S, E)));
                } SEAM(14); PH_END(14);
                PH_BEGIN(15); if (IN(15)) {
                    S.nN = 8; S.pm0 = 128; S.nM = ntl > 128 ? ntl - 128 : 0; S.nwg = S.nM * 8;
                    if (S.nwg > 0) {
                        pg8::Gemm g{ws + WS_H, ws + WS_WMDN, ntl * 256, 8 * DM, DFF};
                        pg8::EpiY E{(bf16*)(ws + WS_Y), 8, 1.f / (pg8::FP8_SH * pg8::FP8_SWD)};
                        pg8::gemm_phase<pg8::EpiY, pg8::GroupedOrder, true, true, true>(F.lds + RING_OFF, F.wave, g, S, E);
                    }
                    {
                        LAS int* qw = (LAS int*)(F.lds + MIX_QW);
                        for (;;) {
                            if (F.tid == 0) *qw = (int)__hip_atomic_fetch_add(F.ctl + CW_WQ + 64 * 12, 1u, RLX_AGENT);
                            __syncthreads();
                            const int grp64 = __builtin_amdgcn_readfirstlane(*qw);
                            __syncthreads();
                            if (grp64 >= NTOK / 64) break;
                            ln_phase<2>(F, args, T, args.in[9] + DM, args.in[10] + DM, nullptr, grp64 * 64 + F.wave * 8, 1);
                        }
                    }
                    xcd_barrier(bar);
                    ln_phase<2>(F, args, T, args.in[9] + DM, args.in[10] + DM, nullptr, -1, 2);
                } PH_END(15);
            }
        }
}
constexpr int N_PHASES = 16;
__global__ void __launch_bounds__(NWAVES * 64, 2) hymba_fwd(Args args) {
    extern __shared__ __attribute__((aligned(16))) unsigned char lds[];
    Frame F;
    F.lds = (LAS unsigned char*)lds;
    volatile LAS unsigned* MISC = (volatile LAS unsigned*)(F.lds + MISC_OFF);
    F.wave = __builtin_amdgcn_readfirstlane((int)threadIdx.x >> 6); F.lane = (int)__builtin_amdgcn_mbcnt_hi(~0u, __builtin_amdgcn_mbcnt_lo(~0u, 0u)); F.tid = F.wave * 64 + F.lane;
    F.G = gridDim.x; { const int bx = blockIdx.x; F.vcu = (F.G % 8 == 0) ? (bx % 8) * (F.G / 8) + bx / 8 : bx; }
    unsigned char* ws = args.ws;
    F.ctl = (gu32*)(ws + WS_CTL);
    for (int u = F.tid; u < 1024 / 4; u += NWAVES * 64) ((LAS unsigned*)(F.lds + LDSCTL_OFF))[u] = 0u;
    __syncthreads();
    XcdBarrier bar = xcd_barrier_post((unsigned*)(F.ctl + CW_BAR) + args.li * 4096, MISC + 8);
    build_lut(F, args.in[2]);
    __syncthreads();
    const int lo = args.ph_lo, hi = args.ph_hi;
    unsigned long long spin_t0 = 0ull, spin_dt = 0ull;
    PH_BEGIN(0); if (IN(0)) { REPEAT(PROBE_P0) { p0_prologue(F, args); REPBAR(PROBE_P0); } } SEAM(0); PH_END(0);
    run_layer<0>(F, args, bar, lo, hi, spin_t0, spin_dt);
    run_layer<1>(F, args, bar, lo, hi, spin_t0, spin_dt);
    if (PROBE_SPIN_PHASE >= 0 && blockIdx.x == 0) { const unsigned long long te = __builtin_amdgcn_s_memrealtime() + 10ull * spin_dt; while (__builtin_amdgcn_s_memrealtime() < te) __builtin_amdgcn_s_sleep(16); }
#undef IN
#undef SEAM
}

#ifndef N_LAUNCHES
#define N_LAUNCHES 1
#endif
extern "C" void kernel_launch(void* const* d_in, const int* in_sizes, int n_in, void* d_out, int out_size, void* d_ws, size_t ws_size, hipStream_t stream) {
    static int grid = 0;
    if (grid == 0) {
        if (n_in != 18 || in_sizes[0] != NTOK * DM || out_size != NTOK * DM || ws_size < WS_END) { fprintf(stderr, "kernel_launch: unexpected shapes / workspace (%d inputs, ws %zu < %zu)\n", n_in, ws_size, (size_t)WS_END); grid = -1; return; }
        int dev = 0, cus = 0, per_cu = 0;
        if (hipGetDevice(&dev) != hipSuccess || hipDeviceGetAttribute(&cus, hipDeviceAttributeMultiprocessorCount, dev) != hipSuccess) { grid = -1; return; }
        if (hipFuncSetAttribute((const void*)hymba_fwd, hipFuncAttributeMaxDynamicSharedMemorySize, LDS_BYTES) != hipSuccess) { fprintf(stderr, "kernel_launch: hipFuncSetAttribute failed\n"); grid = -1; return; }
        if (hipOccupancyMaxActiveBlocksPerMultiprocessor(&per_cu, (const void*)hymba_fwd, NWAVES * 64, LDS_BYTES) != hipSuccess || per_cu < 1) fprintf(stderr, "kernel_launch: occupancy query reports %d\n", per_cu);
        (void)hipGetLastError();
        grid = (cus == 256) ? 256 : -1;
        if (grid < 0) { fprintf(stderr, "kernel_launch: built for a 256-CU device, found %d CUs\n", cus); return; }
    }
    if (grid < 0) return;
    if (hipMemsetAsync((char*)d_ws + WS_CTL, 0, CTL_ZERO_BYTES, stream) != hipSuccess) return;
    Args a{};
    for (int i = 0; i < 18; ++i) a.in[i] = (const float*)d_in[i];
    a.out = (float*)d_out; a.ws = (unsigned char*)d_ws;
    for (int i = 0; i < 32; ++i) a.invf[i] = (float)(1.0 / pow(10000.0, (double)((float)i / 31.0f)));
#if N_LAUNCHES == 1
    const int cuts[2] = {0, N_PHASES};
#else
    int cuts[N_PHASES + 1]; for (int i = 0; i <= N_PHASES; ++i) cuts[i] = i;
#endif
    const int nl = (N_LAUNCHES == 1) ? 1 : N_PHASES;
    for (int li = 0; li < nl; ++li) {
        a.ph_lo = cuts[li]; a.ph_hi = cuts[li + 1]; a.li = li; a.pad = 0;
        hipLaunchKernelGGL(hymba_fwd, dim3(grid), dim3(NWAVES * 64), LDS_BYTES, stream, a);
        const hipError_t le = hipPeekAtLastError();
        if (le != hipSuccess) { fprintf(stderr, "kernel_launch: launch %d failed: %s\n", li, hipGetErrorName(le)); break; }
    }
}
```

```cpp
#include <hip/hip_runtime.h>
#include <cstdio>
#include <cstdint>
#include <cmath>
namespace pg8 {
#define PG8_LAS __attribute__((address_space(3)))
typedef unsigned short bf16_t;
typedef short bf16x8 __attribute__((ext_vector_type(8)));
typedef float f32x4 __attribute__((ext_vector_type(4)));
typedef unsigned u32x4 __attribute__((ext_vector_type(4)));
constexpr int BM = 256, BK = 64, HALF = 128, HTB = HALF * BK * 2  , STAGE_BYTES = 8 * HTB, NXCD = 8, WGM = 8;

__host__ __device__ __forceinline__ int lds_byte(int r, int c) { const int st = (r >> 4) * 2 + (c >> 5), rr = r & 15, cc = c & 31, ob = rr * 64 + cc * 2; return st * 1024 + (ob ^ (((ob >> 9) & 1) << 5)); }
__host__ __device__ __forceinline__ void stage_rc(int b, int& R, int& C) { const int st = b / 1024, sb = b % 1024, swz = sb ^ (((sb >> 9) & 1) << 5); R = (st >> 1) * 16 + swz / 64; C = (st & 1) * 32 + (swz % 64) / 2; }
__host__ __device__ __forceinline__ int perm32(int rho) { const int n = rho >> 4, i = rho & 15; return 8 * (i >> 2) + 4 * n + (i & 3); }

struct Unit { int pm, pn; };
struct Gemm { const void* A; const void* Bt; int M, N, KB; };
typedef int v4i_t __attribute__((ext_vector_type(4)));
typedef int v8i_t __attribute__((ext_vector_type(8)));

struct StaticOrder {
    int nM, nN, nwg, G, c;
    __host__ __device__ void init(int M, int N, int G_, int c_) { nM = M / BM; nN = N / BM; nwg = nM * nN; G = G_; c = c_; }
    __host__ __device__ bool next(int i, Unit& u) const {
        const long L = (long)i * G + c; if (L >= nwg) return false;
        int wgid = (int)L; { const int q = nwg / NXCD, r = nwg % NXCD, xcd = wgid % NXCD, off = wgid / NXCD; wgid = (xcd < r ? xcd * (q + 1) : r * (q + 1) + (xcd - r) * q) + off; }
        const int nig = WGM * nN, gid = wgid / nig, fm = gid * WGM, gsz = (nM - fm) < WGM ? (nM - fm) : WGM;
        u.pm = fm + ((wgid % nig) % gsz); u.pn = (wgid % nig) / gsz; return true;
    }
    __device__ __forceinline__ void a_ready(const Unit&) const {}
    __device__ __forceinline__ void done(const Unit&) const {}
};

__device__ __forceinline__ unsigned cvt_pk_bf16(float lo, float hi) { unsigned r; asm volatile("v_cvt_pk_bf16_f32 %0, %1, %2" : "=v"(r) : "v"(lo), "v"(hi)); return r; }
typedef float f32x2 __attribute__((ext_vector_type(2)));
typedef float f32x2 __attribute__((ext_vector_type(2)));
typedef unsigned u32x2 __attribute__((ext_vector_type(2)));
constexpr float ALPHA_F = 1.41421356237309515f;
constexpr float C2_F = 0.125f * 1.4426950408889634f;
__device__ __forceinline__ u32x4 pack8(const f32x4 v0, const f32x4 v1) { u32x4 w; w.x = cvt_pk_bf16(v0[0], v0[1]); w.y = cvt_pk_bf16(v0[2], v0[3]); w.z = cvt_pk_bf16(v1[0], v1[1]); w.w = cvt_pk_bf16(v1[2], v1[3]); return w; }

struct EpiProj {
    static constexpr bool PERM = true, AFTER_DRAIN = false;
    bf16_t* O; const float* sinT; const float* cosT;
    __device__ __forceinline__ void operator()(const f32x4 (&acc)[2][2][4][2], const Unit& u, int wr, int wc, int fr, int fq) const {
        const int row0 = u.pm * BM + wr * 64 + fr;
#pragma unroll
        for (int bj = 0; bj < 2; ++bj) {
            const int cw = u.pn * BM + bj * HALF + wc * 32;
            const int c0 = cw + 8 * fq;
            float sc = 1.f; bool rope = false;
            if (cw < 768 || (cw >= 2304 && cw < 3072)) sc = C2_F;
            else if (cw >= 3456 && cw < 3968) { rope = true; if (cw >= 3712) sc = 0.125f; }
            const float klg2 = (cw >= 3712 && cw < 3968) ? -__builtin_amdgcn_logf(1.f - __builtin_amdgcn_exp2f(-5.f - (float)((cw - 3712) >> 6))) : 0.f;
            const int i0 = ((c0 - 3456) & 63) >> 1;
#pragma unroll
            for (int ai = 0; ai < 2; ++ai)
#pragma unroll
                for (int m = 0; m < 4; ++m) {
                    const int row = row0 + ai * HALF + m * 16;
                    const float scr_ = sc * __builtin_amdgcn_exp2f(klg2 * (float)(row & 127));
                    f32x4 v0 = acc[ai][bj][m][0] * scr_, v1 = acc[ai][bj][m][1] * scr_;
                    if (rope) {
                        const int pos = row & 2047;
                        const f32x4 sn = *(const f32x4*)(sinT + pos * 32 + i0), cs = *(const f32x4*)(cosT + pos * 32 + i0);
                        f32x4 w0, w1;
                        w0[0] = v0[0] * cs[0] - v0[1] * sn[0]; w0[1] = v0[1] * cs[0] + v0[0] * sn[0];
                        w0[2] = v0[2] * cs[1] - v0[3] * sn[1]; w0[3] = v0[3] * cs[1] + v0[2] * sn[1];
                        w1[0] = v1[0] * cs[2] - v1[1] * sn[2]; w1[1] = v1[1] * cs[2] + v1[0] * sn[2];
                        w1[2] = v1[2] * cs[3] - v1[3] * sn[3]; w1[3] = v1[3] * cs[3] + v1[2] * sn[3];
                        v0 = w0; v1 = w1;
                    }
                    *(u32x4*)(O + (size_t)row * 5120 + c0) = pack8(v0, v1);
                }
        }
    }
};
struct EpiResid {
    static constexpr bool PERM = true, AFTER_DRAIN = false;
    float* T; const bf16_t* R; float scale;
    __device__ __forceinline__ void operator()(const f32x4 (&acc)[2][2][4][2], const Unit& u, int wr, int wc, int fr, int fq) const {
        const int row0 = u.pm * BM + wr * 64 + fr, col0 = u.pn * BM + wc * 32 + 8 * fq;
#pragma unroll
        for (int ai = 0; ai < 2; ++ai)
#pragma unroll
            for (int m = 0; m < 4; ++m) {
                const size_t ro = (size_t)(row0 + ai * HALF + m * 16) * 2048 + col0;
#pragma unroll
                for (int bj = 0; bj < 2; ++bj) {
                    const u32x4 r = *(const u32x4*)(R + ro + bj * HALF);
                    f32x4 r0, r1;
                    r0[0] = __builtin_bit_cast(float, r.x << 16); r0[1] = __builtin_bit_cast(float, r.x & 0xffff0000u); r0[2] = __builtin_bit_cast(float, r.y << 16); r0[3] = __builtin_bit_cast(float, r.y & 0xffff0000u);
                    r1[0] = __builtin_bit_cast(float, r.z << 16); r1[1] = __builtin_bit_cast(float, r.z & 0xffff0000u); r1[2] = __builtin_bit_cast(float, r.w << 16); r1[3] = __builtin_bit_cast(float, r.w & 0xffff0000u);
                    *(f32x4*)(T + ro + bj * HALF) = r0 * ALPHA_F + acc[ai][bj][m][0] * scale;
                    *(f32x4*)(T + ro + bj * HALF + 4) = r1 * ALPHA_F + acc[ai][bj][m][1] * scale;
                }
            }
    }
};
__device__ __forceinline__ float silu_f(float x) { return x * __builtin_amdgcn_rcpf(1.f + __builtin_amdgcn_exp2f(-1.4426950408889634f * x)); }
struct EpiSwiGLU {
    static constexpr bool PERM = true, AFTER_DRAIN = false;
    bf16_t* H; int ntn;
    __device__ __forceinline__ void operator()(const f32x4 (&acc)[2][2][4][2], const Unit& u, int wr, int wc, int fr, int fq) const {
        const int row0 = u.pm * BM + wr * 64 + fr, col0 = (u.pn % ntn) * HALF + wc * 32 + 8 * fq;
#pragma unroll
        for (int ai = 0; ai < 2; ++ai)
#pragma unroll
            for (int m = 0; m < 4; ++m) {
                f32x4 h0, h1;
#pragma unroll
                for (int j = 0; j < 4; ++j) { h0[j] = silu_f(acc[ai][0][m][0][j]) * acc[ai][1][m][0][j]; h1[j] = silu_f(acc[ai][0][m][1][j]) * acc[ai][1][m][1][j]; }
                *(u32x4*)(H + (size_t)(row0 + ai * HALF + m * 16) * 5632 + col0) = pack8(h0, h1);
            }
    }
};
constexpr float FP8_SX = 16.f, FP8_SWU = 512.f, FP8_SH = 8.f, FP8_SWD = 2048.f;
__device__ __forceinline__ unsigned pack4_fp8(float a, float b, float c, float d) {
    a = __builtin_amdgcn_fmed3f(a, -448.f, 448.f); b = __builtin_amdgcn_fmed3f(b, -448.f, 448.f); c = __builtin_amdgcn_fmed3f(c, -448.f, 448.f); d = __builtin_amdgcn_fmed3f(d, -448.f, 448.f);
    int w = __builtin_amdgcn_cvt_pk_fp8_f32(a, b, 0, false); w = __builtin_amdgcn_cvt_pk_fp8_f32(c, d, w, true); return (unsigned)w;
}
struct EpiSwiGLU8 {
    static constexpr bool PERM = true, AFTER_DRAIN = false;
    unsigned char* H; int ntn; float si;
    __device__ __forceinline__ void operator()(const f32x4 (&acc)[2][2][4][2], const Unit& u, int wr, int wc, int fr, int fq) const {
        const int row0 = u.pm * BM + wr * 64 + fr, col0 = (u.pn % ntn) * HALF + wc * 32 + 8 * fq;
#pragma unroll
        for (int ai = 0; ai < 2; ++ai)
#pragma unroll
            for (int m = 0; m < 4; ++m) {
                f32x4 h0, h1;
#pragma unroll
                for (int j = 0; j < 4; ++j) { h0[j] = silu_f(acc[ai][0][m][0][j] * si) * (acc[ai][1][m][0][j] * (si * FP8_SH)); h1[j] = silu_f(acc[ai][0][m][1][j] * si) * (acc[ai][1][m][1][j] * (si * FP8_SH)); }
                u32x2 w; w.x = pack4_fp8(h0[0], h0[1], h0[2], h0[3]); w.y = pack4_fp8(h1[0], h1[1], h1[2], h1[3]);
                *(u32x2*)(H + (size_t)(row0 + ai * HALF + m * 16) * 5632 + col0) = w;
            }
    }
};
struct EpiY {
    static constexpr bool PERM = true, AFTER_DRAIN = false;
    bf16_t* Y; int ntn; float scale;
    __device__ __forceinline__ void operator()(const f32x4 (&acc)[2][2][4][2], const Unit& u, int wr, int wc, int fr, int fq) const {
        const int row0 = u.pm * BM + wr * 64 + fr, col0 = (u.pn % ntn) * BM + wc * 32 + 8 * fq;
#pragma unroll
        for (int ai = 0; ai < 2; ++ai)
#pragma unroll
            for (int m = 0; m < 4; ++m)
#pragma unroll
                for (int bj = 0; bj < 2; ++bj)
                    *(u32x4*)(Y + (size_t)(row0 + ai * HALF + m * 16) * 2048 + col0 + bj * HALF) = pack8(acc[ai][bj][m][0] * scale, acc[ai][bj][m][1] * scale);
    }
};
struct GroupedOrder {
    int nM, nN, nwg, G, c, pm0; int cum[8];
    __device__ __forceinline__ bool next(int i, Unit& u) const {
        const long L = (long)i * G + c; if (L >= nwg) return false;
        int wgid = (int)L; { const int q = nwg / NXCD, r = nwg % NXCD, xcd = wgid % NXCD, off = wgid / NXCD; wgid = (xcd < r ? xcd * (q + 1) : r * (q + 1) + (xcd - r) * q) + off; }
        const int nig = WGM * nN, gid = wgid / nig, fm = gid * WGM, gsz = (nM - fm) < WGM ? (nM - fm) : WGM;
        const int pm = pm0 + fm + ((wgid % nig) % gsz), pn = (wgid % nig) / gsz;
        int e = 0;
#pragma unroll
        for (int j = 0; j < 7; ++j) e += (pm >= cum[j]) ? 1 : 0;
        u.pm = pm; u.pn = e * nN + pn; return true;
    }
    __device__ __forceinline__ void a_ready(const Unit&) const {}
    __device__ __forceinline__ void done(const Unit&) const {}
};
template <class Epi, class Sched, bool ALIGN_EPI = false, bool SP2 = false, bool FP8 = false>
__device__ __forceinline__ void gemm_phase(PG8_LAS unsigned char* lds, const int wid, const Gemm g, const Sched& S, const Epi& E) {
    const int lane = (int)__builtin_amdgcn_mbcnt_hi(~0u, __builtin_amdgcn_mbcnt_lo(~0u, 0u)), tid = wid * 64 + lane,
        wr = wid >> 2, wc = wid & 3, fr = lane & 15, fq = lane >> 4;
    const int KB = g.KB, nt = KB / 128;
    unsigned voffA[2], voffB[2];
#pragma unroll
    for (int i = 0; i < 2; ++i) { int R, C; stage_rc(tid * 16 + i * 8192, R, C); const int Rb = Epi::PERM ? ((R & ~31) + perm32(R & 31)) : R;
        voffA[i] = (unsigned)(R * KB + C * 2); voffB[i] = (unsigned)(Rb * KB + C * 2); }
    const size_t kstep = (size_t)128;
    const size_t hstep = (size_t)HALF * KB;
    const size_t tstep = 2 * hstep;
    const unsigned ldsw = (unsigned)wid * 1024u;
    const int aoff = lds_byte(wr * 64 + fr, fq * 8), boff = lds_byte(wc * 32 + fr, fq * 8);
#define PG8_SA(b, h) (((b) * 2 + (h)) * HTB)
#define PG8_SB(b, h) ((4 + (b) * 2 + (h)) * HTB)
#define PG8_STAGE(bufoff, gbase, voff) do { _Pragma("unroll") for (int _i = 0; _i < 2; ++_i) \
        __builtin_amdgcn_global_load_lds((const unsigned*)((const char*)(gbase) + (voff)[_i]), (PG8_LAS unsigned*)(lds + (bufoff) + ldsw + _i * 8192), 16, 0, 0); } while (0)
#define PG8_LDA(dst, b, h) do { _Pragma("unroll") for (int m = 0; m < 4; ++m) _Pragma("unroll") for (int k = 0; k < 2; ++k) dst[m][k] = *(const PG8_LAS bf16x8*)(lds + PG8_SA(b, h) + aoff + m * 2048 + k * 1024); } while (0)
#define PG8_LDB(dst, b, h) do { _Pragma("unroll") for (int n = 0; n < 2; ++n) _Pragma("unroll") for (int k = 0; k < 2; ++k) dst[n][k] = *(const PG8_LAS bf16x8*)(lds + PG8_SB(b, h) + boff + n * 2048 + k * 1024); } while (0)
#define PG8_MMA(ai, bj, At, Bt) do { __builtin_amdgcn_s_setprio(1); _Pragma("unroll") for (int m = 0; m < 4; ++m) _Pragma("unroll") for (int n = 0; n < 2; ++n) { \
        if constexpr (FP8) { const v4i_t b0_ = __builtin_bit_cast(v4i_t, Bt[n][0]), b1_ = __builtin_bit_cast(v4i_t, Bt[n][1]), a0_ = __builtin_bit_cast(v4i_t, At[m][0]), a1_ = __builtin_bit_cast(v4i_t, At[m][1]); \
            const v8i_t b8_ = __builtin_shufflevector(b0_, b1_, 0, 1, 2, 3, 4, 5, 6, 7), a8_ = __builtin_shufflevector(a0_, a1_, 0, 1, 2, 3, 4, 5, 6, 7); \
            asm volatile("v_mfma_f32_16x16x128_f8f6f4 %0, %1, %2, %0" : "+v"(acc[ai][bj][m][n]) : "v"(b8_), "v"(a8_)); } \
        else { _Pragma("unroll") for (int k = 0; k < 2; ++k) acc[ai][bj][m][n] = __builtin_amdgcn_mfma_f32_16x16x32_bf16(Bt[n][k], At[m][k], acc[ai][bj][m][n], 0, 0, 0); } } __builtin_amdgcn_s_setprio(0); } while (0)
#define PG8_WAIT_V(n) asm volatile("s_waitcnt vmcnt(" #n ")" ::: "memory")
#define PG8_WAIT_L(n) asm volatile("s_waitcnt lgkmcnt(" #n ")" ::: "memory")
#define PG8_BAR __builtin_amdgcn_s_barrier()
#define PG8_SCHED __builtin_amdgcn_sched_barrier(0)
    Unit cur, nxt; int ui = 0;
    if (!S.next(0, cur)) return;
    f32x4 acc[2][2][4][2];
#pragma unroll
    for (int a = 0; a < 2; ++a)
#pragma unroll
        for (int b = 0; b < 2; ++b)
#pragma unroll
            for (int m = 0; m < 4; ++m)
#pragma unroll
                for (int n = 0; n < 2; ++n) acc[a][b][m][n] = (f32x4){0.f, 0.f, 0.f, 0.f};
    bf16x8 At[4][2], B0[2][2], B1[2][2];
    const char* cA = (const char*)g.A + (size_t)cur.pm * tstep; const char* cB = (const char*)g.Bt + (size_t)cur.pn * tstep;
    S.a_ready(cur);
    if constexpr (SP2) {
        PG8_STAGE(PG8_SB(0, 0), cB, voffB); PG8_STAGE(PG8_SB(0, 1), cB + hstep, voffB); PG8_STAGE(PG8_SA(0, 0), cA, voffA); PG8_STAGE(PG8_SA(0, 1), cA + hstep, voffA);
        if (wr == 1) PG8_BAR;
        PG8_WAIT_V(2); PG8_BAR;
        PG8_STAGE(PG8_SB(1, 0), cB + kstep, voffB); PG8_STAGE(PG8_SA(1, 0), cA + kstep, voffA); PG8_STAGE(PG8_SB(1, 1), cB + hstep + kstep, voffB);
        PG8_WAIT_V(6); PG8_BAR;
    } else {
        PG8_STAGE(PG8_SB(0, 0), cB, voffB); PG8_STAGE(PG8_SA(0, 0), cA, voffA); PG8_STAGE(PG8_SB(0, 1), cB + hstep, voffB); PG8_STAGE(PG8_SA(0, 1), cA + hstep, voffA);
        if (wr == 1) PG8_BAR;
        PG8_WAIT_V(4); PG8_BAR;
        PG8_STAGE(PG8_SB(1, 0), cB + kstep, voffB); PG8_STAGE(PG8_SA(1, 0), cA + kstep, voffA); PG8_STAGE(PG8_SB(1, 1), cB + hstep + kstep, voffB);
        PG8_WAIT_V(6); PG8_BAR;
    }
    for (;;) {
        const bool has_next = S.next(ui + 1, nxt);
        const char* nA = has_next ? (const char*)g.A + (size_t)nxt.pm * tstep : cA; const char* nB = has_next ? (const char*)g.Bt + (size_t)nxt.pn * tstep : cB;
        for (int t = 0; t < nt; t += 2) {
            const bool last = (t == nt - 2);
            const char* a1 = cA + (size_t)(t + 1) * kstep;
            const char* a2 = last ? nA : cA + (size_t)(t + 2) * kstep; const char* b2 = last ? nB : cB + (size_t)(t + 2) * kstep;
            const char* a3 = a2 + kstep; const char* b3 = b2 + kstep;
            if (last && has_next) S.a_ready(nxt);
            if constexpr (SP2) {
            PG8_LDB(B0, 0, 0); PG8_LDB(B1, 0, 1); PG8_SCHED; PG8_LDA(At, 0, 0); PG8_STAGE(PG8_SA(1, 1), a1 + hstep, voffA);
            PG8_WAIT_V(8); PG8_WAIT_L(0); PG8_BAR; PG8_MMA(0, 0, At, B0); PG8_MMA(0, 1, At, B1); PG8_BAR; PG8_SCHED;
            PG8_LDA(At, 0, 1); PG8_STAGE(PG8_SB(0, 0), b2, voffB); PG8_STAGE(PG8_SB(0, 1), b2 + hstep, voffB); PG8_STAGE(PG8_SA(0, 0), a2, voffA);
            PG8_WAIT_V(8); PG8_WAIT_L(0); PG8_BAR; PG8_MMA(1, 0, At, B0); PG8_MMA(1, 1, At, B1); PG8_BAR; PG8_SCHED;
            PG8_LDB(B0, 1, 0); PG8_LDB(B1, 1, 1); PG8_SCHED; PG8_LDA(At, 1, 0); PG8_STAGE(PG8_SA(0, 1), a2 + hstep, voffA);
            PG8_WAIT_V(8); PG8_WAIT_L(0); PG8_BAR; PG8_MMA(0, 0, At, B0); PG8_MMA(0, 1, At, B1); PG8_BAR; PG8_SCHED;
            PG8_LDA(At, 1, 1); PG8_STAGE(PG8_SB(1, 0), b3, voffB); PG8_STAGE(PG8_SB(1, 1), b3 + hstep, voffB); PG8_STAGE(PG8_SA(1, 0), a3, voffA);
            PG8_WAIT_V(8); PG8_WAIT_L(0); PG8_BAR; PG8_MMA(1, 0, At, B0); PG8_MMA(1, 1, At, B1); PG8_BAR; PG8_SCHED;
            } else {
            PG8_LDB(B0, 0, 0); PG8_SCHED; PG8_LDA(At, 0, 0); PG8_STAGE(PG8_SA(1, 1), a1 + hstep, voffA);
            PG8_WAIT_L(8); PG8_BAR; PG8_WAIT_L(0); PG8_MMA(0, 0, At, B0); PG8_BAR; PG8_SCHED;
            PG8_LDB(B1, 0, 1); PG8_STAGE(PG8_SB(0, 0), b2, voffB);
            PG8_BAR; PG8_WAIT_L(0); PG8_MMA(0, 1, At, B1); PG8_BAR;
            PG8_LDA(At, 0, 1); PG8_STAGE(PG8_SA(0, 0), a2, voffA);
            PG8_BAR; PG8_WAIT_L(0); PG8_MMA(1, 0, At, B0); PG8_BAR; PG8_SCHED;
            PG8_STAGE(PG8_SB(0, 1), b2 + hstep, voffB);
            PG8_WAIT_V(6); PG8_BAR; PG8_MMA(1, 1, At, B1); PG8_BAR;
            PG8_LDB(B0, 1, 0); PG8_SCHED; PG8_LDA(At, 1, 0); PG8_STAGE(PG8_SA(0, 1), a2 + hstep, voffA);
            PG8_WAIT_L(8); PG8_BAR; PG8_WAIT_L(0); PG8_MMA(0, 0, At, B0); PG8_BAR; PG8_SCHED;
            PG8_LDB(B1, 1, 1); PG8_STAGE(PG8_SB(1, 0), b3, voffB);
            PG8_BAR; PG8_WAIT_L(0); PG8_MMA(0, 1, At, B1); PG8_BAR;
            PG8_LDA(At, 1, 1); PG8_STAGE(PG8_SA(1, 0), a3, voffA);
            PG8_BAR; PG8_WAIT_L(0); PG8_MMA(1, 0, At, B0); PG8_BAR; PG8_SCHED;
            PG8_STAGE(PG8_SB(1, 1), b3 + hstep, voffB);
            PG8_WAIT_V(6); PG8_BAR; PG8_MMA(1, 1, At, B1); PG8_BAR;
            }
        }
        if constexpr (ALIGN_EPI) { if (wr == 0) PG8_BAR; }
        if constexpr (FP8) asm volatile("s_nop 15\n\ts_nop 15" ::: "memory");
        if constexpr (!Epi::AFTER_DRAIN) { E(acc, cur, wr, wc, fr, fq); S.done(cur); }
        if (!has_next) break;
#pragma unroll
        for (int a = 0; a < 2; ++a)
#pragma unroll
            for (int b = 0; b < 2; ++b)
#pragma unroll
                for (int m = 0; m < 4; ++m)
#pragma unroll
                    for (int n = 0; n < 2; ++n) acc[a][b][m][n] = (f32x4){0.f, 0.f, 0.f, 0.f};
        cur = nxt; cA = nA; cB = nB; ++ui;
        if constexpr (ALIGN_EPI) { if (wr == 1) PG8_BAR; }
    }
    PG8_WAIT_V(0);
    if constexpr (!ALIGN_EPI) { if (wr == 0) PG8_BAR; }
    PG8_BAR;
    if constexpr (Epi::AFTER_DRAIN) { E.fused(acc, cur, wr, wc, fr, fq, lds, wid, lane); S.done(cur); }
#undef PG8_SA
#undef PG8_SB
#undef PG8_STAGE
#undef PG8_LDA
#undef PG8_LDB
#undef PG8_MMA
#undef PG8_WAIT_V
#undef PG8_WAIT_L
#undef PG8_BAR
#undef PG8_SCHED
}
}
constexpr int NWAVES = 8;
constexpr int NTOK = 16384, SEQ = 2048, DM = 2048, PW = 4992, PWP = 5120, DFF = 5632, NEXP = 8, MAXTILES = 136;
constexpr float LN_EPS = 1e-5f;
constexpr float LOG2E = 1.4426950408889634f;
constexpr int C_AQ = 0, C_AK = 768, C_AV = 1536, C_BQ = 2304, C_BK = 3072, C_BV = 3264, C_CQ = 3456, C_CK = 3712, C_CV = 3968, C_CG = 4480;
constexpr size_t MiB = 1u << 20;
constexpr size_t WS_CTL = 0, CTL_ZERO_BYTES = 1 * MiB;
constexpr size_t WS_TAB = 1 * MiB;
constexpr size_t WS_ROUTE = 2 * MiB;
constexpr size_t WS_WIN = 4 * MiB, WS_WOUT = 44 * MiB, WS_WDGU = 60 * MiB, WS_WDDN = 104 * MiB, WS_WMGU = 126 * MiB, WS_WMDN = 478 * MiB;
constexpr size_t WS_XB = 654 * MiB, WS_XG = 718 * MiB, WS_U1 = 854 * MiB, WS_END = 1228 * MiB;
constexpr size_t WS_PROJ = WS_U1, WS_CAT = WS_U1 + 160 * MiB, WS_H = WS_U1, WS_Y = WS_XG;
static_assert(WS_WIN + 2ull * PWP * DM * 2 <= WS_WOUT && WS_WOUT + 2ull * DM * DM * 2 <= WS_WDGU && WS_WDGU + 2ull * DFF * DM * 2 <= WS_WDDN && WS_WDDN + (size_t)DM * DFF * 2 <= WS_WMGU, "ws map 1");
static_assert(WS_WMGU + 8ull * 2 * DFF * DM * 2 <= WS_WMDN && WS_WMDN + 8ull * DM * DFF * 2 <= WS_XB && WS_XB + (size_t)NTOK * DM * 2 <= WS_XG && WS_XG + (size_t)MAXTILES * 256 * DM * 2 <= WS_U1, "ws map 2");
static_assert(WS_U1 + (size_t)MAXTILES * 256 * DFF * 2 <= WS_END && WS_PROJ + (size_t)NTOK * PWP * 2 <= WS_CAT && WS_CAT + (size_t)NTOK * DM * 2 <= WS_END, "ws map 3");
constexpr int CW_TMO = 0, CW_CODE = 1, CW_CNT = 1024  , CW_WQ = 2048  , CW_BAR = 4096  ;
constexpr int RING_OFF = 0, RING_BYTES = 131072;
constexpr int LDSCTL_OFF = RING_BYTES, MISC_OFF = LDSCTL_OFF + 320;
constexpr int LUT_OFF = LDSCTL_OFF + 1024;
constexpr int LUT_STRIDE = 132;
constexpr int LDS_BYTES = 147456;
static_assert(LUT_OFF + 18 * LUT_STRIDE * 4 <= LDS_BYTES, "LDS map");

#define GAS __attribute__((address_space(1)))
#define LAS __attribute__((address_space(3)))
typedef unsigned short bf16;
typedef unsigned v4u __attribute__((ext_vector_type(4)));
typedef unsigned v2u __attribute__((ext_vector_type(2)));
typedef float f32x4 __attribute__((ext_vector_type(4)));
typedef short bf16x8 __attribute__((ext_vector_type(8)));
typedef GAS unsigned gu32;
#define RLX_AGENT __ATOMIC_RELAXED, __HIP_MEMORY_SCOPE_AGENT
#define LDS_WAIT() asm volatile("s_waitcnt lgkmcnt(0)" ::: "memory")
#define VM_WAIT() asm volatile("s_waitcnt vmcnt(0)" ::: "memory")
__device__ __forceinline__ unsigned f2bf(float f) { unsigned u = __builtin_bit_cast(unsigned, f); return (u + 0x7fffu + ((u >> 16) & 1u)) >> 16; }
__device__ __forceinline__ unsigned pk2(float lo, float hi) { return f2bf(lo) | (f2bf(hi) << 16); }
__device__ __forceinline__ float bflo(unsigned w) { return __builtin_bit_cast(float, w << 16); }
__device__ __forceinline__ float bfhi(unsigned w) { return __builtin_bit_cast(float, w & 0xffff0000u); }
__device__ __forceinline__ float bf2f(bf16 h) { return __builtin_bit_cast(float, (unsigned)h << 16); }
__device__ const unsigned char BUCKET[129] = {0,1,2,3,4,5,6,7,8,9,10,11,12,13,14,15,16,16,16,17,17,18,18,18,19,19,19,20,20,20,20,21,21,21,21,22,22,22,22,22,23,23,23,23,23,23,24,24,24,24,24,24,25,25,25,25,25,25,25,
    26,26,26,26,26,26,26,26,27,27,27,27,27,27,27,27,27,27,28,28,28,28,28,28,28,28,28,28,29,29,29,29,29,29,29,29,29,29,29,29,30,30,30,30,30,30,30,30,30,30,30,30,30,30,31,31,31,31,31,31,31,31,31,31,31,31,31,31,31,31};
#define XB_TMO      128
#define XB_XCNT(j)  (256  + 64 * (j))
#define XB_XSUB(j)  (1280 + 64 * (j))
#define XB_XGEN(j)  (2304 + 64 * (j))
#define XB_TOP      3328
#define XB_TOPGEN   3392
#define XCD_BAR_WORDS 3456
#define XB_SPIN_CAP (1u << 18)

__device__ __forceinline__ unsigned xb_ld(unsigned* p)              { return __hip_atomic_load(p, __ATOMIC_RELAXED, __HIP_MEMORY_SCOPE_AGENT); }
__device__ __forceinline__ unsigned xb_add(unsigned* p, unsigned v) { return __hip_atomic_fetch_add(p, v, __ATOMIC_RELAXED, __HIP_MEMORY_SCOPE_AGENT); }
__device__ __forceinline__ unsigned xb_xcc_id() { return (unsigned)__builtin_amdgcn_s_getreg((3 << 11) | 20) & 0xFu; }
#define XB_SPIN(cond, bar) do { unsigned _sp = 0; while (cond) { __builtin_amdgcn_s_sleep(1); \
    if ((++_sp & 255u) == 0u) { if (xb_ld(&(bar)[XB_TMO])) break; if (_sp > XB_SPIN_CAP) { atomicAdd(&(bar)[XB_TMO], 1u); break; } } } } while (0)

struct XcdBarrier {
    unsigned* bar; unsigned x;
    volatile LAS unsigned* st;
};

__device__ __forceinline__ XcdBarrier xcd_barrier_post(unsigned* bar, volatile LAS unsigned* st) {
    XcdBarrier b; b.bar = bar; b.x = xb_xcc_id(); b.st = st;
    if (threadIdx.x == 0) (void)xb_add(&bar[XB_XCNT(b.x)], 1u);
    return b;
}
__device__ __forceinline__ void xcd_barrier_complete(unsigned* bar, unsigned x, unsigned& nloc, unsigned& nx) {
    const unsigned G = gridDim.x * gridDim.y * gridDim.z;
    unsigned sum, cnt, mine, sp = 0u;
    for (;;) {
        sum = 0u; cnt = 0u; mine = 0u;
#pragma unroll
        for (unsigned j = 0; j < 16; ++j) { const unsigned c = xb_ld(&bar[XB_XCNT(j)]); sum += c; cnt += (c > 0u) ? 1u : 0u; mine = (j == x) ? c : mine; }
        if (sum == G) break;
        __builtin_amdgcn_s_sleep(1);
        if ((++sp & 255u) == 0u) { if (xb_ld(&bar[XB_TMO])) break; if (sp > XB_SPIN_CAP) { atomicAdd(&bar[XB_TMO], 1u); break; } }
    }
    nloc = mine > 0u ? mine : 1u; nx = cnt > 0u ? cnt : 1u;
}

__device__ __forceinline__ void xcd_barrier(const XcdBarrier& b) {
    asm volatile("s_waitcnt vmcnt(0)" ::: "memory");
    __syncthreads();
    if (threadIdx.x == 0) {
        unsigned* bar = b.bar;
        __builtin_amdgcn_s_waitcnt(0);
        unsigned nloc = b.st[0], nx = b.st[1];
        if (nloc == 0u) { xcd_barrier_complete(bar, b.x, nloc, nx); b.st[0] = nloc; b.st[1] = nx; }
        const unsigned old = xb_add(&bar[XB_XSUB(b.x)], 1u);
        const unsigned gen = old / nloc;
        if (old + 1u == (gen + 1u) * nloc) {
            __builtin_amdgcn_fence(__ATOMIC_RELEASE, "agent");
            asm volatile("s_waitcnt vmcnt(0)" ::: "memory");
            const unsigned og = xb_add(&bar[XB_TOP], 1u);
            const unsigned tg = og / nx;
            if (og + 1u == (tg + 1u) * nx) xb_add(&bar[XB_TOPGEN], 1u);
            else XB_SPIN(xb_ld(&bar[XB_TOPGEN]) == tg, bar);
            __builtin_amdgcn_fence(__ATOMIC_ACQUIRE, "agent");
            xb_add(&bar[XB_XGEN(b.x)], 1u);
            asm volatile("s_waitcnt vmcnt(0)" ::: "memory");
        } else {
            XB_SPIN(xb_ld(&bar[XB_XGEN(b.x)]) == gen, bar);
            __builtin_amdgcn_fence(__ATOMIC_ACQUIRE, "agent");
            asm volatile("s_waitcnt vmcnt(0)" ::: "memory");
        }
    }
    __syncthreads();
}
struct Args { const float* in[18]; float* out; unsigned char* ws; int ph_lo, ph_hi, li, pad; float invf[32]; };
static_assert(sizeof(Args) == 20 * 8 + 16 + 128, "Args has no padding bytes");
struct Frame {
    LAS unsigned char* lds;
    gu32* ctl;
    int tid, lane, wave, vcu, G;
};
__device__ __forceinline__ int flane() { int l = (int)__builtin_amdgcn_mbcnt_hi(~0u, __builtin_amdgcn_mbcnt_lo(~0u, 0u)); asm volatile("" : "+v"(l)); return l; }
__device__ __forceinline__ int ftid(const Frame& F) { return F.wave * 64 + flane(); }
__device__ __forceinline__ float wave_sum(float v) {
#pragma unroll
    for (int o = 1; o < 64; o <<= 1) v += __shfl_xor(v, o);
    return v;
}
__device__ __forceinline__ float wave_max(float v) {
#pragma unroll
    for (int o = 1; o < 64; o <<= 1) v = fmaxf(v, __shfl_xor(v, o));
    return v;
}
__device__ __forceinline__ void p0_transpose_item(const float* W, int K, int N, bf16* WT, int k0, int n0, int drow0, LAS float* scr, int lane) {
#pragma unroll 8
    for (int i = 0; i < 32; ++i) { const int kk = 2 * i + (lane >> 5); scr[kk * 33 + (lane & 31)] = __builtin_nontemporal_load(W + (size_t)(k0 + kk) * N + n0 + (lane & 31)); }
    LDS_WAIT(); asm volatile("" ::: "memory");
    const int c = lane & 7;
#pragma unroll
    for (int j = 0; j < 4; ++j) { const int n = (lane >> 3) + 8 * j; const LAS float* s = scr + (8 * c) * 33 + n;
        v4u o; o.x = pk2(s[0 * 33], s[1 * 33]); o.y = pk2(s[2 * 33], s[3 * 33]); o.z = pk2(s[4 * 33], s[5 * 33]); o.w = pk2(s[6 * 33], s[7 * 33]);
        __builtin_nontemporal_store(o, (GAS v4u*)(WT + (size_t)(drow0 + n) * K + k0 + 8 * c)); }
    LDS_WAIT(); asm volatile("" ::: "memory");
}
template <int MODE> __device__ __forceinline__ void p0_matrix_item(const float* W, int K, int N, bf16* WT, int item, LAS float* scr, int lane) {
    const int nblk = N / 32, kb = item / nblk, nb = item % nblk, n0 = 32 * nb;
    const int drow0 = (MODE == 0) ? n0 : ((n0 >> 7) * 256 + (n0 & 127) + (MODE == 2 ? 128 : 0));
    p0_transpose_item(W, K, N, WT, 64 * kb, n0, drow0, scr, lane);
}
__device__ __forceinline__ void p0_transpose_item8(const float* W, int K, int N, unsigned char* WT, int k0, int n0, int drow0, float scale, LAS float* scr, int lane) {
#pragma unroll 8
    for (int i = 0; i < 32; ++i) { const int kk = 2 * i + (lane >> 5); scr[kk * 33 + (lane & 31)] = __builtin_nontemporal_load(W + (size_t)(k0 + kk) * N + n0 + (lane & 31)) * scale; }
    LDS_WAIT(); asm volatile("" ::: "memory");
    const int c = lane & 7;
#pragma unroll
    for (int j = 0; j < 4; ++j) { const int n = (lane >> 3) + 8 * j; const LAS float* s = scr + (8 * c) * 33 + n;
        v2u o; o.x = pg8::pack4_fp8(s[0 * 33], s[1 * 33], s[2 * 33], s[3 * 33]); o.y = pg8::pack4_fp8(s[4 * 33], s[5 * 33], s[6 * 33], s[7 * 33]);
        __builtin_nontemporal_store(o, (GAS v2u*)(WT + (size_t)(drow0 + n) * K + k0 + 8 * c)); }
    LDS_WAIT(); asm volatile("" ::: "memory");
}
template <int MODE> __device__ __forceinline__ void p0_matrix_item8(const float* W, int K, int N, unsigned char* WT, int item, float scale, LAS float* scr, int lane) {
    const int nblk = N / 32, kb = item / nblk, nb = item % nblk, n0 = 32 * nb;
    const int drow0 = (MODE == 0) ? n0 : ((n0 >> 7) * 256 + (n0 & 127) + (MODE == 2 ? 128 : 0));
    p0_transpose_item8(W, K, N, WT, 64 * kb, n0, drow0, scale, scr, lane);
}
__device__ __forceinline__ void p0_prologue(Frame& F, const Args& a) {
    LAS float* scr = (LAS float*)(F.lds + RING_OFF + F.wave * 16384);
    const int gw = F.vcu * NWAVES + F.wave, NGW = F.G * NWAVES;
    unsigned char* ws = a.ws;
    constexpr int I_IN = (DM / 64) * (PW / 32), I_OUT = (DM / 64) * (DM / 32), I_GU = (DM / 64) * (DFF / 32), I_DN = (DFF / 64) * (DM / 32);
    constexpr int NITEMS = 2 * I_IN + 2 * I_OUT + 2 * I_GU + I_DN;
    for (int it = gw; it < NITEMS; it += NGW) {
        int r = it;
        if (r < 2 * I_IN) { const int l = r / I_IN; p0_matrix_item<0>(a.in[1] + (size_t)l * DM * PW, DM, PW, (bf16*)(ws + WS_WIN) + (size_t)l * PWP * DM, r % I_IN, scr, flane()); continue; } r -= 2 * I_IN;
        if (r < 2 * I_OUT) { const int l = r / I_OUT; p0_matrix_item<0>(a.in[6] + (size_t)l * DM * DM, DM, DM, (bf16*)(ws + WS_WOUT) + (size_t)l * DM * DM, r % I_OUT, scr, flane()); continue; } r -= 2 * I_OUT;
        if (r < I_GU) { p0_matrix_item<1>(a.in[11], DM, DFF, (bf16*)(ws + WS_WDGU), r, scr, flane()); continue; } r -= I_GU;
        if (r < I_GU) { p0_matrix_item<2>(a.in[12], DM, DFF, (bf16*)(ws + WS_WDGU), r, scr, flane()); continue; } r -= I_GU;
        { p0_matrix_item8<0>(a.in[13], DFF, DM, ws + WS_WDDN, r, pg8::FP8_SWD, scr, flane()); }
    }
    { const int gt = gw * 64 + flane(), NGT = NGW * 64; const GAS f32x4* x4 = (const GAS f32x4*)a.in[0]; GAS v4u* o4 = (GAS v4u*)(ws + WS_XB);
      for (int i = gt; i < NTOK * DM / 8; i += NGT) { const f32x4 p = __builtin_nontemporal_load(x4 + 2 * i), q = __builtin_nontemporal_load(x4 + 2 * i + 1); v4u o; o.x = pk2(p[0], p[1]); o.y = pk2(p[2], p[3]); o.z = pk2(q[0], q[1]); o.w = pk2(q[2], q[3]); o4[i] = o; } }
    { const int gt = gw * 64 + flane(); if (gt < SEQ * 32) { const int pos = gt >> 5, i = gt & 31; const float ang = (float)pos * a.invf[i];
        const double t = (double)ang * 0.15915494309189535; const float fr = (float)(t - __builtin_rint(t));
        ((float*)(ws + WS_TAB))[gt] = __builtin_amdgcn_sinf(fr); ((float*)(ws + WS_TAB + 256 * 1024))[gt] = __builtin_amdgcn_cosf(fr); } }
}
constexpr int MOE_I_GU = (DM / 64) * (DFF / 32), MOE_I_DN = (DFF / 64) * (DM / 32), MOE_ITEMS = 8 * (2 * MOE_I_GU + MOE_I_DN), MOE_CHUNKS = MOE_ITEMS / 64;
static_assert(MOE_ITEMS % 64 == 0 && MOE_CHUNKS % 2 == 0, "expert conversion chunks");
struct MoeItem { const float* W; unsigned char* dst; int K, N, k0, n0, drow0; float scale; };
__device__ __forceinline__ void moe_item(const Args& a, int idx, MoeItem& o) {
    unsigned char* ws = a.ws; int r = idx, mode; const float* W; unsigned char* dst; int K, N, item;
    if (r < 8 * MOE_I_GU) { const int e = r / MOE_I_GU; W = a.in[15] + (size_t)e * DM * DFF; dst = ws + WS_WMGU + (size_t)e * 2 * DFF * DM; K = DM; N = DFF; item = r % MOE_I_GU; mode = 1; o.scale = pg8::FP8_SWU; }
    else if (r < 16 * MOE_I_GU) { r -= 8 * MOE_I_GU; const int e = r / MOE_I_GU; W = a.in[16] + (size_t)e * DM * DFF; dst = ws + WS_WMGU + (size_t)e * 2 * DFF * DM; K = DM; N = DFF; item = r % MOE_I_GU; mode = 2; o.scale = pg8::FP8_SWU; }
    else { r -= 16 * MOE_I_GU; const int e = r / MOE_I_DN; W = a.in[17] + (size_t)e * DFF * DM; dst = ws + WS_WMDN + (size_t)e * DM * DFF; K = DFF; N = DM; item = r % MOE_I_DN; mode = 0; o.scale = pg8::FP8_SWD; }
    const int nblk = N / 32, kb = item / nblk, nb = item % nblk, n0 = 32 * nb;
    o.W = W; o.dst = dst; o.K = K; o.N = N; o.k0 = 64 * kb; o.n0 = n0;
    o.drow0 = (mode == 0) ? n0 : ((n0 >> 7) * 256 + (n0 & 127) + (mode == 2 ? 128 : 0));
}
__device__ __forceinline__ void moe_issue(const MoeItem& o, int lane, f32x4 (&v)[8]) {
    const f32x4* p = (const f32x4*)(o.W + (size_t)(o.k0 + (lane >> 3)) * o.N + o.n0 + 4 * (lane & 7));
#pragma unroll
    for (int i = 0; i < 8; ++i) v[i] = __builtin_nontemporal_load((const f32x4*)((const float*)p + (size_t)(8 * i) * o.N));
}
__device__ __forceinline__ void moe_finish(const MoeItem& o, int lane, const f32x4 (&v)[8], LAS float* scr) {
    { const int kr = lane >> 3, nq = 4 * (lane & 7);
#pragma unroll
      for (int i = 0; i < 8; ++i) { LAS float* d = scr + (8 * i + kr) * 33 + nq; d[0] = v[i][0] * o.scale; d[1] = v[i][1] * o.scale; d[2] = v[i][2] * o.scale; d[3] = v[i][3] * o.scale; } }
    LDS_WAIT(); asm volatile("" ::: "memory");
    const int c = lane & 7;
#pragma unroll
    for (int j = 0; j < 4; ++j) { const int n = (lane >> 3) + 8 * j; const LAS float* s = scr + (8 * c) * 33 + n;
        v2u w; w.x = pg8::pack4_fp8(s[0 * 33], s[1 * 33], s[2 * 33], s[3 * 33]); w.y = pg8::pack4_fp8(s[4 * 33], s[5 * 33], s[6 * 33], s[7 * 33]);
        __builtin_nontemporal_store(w, (GAS v2u*)(o.dst + (size_t)(o.drow0 + n) * o.K + o.k0 + 8 * c)); }
    LDS_WAIT(); asm volatile("" ::: "memory");
}
__device__ __forceinline__ void moe_convert_chunk(Frame& F, const Args& a, int chunk) {
    int lane = (int)__builtin_amdgcn_mbcnt_hi(~0u, __builtin_amdgcn_mbcnt_lo(~0u, 0u)); asm volatile("" : "+v"(lane));
    LAS float* scr = (LAS float*)(F.lds + RING_OFF + F.wave * 16384);
    const int i0 = 64 * chunk + F.wave;
    MoeItem A, B; f32x4 va[8], vb[8];
    moe_item(a, i0, A); moe_issue(A, lane, va);
#pragma unroll 1
    for (int i = 0; i < 8; i += 2) {
        moe_item(a, i0 + 8 * (i + 1), B); moe_issue(B, lane, vb);
        moe_finish(A, lane, va, scr);
        if (i + 2 < 8) { moe_item(a, i0 + 8 * (i + 2), A); moe_issue(A, lane, va); }
        moe_finish(B, lane, vb, scr);
    }
}
__device__ __forceinline__ void build_lut(Frame& F, const float* rel_bias) {
    LAS float* lut = (LAS float*)(F.lds + LUT_OFF);
    for (int i = ftid(F); i < 18 * 129; i += NWAVES * 64) { const int hh = i / 129, d = i % 129; lut[hh * LUT_STRIDE + d] = (rel_bias[BUCKET[d] * 18 + hh] - (hh < 6 ? rel_bias[31 * 18 + hh] : 0.f)) * LOG2E; }
}
__device__ __forceinline__ void ln_stats(f32x4 (&v)[8], float& mean, float& rstd) {
    float s = 0.f;
#pragma unroll
    for (int j = 0; j < 8; ++j) s += (v[j][0] + v[j][1]) + (v[j][2] + v[j][3]);
    mean = wave_sum(s) * (1.f / DM); float s2 = 0.f;
#pragma unroll
    for (int j = 0; j < 8; ++j) { v[j] = v[j] - mean; s2 += (v[j][0] * v[j][0] + v[j][1] * v[j][1]) + (v[j][2] * v[j][2] + v[j][3] * v[j][3]); }
    rstd = 1.f / sqrtf(wave_sum(s2) * (1.f / DM) + LN_EPS);
}
__device__ __forceinline__ int expert_offsets(Frame& F, int& ntiles) {
    const unsigned c = (flane() < 8) ? __hip_atomic_load(F.ctl + CW_CNT + 64 * flane(), RLX_AGENT) : 0u;
    const int t = (int)((c + 255u) >> 8);
    int inc = t;
#pragma unroll
    for (int o = 1; o < 8; o <<= 1) { const int u = __shfl_up(inc, o); if (flane() >= o) inc += u; }
    ntiles = __shfl(inc, 7);
    return (inc - t) * 256;
}
template <int MODE> __device__ __forceinline__ void ln_phase(Frame& F, const Args& a, float* T, const float* gam, const float* bet, const float* w_router, int rb_in = -1, int pass = 0) {
    unsigned char* ws = a.ws;
    bf16* XB = (bf16*)(ws + WS_XB);
    const int lane = flane();
    LAS float* wrT = (LAS float*)(F.lds + RING_OFF);
    LAS int* cwL = (LAS int*)(F.lds + RING_OFF + 65536);
    LAS int* baseL = (LAS int*)(F.lds + RING_OFF + 65536 + 256);
    if (MODE == 1) {
        for (int i = ftid(F); i < DM * 8; i += NWAVES * 64) wrT[(i & 7) * DM + (i >> 3)] = w_router[i];
        __syncthreads();
    }
    f32x4 g4[8], b4[8];
#pragma unroll
    for (int j = 0; j < 8; ++j) { g4[j] = *(const f32x4*)(gam + 4 * lane + 256 * j); b4[j] = *(const f32x4*)(bet + 4 * lane + 256 * j); }
    int offv = 0, ntl = 0;
    if (MODE == 2) offv = expert_offsets(F, ntl);
    const int rb = (rb_in >= 0) ? rb_in : (F.vcu * NWAVES + F.wave) * 8;
    unsigned long long cntp = 0ull; int me1 = 0, me2 = 0, mr1 = 0, mr2 = 0; float mg1 = 0.f, mg2 = 0.f;
    for (int r = 0; r < 8; ++r) {
        const int row = rb + r;
        float* trow = T + (size_t)row * DM;
        if (MODE == 2 && pass != 0) {
            const int* rt = (const int*)(ws + WS_ROUTE) + row * 8;
            const bool late = (__shfl(offv, rt[0]) + rt[1] >= 32768) || (__shfl(offv, rt[2]) + rt[3] >= 32768);
            if (late != (pass == 2)) continue;
        }
        f32x4 v[8];
#pragma unroll
        for (int j = 0; j < 8; ++j) v[j] = *(const f32x4*)(trow + 4 * lane + 256 * j);
        if (MODE == 2) {
            const int* rt = (const int*)(ws + WS_ROUTE) + row * 8;
            const int e1 = rt[0], p1 = rt[1], e2 = rt[2], p2 = rt[3]; const float g1 = __builtin_bit_cast(float, rt[4]), g2 = __builtin_bit_cast(float, rt[5]);
            const int r1 = __shfl(offv, e1) + p1, r2 = __shfl(offv, e2) + p2;
            const bf16* y1 = (const bf16*)(ws + WS_Y) + (size_t)r1 * DM; const bf16* y2 = (const bf16*)(ws + WS_Y) + (size_t)r2 * DM;
#pragma unroll
            for (int j = 0; j < 8; ++j) { const v2u a1 = *(const v2u*)(y1 + 4 * lane + 256 * j), a2 = *(const v2u*)(y2 + 4 * lane + 256 * j);
                v[j][0] = v[j][0] * pg8::ALPHA_F + g1 * bflo(a1.x) + g2 * bflo(a2.x); v[j][1] = v[j][1] * pg8::ALPHA_F + g1 * bfhi(a1.x) + g2 * bfhi(a2.x);
                v[j][2] = v[j][2] * pg8::ALPHA_F + g1 * bflo(a1.y) + g2 * bflo(a2.y); v[j][3] = v[j][3] * pg8::ALPHA_F + g1 * bfhi(a1.y) + g2 * bfhi(a2.y); }
        }
        float mean, rstd; ln_stats(v, mean, rstd);
#pragma unroll
        for (int j = 0; j < 8; ++j) v[j] = v[j] * rstd * g4[j] + b4[j];
        if (MODE == 2) {
            float* orow = a.out + (size_t)row * DM;
#pragma unroll
            for (int j = 0; j < 8; ++j) *(f32x4*)(orow + 4 * lane + 256 * j) = v[j];
        } else {
            bf16* xrow = XB + (size_t)row * DM;
#pragma unroll
            for (int j = 0; j < 8; ++j) { if (MODE != 0) *(f32x4*)(trow + 4 * lane + 256 * j) = v[j]; if (MODE == 0) { v2u o; o.x = pk2(v[j][0], v[j][1]); o.y = pk2(v[j][2], v[j][3]); *(v2u*)(xrow + 4 * lane + 256 * j) = o; }
                if (MODE == 3) { const f32x4 s = v[j] * pg8::FP8_SX; ((GAS unsigned*)(ws + WS_XG + (size_t)row * DM))[lane + 64 * j] = pg8::pack4_fp8(s[0], s[1], s[2], s[3]); } }
        }
        if (MODE == 1) {
            int i1 = -1, i2 = -1; float v1 = -3.0e38f, v2 = -3.0e38f;
#pragma unroll 1
            for (int e = 0; e < 8; ++e) { float s = 0.f;
#pragma unroll
                for (int j = 0; j < 8; ++j) { const f32x4 w = *(const LAS f32x4*)(wrT + e * DM + 4 * lane + 256 * j); s += (v[j][0] * w[0] + v[j][1] * w[1]) + (v[j][2] * w[2] + v[j][3] * w[3]); }
                const float t = wave_sum(s);
                if (t > v1) { v2 = v1; i2 = i1; v1 = t; i1 = e; } else if (t > v2) { v2 = t; i2 = e; } }
            if (i1 < 0) i1 = 0;
            if (i2 < 0) i2 = (i1 + 1) & 7;
            const float ex = __expf(v2 - v1), w1 = 1.f / (1.f + ex), w2 = ex * w1;
            const int k1 = (int)((cntp >> (8 * i1)) & 0xffull); cntp += 1ull << (8 * i1);
            const int k2 = (int)((cntp >> (8 * i2)) & 0xffull); cntp += 1ull << (8 * i2);
            if (lane == r) { me1 = i1; me2 = i2; mr1 = k1; mr2 = k2; mg1 = w1; mg2 = w2; }
        }
    }
    if (MODE == 1) {
        if (lane < 8) cwL[F.wave * 8 + lane] = (int)((cntp >> (8 * lane)) & 0xffull);
        __syncthreads();
        if (ftid(F) < 8) { int tot = 0;
#pragma unroll
            for (int w = 0; w < 8; ++w) tot += cwL[w * 8 + ftid(F)];
            baseL[ftid(F)] = (int)__hip_atomic_fetch_add(F.ctl + CW_CNT + 64 * ftid(F), (unsigned)tot, RLX_AGENT); }
        __syncthreads();
        if (lane < 8) {
            int p1 = baseL[me1] + mr1, p2 = baseL[me2] + mr2;
            for (int w = 0; w < F.wave; ++w) { p1 += cwL[w * 8 + me1]; p2 += cwL[w * 8 + me2]; }
            int* rt = (int*)(ws + WS_ROUTE) + (rb + lane) * 8;
            rt[0] = me1; rt[1] = p1; rt[2] = me2; rt[3] = p2; rt[4] = __builtin_bit_cast(int, mg1); rt[5] = __builtin_bit_cast(int, mg2);
        }
    }
}
__device__ __forceinline__ void gather_phase(Frame& F, const Args& a, const float* T) {
    unsigned char* ws = a.ws; int ntl; const int offv = expert_offsets(F, ntl);
    const int gw = F.vcu * NWAVES + F.wave, NGW = F.G * NWAVES;
    for (int tok = gw; tok < NTOK; tok += NGW) {
        const int* rt = (const int*)(ws + WS_ROUTE) + tok * 8;
        const int d1 = __shfl(offv, rt[0]) + rt[1], d2 = __shfl(offv, rt[2]) + rt[3];
        const GAS f32x4* s = (const GAS f32x4*)(T + (size_t)tok * DM);
        GAS unsigned* o1 = (GAS unsigned*)(ws + WS_XG + (size_t)d1 * DM); GAS unsigned* o2 = (GAS unsigned*)(ws + WS_XG + (size_t)d2 * DM);
#pragma unroll
        for (int j = 0; j < 8; ++j) { const f32x4 v = s[flane() + 64 * j] * pg8::FP8_SX; const unsigned w = pg8::pack4_fp8(v[0], v[1], v[2], v[3]); o1[flane() + 64 * j] = w; o2[flane() + 64 * j] = w; }
    }
}
__device__ __forceinline__ float dot8(const v4u q, const v4u k) {
    return (bflo(q.x) * bflo(k.x) + bfhi(q.x) * bfhi(k.x)) + (bflo(q.y) * bflo(k.y) + bfhi(q.y) * bfhi(k.y)) + (bflo(q.z) * bflo(k.z) + bfhi(q.z) * bfhi(k.z)) + (bflo(q.w) * bflo(k.w) + bfhi(q.w) * bfhi(k.w));
}
__device__ __forceinline__ float lambda_of(const float* lp, int lane, float lam_init) {
    const float s1 = wave_sum(lp[lane] * lp[64 + lane]), s2 = wave_sum(lp[128 + lane] * lp[192 + lane]);
    return __expf(s1) - __expf(s2) + lam_init;
}
__device__ __forceinline__ void naive_mixers(Frame& F, const Args& a, int layer) {
    unsigned char* ws = a.ws; const bf16* PROJ = (const bf16*)(ws + WS_PROJ); bf16* CAT = (bf16*)(ws + WS_CAT);
    const int lane = F.lane; const int gw = F.vcu * NWAVES + F.wave, NGW = F.G * NWAVES;
    LAS float* sc = (LAS float*)(F.lds + RING_OFF + F.wave * 16384);
    const LAS float* lut = (const LAS float*)(F.lds + LUT_OFF);
    const float lam_init = 0.8f - 0.6f * __expf(-0.3f * (float)layer);
    const float lam = lambda_of(a.in[3] + layer * 256, lane, lam_init);
    const float* subg = a.in[4] + layer * 128; const float* sinks = a.in[5] + layer * 12;
    for (int task = gw; task < NTOK * 6; task += NGW) {
        const int tok = task / 6, h = task - tok * 6, q = tok & (SEQ - 1), base = tok - q;
        v4u qv[16]; { const v4u* qp = (const v4u*)(PROJ + (size_t)tok * PWP + C_AQ + h * 128);
#pragma unroll
            for (int c = 0; c < 16; ++c) qv[c] = qp[c]; }
        float m1 = -3.0e38f, m2 = -3.0e38f;
        for (int j = lane; j <= q; j += 64) {
            const v4u* kp = (const v4u*)(PROJ + (size_t)(base + j) * PWP + C_AK + h * 128); float d1 = 0.f, d2 = 0.f;
#pragma unroll
            for (int c = 0; c < 8; ++c) { d1 += dot8(qv[c], kp[c]); d2 += dot8(qv[8 + c], kp[8 + c]); }
            const int dd = q - j; const float bias = lut[h * LUT_STRIDE + (dd < 128 ? dd : 128)];
            d1 += bias; d2 += bias; sc[j] = d1; sc[2048 + j] = d2; m1 = fmaxf(m1, d1); m2 = fmaxf(m2, d2);
        }
        m1 = wave_max(m1); m2 = wave_max(m2); float l1 = 0.f, l2 = 0.f;
        for (int j = lane; j <= q; j += 64) { const float p1 = __builtin_amdgcn_exp2f(sc[j] - m1), p2 = __builtin_amdgcn_exp2f(sc[2048 + j] - m2); sc[j] = p1; sc[2048 + j] = p2; l1 += p1; l2 += p2; }
        l1 = wave_sum(l1); l2 = wave_sum(l2); const float c1 = 1.f / l1, c2 = lam / l2;
        float o0 = 0.f, o1 = 0.f;
        for (int j = 0; j <= q; ++j) { const float w = sc[j] * c1 - sc[2048 + j] * c2; const bf16* vr = PROJ + (size_t)(base + j) * PWP + C_AV + h * 128; o0 += w * bf2f(vr[lane]); o1 += w * bf2f(vr[64 + lane]); }
        const float ss = wave_sum(o0 * o0 + o1 * o1), rr = (1.f / sqrtf(ss * (1.f / 128.f) + LN_EPS)) * (1.f - lam_init);
        bf16* orow = CAT + (size_t)tok * DM + h * 128; orow[lane] = (bf16)f2bf(o0 * rr * subg[lane]); orow[64 + lane] = (bf16)f2bf(o1 * rr * subg[64 + lane]);
    }
    for (int task = gw; task < NTOK * 12; task += NGW) {
        const int tok = task / 12, hq = task - tok * 12, kvh = hq >> 2, q = tok & (SEQ - 1), base = tok - q;
        v4u qv[8]; { const v4u* qp = (const v4u*)(PROJ + (size_t)tok * PWP + C_BQ + hq * 64);
#pragma unroll
            for (int c = 0; c < 8; ++c) qv[c] = qp[c]; }
        float s[2];
#pragma unroll
        for (int i = 0; i < 2; ++i) { const int dd = lane + 64 * i, j = q - dd; s[i] = -3.0e38f;
            if (j >= 0) { const v4u* kp = (const v4u*)(PROJ + (size_t)(base + j) * PWP + C_BK + kvh * 64); float d = 0.f;
#pragma unroll
                for (int c = 0; c < 8; ++c) d += dot8(qv[c], kp[c]);
                s[i] = d + lut[(6 + hq) * LUT_STRIDE + dd]; } }
        const float sink2 = sinks[hq] * LOG2E; const float m = fmaxf(wave_max(fmaxf(s[0], s[1])), sink2);
        const float p0 = (q - lane >= 0) ? __builtin_amdgcn_exp2f(s[0] - m) : 0.f, p1 = (q - lane - 64 >= 0) ? __builtin_amdgcn_exp2f(s[1] - m) : 0.f;
        const float l = wave_sum(p0 + p1) + __builtin_amdgcn_exp2f(sink2 - m);
        sc[lane] = p0; sc[64 + lane] = p1;
        float o = 0.f; const int nk = (q + 1 < 128) ? q + 1 : 128;
        for (int dd = 0; dd < nk; ++dd) o += sc[dd] * bf2f(PROJ[(size_t)(base + q - dd) * PWP + C_BV + kvh * 64 + lane]);
        CAT[(size_t)tok * DM + 768 + hq * 64 + lane] = (bf16)f2bf(o / l);
    }
    for (int task = gw; task < NTOK * 4; task += NGW) {
        const int tok = task >> 2, h = task & 3, q = tok & (SEQ - 1), base = tok - q;
        const float lg2 = log2f(1.f - exp2f(-5.f - (float)h));
        v4u qv[8]; { const v4u* qp = (const v4u*)(PROJ + (size_t)tok * PWP + C_CQ + h * 64);
#pragma unroll
            for (int c = 0; c < 8; ++c) qv[c] = qp[c]; }
        for (int j = lane; j <= q; j += 64) { const v4u* kp = (const v4u*)(PROJ + (size_t)(base + j) * PWP + C_CK + h * 64); float d = 0.f;
#pragma unroll
            for (int c = 0; c < 8; ++c) d += dot8(qv[c], kp[c]);
            sc[j] = d * __builtin_amdgcn_exp2f((float)(q - j) * lg2); }
        float o0 = 0.f, o1 = 0.f;
        for (int j = 0; j <= q; ++j) { const float w = sc[j]; const bf16* vr = PROJ + (size_t)(base + j) * PWP + C_CV + h * 128; o0 += w * bf2f(vr[lane]); o1 += w * bf2f(vr[64 + lane]); }
        const float mu = wave_sum(o0 + o1) * (1.f / 128.f); o0 -= mu; o1 -= mu;
        const float rs = 1.f / sqrtf(wave_sum(o0 * o0 + o1 * o1) * (1.f / 128.f) + LN_EPS);
        const bf16* gr = PROJ + (size_t)tok * PWP + C_CG + h * 128;
        bf16* orow = CAT + (size_t)tok * DM + 1536 + h * 128;
        orow[lane] = (bf16)f2bf(pg8::silu_f(bf2f(gr[lane])) * o0 * rs); orow[64 + lane] = (bf16)f2bf(pg8::silu_f(bf2f(gr[64 + lane])) * o1 * rs);
    }
}
typedef float f32x16 __attribute__((ext_vector_type(16)));
typedef short s16x4 __attribute__((ext_vector_type(4)));
typedef short v4i16_t __attribute__((ext_vector_type(4)));
typedef float f32x2_t __attribute__((ext_vector_type(2))); typedef __bf16 bf16x2_t __attribute__((ext_vector_type(2)));
__device__ __forceinline__ int crow(int r, int hi) { return (r & 3) + 8 * (r >> 2) + 4 * hi; }
__device__ __forceinline__ s16x4 vtr(const LAS unsigned char* p) { return __builtin_bit_cast(s16x4, __builtin_amdgcn_ds_read_tr16_b64_v4i16((LAS v4i16_t*)p)); }
__device__ __forceinline__ unsigned cvtpk_s(float lo, float hi) { f32x2_t v = {lo, hi}; bf16x2_t b = __builtin_convertvector(v, bf16x2_t); return __builtin_bit_cast(unsigned, b); }
__device__ __forceinline__ bf16x8 pack_p(const f32x16& p, int s2) {
    v4u w; w.x = cvtpk_s(p[8 * s2 + 0], p[8 * s2 + 1]); w.y = cvtpk_s(p[8 * s2 + 2], p[8 * s2 + 3]); w.z = cvtpk_s(p[8 * s2 + 4], p[8 * s2 + 5]); w.w = cvtpk_s(p[8 * s2 + 6], p[8 * s2 + 7]);
    return __builtin_bit_cast(bf16x8, w);
}
constexpr int MIX_WSF = 131072 + 1024 + 10240, MIX_QW = MIX_WSF + 2048;
static_assert(MIX_QW + 64 <= LDS_BYTES && LUT_OFF + 18 * LUT_STRIDE * 4 <= MIX_WSF, "mixer LDS map");
constexpr int LUTX_OFF = 98304, LUTX_STRIDE = 320;
constexpr float MIX_THR = 6.f;
__device__ __forceinline__ void glds16(const void* gsrc, unsigned lds_dst) { unsigned keep;
    asm volatile("s_mov_b32 %0, m0\n\ts_mov_b32 m0, %2\n\ts_nop 0\n\tglobal_load_lds_dwordx4 %1, off\n\ts_mov_b32 m0, %0" : "=&s"(keep) : "v"(gsrc), "s"(lds_dst) : "memory"); }
template <int IMM> __device__ __forceinline__ void glds16s(const void* sbase, unsigned voff, unsigned lds_dst) { unsigned keep;
    lds_dst -= (unsigned)IMM;
    asm volatile("s_mov_b32 %0, m0\n\ts_mov_b32 m0, %3\n\ts_nop 0\n\tglobal_load_lds_dwordx4 %1, %2 offset:%c4\n\ts_mov_b32 m0, %0" : "=&s"(keep) : "v"(voff), "s"(sbase), "s"(lds_dst), "i"(IMM) : "memory"); }
template <int MODE> __device__ __forceinline__ void mix_unit(Frame& F, const Args& a, int layer, int b, int hh, int qb, float lam, float lam_init) {
    constexpr int KW = (MODE == 0) ? 128 : 64, VW = (MODE == 1) ? 64 : 128, NEB = VW / 32, NSUB = 1;
    constexpr int KBYTES = 64 * KW * 2, VBYTES = 64 * VW * 2, BUFB = KBYTES + VBYTES, NST = 3;
    constexpr int KD = KBYTES / 1024, VD = VBYTES / 1024, PW = (KD + VD) / 8;
    static_assert(NST * BUFB <= LUTX_OFF && LUTX_OFF + 18 * LUTX_STRIDE * 4 <= RING_BYTES && (KD + VD) % 8 == 0, "mixer LDS ring");
    unsigned char* ws = a.ws; const bf16* PROJ = (const bf16*)(ws + WS_PROJ); bf16* CAT = (bf16*)(ws + WS_CAT);
    const int wave = F.wave; int lane = (int)__builtin_amdgcn_mbcnt_hi(~0u, __builtin_amdgcn_mbcnt_lo(~0u, 0u)); asm volatile("" : "+v"(lane));
    const int tid = wave * 64 + lane, r32 = lane & 31, hi = lane >> 5;
    LAS unsigned char* L = F.lds + RING_OFF;
    const unsigned Lb = (unsigned)(uintptr_t)L;
    LAS float* wsf = (LAS float*)(F.lds + MIX_WSF) + wave * 64;
    const LAS float* lut = (const LAS float*)(F.lds + LUT_OFF);
    const int rowbase = b * SEQ;
    const int q0 = (MODE == 2) ? qb * 256 : qb * 128;
    const int rg = (MODE == 2) ? wave : (wave & 3), wsel = (MODE == 2) ? 0 : (wave >> 2);
    const int qw0 = q0 + 32 * rg;
    const int kcol = (MODE == 0) ? C_AK + hh * 128 : (MODE == 1) ? C_BK + (hh >> 1) * 64 : C_CK + hh * 64;
    const int vcol = (MODE == 0) ? C_AV + hh * 128 : (MODE == 1) ? C_BV + (hh >> 1) * 64 : C_CV + hh * 128;
    const int kch0 = (MODE == 0) ? wsel * 8 : 0;
    const int t_lo = (MODE == 1) ? (qb > 0 ? 2 * qb - 2 : 0) : 0, t_hi = (MODE == 2) ? 4 * qb + 4 : 2 * qb + 2;
    bf16x8 qf[NSUB][4];
#pragma unroll
    for (int s = 0; s < NSUB; ++s) {
        const int qcol = (MODE == 0) ? C_AQ + hh * 128 + wsel * 64 : (MODE == 1) ? C_BQ + (hh * 2 + wsel) * 64 : C_CQ + hh * 64;
        const bf16* qp = PROJ + (size_t)(rowbase + qw0 + r32) * PWP + qcol + hi * 8;
#pragma unroll
        for (int d0 = 0; d0 < 4; ++d0) qf[s][d0] = *(const bf16x8*)(qp + d0 * 16);
    }
    float m_run[NSUB], l_run[NSUB]; f32x16 o[NSUB][NEB];
#pragma unroll
    for (int s = 0; s < NSUB; ++s) {
        m_run[s] = (MODE == 1) ? a.in[5][layer * 12 + hh * 2 + wsel] * LOG2E : -1.0e30f; l_run[s] = (MODE == 1) ? 1.f : 0.f;
#pragma unroll
        for (int e = 0; e < NEB; ++e) o[s][e] = f32x16{};
    }
    const float lg2 = (MODE == 2) ? log2f(1.f - exp2f(-5.f - (float)hh)) : 0.f;
    unsigned dsrc[PW]; unsigned ddst[PW];
#pragma unroll
    for (int i = 0; i < PW; ++i) {
        const int j = wave + 8 * i;
        if (j < KD) {
            int row, ch;
            if (KW == 128) { row = 4 * j + (lane >> 4); ch = (lane & 15) ^ (row & 15); }
            else { row = 8 * j + (lane >> 3); ch = (lane & 7) ^ ((row >> 1) & 7); }
            dsrc[i] = (unsigned)(((rowbase + row) * PWP + kcol + ch * 8) * 2); ddst[i] = (unsigned)(j * 1024);
        } else {
            const int jv = j - KD, eb = jv >> 2, key = 16 * (jv & 3) + 8 * (lane >> 5) + ((lane >> 2) & 7);
            dsrc[i] = (unsigned)(((rowbase + key) * PWP + vcol + eb * 32 + (lane & 3) * 8) * 2); ddst[i] = (unsigned)(KBYTES + jv * 1024);
        }
    }
#define MIX_DMA(t) do { const unsigned st_ = Lb + (unsigned)((((t) - t_lo) % NST) * BUFB); \
        _Pragma("unroll") for (int i_ = 0; i_ < PW; ++i_) glds16((const char*)PROJ + (size_t)(t) * (64 * PWP * 2) + dsrc[i_], (unsigned)__builtin_amdgcn_readfirstlane(st_ + ddst[i_])); } while (0)
    const int vlane = (4 * hi + ((lane & 15) >> 2)) * 64 + ((lane >> 4) & 1) * 32 + (lane & 3) * 8;
    asm volatile("s_waitcnt vmcnt(0)" ::: "memory");
#pragma unroll
    for (int s = 0; s < NSUB; ++s) {
        asm volatile("" : "+v"(m_run[s]));
#pragma unroll
        for (int d0 = 0; d0 < 4; ++d0) asm volatile("" : "+v"(qf[s][d0]));
    }
    MIX_DMA(t_lo);
    if (t_lo + 1 < t_hi) MIX_DMA(t_lo + 1);
#pragma unroll 1
    for (int t = t_lo; t < t_hi; ++t) {
        if (t + 1 < t_hi) { if (PW == 2) asm volatile("s_waitcnt vmcnt(2)" ::: "memory"); else if (PW == 3) asm volatile("s_waitcnt vmcnt(3)" ::: "memory"); else asm volatile("s_waitcnt vmcnt(4)" ::: "memory"); }
        else asm volatile("s_waitcnt vmcnt(0)" ::: "memory");
        asm volatile("s_waitcnt lgkmcnt(0)\n\ts_barrier" ::: "memory");
        if (t + 2 < t_hi) MIX_DMA(t + 2);
        const LAS unsigned char* Kb = L + ((t - t_lo) % NST) * BUFB; const LAS unsigned char* Vb = Kb + KBYTES;
        const int k0 = 64 * t;
        const bool active = (k0 <= qw0 + 31) && (MODE != 1 || k0 + 63 >= qw0 - 127);
        if (active) {
#pragma unroll
            for (int s = 0; s < NSUB; ++s) {
                f32x16 p0 = f32x16{}, p1 = f32x16{};
#pragma unroll
                for (int d0 = 0; d0 < 4; ++d0) {
                    const int ch = kch0 + 2 * d0 + hi;
                    const int ofs = (KW == 128) ? (r32 * 256 + ((ch ^ (r32 & 15)) << 4)) : (r32 * 128 + ((ch ^ ((r32 >> 1) & 7)) << 4));
                    const bf16x8 ka = *(const LAS bf16x8*)(Kb + ofs);
                    const bf16x8 kb2 = *(const LAS bf16x8*)(Kb + 32 * KW * 2 + ofs);
                    p0 = __builtin_amdgcn_mfma_f32_32x32x16_bf16(ka, qf[s][d0], p0, 0, 0, 0);
                    p1 = __builtin_amdgcn_mfma_f32_32x32x16_bf16(kb2, qf[s][d0], p1, 0, 0, 0);
                }
                const int qi = qw0 + r32;
                if (MODE == 2) {
#pragma unroll
                    for (int r = 0; r < 16; ++r) { const int d0_ = qi - (k0 + crow(r, hi)), d1_ = d0_ - 32;
                        const float dec = __builtin_amdgcn_exp2f((float)(qi - (k0 & ~127)) * lg2);
                        p0[r] = d0_ >= 0 ? p0[r] * dec : 0.f; p1[r] = d1_ >= 0 ? p1[r] * dec : 0.f; }
                } else {
                    const bool nearb = (MODE == 1) || (k0 + 63 + 128 > qw0);
                    if (nearb) {
                        const LAS float* lrow = lut + ((MODE == 0) ? hh : 6 + hh * 2 + wsel) * LUT_STRIDE;
#pragma unroll
                        for (int r = 0; r < 16; ++r) { const int d0_ = qi - (k0 + crow(r, hi)), d1_ = d0_ - 32;
                            const bool ok0 = (MODE == 0) ? (d0_ >= 0) : (d0_ >= 0 && d0_ < 128), ok1 = (MODE == 0) ? (d1_ >= 0) : (d1_ >= 0 && d1_ < 128);
                            const int i0_ = d0_ < 0 ? 0 : (d0_ > 128 ? 128 : d0_), i1_ = d1_ < 0 ? 0 : (d1_ > 128 ? 128 : d1_);
                            p0[r] = ok0 ? p0[r] + lrow[i0_] : -INFINITY; p1[r] = ok1 ? p1[r] + lrow[i1_] : -INFINITY; }
                    }
                    float rm = fmaxf(p0[0], p1[0]);
#pragma unroll
                    for (int r = 1; r < 16; ++r) rm = fmaxf(rm, fmaxf(p0[r], p1[r]));
                    rm = fmaxf(rm, __shfl_xor(rm, 32));
                    if (__any(rm > m_run[s] + MIX_THR)) {
                        const float mn = fmaxf(m_run[s], rm), al = __builtin_amdgcn_exp2f(m_run[s] - mn);
                        m_run[s] = mn; l_run[s] *= al;
                        if (hi == 0) wsf[r32] = al;
                        LDS_WAIT();
#pragma unroll
                        for (int r = 0; r < 16; ++r) { const float f = wsf[crow(r, hi)];
#pragma unroll
                            for (int e = 0; e < NEB; ++e) o[s][e][r] *= f; }
                        LDS_WAIT();
                    }
                    float ls = 0.f; const float mm = m_run[s];
#pragma unroll
                    for (int r = 0; r < 16; ++r) { p0[r] = __builtin_amdgcn_exp2f(p0[r] - mm); p1[r] = __builtin_amdgcn_exp2f(p1[r] - mm); ls += p0[r] + p1[r]; }
                    l_run[s] += ls;
                }
                s16x4 vlo[2][NEB], vhi[2][NEB];
#pragma unroll
                for (int e = 0; e < NEB; ++e) { vlo[0][e] = vtr(Vb + e * 4096 + vlane); vhi[0][e] = vtr(Vb + e * 4096 + vlane + 512); }
#pragma unroll
                for (int g = 0; g < 4; ++g) {
                    if (g < 3) {
#pragma unroll
                        for (int e = 0; e < NEB; ++e) { vlo[(g + 1) & 1][e] = vtr(Vb + e * 4096 + (g + 1) * 1024 + vlane); vhi[(g + 1) & 1][e] = vtr(Vb + e * 4096 + (g + 1) * 1024 + vlane + 512); }
                    }
                    const bf16x8 pa = pack_p((g >> 1) == 0 ? p0 : p1, g & 1);
#pragma unroll
                    for (int e = 0; e < NEB; ++e) {
                        const s16x4 lo = vlo[g & 1][e], hh2 = vhi[g & 1][e];
                        const bf16x8 vb = (bf16x8){lo[0], lo[1], lo[2], lo[3], hh2[0], hh2[1], hh2[2], hh2[3]};
                        o[s][e] = __builtin_amdgcn_mfma_f32_32x32x16_bf16(pa, vb, o[s][e], 0, 0, 0);
                    }
                }
                if (NSUB > 1) __builtin_amdgcn_sched_barrier(0);
            }
        }
    }
#undef MIX_DMA
    __syncthreads();
    if (MODE == 1) {
#pragma unroll
        for (int s = 0; s < NSUB; ++s) {
            const float sink2 = a.in[5][layer * 12 + hh * 2 + wsel] * LOG2E;
            const float lt = l_run[s] + __shfl_xor(l_run[s], 32) - __builtin_amdgcn_exp2f(sink2 - m_run[s]);
            if (hi == 0) wsf[r32] = 1.f / lt;
            LDS_WAIT();
            bf16* orow = CAT + (size_t)(rowbase + qw0) * DM + 768 + (hh * 2 + wsel) * 64 + r32;
#pragma unroll
            for (int r = 0; r < 16; ++r) { const int qr = crow(r, hi); const float f = wsf[qr];
#pragma unroll
                for (int e = 0; e < NEB; ++e) orow[(size_t)qr * DM + 32 * e] = (bf16)f2bf(o[s][e][r] * f); }
            LDS_WAIT();
        }
    } else if (MODE == 2) {
        const bf16* grow = PROJ + (size_t)(rowbase + qw0) * PWP + C_CG + hh * 128 + r32;
        bf16* orow = CAT + (size_t)(rowbase + qw0) * DM + 1536 + hh * 128 + r32;
#pragma unroll
        for (int r = 0; r < 16; ++r) {
            float s1 = 0.f;
#pragma unroll
            for (int e = 0; e < NEB; ++e) s1 += o[0][e][r];
#pragma unroll
            for (int sh = 1; sh < 32; sh <<= 1) s1 += __shfl_xor(s1, sh);
            const float mu = s1 * (1.f / 128.f); float s2 = 0.f;
#pragma unroll
            for (int e = 0; e < NEB; ++e) { const float d = o[0][e][r] - mu; s2 += d * d; }
#pragma unroll
            for (int sh = 1; sh < 32; sh <<= 1) s2 += __shfl_xor(s2, sh);
            const float rs = 1.f / sqrtf(s2 * (1.f / 128.f) + LN_EPS); const int qr = crow(r, hi);
#pragma unroll
            for (int e = 0; e < NEB; ++e) orow[(size_t)qr * DM + 32 * e] = (bf16)f2bf(pg8::silu_f(bf2f(grow[(size_t)qr * PWP + 32 * e])) * (o[0][e][r] - mu) * rs);
        }
    } else {
        const float lt = l_run[0] + __shfl_xor(l_run[0], 32);
        if (hi == 0) wsf[r32] = 1.f / lt;
        LDS_WAIT();
        LAS float* xb = (LAS float*)L + rg * 4096;
        if (wsel == 1) {
#pragma unroll
            for (int r = 0; r < 16; ++r) { const float f = wsf[crow(r, hi)];
#pragma unroll
                for (int e = 0; e < NEB; ++e) xb[(e * 16 + r) * 64 + lane] = o[0][e][r] * f; }
        }
        __syncthreads();
        if (wsel == 0) {
            const float* subg = a.in[4] + layer * 128; const float post = 1.f - lam_init;
            bf16* orow = CAT + (size_t)(rowbase + qw0) * DM + hh * 128 + r32;
#pragma unroll
            for (int r = 0; r < 16; ++r) { const float f = wsf[crow(r, hi)]; float d[NEB]; float ss = 0.f;
#pragma unroll
                for (int e = 0; e < NEB; ++e) { d[e] = o[0][e][r] * f - lam * xb[(e * 16 + r) * 64 + lane]; ss += d[e] * d[e]; }
#pragma unroll
                for (int sh = 1; sh < 32; sh <<= 1) ss += __shfl_xor(ss, sh);
                const float rs = (1.f / sqrtf(ss * (1.f / 128.f) + LN_EPS)) * post; const int qr = crow(r, hi);
#pragma unroll
                for (int e = 0; e < NEB; ++e) orow[(size_t)qr * DM + 32 * e] = (bf16)f2bf(d[e] * rs * subg[32 * e + r32]); }
        }
    }
    __syncthreads();
}
__device__ __forceinline__ void attn3_unit(Frame& F, const Args& a, int layer, int b, int hh, int qb, float lam, float lam_init) {
    constexpr int KBYTES = 128 * 256, VBYTES = 128 * 256, BUFB = KBYTES + VBYTES;
    static_assert(2 * BUFB <= RING_BYTES, "attn3 LDS ring");
    unsigned char* ws = a.ws; const bf16* PROJ = (const bf16*)(ws + WS_PROJ); bf16* CAT = (bf16*)(ws + WS_CAT);
    const int wave = F.wave; int lane = (int)__builtin_amdgcn_mbcnt_hi(~0u, __builtin_amdgcn_mbcnt_lo(~0u, 0u)); asm volatile("" : "+v"(lane));
    const int r32 = lane & 31, hi = lane >> 5;
    LAS unsigned char* L = F.lds + RING_OFF; const unsigned Lb = (unsigned)(uintptr_t)L;
    LAS float* wsf = (LAS float*)(F.lds + MIX_WSF) + wave * 64;
    const LAS float* lrow = (const LAS float*)(F.lds + LUT_OFF) + hh * LUT_STRIDE;
    const int rowbase = b * SEQ, q0 = qb * 128, rg = wave & 3, wsel = wave >> 2, qw0 = q0 + 32 * rg, t_hi = qb + 1;
    unsigned srcK, srcV;
    { const int row = 4 * wave + (lane >> 4), ch = (lane & 15) ^ (row & 15); srcK = (unsigned)(((rowbase + row) * PWP + C_AK + hh * 128 + ch * 8) * 2);
      const int key = 16 * wave + 8 * (lane >> 5) + ((lane >> 2) & 7); srcV = (unsigned)(((rowbase + key) * PWP + C_AV + hh * 128 + (lane & 3) * 8) * 2); }
#define A3_DMA(t) do { const char* tb_ = (const char*)PROJ + (size_t)(t) * (128 * PWP * 2); const unsigned st_ = (unsigned)__builtin_amdgcn_readfirstlane(Lb + (unsigned)(((t) & 1) * BUFB) + wave * 1024); \
        glds16s<0>(tb_, srcK, st_); glds16s<0>(tb_ + 32 * PWP * 2, srcK, st_ + 8192); glds16s<0>(tb_ + 64 * PWP * 2, srcK, st_ + 16384); glds16s<0>(tb_ + 96 * PWP * 2, srcK, st_ + 24576); \
        glds16s<0>(tb_, srcV, st_ + KBYTES); glds16s<64>(tb_, srcV, st_ + KBYTES + 8192); glds16s<128>(tb_, srcV, st_ + KBYTES + 16384); glds16s<192>(tb_, srcV, st_ + KBYTES + 24576); } while (0)
    const int vlane = (4 * hi + ((lane & 15) >> 2)) * 64 + ((lane >> 4) & 1) * 32 + (lane & 3) * 8;
    A3_DMA(0);
    bf16x8 qf[4];
    { const bf16* qp = PROJ + (size_t)(rowbase + qw0 + r32) * PWP + C_AQ + hh * 128 + wsel * 64 + hi * 8;
#pragma unroll
      for (int d0 = 0; d0 < 4; ++d0) qf[d0] = *(const bf16x8*)(qp + d0 * 16); }
    float m_run = -1.0e30f, l_run = 0.f; f32x16 o[4];
#pragma unroll
    for (int e = 0; e < 4; ++e) o[e] = f32x16{};
    asm volatile("s_waitcnt vmcnt(0)" ::: "memory");
#pragma unroll
    for (int d0 = 0; d0 < 4; ++d0) asm volatile("" : "+v"(qf[d0]));
    asm volatile("s_waitcnt lgkmcnt(0)\n\ts_barrier" ::: "memory");
#pragma unroll 1
    for (int t = 0; t < t_hi; ++t) {
        if (t + 1 < t_hi) A3_DMA(t + 1);
        const LAS unsigned char* Kb = L + (t & 1) * BUFB; const LAS unsigned char* Vb = Kb + KBYTES;
        const int k0 = 128 * t;
        if (k0 <= qw0 + 31) {
            f32x16 p[4];
#pragma unroll
            for (int j = 0; j < 4; ++j) p[j] = f32x16{};
#pragma unroll
            for (int d0 = 0; d0 < 4; ++d0) {
                const int ofs = r32 * 256 + (((8 * wsel + 2 * d0 + hi) ^ (r32 & 15)) << 4);
#pragma unroll
                for (int j = 0; j < 4; ++j) p[j] = __builtin_amdgcn_mfma_f32_32x32x16_bf16(*(const LAS bf16x8*)(Kb + j * 8192 + ofs), qf[d0], p[j], 0, 0, 0);
            }
            const int qi = qw0 + r32;
            if (k0 + 127 + 128 > qw0) {
#pragma unroll
                for (int r = 0; r < 16; ++r) { const int dd = qi - (k0 + crow(r, hi));
#pragma unroll
                    for (int j = 0; j < 4; ++j) { const int dj = dd - 32 * j; const int ij = dj < 0 ? 0 : (dj > 128 ? 128 : dj); p[j][r] = dj >= 0 ? p[j][r] + lrow[ij] : -INFINITY; } }
            }
            float rm = fmaxf(fmaxf(p[0][0], p[1][0]), fmaxf(p[2][0], p[3][0]));
#pragma unroll
            for (int r = 1; r < 16; ++r) rm = fmaxf(rm, fmaxf(fmaxf(p[0][r], p[1][r]), fmaxf(p[2][r], p[3][r])));
            rm = fmaxf(rm, __shfl_xor(rm, 32));
            if (__any(rm > m_run + MIX_THR)) {
                const float mn = fmaxf(m_run, rm), al = __builtin_amdgcn_exp2f(m_run - mn);
                m_run = mn; l_run *= al;
                if (hi == 0) wsf[r32] = al;
                LDS_WAIT();
#pragma unroll
                for (int r = 0; r < 16; ++r) { const float f = wsf[crow(r, hi)];
#pragma unroll
                    for (int e = 0; e < 4; ++e) o[e][r] *= f; }
                LDS_WAIT();
            }
            float ls0 = 0.f, ls1 = 0.f;
#pragma unroll
            for (int r = 0; r < 16; ++r) { p[0][r] = __builtin_amdgcn_exp2f(p[0][r] - m_run); p[1][r] = __builtin_amdgcn_exp2f(p[1][r] - m_run); p[2][r] = __builtin_amdgcn_exp2f(p[2][r] - m_run); p[3][r] = __builtin_amdgcn_exp2f(p[3][r] - m_run);
                ls0 += p[0][r] + p[1][r]; ls1 += p[2][r] + p[3][r]; }
            l_run += ls0 + ls1;
#pragma unroll
            for (int g = 0; g < 8; ++g) {
                const bf16x8 pa = pack_p(p[g >> 1], g & 1);
#pragma unroll
                for (int e = 0; e < 4; ++e) {
                    const LAS unsigned char* vp = Vb + e * 8192 + g * 1024 + vlane;
                    const s16x4 lo = vtr(vp), h2 = vtr(vp + 512);
                    const bf16x8 vb = (bf16x8){lo[0], lo[1], lo[2], lo[3], h2[0], h2[1], h2[2], h2[3]};
                    o[e] = __builtin_amdgcn_mfma_f32_32x32x16_bf16(pa, vb, o[e], 0, 0, 0);
                }
            }
        }
        asm volatile("s_waitcnt vmcnt(0) lgkmcnt(0)\n\ts_barrier" ::: "memory");
    }
#undef A3_DMA
    {
        const float lt = l_run + __shfl_xor(l_run, 32);
        if (hi == 0) wsf[r32] = 1.f / lt;
        LDS_WAIT();
        LAS float* xb = (LAS float*)L + rg * 4096;
        if (wsel == 1) {
#pragma unroll
            for (int r = 0; r < 16; ++r) { const float f = wsf[crow(r, hi)];
#pragma unroll
                for (int e = 0; e < 4; ++e) xb[(e * 16 + r) * 64 + lane] = o[e][r] * f; }
        }
        __syncthreads();
        if (wsel == 0) {
            const float* subg = a.in[4] + layer * 128; const float post = 1.f - lam_init;
            bf16* orow = CAT + (size_t)(rowbase + qw0) * DM + hh * 128 + r32;
#pragma unroll
            for (int r = 0; r < 16; ++r) { const float f = wsf[crow(r, hi)]; float d[4]; float ss = 0.f;
#pragma unroll
                for (int e = 0; e < 4; ++e) { d[e] = o[e][r] * f - lam * xb[(e * 16 + r) * 64 + lane]; ss += d[e] * d[e]; }
#pragma unroll
                for (int sh = 1; sh < 32; sh <<= 1) ss += __shfl_xor(ss, sh);
                const float rs = (1.f / sqrtf(ss * (1.f / 128.f) + LN_EPS)) * post; const int qr = crow(r, hi);
#pragma unroll
                for (int e = 0; e < 4; ++e) orow[(size_t)qr * DM + 32 * e] = (bf16)f2bf(d[e] * rs * subg[32 * e + r32]); }
        }
    }
    __syncthreads();
}
constexpr int C2_KR = 0, C2_KT = 16384, C2_VT = 32768, C2_ST = 65536, C2_STATS = 81920, C2_G = 83968;
static_assert(C2_G + 32768 <= RING_BYTES, "chunkwise retention LDS map");
__device__ __forceinline__ void retention_unit(Frame& F, const Args& a, int b, int hh) {
    unsigned char* ws = a.ws; const bf16* PROJ = (const bf16*)(ws + WS_PROJ); bf16* CAT = (bf16*)(ws + WS_CAT);
    const int wave = F.wave; int lane = (int)__builtin_amdgcn_mbcnt_hi(~0u, __builtin_amdgcn_mbcnt_lo(~0u, 0u)); asm volatile("" : "+v"(lane));
    const int r32 = lane & 31, hi = lane >> 5;
    LAS unsigned char* L = F.lds + RING_OFF; const unsigned Lb = (unsigned)(uintptr_t)L;
    const int rowbase = b * SEQ, rg = wave & 3, eh = wave >> 2, dh = wave & 1, eq = wave >> 1;
    const float lg2 = log2f(1.f - exp2f(-5.f - (float)hh));
    const float gq = __builtin_amdgcn_exp2f(lg2 * (float)(32 * rg + r32));
    const float gC = __builtin_amdgcn_exp2f(lg2 * 128.f), gC1 = __builtin_amdgcn_exp2f(lg2 * 127.f);
    unsigned srcKr, srcKt, srcVt;
    { const int row = 8 * wave + (lane >> 3), ch = (lane & 7) ^ ((row >> 1) & 7); srcKr = (unsigned)(((rowbase + row) * PWP + C_CK + hh * 64 + ch * 8) * 2);
      const int key = 16 * wave + 8 * (lane >> 5) + ((lane >> 2) & 7);
      srcKt = (unsigned)(((rowbase + key) * PWP + C_CK + hh * 64 + (lane & 3) * 8) * 2); srcVt = (unsigned)(((rowbase + key) * PWP + C_CV + hh * 128 + (lane & 3) * 8) * 2); }
    const unsigned srcG = (unsigned)(((rowbase + 4 * wave + (lane >> 4)) * PWP + C_CG + hh * 128 + (lane & 15) * 8) * 2);
#define C2_GDMA(n) do { const char* gb_ = (const char*)PROJ + (size_t)(n) * (128 * PWP * 2); const unsigned wg_ = (unsigned)__builtin_amdgcn_readfirstlane(Lb + C2_G + wave * 1024); \
        glds16s<0>(gb_, srcG, wg_); glds16s<0>(gb_ + 32 * PWP * 2, srcG, wg_ + 8192); glds16s<0>(gb_ + 64 * PWP * 2, srcG, wg_ + 16384); glds16s<0>(gb_ + 96 * PWP * 2, srcG, wg_ + 24576); } while (0)
#define C2_DMA(n) do { const char* cb_ = (const char*)PROJ + (size_t)(n) * (128 * PWP * 2); const char* cb2_ = cb_ + 64 * PWP * 2; const unsigned w1k_ = (unsigned)__builtin_amdgcn_readfirstlane(Lb + wave * 1024); \
        glds16s<0>(cb_, srcKr, w1k_ + C2_KR); glds16s<0>(cb2_, srcKr, w1k_ + C2_KR + 8192); \
        glds16s<0>(cb_, srcKt, w1k_ + C2_KT); glds16s<64>(cb_, srcKt, w1k_ + C2_KT + 8192); \
        glds16s<0>(cb_, srcVt, w1k_ + C2_VT); glds16s<64>(cb_, srcVt, w1k_ + C2_VT + 8192); glds16s<128>(cb_, srcVt, w1k_ + C2_VT + 16384); glds16s<192>(cb_, srcVt, w1k_ + C2_VT + 24576); } while (0)
    const int vlane = (4 * hi + ((lane & 15) >> 2)) * 64 + ((lane >> 4) & 1) * 32 + (lane & 3) * 8;
    const int krow = r32 * 128, kkey = (r32 >> 1) & 7;
    f32x16 Sb = f32x16{};
    bf16x8 qf[4];
    { const bf16* qbase = PROJ + (size_t)(rowbase + 32 * rg + r32) * PWP + C_CQ + hh * 64 + hi * 8;
#pragma unroll
      for (int d0 = 0; d0 < 4; ++d0) qf[d0] = *(const bf16x8*)(qbase + d0 * 16); }
    asm volatile("s_waitcnt vmcnt(0)" ::: "memory");
#pragma unroll
    for (int d0 = 0; d0 < 4; ++d0) asm volatile("" : "+v"(qf[d0]));
    C2_DMA(0);
#pragma unroll 1
    for (int n = 0; n < 16; ++n) {
        asm volatile("s_waitcnt vmcnt(0) lgkmcnt(0)\n\ts_barrier" ::: "memory");
        C2_GDMA(n);
        f32x16 o[2]; o[0] = f32x16{}; o[1] = f32x16{};
        for (int kb = 0; kb <= rg; ++kb) {
            f32x16 T = f32x16{};
#pragma unroll
            for (int d0 = 0; d0 < 4; ++d0) {
                const bf16x8 ka = *(const LAS bf16x8*)(L + C2_KR + kb * 4096 + krow + (((2 * d0 + hi) ^ kkey) << 4));
                T = __builtin_amdgcn_mfma_f32_32x32x16_bf16(ka, qf[d0], T, 0, 0, 0);
            }
#pragma unroll
            for (int r = 0; r < 16; ++r) T[r] = (kb == rg && crow(r, hi) > r32) ? 0.f : T[r] * gq;
#pragma unroll
            for (int s2 = 0; s2 < 2; ++s2) {
                const bf16x8 pa = pack_p(T, s2);
#pragma unroll
                for (int e = 0; e < 2; ++e) {
                    const LAS unsigned char* vp = L + C2_VT + (2 * eh + e) * 8192 + (4 * kb + 2 * s2) * 512 + vlane;
                    const s16x4 lo = vtr(vp), h2 = vtr(vp + 512);
                    const bf16x8 vb = (bf16x8){lo[0], lo[1], lo[2], lo[3], h2[0], h2[1], h2[2], h2[3]};
                    o[e] = __builtin_amdgcn_mfma_f32_32x32x16_bf16(pa, vb, o[e], 0, 0, 0);
                }
                __builtin_amdgcn_sched_barrier(0);
            }
        }
        __builtin_amdgcn_sched_barrier(0);
        if (n > 0) {
            f32x16 oc[2]; oc[0] = f32x16{}; oc[1] = f32x16{};
#pragma unroll
            for (int d0 = 0; d0 < 4; ++d0)
#pragma unroll
                for (int e = 0; e < 2; ++e) {
                    const bf16x8 sb = *(const LAS bf16x8*)(L + C2_ST + (2 * eh + e) * 4096 + krow + (((2 * d0 + hi) ^ kkey) << 4));
                    oc[e] = __builtin_amdgcn_mfma_f32_32x32x16_bf16(qf[d0], sb, oc[e], 0, 0, 0);
                }
#pragma unroll
            for (int r = 0; r < 16; ++r) { const float xi = __builtin_amdgcn_exp2f(lg2 * (float)(32 * rg + crow(r, hi) + 1)); o[0][r] += xi * oc[0][r]; o[1][r] += xi * oc[1][r]; }
        }
        __builtin_amdgcn_sched_barrier(0);
        {
            f32x16 kv = f32x16{};
#pragma unroll
            for (int g = 0; g < 8; ++g) {
                const LAS unsigned char* kp = L + C2_KT + dh * 8192 + (2 * g) * 512 + vlane; const LAS unsigned char* vp = L + C2_VT + eq * 8192 + (2 * g) * 512 + vlane;
                const s16x4 kl = vtr(kp), kh2 = vtr(kp + 512), vl = vtr(vp), vh2 = vtr(vp + 512);
                const bf16x8 ka = (bf16x8){kl[0], kl[1], kl[2], kl[3], kh2[0], kh2[1], kh2[2], kh2[3]}, vb = (bf16x8){vl[0], vl[1], vl[2], vl[3], vh2[0], vh2[1], vh2[2], vh2[3]};
                kv = __builtin_amdgcn_mfma_f32_32x32x16_bf16(ka, vb, kv, 0, 0, 0);
                if (g & 1) __builtin_amdgcn_sched_barrier(0);
            }
#pragma unroll
            for (int r = 0; r < 16; ++r) Sb[r] = gC * Sb[r] + gC1 * kv[r];
        }
        __builtin_amdgcn_sched_barrier(0);
        if (n + 1 < 16) {
            int l2 = lane; asm volatile("" : "+v"(l2));
            const bf16* qn = PROJ + (size_t)(rowbase + 128 * (n + 1) + 32 * rg + (l2 & 31)) * PWP + C_CQ + hh * 64 + (l2 >> 5) * 8;
#pragma unroll
            for (int d0 = 0; d0 < 4; ++d0) qf[d0] = *(const bf16x8*)(qn + d0 * 16);
        }
        LAS float* st = (LAS float*)(L + C2_STATS);
#pragma unroll
        for (int r4 = 0; r4 < 4; ++r4) {
            float s1[4], s2[4];
#pragma unroll
            for (int i = 0; i < 4; ++i) { const int r = 4 * r4 + i; s1[i] = o[0][r] + o[1][r]; s2[i] = o[0][r] * o[0][r] + o[1][r] * o[1][r]; }
#pragma unroll
            for (int sh = 1; sh < 32; sh <<= 1)
#pragma unroll
                for (int i = 0; i < 4; ++i) { s1[i] += __shfl_xor(s1[i], sh); s2[i] += __shfl_xor(s2[i], sh); }
            if (r32 == 0) {
#pragma unroll
                for (int i = 0; i < 4; ++i) { const int qr = crow(4 * r4 + i, hi); st[((rg * 2 + eh) * 32 + qr) * 2 + 0] = s1[i]; st[((rg * 2 + eh) * 32 + qr) * 2 + 1] = s2[i]; }
            }
            __builtin_amdgcn_sched_barrier(0);
        }
        __builtin_amdgcn_sched_barrier(0);
        asm volatile("s_waitcnt vmcnt(0) lgkmcnt(0)\n\ts_barrier" ::: "memory");
        if (n + 1 < 16) C2_DMA(n + 1);
        {
            const int e_ = 32 * eq + r32;
#pragma unroll
            for (int q4 = 0; q4 < 4; ++q4) { v2u w; w.x = cvtpk_s(Sb[4 * q4 + 0], Sb[4 * q4 + 1]); w.y = cvtpk_s(Sb[4 * q4 + 2], Sb[4 * q4 + 3]);
                *(LAS v2u*)(L + C2_ST + e_ * 128 + (((4 * dh + q4) ^ ((e_ >> 1) & 7)) << 4) + 8 * hi) = w; }
        }
        asm volatile("s_waitcnt lgkmcnt(0)\n\ts_barrier" ::: "memory");
        {
            const LAS bf16* grow = (const LAS bf16*)(L + C2_G) + (32 * rg) * 128 + 64 * eh + r32;
            bf16* orow = CAT + (size_t)(rowbase + 128 * n + 32 * rg) * DM + 1536 + hh * 128 + 64 * eh + r32;
#pragma unroll
            for (int r = 0; r < 16; ++r) {
                const int qr = crow(r, hi);
                const float t1 = st[((rg * 2) * 32 + qr) * 2 + 0] + st[((rg * 2 + 1) * 32 + qr) * 2 + 0], t2 = st[((rg * 2) * 32 + qr) * 2 + 1] + st[((rg * 2 + 1) * 32 + qr) * 2 + 1];
                const float mu = t1 * (1.f / 128.f), var = fmaxf(t2 * (1.f / 128.f) - mu * mu, 0.f), rs = 1.f / sqrtf(var + LN_EPS);
#pragma unroll
                for (int e = 0; e < 2; ++e) orow[(size_t)qr * DM + 32 * e] = (bf16)f2bf(pg8::silu_f(bf2f(grow[qr * 128 + 32 * e])) * (o[e][r] - mu) * rs);
                if ((r & 3) == 3) __builtin_amdgcn_sched_barrier(0);
            }
        }
    }
#undef C2_DMA
#undef C2_GDMA
    __syncthreads();
}
constexpr int B2_K = 0, B2_V = 32768;
__device__ __forceinline__ void swa_unit(Frame& F, const Args& a, int layer, int b, int kvh, int qb) {
    unsigned char* ws = a.ws; const bf16* PROJ = (const bf16*)(ws + WS_PROJ); bf16* CAT = (bf16*)(ws + WS_CAT);
    const int wave = F.wave; int lane = (int)__builtin_amdgcn_mbcnt_hi(~0u, __builtin_amdgcn_mbcnt_lo(~0u, 0u)); asm volatile("" : "+v"(lane));
    const int r32 = lane & 31, hi = lane >> 5;
    LAS unsigned char* L = F.lds + RING_OFF; const unsigned Lb = (unsigned)(uintptr_t)L;
    LAS float* wsf = (LAS float*)(F.lds + MIX_WSF) + wave * 64;
    const LAS float* lut = (const LAS float*)(F.lds + LUT_OFF);
    const int rowbase = b * SEQ, q0 = qb * 128;
    const int tl0 = (qb == 0) ? 2 : 0;
    unsigned srcK, srcV;
    { const int row = 8 * wave + (lane >> 3), ch = (lane & 7) ^ ((row >> 1) & 7); srcK = (unsigned)(((rowbase + q0 + row) * PWP + C_BK + kvh * 64 + ch * 8) * 2);
      const int key = 16 * (wave & 3) + 8 * (lane >> 5) + ((lane >> 2) & 7); srcV = (unsigned)(((rowbase + q0 + key) * PWP + C_BV + kvh * 64 + (wave >> 2) * 32 + (lane & 3) * 8) * 2); }
    {
        const unsigned wk = (unsigned)__builtin_amdgcn_readfirstlane(Lb + wave * 1024);
        for (int tl = tl0; tl < 4; ++tl) {
            const char* tb = (const char*)PROJ + (long)(tl - 2) * (64 * PWP * 2);
            glds16s<0>(tb, srcK, wk + B2_K + tl * 8192); glds16s<0>(tb, srcV, wk + B2_V + tl * 8192);
        }
    }
    const int vlane = (4 * hi + ((lane & 15) >> 2)) * 64 + ((lane >> 4) & 1) * 32 + (lane & 3) * 8;
    const int kofs0 = r32 * 128, kkey = (r32 >> 1) & 7;
    const int rg = wave & 3, qw0 = q0 + 32 * rg;
    bf16x8 qf[2][4]; float sink2[2], m_run[2], l_run[2]; f32x16 o[2][2]; const LAS float* lrow[2];
#pragma unroll
    for (int s = 0; s < 2; ++s) {
        const int hq = kvh * 4 + (wave >> 2) + 2 * s;
        const bf16* qp = PROJ + (size_t)(rowbase + qw0 + r32) * PWP + C_BQ + hq * 64 + hi * 8;
#pragma unroll
        for (int d0 = 0; d0 < 4; ++d0) qf[s][d0] = *(const bf16x8*)(qp + d0 * 16);
        sink2[s] = a.in[5][layer * 12 + hq] * LOG2E; m_run[s] = sink2[s]; l_run[s] = 1.f; o[s][0] = f32x16{}; o[s][1] = f32x16{};
        lrow[s] = lut + (6 + hq) * LUT_STRIDE;
    }
    asm volatile("s_waitcnt vmcnt(0)" ::: "memory"); __syncthreads();
    const int t_a = (rg < 2) ? 0 : 1;
    for (int tl = (t_a < tl0 ? tl0 : t_a); tl < t_a + 3; ++tl) {
        const LAS unsigned char* Kb = L + B2_K + tl * 8192; const LAS unsigned char* Vb = L + B2_V + tl * 8192;
        const int k0 = q0 - 128 + 64 * tl;
        f32x16 p0[2], p1[2]; p0[0] = f32x16{}; p0[1] = f32x16{}; p1[0] = f32x16{}; p1[1] = f32x16{};
#pragma unroll
        for (int d0 = 0; d0 < 4; ++d0) {
            const int ofs = kofs0 + (((2 * d0 + hi) ^ kkey) << 4);
            const bf16x8 ka = *(const LAS bf16x8*)(Kb + ofs), kb2 = *(const LAS bf16x8*)(Kb + 4096 + ofs);
#pragma unroll
            for (int s = 0; s < 2; ++s) { p0[s] = __builtin_amdgcn_mfma_f32_32x32x16_bf16(ka, qf[s][d0], p0[s], 0, 0, 0); p1[s] = __builtin_amdgcn_mfma_f32_32x32x16_bf16(kb2, qf[s][d0], p1[s], 0, 0, 0); }
        }
        const int qi = qw0 + r32;
#pragma unroll
        for (int r = 0; r < 16; ++r) { const int d0_ = qi - (k0 + crow(r, hi)), d1_ = d0_ - 32;
            const bool ok0 = (d0_ >= 0 && d0_ < 128), ok1 = (d1_ >= 0 && d1_ < 128);
            const int i0_ = d0_ < 0 ? 0 : (d0_ > 128 ? 128 : d0_), i1_ = d1_ < 0 ? 0 : (d1_ > 128 ? 128 : d1_);
#pragma unroll
            for (int s = 0; s < 2; ++s) { p0[s][r] = ok0 ? p0[s][r] + lrow[s][i0_] : -INFINITY; p1[s][r] = ok1 ? p1[s][r] + lrow[s][i1_] : -INFINITY; } }
#pragma unroll
        for (int s = 0; s < 2; ++s) {
            float rm = fmaxf(p0[s][0], p1[s][0]);
#pragma unroll
            for (int r = 1; r < 16; ++r) rm = fmaxf(rm, fmaxf(p0[s][r], p1[s][r]));
            rm = fmaxf(rm, __shfl_xor(rm, 32));
            if (__any(rm > m_run[s] + MIX_THR)) {
                const float mn = fmaxf(m_run[s], rm), al = __builtin_amdgcn_exp2f(m_run[s] - mn);
                m_run[s] = mn; l_run[s] *= al;
                if (hi == 0) wsf[r32] = al;
                LDS_WAIT();
#pragma unroll
                for (int r = 0; r < 16; ++r) { const float f = wsf[crow(r, hi)]; o[s][0][r] *= f; o[s][1][r] *= f; }
                LDS_WAIT();
            }
            float ls = 0.f;
#pragma unroll
            for (int r = 0; r < 16; ++r) { p0[s][r] = __builtin_amdgcn_exp2f(p0[s][r] - m_run[s]); p1[s][r] = __builtin_amdgcn_exp2f(p1[s][r] - m_run[s]); ls += p0[s][r] + p1[s][r]; }
            l_run[s] += ls;
        }
#pragma unroll
        for (int gq = 0; gq < 4; ++gq) {
            bf16x8 pa[2];
#pragma unroll
            for (int s = 0; s < 2; ++s) pa[s] = pack_p((gq >> 1) == 0 ? p0[s] : p1[s], gq & 1);
#pragma unroll
            for (int e = 0; e < 2; ++e) {
                const LAS unsigned char* vp = Vb + e * 4096 + gq * 1024 + vlane;
                const s16x4 lo = vtr(vp), h2 = vtr(vp + 512);
                const bf16x8 vb = (bf16x8){lo[0], lo[1], lo[2], lo[3], h2[0], h2[1], h2[2], h2[3]};
#pragma unroll
                for (int s = 0; s < 2; ++s) o[s][e] = __builtin_amdgcn_mfma_f32_32x32x16_bf16(pa[s], vb, o[s][e], 0, 0, 0);
            }
        }
    }
#pragma unroll
    for (int s = 0; s < 2; ++s) {
        const int hq = kvh * 4 + (wave >> 2) + 2 * s;
        const float lt = l_run[s] + __shfl_xor(l_run[s], 32) - __builtin_amdgcn_exp2f(sink2[s] - m_run[s]);
        if (hi == 0) wsf[r32] = 1.f / lt;
        LDS_WAIT();
        bf16* orow = CAT + (size_t)(rowbase + qw0) * DM + 768 + hq * 64 + r32;
#pragma unroll
        for (int r = 0; r < 16; ++r) { const int qr = crow(r, hi); const float f = wsf[qr]; orow[(size_t)qr * DM] = (bf16)f2bf(o[s][0][r] * f); orow[(size_t)qr * DM + 32] = (bf16)f2bf(o[s][1][r] * f); }
        LDS_WAIT();
    }
    __syncthreads();
}
template <int MODE> __device__ __forceinline__ void mixer_queue(Frame& F, const Args& a, int layer, int qword, float lam, float lam_init) {
    constexpr int NU = (MODE == 0) ? 768 : (MODE == 1) ? 384 : (MODE == 3) ? 32 : 256;
    LAS int* qw = (LAS int*)(F.lds + MIX_QW);
    const int c_lo = layer * (MOE_CHUNKS / 2), c_hi = c_lo + MOE_CHUNKS / 2;
    for (;;) {
        if (ftid(F) == 0) { qw[0] = (int)__hip_atomic_fetch_add(F.ctl + CW_WQ + 64 * qword, 1u, RLX_AGENT); qw[1] = (MODE == 0) ? (int)__hip_atomic_fetch_add(F.ctl + CW_WQ + 64 * (14 + layer), 1u, RLX_AGENT) : (1 << 30); }
        __syncthreads();
        const int it = __builtin_amdgcn_readfirstlane(qw[0]), ci = c_lo + __builtin_amdgcn_readfirstlane(qw[1]);
        __syncthreads();
        if (it < NU) {
            if (MODE == 3) retention_unit(F, a, it >> 2, it & 3);
            else if (MODE == 0) attn3_unit(F, a, layer, (it % 48) / 6, it % 6, 15 - it / 48, lam, lam_init);
            else swa_unit(F, a, layer, it / 48, (it % 48) / 16, it & 15);
        }
        if (MODE == 0 && ci < c_hi) moe_convert_chunk(F, a, ci);
        if (it >= NU) break;
    }
}
__device__ __forceinline__ void moe_convert_drain(Frame& F, const Args& a, int layer) {
    LAS int* qw = (LAS int*)(F.lds + MIX_QW);
    const int c_lo = layer * (MOE_CHUNKS / 2), c_hi = c_lo + MOE_CHUNKS / 2;
    for (;;) {
        if (ftid(F) == 0) qw[1] = (int)__hip_atomic_fetch_add(F.ctl + CW_WQ + 64 * (14 + layer), 1u, RLX_AGENT);
        __syncthreads();
        const int ci = c_lo + __builtin_amdgcn_readfirstlane(qw[1]);
        __syncthreads();
        if (ci >= c_hi) break;
        moe_convert_chunk(F, a, ci);
    }
}
__device__ __forceinline__ void mixer_phase(Frame& F, const Args& a, int layer, int rep) {
    const int qbase = 3 * (layer + 2 * rep);
    mixer_queue<3>(F, a, layer, qbase + 0, 0.f, 0.f);
    asm volatile("" ::: "memory");
    const float lam_init = 0.8f - 0.6f * __expf(-0.3f * (float)layer);
    const float lam = __builtin_bit_cast(float, __builtin_amdgcn_readfirstlane(__builtin_bit_cast(int, lambda_of(a.in[3] + layer * 256, flane(), lam_init))));
    mixer_queue<0>(F, a, layer, qbase + 1, lam, lam_init);
    mixer_queue<1>(F, a, layer, qbase + 2, lam, lam_init);
    moe_convert_drain(F, a, layer);
}
#ifndef MIXER_NAIVE
#define MIXER_NAIVE 0
#endif
#ifndef PROBE_P0
#define PROBE_P0 1
#endif
#ifndef PROBE_MIX
#define PROBE_MIX 1
#endif
#ifndef PROBE_PROJ
#define PROBE_PROJ 1
#endif
#ifndef PROBE_DUP
#define PROBE_DUP 1
#endif
#ifndef PROBE_MUP
#define PROBE_MUP 1
#endif
#ifndef PROBE_MDN
#define PROBE_MDN 1
#endif
#ifndef PROBE_SPIN_PHASE
#define PROBE_SPIN_PHASE -1
#endif
#define PH_BEGIN(k) do { if (PROBE_SPIN_PHASE == (k)) spin_t0 = __builtin_amdgcn_s_memrealtime(); } while (0)
#define PH_END(k) do { if (PROBE_SPIN_PHASE == (k)) spin_dt = __builtin_amdgcn_s_memrealtime() - spin_t0; } while (0)
#define REPEAT(N) for (int rep = 0; rep < (N); ++rep)
#define TWICE_IF(N, CALL) do { CALL; if ((N) == 2) { xcd_barrier(bar); CALL; } } while (0)
#define REPBAR(N) do { if (rep + 1 < (N)) xcd_barrier(bar); } while (0)
#define IN(k) (lo <= (k) && (k) < hi)
#define SEAM(k) do { if (IN(k) && IN((k) + 1)) xcd_barrier(bar); } while (0)
template <int l> __device__ __forceinline__ void run_layer(Frame& F, const Args& args, const XcdBarrier& bar, int lo, int hi, unsigned long long& spin_t0, unsigned long long& spin_dt) {
    unsigned char* ws = args.ws;
    bf16* XB = (bf16*)(ws + WS_XB); bf16* PROJ = (bf16*)(ws + WS_PROJ); bf16* CAT = (bf16*)(ws + WS_CAT); bf16* HB = (bf16*)(ws + WS_H);
    float* T = args.out;
        const int pb = 1 + 7 * l;
        PH_BEGIN(pb); if (IN(pb)) {
            pg8::Gemm g{XB, (const bf16*)(ws + WS_WIN) + (size_t)l * PWP * DM, NTOK, PWP, DM * 2}; pg8::StaticOrder S; S.init(NTOK, PWP, F.G, (int)blockIdx.x);
            pg8::EpiProj E{PROJ, (const float*)(ws + WS_TAB), (const float*)(ws + WS_TAB + 256 * 1024)};
            TWICE_IF(PROBE_PROJ, (pg8::gemm_phase<pg8::EpiProj, pg8::StaticOrder, true, true>(F.lds + RING_OFF, F.wave, g, S, E)));
        } SEAM(pb); PH_END(pb);
        PH_BEGIN(pb + 1); if (IN(pb + 1)) {
#if MIXER_NAIVE
            naive_mixers(F, args, l);
#else
            REPEAT(PROBE_MIX) { mixer_phase(F, args, l, rep); REPBAR(PROBE_MIX); }
#endif
        } SEAM(pb + 1); PH_END(pb + 1);
        PH_BEGIN(pb + 2); if (IN(pb + 2)) {
            pg8::Gemm g{CAT, (const bf16*)(ws + WS_WOUT) + (size_t)l * DM * DM, NTOK, DM, DM * 2}; pg8::StaticOrder S; S.init(NTOK, DM, F.G, (int)blockIdx.x);
            pg8::EpiResid E{T, XB, 1.f};
            pg8::gemm_phase<pg8::EpiResid, pg8::StaticOrder, true, true>(F.lds + RING_OFF, F.wave, g, S, E);
        } SEAM(pb + 2); PH_END(pb + 2);
        if constexpr (l == 0) {
            PH_BEGIN(4); if (IN(4)) { ln_phase<0>(F, args, T, args.in[7], args.in[8], nullptr); } SEAM(4); PH_END(4);
            PH_BEGIN(5); if (IN(5)) {
                pg8::Gemm g{XB, (const bf16*)(ws + WS_WDGU), NTOK, 2 * DFF, DM * 2}; pg8::StaticOrder S; S.init(NTOK, 2 * DFF, F.G, (int)blockIdx.x);
                pg8::EpiSwiGLU8 E{ws + WS_H, 44, 1.f};
                TWICE_IF(PROBE_DUP, (pg8::gemm_phase<pg8::EpiSwiGLU8, pg8::StaticOrder, true, true, false>(F.lds + RING_OFF, F.wave, g, S, E)));
            } SEAM(5); PH_END(5);
            PH_BEGIN(6); if (IN(6)) {
                pg8::Gemm g{ws + WS_H, ws + WS_WDDN, NTOK, DM, DFF}; pg8::StaticOrder S; S.init(NTOK, DM, F.G, (int)blockIdx.x);
                pg8::EpiResid E{T, XB, 1.f / (pg8::FP8_SH * pg8::FP8_SWD)};
                pg8::gemm_phase<pg8::EpiResid, pg8::StaticOrder, true, true, true>(F.lds + RING_OFF, F.wave, g, S, E);
            } SEAM(6); PH_END(6);
            PH_BEGIN(7); if (IN(7)) { ln_phase<0>(F, args, T, args.in[9], args.in[10], nullptr); } SEAM(7); PH_END(7);
        } else {
            PH_BEGIN(11); if (IN(11)) { ln_phase<1>(F, args, T, args.in[7] + DM, args.in[8] + DM, args.in[14]); } SEAM(11); PH_END(11);
            PH_BEGIN(12); if (IN(12)) { gather_phase(F, args, T); } SEAM(12); PH_END(12);
            if (IN(13) || IN(14) || IN(15)) {
                int ntl_v; const int offv = expert_offsets(F, ntl_v); const int ntl = __builtin_amdgcn_readfirstlane(ntl_v);
                pg8::GroupedOrder S; S.nM = ntl; S.pm0 = 0; S.G = F.G; S.c = (int)blockIdx.x;
#pragma unroll
                for (int e = 0; e < 8; ++e) S.cum[e] = (e < 7) ? __builtin_amdgcn_readfirstlane(__shfl(offv, e + 1) >> 8) : ntl;
                PH_BEGIN(13); if (IN(13)) {
                    S.nN = 44; S.nwg = ntl * 44;
                    pg8::Gemm g{ws + WS_XG, ws + WS_WMGU, ntl * 256, 8 * 2 * DFF, DM};
                    pg8::EpiSwiGLU8 E{ws + WS_H, 44, 1.f / (pg8::FP8_SX * pg8::FP8_SWU)};
                    TWICE_IF(PROBE_MUP, (pg8::gemm_phase<pg8::EpiSwiGLU8, pg8::GroupedOrder, true, true, true>(F.lds + RING_OFF, F.wave, g, S, E)));
                } SEAM(13); PH_END(13);
                PH_BEGIN(14); if (IN(14)) {
                    S.nN = 8; S.pm0 = 0; S.nM = ntl < 128 ? ntl : 128; S.nwg = S.nM * 8;
                    pg8::Gemm g{ws + WS_H, ws + WS_WMDN, ntl * 256, 8 * DM, DFF};
                    pg8::EpiY E{(bf16*)(ws + WS_Y), 8, 1.f / (pg8::FP8_SH * pg8::FP8_SWD)};
                    TWICE_IF(PROBE_MDN, (pg8::gemm_phase<pg8::EpiY, pg8::GroupedOrder, true, true, true>(F.lds + RING_OFF, F.wave, g, S, E)));
                } SEAM(14); PH_END(14);
                PH_BEGIN(15); if (IN(15)) {
                    S.nN = 8; S.pm0 = 128; S.nM = ntl > 128 ? ntl - 128 : 0; S.nwg = S.nM * 8;
                    if (S.nwg > 0) {
                        pg8::Gemm g{ws + WS_H, ws + WS_WMDN, ntl * 256, 8 * DM, DFF};
                        pg8::EpiY E{(bf16*)(ws + WS_Y), 8, 1.f / (pg8::FP8_SH * pg8::FP8_SWD)};
                        pg8::gemm_phase<pg8::EpiY, pg8::GroupedOrder, true, true, true>(F.lds + RING_OFF, F.wave, g, S, E);
                    }
                    {
                        LAS int* qw = (LAS int*)(F.lds + MIX_QW);
                        for (;;) {
                            if (ftid(F) == 0) *qw = (int)__hip_atomic_fetch_add(F.ctl + CW_WQ + 64 * 12, 1u, RLX_AGENT);
                            __syncthreads();
                            const int grp64 = __builtin_amdgcn_readfirstlane(*qw);
                            __syncthreads();
                            if (grp64 >= NTOK / 64) break;
                            ln_phase<2>(F, args, T, args.in[9] + DM, args.in[10] + DM, nullptr, grp64 * 64 + F.wave * 8, 1);
                        }
                    }
                    xcd_barrier(bar);
                    ln_phase<2>(F, args, T, args.in[9] + DM, args.in[10] + DM, nullptr, -1, 2);
                } PH_END(15);
            }
        }
}
constexpr int N_PHASES = 16;
__global__ void __launch_bounds__(NWAVES * 64, 2) hymba_fwd(Args args) {
    extern __shared__ __attribute__((aligned(16))) unsigned char lds[];
    Frame F;
    F.lds = (LAS unsigned char*)lds;
    volatile LAS unsigned* MISC = (volatile LAS unsigned*)(F.lds + MISC_OFF);
    F.wave = __builtin_amdgcn_readfirstlane((int)threadIdx.x >> 6); F.lane = (int)__builtin_amdgcn_mbcnt_hi(~0u, __builtin_amdgcn_mbcnt_lo(~0u, 0u)); F.tid = 0;
    F.G = gridDim.x; { const int bx = blockIdx.x; F.vcu = (F.G % 8 == 0) ? (bx % 8) * (F.G / 8) + bx / 8 : bx; }
    unsigned char* ws = args.ws;
    F.ctl = (gu32*)(ws + WS_CTL);
    for (int u = ftid(F); u < 1024 / 4; u += NWAVES * 64) ((LAS unsigned*)(F.lds + LDSCTL_OFF))[u] = 0u;
    __syncthreads();
    XcdBarrier bar = xcd_barrier_post((unsigned*)(F.ctl + CW_BAR) + args.li * 4096, MISC + 8);
    build_lut(F, args.in[2]);
    __syncthreads();
    const int lo = args.ph_lo, hi = args.ph_hi;
    unsigned long long spin_t0 = 0ull, spin_dt = 0ull;
    PH_BEGIN(0); if (IN(0)) { REPEAT(PROBE_P0) { p0_prologue(F, args); REPBAR(PROBE_P0); } } SEAM(0); PH_END(0);
    run_layer<0>(F, args, bar, lo, hi, spin_t0, spin_dt);
    run_layer<1>(F, args, bar, lo, hi, spin_t0, spin_dt);
    if (PROBE_SPIN_PHASE >= 0 && blockIdx.x == 0) { const unsigned long long te = __builtin_amdgcn_s_memrealtime() + 10ull * spin_dt; while (__builtin_amdgcn_s_memrealtime() < te) __builtin_amdgcn_s_sleep(16); }
#undef IN
#undef SEAM
}

#ifndef N_LAUNCHES
#define N_LAUNCHES 1
#endif
extern "C" void kernel_launch(void* const* d_in, const int* in_sizes, int n_in, void* d_out, int out_size, void* d_ws, size_t ws_size, hipStream_t stream) {
    static int grid = 0;
    if (grid == 0) {
        if (n_in != 18 || in_sizes[0] != NTOK * DM || out_size != NTOK * DM || ws_size < WS_END) { fprintf(stderr, "kernel_launch: unexpected shapes / workspace (%d inputs, ws %zu < %zu)\n", n_in, ws_size, (size_t)WS_END); grid = -1; return; }
        int dev = 0, cus = 0, per_cu = 0;
        if (hipGetDevice(&dev) != hipSuccess || hipDeviceGetAttribute(&cus, hipDeviceAttributeMultiprocessorCount, dev) != hipSuccess) { grid = -1; return; }
        if (hipFuncSetAttribute((const void*)hymba_fwd, hipFuncAttributeMaxDynamicSharedMemorySize, LDS_BYTES) != hipSuccess) { fprintf(stderr, "kernel_launch: hipFuncSetAttribute failed\n"); grid = -1; return; }
        if (hipOccupancyMaxActiveBlocksPerMultiprocessor(&per_cu, (const void*)hymba_fwd, NWAVES * 64, LDS_BYTES) != hipSuccess || per_cu < 1) fprintf(stderr, "kernel_launch: occupancy query reports %d\n", per_cu);
        (void)hipGetLastError();
        grid = (cus == 256) ? 256 : -1;
        if (grid < 0) { fprintf(stderr, "kernel_launch: built for a 256-CU device, found %d CUs\n", cus); return; }
    }
    if (grid < 0) return;
    if (hipMemsetAsync((char*)d_ws + WS_CTL, 0, CTL_ZERO_BYTES, stream) != hipSuccess) return;
    Args a{};
    for (int i = 0; i < 18; ++i) a.in[i] = (const float*)d_in[i];
    a.out = (float*)d_out; a.ws = (unsigned char*)d_ws;
    for (int i = 0; i < 32; ++i) a.invf[i] = (float)(1.0 / pow(10000.0, (double)((float)i / 31.0f)));
#if N_LAUNCHES == 1
    const int cuts[2] = {0, N_PHASES};
#else
    int cuts[N_PHASES + 1]; for (int i = 0; i <= N_PHASES; ++i) cuts[i] = i;
#endif
    const int nl = (N_LAUNCHES == 1) ? 1 : N_PHASES;
    for (int li = 0; li < nl; ++li) {
        a.ph_lo = cuts[li]; a.ph_hi = cuts[li + 1]; a.li = li; a.pad = 0;
        hipLaunchKernelGGL(hymba_fwd, dim3(grid), dim3(NWAVES * 64), LDS_BYTES, stream, a);
        const hipError_t le = hipPeekAtLastError();
        if (le != hipSuccess) { fprintf(stderr, "kernel_launch: launch %d failed: %s\n", li, hipGetErrorName(le)); break; }
    }
}
```

```cpp
#include <hip/hip_runtime.h>
#include <cstdio>
#include <cstdint>
#include <cmath>
namespace pg8 {
#define PG8_LAS __attribute__((address_space(3)))
typedef unsigned short bf16_t;
typedef short bf16x8 __attribute__((ext_vector_type(8)));
typedef float f32x4 __attribute__((ext_vector_type(4)));
typedef unsigned u32x4 __attribute__((ext_vector_type(4)));
constexpr int BM = 256, BK = 64, HALF = 128, HTB = HALF * BK * 2  , STAGE_BYTES = 8 * HTB, NXCD = 8, WGM = 8;

__host__ __device__ __forceinline__ int lds_byte(int r, int c) { const int st = (r >> 4) * 2 + (c >> 5), rr = r & 15, cc = c & 31, ob = rr * 64 + cc * 2; return st * 1024 + (ob ^ (((ob >> 9) & 1) << 5)); }
__host__ __device__ __forceinline__ void stage_rc(int b, int& R, int& C) { const int st = b / 1024, sb = b % 1024, swz = sb ^ (((sb >> 9) & 1) << 5); R = (st >> 1) * 16 + swz / 64; C = (st & 1) * 32 + (swz % 64) / 2; }
__host__ __device__ __forceinline__ int perm32(int rho) { const int n = rho >> 4, i = rho & 15; return 8 * (i >> 2) + 4 * n + (i & 3); }

struct Unit { int pm, pn; };
struct Gemm { const void* A; const void* Bt; int M, N, KB; };
typedef int v4i_t __attribute__((ext_vector_type(4)));
typedef int v8i_t __attribute__((ext_vector_type(8)));

struct StaticOrder {
    int nM, nN, nwg, G, c;
    __host__ __device__ void init(int M, int N, int G_, int c_) { nM = M / BM; nN = N / BM; nwg = nM * nN; G = G_; c = c_; }
    __host__ __device__ bool next(int i, Unit& u) const {
        const long L = (long)i * G + c; if (L >= nwg) return false;
        int wgid = (int)L; { const int q = nwg / NXCD, r = nwg % NXCD, xcd = wgid % NXCD, off = wgid / NXCD; wgid = (xcd < r ? xcd * (q + 1) : r * (q + 1) + (xcd - r) * q) + off; }
        const int nig = WGM * nN, gid = wgid / nig, fm = gid * WGM, gsz = (nM - fm) < WGM ? (nM - fm) : WGM;
        u.pm = fm + ((wgid % nig) % gsz); u.pn = (wgid % nig) / gsz; return true;
    }
    __device__ __forceinline__ void a_ready(const Unit&) const {}
    __device__ __forceinline__ void done(const Unit&) const {}
};

__device__ __forceinline__ unsigned cvt_pk_bf16(float lo, float hi) { unsigned r; asm volatile("v_cvt_pk_bf16_f32 %0, %1, %2" : "=v"(r) : "v"(lo), "v"(hi)); return r; }
typedef float f32x2 __attribute__((ext_vector_type(2)));
typedef float f32x2 __attribute__((ext_vector_type(2)));
typedef unsigned u32x2 __attribute__((ext_vector_type(2)));
constexpr float ALPHA_F = 1.41421356237309515f;
constexpr float C2_F = 0.125f * 1.4426950408889634f;
__device__ __forceinline__ u32x4 pack8(const f32x4 v0, const f32x4 v1) { u32x4 w; w.x = cvt_pk_bf16(v0[0], v0[1]); w.y = cvt_pk_bf16(v0[2], v0[3]); w.z = cvt_pk_bf16(v1[0], v1[1]); w.w = cvt_pk_bf16(v1[2], v1[3]); return w; }

struct EpiProj {
    static constexpr bool PERM = true, AFTER_DRAIN = false;
    bf16_t* O; const float* sinT; const float* cosT;
    __device__ __forceinline__ void operator()(const f32x4 (&acc)[2][2][4][2], const Unit& u, int wr, int wc, int fr, int fq) const {
        const int row0 = u.pm * BM + wr * 64 + fr;
#pragma unroll
        for (int bj = 0; bj < 2; ++bj) {
            const int cw = u.pn * BM + bj * HALF + wc * 32;
            const int c0 = cw + 8 * fq;
            float sc = 1.f; bool rope = false;
            if (cw < 768 || (cw >= 2304 && cw < 3072)) sc = C2_F;
            else if (cw >= 3456 && cw < 3968) { rope = true; if (cw >= 3712) sc = 0.125f; }
            const float klg2 = (cw >= 3712 && cw < 3968) ? -__builtin_amdgcn_logf(1.f - __builtin_amdgcn_exp2f(-5.f - (float)((cw - 3712) >> 6))) : 0.f;
            const int i0 = ((c0 - 3456) & 63) >> 1;
#pragma unroll
            for (int ai = 0; ai < 2; ++ai)
#pragma unroll
                for (int m = 0; m < 4; ++m) {
                    const int row = row0 + ai * HALF + m * 16;
                    const float scr_ = sc * __builtin_amdgcn_exp2f(klg2 * (float)(row & 127));
                    f32x4 v0 = acc[ai][bj][m][0] * scr_, v1 = acc[ai][bj][m][1] * scr_;
                    if (rope) {
                        const int pos = row & 2047;
                        const f32x4 sn = *(const f32x4*)(sinT + pos * 32 + i0), cs = *(const f32x4*)(cosT + pos * 32 + i0);
                        f32x4 w0, w1;
                        w0[0] = v0[0] * cs[0] - v0[1] * sn[0]; w0[1] = v0[1] * cs[0] + v0[0] * sn[0];
                        w0[2] = v0[2] * cs[1] - v0[3] * sn[1]; w0[3] = v0[3] * cs[1] + v0[2] * sn[1];
                        w1[0] = v1[0] * cs[2] - v1[1] * sn[2]; w1[1] = v1[1] * cs[2] + v1[0] * sn[2];
                        w1[2] = v1[2] * cs[3] - v1[3] * sn[3]; w1[3] = v1[3] * cs[3] + v1[2] * sn[3];
                        v0 = w0; v1 = w1;
                    }
                    *(u32x4*)(O + (size_t)row * 5120 + c0) = pack8(v0, v1);
                }
        }
    }
};
struct EpiResid {
    static constexpr bool PERM = true, AFTER_DRAIN = false;
    float* T; const bf16_t* R; float scale;
    __device__ __forceinline__ void operator()(const f32x4 (&acc)[2][2][4][2], const Unit& u, int wr, int wc, int fr, int fq) const {
        const int row0 = u.pm * BM + wr * 64 + fr, col0 = u.pn * BM + wc * 32 + 8 * fq;
#pragma unroll
        for (int ai = 0; ai < 2; ++ai)
#pragma unroll
            for (int m = 0; m < 4; ++m) {
                const size_t ro = (size_t)(row0 + ai * HALF + m * 16) * 2048 + col0;
#pragma unroll
                for (int bj = 0; bj < 2; ++bj) {
                    const u32x4 r = *(const u32x4*)(R + ro + bj * HALF);
                    f32x4 r0, r1;
                    r0[0] = __builtin_bit_cast(float, r.x << 16); r0[1] = __builtin_bit_cast(float, r.x & 0xffff0000u); r0[2] = __builtin_bit_cast(float, r.y << 16); r0[3] = __builtin_bit_cast(float, r.y & 0xffff0000u);
                    r1[0] = __builtin_bit_cast(float, r.z << 16); r1[1] = __builtin_bit_cast(float, r.z & 0xffff0000u); r1[2] = __builtin_bit_cast(float, r.w << 16); r1[3] = __builtin_bit_cast(float, r.w & 0xffff0000u);
                    *(f32x4*)(T + ro + bj * HALF) = r0 * ALPHA_F + acc[ai][bj][m][0] * scale;
                    *(f32x4*)(T + ro + bj * HALF + 4) = r1 * ALPHA_F + acc[ai][bj][m][1] * scale;
                }
            }
    }
};
__device__ __forceinline__ float silu_f(float x) { return x * __builtin_amdgcn_rcpf(1.f + __builtin_amdgcn_exp2f(-1.4426950408889634f * x)); }
struct EpiSwiGLU {
    static constexpr bool PERM = true, AFTER_DRAIN = false;
    bf16_t* H; int ntn;
    __device__ __forceinline__ void operator()(const f32x4 (&acc)[2][2][4][2], const Unit& u, int wr, int wc, int fr, int fq) const {
        const int row0 = u.pm * BM + wr * 64 + fr, col0 = (u.pn % ntn) * HALF + wc * 32 + 8 * fq;
#pragma unroll
        for (int ai = 0; ai < 2; ++ai)
#pragma unroll
            for (int m = 0; m < 4; ++m) {
                f32x4 h0, h1;
#pragma unroll
                for (int j = 0; j < 4; ++j) { h0[j] = silu_f(acc[ai][0][m][0][j]) * acc[ai][1][m][0][j]; h1[j] = silu_f(acc[ai][0][m][1][j]) * acc[ai][1][m][1][j]; }
                *(u32x4*)(H + (size_t)(row0 + ai * HALF + m * 16) * 5632 + col0) = pack8(h0, h1);
            }
    }
};
constexpr float FP8_SX = 16.f, FP8_SWU = 512.f, FP8_SH = 8.f, FP8_SWD = 2048.f;
__device__ __forceinline__ unsigned pack4_fp8(float a, float b, float c, float d) {
    a = __builtin_amdgcn_fmed3f(a, -448.f, 448.f); b = __builtin_amdgcn_fmed3f(b, -448.f, 448.f); c = __builtin_amdgcn_fmed3f(c, -448.f, 448.f); d = __builtin_amdgcn_fmed3f(d, -448.f, 448.f);
    int w = __builtin_amdgcn_cvt_pk_fp8_f32(a, b, 0, false); w = __builtin_amdgcn_cvt_pk_fp8_f32(c, d, w, true); return (unsigned)w;
}
struct EpiSwiGLU8 {
    static constexpr bool PERM = true, AFTER_DRAIN = false;
    unsigned char* H; int ntn; float si;
    __device__ __forceinline__ void operator()(const f32x4 (&acc)[2][2][4][2], const Unit& u, int wr, int wc, int fr, int fq) const {
        const int row0 = u.pm * BM + wr * 64 + fr, col0 = (u.pn % ntn) * HALF + wc * 32 + 8 * fq;
#pragma unroll
        for (int ai = 0; ai < 2; ++ai)
#pragma unroll
            for (int m = 0; m < 4; ++m) {
                f32x4 h0, h1;
#pragma unroll
                for (int j = 0; j < 4; ++j) { h0[j] = silu_f(acc[ai][0][m][0][j] * si) * (acc[ai][1][m][0][j] * (si * FP8_SH)); h1[j] = silu_f(acc[ai][0][m][1][j] * si) * (acc[ai][1][m][1][j] * (si * FP8_SH)); }
                u32x2 w; w.x = pack4_fp8(h0[0], h0[1], h0[2], h0[3]); w.y = pack4_fp8(h1[0], h1[1], h1[2], h1[3]);
                *(u32x2*)(H + (size_t)(row0 + ai * HALF + m * 16) * 5632 + col0) = w;
            }
    }
};
struct EpiY {
    static constexpr bool PERM = true, AFTER_DRAIN = false;
    bf16_t* Y; int ntn; float scale;
    __device__ __forceinline__ void operator()(const f32x4 (&acc)[2][2][4][2], const Unit& u, int wr, int wc, int fr, int fq) const {
        const int row0 = u.pm * BM + wr * 64 + fr, col0 = (u.pn % ntn) * BM + wc * 32 + 8 * fq;
#pragma unroll
        for (int ai = 0; ai < 2; ++ai)
#pragma unroll
            for (int m = 0; m < 4; ++m)
#pragma unroll
                for (int bj = 0; bj < 2; ++bj)
                    *(u32x4*)(Y + (size_t)(row0 + ai * HALF + m * 16) * 2048 + col0 + bj * HALF) = pack8(acc[ai][bj][m][0] * scale, acc[ai][bj][m][1] * scale);
    }
};
struct GroupedOrder {
    int nM, nN, nwg, G, c, pm0; int cum[8];
    __device__ __forceinline__ bool next(int i, Unit& u) const {
        const long L = (long)i * G + c; if (L >= nwg) return false;
        int wgid = (int)L; { const int q = nwg / NXCD, r = nwg % NXCD, xcd = wgid % NXCD, off = wgid / NXCD; wgid = (xcd < r ? xcd * (q + 1) : r * (q + 1) + (xcd - r) * q) + off; }
        const int nig = WGM * nN, gid = wgid / nig, fm = gid * WGM, gsz = (nM - fm) < WGM ? (nM - fm) : WGM;
        const int pm = pm0 + fm + ((wgid % nig) % gsz), pn = (wgid % nig) / gsz;
        int e = 0;
#pragma unroll
        for (int j = 0; j < 7; ++j) e += (pm >= cum[j]) ? 1 : 0;
        u.pm = pm; u.pn = e * nN + pn; return true;
    }
    __device__ __forceinline__ void a_ready(const Unit&) const {}
    __device__ __forceinline__ void done(const Unit&) const {}
};
template <class Epi, class Sched, bool ALIGN_EPI = false, bool SP2 = false, bool FP8 = false>
__device__ __forceinline__ void gemm_phase(PG8_LAS unsigned char* lds, const int wid, const Gemm g, const Sched& S, const Epi& E) {
    const int lane = (int)__builtin_amdgcn_mbcnt_hi(~0u, __builtin_amdgcn_mbcnt_lo(~0u, 0u)), tid = wid * 64 + lane,
        wr = wid >> 2, wc = wid & 3, fr = lane & 15, fq = lane >> 4;
    const int KB = g.KB, nt = KB / 128;
    unsigned voffA[2], voffB[2];
#pragma unroll
    for (int i = 0; i < 2; ++i) { int R, C; stage_rc(tid * 16 + i * 8192, R, C); const int Rb = Epi::PERM ? ((R & ~31) + perm32(R & 31)) : R;
        voffA[i] = (unsigned)(R * KB + C * 2); voffB[i] = (unsigned)(Rb * KB + C * 2); }
    const size_t kstep = (size_t)128;
    const size_t hstep = (size_t)HALF * KB;
    const size_t tstep = 2 * hstep;
    const unsigned ldsw = (unsigned)wid * 1024u;
    const int aoff = lds_byte(wr * 64 + fr, fq * 8), boff = lds_byte(wc * 32 + fr, fq * 8);
#define PG8_SA(b, h) (((b) * 2 + (h)) * HTB)
#define PG8_SB(b, h) ((4 + (b) * 2 + (h)) * HTB)
#define PG8_STAGE(bufoff, gbase, voff) do { _Pragma("unroll") for (int _i = 0; _i < 2; ++_i) \
        __builtin_amdgcn_global_load_lds((const unsigned*)((const char*)(gbase) + (voff)[_i]), (PG8_LAS unsigned*)(lds + (bufoff) + ldsw + _i * 8192), 16, 0, 0); } while (0)
#define PG8_LDA(dst, b, h) do { _Pragma("unroll") for (int m = 0; m < 4; ++m) _Pragma("unroll") for (int k = 0; k < 2; ++k) dst[m][k] = *(const PG8_LAS bf16x8*)(lds + PG8_SA(b, h) + aoff + m * 2048 + k * 1024); } while (0)
#define PG8_LDB(dst, b, h) do { _Pragma("unroll") for (int n = 0; n < 2; ++n) _Pragma("unroll") for (int k = 0; k < 2; ++k) dst[n][k] = *(const PG8_LAS bf16x8*)(lds + PG8_SB(b, h) + boff + n * 2048 + k * 1024); } while (0)
#define PG8_MMA(ai, bj, At, Bt) do { __builtin_amdgcn_s_setprio(1); _Pragma("unroll") for (int m = 0; m < 4; ++m) _Pragma("unroll") for (int n = 0; n < 2; ++n) { \
        if constexpr (FP8) { const v4i_t b0_ = __builtin_bit_cast(v4i_t, Bt[n][0]), b1_ = __builtin_bit_cast(v4i_t, Bt[n][1]), a0_ = __builtin_bit_cast(v4i_t, At[m][0]), a1_ = __builtin_bit_cast(v4i_t, At[m][1]); \
            const v8i_t b8_ = __builtin_shufflevector(b0_, b1_, 0, 1, 2, 3, 4, 5, 6, 7), a8_ = __builtin_shufflevector(a0_, a1_, 0, 1, 2, 3, 4, 5, 6, 7); \
            asm volatile("v_mfma_f32_16x16x128_f8f6f4 %0, %1, %2, %0" : "+v"(acc[ai][bj][m][n]) : "v"(b8_), "v"(a8_)); } \
        else { _Pragma("unroll") for (int k = 0; k < 2; ++k) acc[ai][bj][m][n] = __builtin_amdgcn_mfma_f32_16x16x32_bf16(Bt[n][k], At[m][k], acc[ai][bj][m][n], 0, 0, 0); } } __builtin_amdgcn_s_setprio(0); } while (0)
#define PG8_WAIT_V(n) asm volatile("s_waitcnt vmcnt(" #n ")" ::: "memory")
#define PG8_WAIT_L(n) asm volatile("s_waitcnt lgkmcnt(" #n ")" ::: "memory")
#define PG8_BAR __builtin_amdgcn_s_barrier()
#define PG8_SCHED __builtin_amdgcn_sched_barrier(0)
    Unit cur, nxt; int ui = 0;
    if (!S.next(0, cur)) return;
    f32x4 acc[2][2][4][2];
#pragma unroll
    for (int a = 0; a < 2; ++a)
#pragma unroll
        for (int b = 0; b < 2; ++b)
#pragma unroll
            for (int m = 0; m < 4; ++m)
#pragma unroll
                for (int n = 0; n < 2; ++n) acc[a][b][m][n] = (f32x4){0.f, 0.f, 0.f, 0.f};
    bf16x8 At[4][2], B0[2][2], B1[2][2];
    const char* cA = (const char*)g.A + (size_t)cur.pm * tstep; const char* cB = (const char*)g.Bt + (size_t)cur.pn * tstep;
    S.a_ready(cur);
    if constexpr (SP2) {
        PG8_STAGE(PG8_SB(0, 0), cB, voffB); PG8_STAGE(PG8_SB(0, 1), cB + hstep, voffB); PG8_STAGE(PG8_SA(0, 0), cA, voffA); PG8_STAGE(PG8_SA(0, 1), cA + hstep, voffA);
        if (wr == 1) PG8_BAR;
        PG8_WAIT_V(2); PG8_BAR;
        PG8_STAGE(PG8_SB(1, 0), cB + kstep, voffB); PG8_STAGE(PG8_SA(1, 0), cA + kstep, voffA); PG8_STAGE(PG8_SB(1, 1), cB + hstep + kstep, voffB);
        PG8_WAIT_V(6); PG8_BAR;
    } else {
        PG8_STAGE(PG8_SB(0, 0), cB, voffB); PG8_STAGE(PG8_SA(0, 0), cA, voffA); PG8_STAGE(PG8_SB(0, 1), cB + hstep, voffB); PG8_STAGE(PG8_SA(0, 1), cA + hstep, voffA);
        if (wr == 1) PG8_BAR;
        PG8_WAIT_V(4); PG8_BAR;
        PG8_STAGE(PG8_SB(1, 0), cB + kstep, voffB); PG8_STAGE(PG8_SA(1, 0), cA + kstep, voffA); PG8_STAGE(PG8_SB(1, 1), cB + hstep + kstep, voffB);
        PG8_WAIT_V(6); PG8_BAR;
    }
    for (;;) {
        const bool has_next = S.next(ui + 1, nxt);
        const char* nA = has_next ? (const char*)g.A + (size_t)nxt.pm * tstep : cA; const char* nB = has_next ? (const char*)g.Bt + (size_t)nxt.pn * tstep : cB;
        for (int t = 0; t < nt; t += 2) {
            const bool last = (t == nt - 2);
            const char* a1 = cA + (size_t)(t + 1) * kstep;
            const char* a2 = last ? nA : cA + (size_t)(t + 2) * kstep; const char* b2 = last ? nB : cB + (size_t)(t + 2) * kstep;
            const char* a3 = a2 + kstep; const char* b3 = b2 + kstep;
            if (last && has_next) S.a_ready(nxt);
            if constexpr (SP2) {
            PG8_LDB(B0, 0, 0); PG8_LDB(B1, 0, 1); PG8_SCHED; PG8_LDA(At, 0, 0); PG8_STAGE(PG8_SA(1, 1), a1 + hstep, voffA);
            PG8_WAIT_V(8); PG8_WAIT_L(0); PG8_BAR; PG8_MMA(0, 0, At, B0); PG8_MMA(0, 1, At, B1); PG8_BAR; PG8_SCHED;
            PG8_LDA(At, 0, 1); PG8_STAGE(PG8_SB(0, 0), b2, voffB); PG8_STAGE(PG8_SB(0, 1), b2 + hstep, voffB); PG8_STAGE(PG8_SA(0, 0), a2, voffA);
            PG8_WAIT_V(8); PG8_WAIT_L(0); PG8_BAR; PG8_MMA(1, 0, At, B0); PG8_MMA(1, 1, At, B1); PG8_BAR; PG8_SCHED;
            PG8_LDB(B0, 1, 0); PG8_LDB(B1, 1, 1); PG8_SCHED; PG8_LDA(At, 1, 0); PG8_STAGE(PG8_SA(0, 1), a2 + hstep, voffA);
            PG8_WAIT_V(8); PG8_WAIT_L(0); PG8_BAR; PG8_MMA(0, 0, At, B0); PG8_MMA(0, 1, At, B1); PG8_BAR; PG8_SCHED;
            PG8_LDA(At, 1, 1); PG8_STAGE(PG8_SB(1, 0), b3, voffB); PG8_STAGE(PG8_SB(1, 1), b3 + hstep, voffB); PG8_STAGE(PG8_SA(1, 0), a3, voffA);
            PG8_WAIT_V(8); PG8_WAIT_L(0); PG8_BAR; PG8_MMA(1, 0, At, B0); PG8_MMA(1, 1, At, B1); PG8_BAR; PG8_SCHED;
            } else {
            PG8_LDB(B0, 0, 0); PG8_SCHED; PG8_LDA(At, 0, 0); PG8_STAGE(PG8_SA(1, 1), a1 + hstep, voffA);
            PG8_WAIT_L(8); PG8_BAR; PG8_WAIT_L(0); PG8_MMA(0, 0, At, B0); PG8_BAR; PG8_SCHED;
            PG8_LDB(B1, 0, 1); PG8_STAGE(PG8_SB(0, 0), b2, voffB);
            PG8_BAR; PG8_WAIT_L(0); PG8_MMA(0, 1, At, B1); PG8_BAR;
            PG8_LDA(At, 0, 1); PG8_STAGE(PG8_SA(0, 0), a2, voffA);
            PG8_BAR; PG8_WAIT_L(0); PG8_MMA(1, 0, At, B0); PG8_BAR; PG8_SCHED;
            PG8_STAGE(PG8_SB(0, 1), b2 + hstep, voffB);
            PG8_WAIT_V(6); PG8_BAR; PG8_MMA(1, 1, At, B1); PG8_BAR;
            PG8_LDB(B0, 1, 0); PG8_SCHED; PG8_LDA(At, 1, 0); PG8_STAGE(PG8_SA(0, 1), a2 + hstep, voffA);
            PG8_WAIT_L(8); PG8_BAR; PG8_WAIT_L(0); PG8_MMA(0, 0, At, B0); PG8_BAR; PG8_SCHED;
            PG8_LDB(B1, 1, 1); PG8_STAGE(PG8_SB(1, 0), b3, voffB);
            PG8_BAR; PG8_WAIT_L(0); PG8_MMA(0, 1, At, B1); PG8_BAR;
            PG8_LDA(At, 1, 1); PG8_STAGE(PG8_SA(1, 0), a3, voffA);
            PG8_BAR; PG8_WAIT_L(0); PG8_MMA(1, 0, At, B0); PG8_BAR; PG8_SCHED;
            PG8_STAGE(PG8_SB(1, 1), b3 + hstep, voffB);
            PG8_WAIT_V(6); PG8_BAR; PG8_MMA(1, 1, At, B1); PG8_BAR;
            }
        }
        if constexpr (ALIGN_EPI) { if (wr == 0) PG8_BAR; }
        if constexpr (FP8) asm volatile("s_nop 15\n\ts_nop 15" ::: "memory");
        if constexpr (!Epi::AFTER_DRAIN) { E(acc, cur, wr, wc, fr, fq); S.done(cur); }
        if (!has_next) break;
#pragma unroll
        for (int a = 0; a < 2; ++a)
#pragma unroll
            for (int b = 0; b < 2; ++b)
#pragma unroll
                for (int m = 0; m < 4; ++m)
#pragma unroll
                    for (int n = 0; n < 2; ++n) acc[a][b][m][n] = (f32x4){0.f, 0.f, 0.f, 0.f};
        cur = nxt; cA = nA; cB = nB; ++ui;
        if constexpr (ALIGN_EPI) { if (wr == 1) PG8_BAR; }
    }
    PG8_WAIT_V(0);
    if constexpr (!ALIGN_EPI) { if (wr == 0) PG8_BAR; }
    PG8_BAR;
    if constexpr (Epi::AFTER_DRAIN) { E.fused(acc, cur, wr, wc, fr, fq, lds, wid, lane); S.done(cur); }
#undef PG8_SA
#undef PG8_SB
#undef PG8_STAGE
#undef PG8_LDA
#undef PG8_LDB
#undef PG8_MMA
#undef PG8_WAIT_V
#undef PG8_WAIT_L
#undef PG8_BAR
#undef PG8_SCHED
}
}
constexpr int NWAVES = 8;
constexpr int NTOK = 16384, SEQ = 2048, DM = 2048, PW = 4992, PWP = 5120, DFF = 5632, NEXP = 8, MAXTILES = 136;
constexpr float LN_EPS = 1e-5f;
constexpr float LOG2E = 1.4426950408889634f;
constexpr int C_AQ = 0, C_AK = 768, C_AV = 1536, C_BQ = 2304, C_BK = 3072, C_BV = 3264, C_CQ = 3456, C_CK = 3712, C_CV = 3968, C_CG = 4480;
constexpr size_t MiB = 1u << 20;
constexpr size_t WS_CTL = 0, CTL_ZERO_BYTES = 1 * MiB;
constexpr size_t WS_TAB = 1 * MiB;
constexpr size_t WS_ROUTE = 2 * MiB;
constexpr size_t WS_WIN = 4 * MiB, WS_WOUT = 44 * MiB, WS_WDGU = 60 * MiB, WS_WDDN = 104 * MiB, WS_WMGU = 126 * MiB, WS_WMDN = 478 * MiB;
constexpr size_t WS_XB = 654 * MiB, WS_XG = 718 * MiB, WS_U1 = 854 * MiB, WS_END = 1228 * MiB;
constexpr size_t WS_PROJ = WS_U1, WS_CAT = WS_U1 + 160 * MiB, WS_H = WS_U1, WS_Y = WS_XG;
static_assert(WS_WIN + 2ull * PWP * DM * 2 <= WS_WOUT && WS_WOUT + 2ull * DM * DM * 2 <= WS_WDGU && WS_WDGU + 2ull * DFF * DM * 2 <= WS_WDDN && WS_WDDN + (size_t)DM * DFF * 2 <= WS_WMGU, "ws map 1");
static_assert(WS_WMGU + 8ull * 2 * DFF * DM * 2 <= WS_WMDN && WS_WMDN + 8ull * DM * DFF * 2 <= WS_XB && WS_XB + (size_t)NTOK * DM * 2 <= WS_XG && WS_XG + (size_t)MAXTILES * 256 * DM * 2 <= WS_U1, "ws map 2");
static_assert(WS_U1 + (size_t)MAXTILES * 256 * DFF * 2 <= WS_END && WS_PROJ + (size_t)NTOK * PWP * 2 <= WS_CAT && WS_CAT + (size_t)NTOK * DM * 2 <= WS_END, "ws map 3");
constexpr int CW_TMO = 0, CW_CODE = 1, CW_CNT = 1024  , CW_WQ = 2048  , CW_BAR = 4096  ;
constexpr int RING_OFF = 0, RING_BYTES = 131072;
constexpr int LDSCTL_OFF = RING_BYTES, MISC_OFF = LDSCTL_OFF + 320;
constexpr int LUT_OFF = LDSCTL_OFF + 1024;
constexpr int LUT_STRIDE = 132;
constexpr int LDS_BYTES = 147456;
static_assert(LUT_OFF + 18 * LUT_STRIDE * 4 <= LDS_BYTES, "LDS map");

#define GAS __attribute__((address_space(1)))
#define LAS __attribute__((address_space(3)))
typedef unsigned short bf16;
typedef unsigned v4u __attribute__((ext_vector_type(4)));
typedef unsigned v2u __attribute__((ext_vector_type(2)));
typedef float f32x4 __attribute__((ext_vector_type(4)));
typedef short bf16x8 __attribute__((ext_vector_type(8)));
typedef GAS unsigned gu32;
#define RLX_AGENT __ATOMIC_RELAXED, __HIP_MEMORY_SCOPE_AGENT
#define LDS_WAIT() asm volatile("s_waitcnt lgkmcnt(0)" ::: "memory")
#define VM_WAIT() asm volatile("s_waitcnt vmcnt(0)" ::: "memory")
__device__ __forceinline__ unsigned f2bf(float f) { unsigned u = __builtin_bit_cast(unsigned, f); return (u + 0x7fffu + ((u >> 16) & 1u)) >> 16; }
__device__ __forceinline__ unsigned pk2(float lo, float hi) { return f2bf(lo) | (f2bf(hi) << 16); }
__device__ __forceinline__ float bflo(unsigned w) { return __builtin_bit_cast(float, w << 16); }
__device__ __forceinline__ float bfhi(unsigned w) { return __builtin_bit_cast(float, w & 0xffff0000u); }
__device__ __forceinline__ float bf2f(bf16 h) { return __builtin_bit_cast(float, (unsigned)h << 16); }
__device__ const unsigned char BUCKET[129] = {0,1,2,3,4,5,6,7,8,9,10,11,12,13,14,15,16,16,16,17,17,18,18,18,19,19,19,20,20,20,20,21,21,21,21,22,22,22,22,22,23,23,23,23,23,23,24,24,24,24,24,24,25,25,25,25,25,25,25,
    26,26,26,26,26,26,26,26,27,27,27,27,27,27,27,27,27,27,28,28,28,28,28,28,28,28,28,28,29,29,29,29,29,29,29,29,29,29,29,29,30,30,30,30,30,30,30,30,30,30,30,30,30,30,31,31,31,31,31,31,31,31,31,31,31,31,31,31,31,31};
#define XB_TMO      128
#define XB_XCNT(j)  (256  + 64 * (j))
#define XB_XSUB(j)  (1280 + 64 * (j))
#define XB_XGEN(j)  (2304 + 64 * (j))
#define XB_TOP      3328
#define XB_TOPGEN   3392
#define XCD_BAR_WORDS 3456
#define XB_SPIN_CAP (1u << 18)

__device__ __forceinline__ unsigned xb_ld(unsigned* p)              { return __hip_atomic_load(p, __ATOMIC_RELAXED, __HIP_MEMORY_SCOPE_AGENT); }
__device__ __forceinline__ unsigned xb_add(unsigned* p, unsigned v) { return __hip_atomic_fetch_add(p, v, __ATOMIC_RELAXED, __HIP_MEMORY_SCOPE_AGENT); }
__device__ __forceinline__ unsigned xb_xcc_id() { return (unsigned)__builtin_amdgcn_s_getreg((3 << 11) | 20) & 0xFu; }
#define XB_SPIN(cond, bar) do { unsigned _sp = 0; while (cond) { __builtin_amdgcn_s_sleep(1); \
    if ((++_sp & 255u) == 0u) { if (xb_ld(&(bar)[XB_TMO])) break; if (_sp > XB_SPIN_CAP) { atomicAdd(&(bar)[XB_TMO], 1u); break; } } } } while (0)

struct XcdBarrier {
    unsigned* bar; unsigned x;
    volatile LAS unsigned* st;
};

__device__ __forceinline__ XcdBarrier xcd_barrier_post(unsigned* bar, volatile LAS unsigned* st) {
    XcdBarrier b; b.bar = bar; b.x = xb_xcc_id(); b.st = st;
    if (threadIdx.x == 0) (void)xb_add(&bar[XB_XCNT(b.x)], 1u);
    return b;
}
__device__ __forceinline__ void xcd_barrier_complete(unsigned* bar, unsigned x, unsigned& nloc, unsigned& nx) {
    const unsigned G = gridDim.x * gridDim.y * gridDim.z;
    unsigned sum, cnt, mine, sp = 0u;
    for (;;) {
        sum = 0u; cnt = 0u; mine = 0u;
#pragma unroll
        for (unsigned j = 0; j < 16; ++j) { const unsigned c = xb_ld(&bar[XB_XCNT(j)]); sum += c; cnt += (c > 0u) ? 1u : 0u; mine = (j == x) ? c : mine; }
        if (sum == G) break;
        __builtin_amdgcn_s_sleep(1);
        if ((++sp & 255u) == 0u) { if (xb_ld(&bar[XB_TMO])) break; if (sp > XB_SPIN_CAP) { atomicAdd(&bar[XB_TMO], 1u); break; } }
    }
    nloc = mine > 0u ? mine : 1u; nx = cnt > 0u ? cnt : 1u;
}

__device__ __forceinline__ void xcd_barrier(const XcdBarrier& b) {
    asm volatile("s_waitcnt vmcnt(0)" ::: "memory");
    __syncthreads();
    if (threadIdx.x == 0) {
        unsigned* bar = b.bar;
        __builtin_amdgcn_s_waitcnt(0);
        unsigned nloc = b.st[0], nx = b.st[1];
        if (nloc == 0u) { xcd_barrier_complete(bar, b.x, nloc, nx); b.st[0] = nloc; b.st[1] = nx; }
        const unsigned old = xb_add(&bar[XB_XSUB(b.x)], 1u);
        const unsigned gen = old / nloc;
        if (old + 1u == (gen + 1u) * nloc) {
            __builtin_amdgcn_fence(__ATOMIC_RELEASE, "agent");
            asm volatile("s_waitcnt vmcnt(0)" ::: "memory");
            const unsigned og = xb_add(&bar[XB_TOP], 1u);
            const unsigned tg = og / nx;
            if (og + 1u == (tg + 1u) * nx) xb_add(&bar[XB_TOPGEN], 1u);
            else XB_SPIN(xb_ld(&bar[XB_TOPGEN]) == tg, bar);
            __builtin_amdgcn_fence(__ATOMIC_ACQUIRE, "agent");
            xb_add(&bar[XB_XGEN(b.x)], 1u);
            asm volatile("s_waitcnt vmcnt(0)" ::: "memory");
        } else {
            XB_SPIN(xb_ld(&bar[XB_XGEN(b.x)]) == gen, bar);
            __builtin_amdgcn_fence(__ATOMIC_ACQUIRE, "agent");
            asm volatile("s_waitcnt vmcnt(0)" ::: "memory");
        }
    }
    __syncthreads();
}
struct Args { const float* in[18]; float* out; unsigned char* ws; int ph_lo, ph_hi, li, pad; float invf[32]; };
static_assert(sizeof(Args) == 20 * 8 + 16 + 128, "Args has no padding bytes");
struct Frame {
    LAS unsigned char* lds;
    gu32* ctl;
    int tid, lane, wave, vcu, G;
};
__device__ __forceinline__ int flane() { int l = (int)__builtin_amdgcn_mbcnt_hi(~0u, __builtin_amdgcn_mbcnt_lo(~0u, 0u)); asm volatile("" : "+v"(l)); return l; }
__device__ __forceinline__ int ftid(const Frame& F) { return F.wave * 64 + flane(); }
__device__ __forceinline__ float wave_sum(float v) {
#pragma unroll
    for (int o = 1; o < 64; o <<= 1) v += __shfl_xor(v, o);
    return v;
}
__device__ __forceinline__ float wave_max(float v) {
#pragma unroll
    for (int o = 1; o < 64; o <<= 1) v = fmaxf(v, __shfl_xor(v, o));
    return v;
}
__device__ __forceinline__ void p0_transpose_item(const float* W, int K, int N, bf16* WT, int k0, int n0, int drow0, LAS float* scr, int lane) {
#pragma unroll 8
    for (int i = 0; i < 32; ++i) { const int kk = 2 * i + (lane >> 5); scr[kk * 33 + (lane & 31)] = __builtin_nontemporal_load(W + (size_t)(k0 + kk) * N + n0 + (lane & 31)); }
    LDS_WAIT(); asm volatile("" ::: "memory");
    const int c = lane & 7;
#pragma unroll
    for (int j = 0; j < 4; ++j) { const int n = (lane >> 3) + 8 * j; const LAS float* s = scr + (8 * c) * 33 + n;
        v4u o; o.x = pk2(s[0 * 33], s[1 * 33]); o.y = pk2(s[2 * 33], s[3 * 33]); o.z = pk2(s[4 * 33], s[5 * 33]); o.w = pk2(s[6 * 33], s[7 * 33]);
        __builtin_nontemporal_store(o, (GAS v4u*)(WT + (size_t)(drow0 + n) * K + k0 + 8 * c)); }
    LDS_WAIT(); asm volatile("" ::: "memory");
}
template <int MODE> __device__ __forceinline__ void p0_matrix_item(const float* W, int K, int N, bf16* WT, int item, LAS float* scr, int lane) {
    const int nblk = N / 32, kb = item / nblk, nb = item % nblk, n0 = 32 * nb;
    const int drow0 = (MODE == 0) ? n0 : ((n0 >> 7) * 256 + (n0 & 127) + (MODE == 2 ? 128 : 0));
    p0_transpose_item(W, K, N, WT, 64 * kb, n0, drow0, scr, lane);
}
__device__ __forceinline__ void p0_transpose_item8(const float* W, int K, int N, unsigned char* WT, int k0, int n0, int drow0, float scale, LAS float* scr, int lane) {
#pragma unroll 8
    for (int i = 0; i < 32; ++i) { const int kk = 2 * i + (lane >> 5); scr[kk * 33 + (lane & 31)] = __builtin_nontemporal_load(W + (size_t)(k0 + kk) * N + n0 + (lane & 31)) * scale; }
    LDS_WAIT(); asm volatile("" ::: "memory");
    const int c = lane & 7;
#pragma unroll
    for (int j = 0; j < 4; ++j) { const int n = (lane >> 3) + 8 * j; const LAS float* s = scr + (8 * c) * 33 + n;
        v2u o; o.x = pg8::pack4_fp8(s[0 * 33], s[1 * 33], s[2 * 33], s[3 * 33]); o.y = pg8::pack4_fp8(s[4 * 33], s[5 * 33], s[6 * 33], s[7 * 33]);
        __builtin_nontemporal_store(o, (GAS v2u*)(WT + (size_t)(drow0 + n) * K + k0 + 8 * c)); }
    LDS_WAIT(); asm volatile("" ::: "memory");
}
template <int MODE> __device__ __forceinline__ void p0_matrix_item8(const float* W, int K, int N, unsigned char* WT, int item, float scale, LAS float* scr, int lane) {
    const int nblk = N / 32, kb = item / nblk, nb = item % nblk, n0 = 32 * nb;
    const int drow0 = (MODE == 0) ? n0 : ((n0 >> 7) * 256 + (n0 & 127) + (MODE == 2 ? 128 : 0));
    p0_transpose_item8(W, K, N, WT, 64 * kb, n0, drow0, scale, scr, lane);
}
__device__ __forceinline__ void p0_prologue(Frame& F, const Args& a) {
    LAS float* scr = (LAS float*)(F.lds + RING_OFF + F.wave * 16384);
    const int gw = F.vcu * NWAVES + F.wave, NGW = F.G * NWAVES;
    unsigned char* ws = a.ws;
    constexpr int I_IN = (DM / 64) * (PW / 32), I_OUT = (DM / 64) * (DM / 32), I_GU = (DM / 64) * (DFF / 32), I_DN = (DFF / 64) * (DM / 32);
    constexpr int NITEMS = 2 * I_IN + 2 * I_OUT + 2 * I_GU + I_DN;
    for (int it = gw; it < NITEMS; it += NGW) {
        int r = it;
        if (r < 2 * I_IN) { const int l = r / I_IN; p0_matrix_item<0>(a.in[1] + (size_t)l * DM * PW, DM, PW, (bf16*)(ws + WS_WIN) + (size_t)l * PWP * DM, r % I_IN, scr, flane()); continue; } r -= 2 * I_IN;
        if (r < 2 * I_OUT) { const int l = r / I_OUT; p0_matrix_item<0>(a.in[6] + (size_t)l * DM * DM, DM, DM, (bf16*)(ws + WS_WOUT) + (size_t)l * DM * DM, r % I_OUT, scr, flane()); continue; } r -= 2 * I_OUT;
        if (r < I_GU) { p0_matrix_item<1>(a.in[11], DM, DFF, (bf16*)(ws + WS_WDGU), r, scr, flane()); continue; } r -= I_GU;
        if (r < I_GU) { p0_matrix_item<2>(a.in[12], DM, DFF, (bf16*)(ws + WS_WDGU), r, scr, flane()); continue; } r -= I_GU;
        { p0_matrix_item8<0>(a.in[13], DFF, DM, ws + WS_WDDN, r, pg8::FP8_SWD, scr, flane()); }
    }
    { const int gt = gw * 64 + flane(), NGT = NGW * 64; const GAS f32x4* x4 = (const GAS f32x4*)a.in[0]; GAS v4u* o4 = (GAS v4u*)(ws + WS_XB);
      for (int i = gt; i < NTOK * DM / 8; i += NGT) { const f32x4 p = __builtin_nontemporal_load(x4 + 2 * i), q = __builtin_nontemporal_load(x4 + 2 * i + 1); v4u o; o.x = pk2(p[0], p[1]); o.y = pk2(p[2], p[3]); o.z = pk2(q[0], q[1]); o.w = pk2(q[2], q[3]); o4[i] = o; } }
    { const int gt = gw * 64 + flane(); if (gt < SEQ * 32) { const int pos = gt >> 5, i = gt & 31; const float ang = (float)pos * a.invf[i];
        const double t = (double)ang * 0.15915494309189535; const float fr = (float)(t - __builtin_rint(t));
        ((float*)(ws + WS_TAB))[gt] = __builtin_amdgcn_sinf(fr); ((float*)(ws + WS_TAB + 256 * 1024))[gt] = __builtin_amdgcn_cosf(fr); } }
}
constexpr int MOE_I_GU = (DM / 128) * (DFF / 32), MOE_I_DN = (DFF / 128) * (DM / 32), MOE_ITEMS = 8 * (2 * MOE_I_GU + MOE_I_DN), MOE_CHUNKS = MOE_ITEMS / 32;
static_assert(MOE_ITEMS % 32 == 0 && MOE_CHUNKS % 2 == 0, "expert conversion chunks");
struct MoeItem { const float* W; unsigned char* dst; int K, N, k0, n0, drow0; float scale; };
__device__ __forceinline__ void moe_item(const Args& a, int idx, MoeItem& o) {
    unsigned char* ws = a.ws; int r = idx, mode; const float* W; unsigned char* dst; int K, N, item;
    if (r < 8 * MOE_I_GU) { const int e = r / MOE_I_GU; W = a.in[15] + (size_t)e * DM * DFF; dst = ws + WS_WMGU + (size_t)e * 2 * DFF * DM; K = DM; N = DFF; item = r % MOE_I_GU; mode = 1; o.scale = pg8::FP8_SWU; }
    else if (r < 16 * MOE_I_GU) { r -= 8 * MOE_I_GU; const int e = r / MOE_I_GU; W = a.in[16] + (size_t)e * DM * DFF; dst = ws + WS_WMGU + (size_t)e * 2 * DFF * DM; K = DM; N = DFF; item = r % MOE_I_GU; mode = 2; o.scale = pg8::FP8_SWU; }
    else { r -= 16 * MOE_I_GU; const int e = r / MOE_I_DN; W = a.in[17] + (size_t)e * DFF * DM; dst = ws + WS_WMDN + (size_t)e * DM * DFF; K = DFF; N = DM; item = r % MOE_I_DN; mode = 0; o.scale = pg8::FP8_SWD; }
    const int nblk = N / 32, kb = item / nblk, nb = item % nblk, n0 = 32 * nb;
    o.W = W; o.dst = dst; o.K = K; o.N = N; o.k0 = 128 * kb; o.n0 = n0;
    o.drow0 = (mode == 0) ? n0 : ((n0 >> 7) * 256 + (n0 & 127) + (mode == 2 ? 128 : 0));
}
__device__ __forceinline__ void moe_issue(const MoeItem& o, int lane, f32x4 (&v)[16]) {
    const float* p = o.W + (size_t)(o.k0 + (lane >> 3)) * o.N + o.n0 + 4 * (lane & 7);
#pragma unroll
    for (int i = 0; i < 16; ++i) v[i] = __builtin_nontemporal_load((const f32x4*)(p + (size_t)(8 * i) * o.N));
}
__device__ __forceinline__ void moe_to_lds(const MoeItem& o, int lane, const f32x4 (&v)[16], LAS float* scr) {
    const int kr = lane >> 3, nq = 4 * (lane & 7);
#pragma unroll
    for (int i = 0; i < 16; ++i) { const int k = 8 * i + kr; LAS float* d = scr + k * 32;
#pragma unroll
        for (int c = 0; c < 4; ++c) d[(nq + c) ^ (k & 31)] = v[i][c] * o.scale; }
    LDS_WAIT(); asm volatile("" ::: "memory");
}
__device__ __forceinline__ void moe_from_lds(const MoeItem& o, int lane, LAS float* scr) {
    const int c16 = lane & 7;
#pragma unroll
    for (int j = 0; j < 4; ++j) { const int n = (lane >> 3) + 8 * j; v4u w;
#define MOE_RD(i) scr[(16 * c16 + (i)) * 32 + (n ^ ((16 * c16 + (i)) & 31))]
        w.x = pg8::pack4_fp8(MOE_RD(0), MOE_RD(1), MOE_RD(2), MOE_RD(3)); w.y = pg8::pack4_fp8(MOE_RD(4), MOE_RD(5), MOE_RD(6), MOE_RD(7));
        w.z = pg8::pack4_fp8(MOE_RD(8), MOE_RD(9), MOE_RD(10), MOE_RD(11)); w.w = pg8::pack4_fp8(MOE_RD(12), MOE_RD(13), MOE_RD(14), MOE_RD(15));
#undef MOE_RD
        *(GAS v4u*)(o.dst + (size_t)(o.drow0 + n) * o.K + o.k0 + 16 * c16) = w; }
    LDS_WAIT(); asm volatile("" ::: "memory");
}
__device__ __forceinline__ void moe_convert_chunk(Frame& F, const Args& a, int chunk) {
    int lane = (int)__builtin_amdgcn_mbcnt_hi(~0u, __builtin_amdgcn_mbcnt_lo(~0u, 0u)); asm volatile("" : "+v"(lane));
    LAS float* scr = (LAS float*)(F.lds + RING_OFF + F.wave * 16384);
    const int i0 = 32 * chunk + F.wave;
    MoeItem A, B; f32x4 v[16];
    moe_item(a, i0, A); moe_issue(A, lane, v);
    moe_to_lds(A, lane, v, scr); moe_item(a, i0 + 8, B); moe_issue(B, lane, v); moe_from_lds(A, lane, scr);
    moe_to_lds(B, lane, v, scr); moe_item(a, i0 + 16, A); moe_issue(A, lane, v); moe_from_lds(B, lane, scr);
    moe_to_lds(A, lane, v, scr); moe_item(a, i0 + 24, B); moe_issue(B, lane, v); moe_from_lds(A, lane, scr);
    moe_to_lds(B, lane, v, scr); moe_from_lds(B, lane, scr);
}
__device__ __forceinline__ void build_lut(Frame& F, const float* rel_bias) {
    LAS float* lut = (LAS float*)(F.lds + LUT_OFF);
    for (int i = ftid(F); i < 18 * 129; i += NWAVES * 64) { const int hh = i / 129, d = i % 129; lut[hh * LUT_STRIDE + d] = (rel_bias[BUCKET[d] * 18 + hh] - (hh < 6 ? rel_bias[31 * 18 + hh] : 0.f)) * LOG2E; }
}
__device__ __forceinline__ void ln_stats(f32x4 (&v)[8], float& mean, float& rstd) {
    float s = 0.f;
#pragma unroll
    for (int j = 0; j < 8; ++j) s += (v[j][0] + v[j][1]) + (v[j][2] + v[j][3]);
    mean = wave_sum(s) * (1.f / DM); float s2 = 0.f;
#pragma unroll
    for (int j = 0; j < 8; ++j) { v[j] = v[j] - mean; s2 += (v[j][0] * v[j][0] + v[j][1] * v[j][1]) + (v[j][2] * v[j][2] + v[j][3] * v[j][3]); }
    rstd = 1.f / sqrtf(wave_sum(s2) * (1.f / DM) + LN_EPS);
}
__device__ __forceinline__ int expert_offsets(Frame& F, int& ntiles) {
    const unsigned c = (flane() < 8) ? __hip_atomic_load(F.ctl + CW_CNT + 64 * flane(), RLX_AGENT) : 0u;
    const int t = (int)((c + 255u) >> 8);
    int inc = t;
#pragma unroll
    for (int o = 1; o < 8; o <<= 1) { const int u = __shfl_up(inc, o); if (flane() >= o) inc += u; }
    ntiles = __shfl(inc, 7);
    return (inc - t) * 256;
}
template <int MODE> __device__ __forceinline__ void ln_phase(Frame& F, const Args& a, float* T, const float* gam, const float* bet, const float* w_router, int rb_in = -1, int pass = 0) {
    unsigned char* ws = a.ws;
    bf16* XB = (bf16*)(ws + WS_XB);
    const int lane = flane();
    LAS float* wrT = (LAS float*)(F.lds + RING_OFF);
    LAS int* cwL = (LAS int*)(F.lds + RING_OFF + 65536);
    LAS int* baseL = (LAS int*)(F.lds + RING_OFF + 65536 + 256);
    if (MODE == 1) {
        for (int i = ftid(F); i < DM * 8; i += NWAVES * 64) wrT[(i & 7) * DM + (i >> 3)] = w_router[i];
        __syncthreads();
    }
    f32x4 g4[8], b4[8];
#pragma unroll
    for (int j = 0; j < 8; ++j) { g4[j] = *(const f32x4*)(gam + 4 * lane + 256 * j); b4[j] = *(const f32x4*)(bet + 4 * lane + 256 * j); }
    int offv = 0, ntl = 0;
    if (MODE == 2) offv = expert_offsets(F, ntl);
    const int rb = (rb_in >= 0) ? rb_in : (F.vcu * NWAVES + F.wave) * 8;
    unsigned long long cntp = 0ull; int me1 = 0, me2 = 0, mr1 = 0, mr2 = 0; float mg1 = 0.f, mg2 = 0.f;
    for (int r = 0; r < 8; ++r) {
        const int row = rb + r;
        float* trow = T + (size_t)row * DM;
        if (MODE == 2 && pass != 0) {
            const int* rt = (const int*)(ws + WS_ROUTE) + row * 8;
            const bool late = (__shfl(offv, rt[0]) + rt[1] >= 32768) || (__shfl(offv, rt[2]) + rt[3] >= 32768);
            if (late != (pass == 2)) continue;
        }
        f32x4 v[8];
#pragma unroll
        for (int j = 0; j < 8; ++j) v[j] = *(const f32x4*)(trow + 4 * lane + 256 * j);
        if (MODE == 2) {
            const int* rt = (const int*)(ws + WS_ROUTE) + row * 8;
            const int e1 = rt[0], p1 = rt[1], e2 = rt[2], p2 = rt[3]; const float g1 = __builtin_bit_cast(float, rt[4]), g2 = __builtin_bit_cast(float, rt[5]);
            const int r1 = __shfl(offv, e1) + p1, r2 = __shfl(offv, e2) + p2;
            const bf16* y1 = (const bf16*)(ws + WS_Y) + (size_t)r1 * DM; const bf16* y2 = (const bf16*)(ws + WS_Y) + (size_t)r2 * DM;
#pragma unroll
            for (int j = 0; j < 8; ++j) { const v2u a1 = *(const v2u*)(y1 + 4 * lane + 256 * j), a2 = *(const v2u*)(y2 + 4 * lane + 256 * j);
                v[j][0] = v[j][0] * pg8::ALPHA_F + g1 * bflo(a1.x) + g2 * bflo(a2.x); v[j][1] = v[j][1] * pg8::ALPHA_F + g1 * bfhi(a1.x) + g2 * bfhi(a2.x);
                v[j][2] = v[j][2] * pg8::ALPHA_F + g1 * bflo(a1.y) + g2 * bflo(a2.y); v[j][3] = v[j][3] * pg8::ALPHA_F + g1 * bfhi(a1.y) + g2 * bfhi(a2.y); }
        }
        float mean, rstd; ln_stats(v, mean, rstd);
#pragma unroll
        for (int j = 0; j < 8; ++j) v[j] = v[j] * rstd * g4[j] + b4[j];
        if (MODE == 2) {
            float* orow = a.out + (size_t)row * DM;
#pragma unroll
            for (int j = 0; j < 8; ++j) *(f32x4*)(orow + 4 * lane + 256 * j) = v[j];
        } else {
            bf16* xrow = XB + (size_t)row * DM;
#pragma unroll
            for (int j = 0; j < 8; ++j) { if (MODE != 0) *(f32x4*)(trow + 4 * lane + 256 * j) = v[j]; if (MODE == 0) { v2u o; o.x = pk2(v[j][0], v[j][1]); o.y = pk2(v[j][2], v[j][3]); *(v2u*)(xrow + 4 * lane + 256 * j) = o; }
                if (MODE == 3) { const f32x4 s = v[j] * pg8::FP8_SX; ((GAS unsigned*)(ws + WS_XG + (size_t)row * DM))[lane + 64 * j] = pg8::pack4_fp8(s[0], s[1], s[2], s[3]); } }
        }
        if (MODE == 1) {
            int i1 = -1, i2 = -1; float v1 = -3.0e38f, v2 = -3.0e38f;
#pragma unroll 1
            for (int e = 0; e < 8; ++e) { float s = 0.f;
#pragma unroll
                for (int j = 0; j < 8; ++j) { const f32x4 w = *(const LAS f32x4*)(wrT + e * DM + 4 * lane + 256 * j); s += (v[j][0] * w[0] + v[j][1] * w[1]) + (v[j][2] * w[2] + v[j][3] * w[3]); }
                const float t = wave_sum(s);
                if (t > v1) { v2 = v1; i2 = i1; v1 = t; i1 = e; } else if (t > v2) { v2 = t; i2 = e; } }
            if (i1 < 0) i1 = 0;
            if (i2 < 0) i2 = (i1 + 1) & 7;
            const float ex = __expf(v2 - v1), w1 = 1.f / (1.f + ex), w2 = ex * w1;
            const int k1 = (int)((cntp >> (8 * i1)) & 0xffull); cntp += 1ull << (8 * i1);
            const int k2 = (int)((cntp >> (8 * i2)) & 0xffull); cntp += 1ull << (8 * i2);
            if (lane == r) { me1 = i1; me2 = i2; mr1 = k1; mr2 = k2; mg1 = w1; mg2 = w2; }
        }
    }
    if (MODE == 1) {
        if (lane < 8) cwL[F.wave * 8 + lane] = (int)((cntp >> (8 * lane)) & 0xffull);
        __syncthreads();
        if (ftid(F) < 8) { int tot = 0;
#pragma unroll
            for (int w = 0; w < 8; ++w) tot += cwL[w * 8 + ftid(F)];
            baseL[ftid(F)] = (int)__hip_atomic_fetch_add(F.ctl + CW_CNT + 64 * ftid(F), (unsigned)tot, RLX_AGENT); }
        __syncthreads();
        if (lane < 8) {
            int p1 = baseL[me1] + mr1, p2 = baseL[me2] + mr2;
            for (int w = 0; w < F.wave; ++w) { p1 += cwL[w * 8 + me1]; p2 += cwL[w * 8 + me2]; }
            int* rt = (int*)(ws + WS_ROUTE) + (rb + lane) * 8;
            rt[0] = me1; rt[1] = p1; rt[2] = me2; rt[3] = p2; rt[4] = __builtin_bit_cast(int, mg1); rt[5] = __builtin_bit_cast(int, mg2);
        }
    }
}
__device__ __forceinline__ void gather_phase(Frame& F, const Args& a, const float* T) {
    unsigned char* ws = a.ws; int ntl; const int offv = expert_offsets(F, ntl);
    const int gw = F.vcu * NWAVES + F.wave, NGW = F.G * NWAVES;
    for (int tok = gw; tok < NTOK; tok += NGW) {
        const int* rt = (const int*)(ws + WS_ROUTE) + tok * 8;
        const int d1 = __shfl(offv, rt[0]) + rt[1], d2 = __shfl(offv, rt[2]) + rt[3];
        const GAS f32x4* s = (const GAS f32x4*)(T + (size_t)tok * DM);
        GAS unsigned* o1 = (GAS unsigned*)(ws + WS_XG + (size_t)d1 * DM); GAS unsigned* o2 = (GAS unsigned*)(ws + WS_XG + (size_t)d2 * DM);
#pragma unroll
        for (int j = 0; j < 8; ++j) { const f32x4 v = s[flane() + 64 * j] * pg8::FP8_SX; const unsigned w = pg8::pack4_fp8(v[0], v[1], v[2], v[3]); o1[flane() + 64 * j] = w; o2[flane() + 64 * j] = w; }
    }
}
__device__ __forceinline__ float dot8(const v4u q, const v4u k) {
    return (bflo(q.x) * bflo(k.x) + bfhi(q.x) * bfhi(k.x)) + (bflo(q.y) * bflo(k.y) + bfhi(q.y) * bfhi(k.y)) + (bflo(q.z) * bflo(k.z) + bfhi(q.z) * bfhi(k.z)) + (bflo(q.w) * bflo(k.w) + bfhi(q.w) * bfhi(k.w));
}
__device__ __forceinline__ float lambda_of(const float* lp, int lane, float lam_init) {
    const float s1 = wave_sum(lp[lane] * lp[64 + lane]), s2 = wave_sum(lp[128 + lane] * lp[192 + lane]);
    return __expf(s1) - __expf(s2) + lam_init;
}
__device__ __forceinline__ void naive_mixers(Frame& F, const Args& a, int layer) {
    unsigned char* ws = a.ws; const bf16* PROJ = (const bf16*)(ws + WS_PROJ); bf16* CAT = (bf16*)(ws + WS_CAT);
    const int lane = F.lane; const int gw = F.vcu * NWAVES + F.wave, NGW = F.G * NWAVES;
    LAS float* sc = (LAS float*)(F.lds + RING_OFF + F.wave * 16384);
    const LAS float* lut = (const LAS float*)(F.lds + LUT_OFF);
    const float lam_init = 0.8f - 0.6f * __expf(-0.3f * (float)layer);
    const float lam = lambda_of(a.in[3] + layer * 256, lane, lam_init);
    const float* subg = a.in[4] + layer * 128; const float* sinks = a.in[5] + layer * 12;
    for (int task = gw; task < NTOK * 6; task += NGW) {
        const int tok = task / 6, h = task - tok * 6, q = tok & (SEQ - 1), base = tok - q;
        v4u qv[16]; { const v4u* qp = (const v4u*)(PROJ + (size_t)tok * PWP + C_AQ + h * 128);
#pragma unroll
            for (int c = 0; c < 16; ++c) qv[c] = qp[c]; }
        float m1 = -3.0e38f, m2 = -3.0e38f;
        for (int j = lane; j <= q; j += 64) {
            const v4u* kp = (const v4u*)(PROJ + (size_t)(base + j) * PWP + C_AK + h * 128); float d1 = 0.f, d2 = 0.f;
#pragma unroll
            for (int c = 0; c < 8; ++c) { d1 += dot8(qv[c], kp[c]); d2 += dot8(qv[8 + c], kp[8 + c]); }
            const int dd = q - j; const float bias = lut[h * LUT_STRIDE + (dd < 128 ? dd : 128)];
            d1 += bias; d2 += bias; sc[j] = d1; sc[2048 + j] = d2; m1 = fmaxf(m1, d1); m2 = fmaxf(m2, d2);
        }
        m1 = wave_max(m1); m2 = wave_max(m2); float l1 = 0.f, l2 = 0.f;
        for (int j = lane; j <= q; j += 64) { const float p1 = __builtin_amdgcn_exp2f(sc[j] - m1), p2 = __builtin_amdgcn_exp2f(sc[2048 + j] - m2); sc[j] = p1; sc[2048 + j] = p2; l1 += p1; l2 += p2; }
        l1 = wave_sum(l1); l2 = wave_sum(l2); const float c1 = 1.f / l1, c2 = lam / l2;
        float o0 = 0.f, o1 = 0.f;
        for (int j = 0; j <= q; ++j) { const float w = sc[j] * c1 - sc[2048 + j] * c2; const bf16* vr = PROJ + (size_t)(base + j) * PWP + C_AV + h * 128; o0 += w * bf2f(vr[lane]); o1 += w * bf2f(vr[64 + lane]); }
        const float ss = wave_sum(o0 * o0 + o1 * o1), rr = (1.f / sqrtf(ss * (1.f / 128.f) + LN_EPS)) * (1.f - lam_init);
        bf16* orow = CAT + (size_t)tok * DM + h * 128; orow[lane] = (bf16)f2bf(o0 * rr * subg[lane]); orow[64 + lane] = (bf16)f2bf(o1 * rr * subg[64 + lane]);
    }
    for (int task = gw; task < NTOK * 12; task += NGW) {
        const int tok = task / 12, hq = task - tok * 12, kvh = hq >> 2, q = tok & (SEQ - 1), base = tok - q;
        v4u qv[8]; { const v4u* qp = (const v4u*)(PROJ + (size_t)tok * PWP + C_BQ + hq * 64);
#pragma unroll
            for (int c = 0; c < 8; ++c) qv[c] = qp[c]; }
        float s[2];
#pragma unroll
        for (int i = 0; i < 2; ++i) { const int dd = lane + 64 * i, j = q - dd; s[i] = -3.0e38f;
            if (j >= 0) { const v4u* kp = (const v4u*)(PROJ + (size_t)(base + j) * PWP + C_BK + kvh * 64); float d = 0.f;
#pragma unroll
                for (int c = 0; c < 8; ++c) d += dot8(qv[c], kp[c]);
                s[i] = d + lut[(6 + hq) * LUT_STRIDE + dd]; } }
        const float sink2 = sinks[hq] * LOG2E; const float m = fmaxf(wave_max(fmaxf(s[0], s[1])), sink2);
        const float p0 = (q - lane >= 0) ? __builtin_amdgcn_exp2f(s[0] - m) : 0.f, p1 = (q - lane - 64 >= 0) ? __builtin_amdgcn_exp2f(s[1] - m) : 0.f;
        const float l = wave_sum(p0 + p1) + __builtin_amdgcn_exp2f(sink2 - m);
        sc[lane] = p0; sc[64 + lane] = p1;
        float o = 0.f; const int nk = (q + 1 < 128) ? q + 1 : 128;
        for (int dd = 0; dd < nk; ++dd) o += sc[dd] * bf2f(PROJ[(size_t)(base + q - dd) * PWP + C_BV + kvh * 64 + lane]);
        CAT[(size_t)tok * DM + 768 + hq * 64 + lane] = (bf16)f2bf(o / l);
    }
    for (int task = gw; task < NTOK * 4; task += NGW) {
        const int tok = task >> 2, h = task & 3, q = tok & (SEQ - 1), base = tok - q;
        const float lg2 = log2f(1.f - exp2f(-5.f - (float)h));
        v4u qv[8]; { const v4u* qp = (const v4u*)(PROJ + (size_t)tok * PWP + C_CQ + h * 64);
#pragma unroll
            for (int c = 0; c < 8; ++c) qv[c] = qp[c]; }
        for (int j = lane; j <= q; j += 64) { const v4u* kp = (const v4u*)(PROJ + (size_t)(base + j) * PWP + C_CK + h * 64); float d = 0.f;
#pragma unroll
            for (int c = 0; c < 8; ++c) d += dot8(qv[c], kp[c]);
            sc[j] = d * __builtin_amdgcn_exp2f((float)(q - j) * lg2); }
        float o0 = 0.f, o1 = 0.f;
        for (int j = 0; j <= q; ++j) { const float w = sc[j]; const bf16* vr = PROJ + (size_t)(base + j) * PWP + C_CV + h * 128; o0 += w * bf2f(vr[lane]); o1 += w * bf2f(vr[64 + lane]); }
        const float mu = wave_sum(o0 + o1) * (1.f / 128.f); o0 -= mu; o1 -= mu;
        const float rs = 1.f / sqrtf(wave_sum(o0 * o0 + o1 * o1) * (1.f / 128.f) + LN_EPS);
        const bf16* gr = PROJ + (size_t)tok * PWP + C_CG + h * 128;
        bf16* orow = CAT + (size_t)tok * DM + 1536 + h * 128;
        orow[lane] = (bf16)f2bf(pg8::silu_f(bf2f(gr[lane])) * o0 * rs); orow[64 + lane] = (bf16)f2bf(pg8::silu_f(bf2f(gr[64 + lane])) * o1 * rs);
    }
}
typedef float f32x16 __attribute__((ext_vector_type(16)));
typedef short s16x4 __attribute__((ext_vector_type(4)));
typedef short v4i16_t __attribute__((ext_vector_type(4)));
typedef float f32x2_t __attribute__((ext_vector_type(2))); typedef __bf16 bf16x2_t __attribute__((ext_vector_type(2)));
__device__ __forceinline__ int crow(int r, int hi) { return (r & 3) + 8 * (r >> 2) + 4 * hi; }
__device__ __forceinline__ s16x4 vtr(const LAS unsigned char* p) { return __builtin_bit_cast(s16x4, __builtin_amdgcn_ds_read_tr16_b64_v4i16((LAS v4i16_t*)p)); }
__device__ __forceinline__ unsigned cvtpk_s(float lo, float hi) { f32x2_t v = {lo, hi}; bf16x2_t b = __builtin_convertvector(v, bf16x2_t); return __builtin_bit_cast(unsigned, b); }
__device__ __forceinline__ bf16x8 pack_p(const f32x16& p, int s2) {
    v4u w; w.x = cvtpk_s(p[8 * s2 + 0], p[8 * s2 + 1]); w.y = cvtpk_s(p[8 * s2 + 2], p[8 * s2 + 3]); w.z = cvtpk_s(p[8 * s2 + 4], p[8 * s2 + 5]); w.w = cvtpk_s(p[8 * s2 + 6], p[8 * s2 + 7]);
    return __builtin_bit_cast(bf16x8, w);
}
constexpr int MIX_WSF = 131072 + 1024 + 10240, MIX_QW = MIX_WSF + 2048;
static_assert(MIX_QW + 64 <= LDS_BYTES && LUT_OFF + 18 * LUT_STRIDE * 4 <= MIX_WSF, "mixer LDS map");
constexpr int LUTX_OFF = 98304, LUTX_STRIDE = 320;
constexpr float MIX_THR = 6.f;
__device__ __forceinline__ void glds16(const void* gsrc, unsigned lds_dst) { unsigned keep;
    asm volatile("s_mov_b32 %0, m0\n\ts_mov_b32 m0, %2\n\ts_nop 0\n\tglobal_load_lds_dwordx4 %1, off\n\ts_mov_b32 m0, %0" : "=&s"(keep) : "v"(gsrc), "s"(lds_dst) : "memory"); }
template <int IMM> __device__ __forceinline__ void glds16s(const void* sbase, unsigned voff, unsigned lds_dst) { unsigned keep;
    lds_dst -= (unsigned)IMM;
    asm volatile("s_mov_b32 %0, m0\n\ts_mov_b32 m0, %3\n\ts_nop 0\n\tglobal_load_lds_dwordx4 %1, %2 offset:%c4\n\ts_mov_b32 m0, %0" : "=&s"(keep) : "v"(voff), "s"(sbase), "s"(lds_dst), "i"(IMM) : "memory"); }
template <int MODE> __device__ __forceinline__ void mix_unit(Frame& F, const Args& a, int layer, int b, int hh, int qb, float lam, float lam_init) {
    constexpr int KW = (MODE == 0) ? 128 : 64, VW = (MODE == 1) ? 64 : 128, NEB = VW / 32, NSUB = 1;
    constexpr int KBYTES = 64 * KW * 2, VBYTES = 64 * VW * 2, BUFB = KBYTES + VBYTES, NST = 3;
    constexpr int KD = KBYTES / 1024, VD = VBYTES / 1024, PW = (KD + VD) / 8;
    static_assert(NST * BUFB <= LUTX_OFF && LUTX_OFF + 18 * LUTX_STRIDE * 4 <= RING_BYTES && (KD + VD) % 8 == 0, "mixer LDS ring");
    unsigned char* ws = a.ws; const bf16* PROJ = (const bf16*)(ws + WS_PROJ); bf16* CAT = (bf16*)(ws + WS_CAT);
    const int wave = F.wave; int lane = (int)__builtin_amdgcn_mbcnt_hi(~0u, __builtin_amdgcn_mbcnt_lo(~0u, 0u)); asm volatile("" : "+v"(lane));
    const int tid = wave * 64 + lane, r32 = lane & 31, hi = lane >> 5;
    LAS unsigned char* L = F.lds + RING_OFF;
    const unsigned Lb = (unsigned)(uintptr_t)L;
    LAS float* wsf = (LAS float*)(F.lds + MIX_WSF) + wave * 64;
    const LAS float* lut = (const LAS float*)(F.lds + LUT_OFF);
    const int rowbase = b * SEQ;
    const int q0 = (MODE == 2) ? qb * 256 : qb * 128;
    const int rg = (MODE == 2) ? wave : (wave & 3), wsel = (MODE == 2) ? 0 : (wave >> 2);
    const int qw0 = q0 + 32 * rg;
    const int kcol = (MODE == 0) ? C_AK + hh * 128 : (MODE == 1) ? C_BK + (hh >> 1) * 64 : C_CK + hh * 64;
    const int vcol = (MODE == 0) ? C_AV + hh * 128 : (MODE == 1) ? C_BV + (hh >> 1) * 64 : C_CV + hh * 128;
    const int kch0 = (MODE == 0) ? wsel * 8 : 0;
    const int t_lo = (MODE == 1) ? (qb > 0 ? 2 * qb - 2 : 0) : 0, t_hi = (MODE == 2) ? 4 * qb + 4 : 2 * qb + 2;
    bf16x8 qf[NSUB][4];
#pragma unroll
    for (int s = 0; s < NSUB; ++s) {
        const int qcol = (MODE == 0) ? C_AQ + hh * 128 + wsel * 64 : (MODE == 1) ? C_BQ + (hh * 2 + wsel) * 64 : C_CQ + hh * 64;
        const bf16* qp = PROJ + (size_t)(rowbase + qw0 + r32) * PWP + qcol + hi * 8;
#pragma unroll
        for (int d0 = 0; d0 < 4; ++d0) qf[s][d0] = *(const bf16x8*)(qp + d0 * 16);
    }
    float m_run[NSUB], l_run[NSUB]; f32x16 o[NSUB][NEB];
#pragma unroll
    for (int s = 0; s < NSUB; ++s) {
        m_run[s] = (MODE == 1) ? a.in[5][layer * 12 + hh * 2 + wsel] * LOG2E : -1.0e30f; l_run[s] = (MODE == 1) ? 1.f : 0.f;
#pragma unroll
        for (int e = 0; e < NEB; ++e) o[s][e] = f32x16{};
    }
    const float lg2 = (MODE == 2) ? log2f(1.f - exp2f(-5.f - (float)hh)) : 0.f;
    unsigned dsrc[PW]; unsigned ddst[PW];
#pragma unroll
    for (int i = 0; i < PW; ++i) {
        const int j = wave + 8 * i;
        if (j < KD) {
            int row, ch;
            if (KW == 128) { row = 4 * j + (lane >> 4); ch = (lane & 15) ^ (row & 15); }
            else { row = 8 * j + (lane >> 3); ch = (lane & 7) ^ ((row >> 1) & 7); }
            dsrc[i] = (unsigned)(((rowbase + row) * PWP + kcol + ch * 8) * 2); ddst[i] = (unsigned)(j * 1024);
        } else {
            const int jv = j - KD, eb = jv >> 2, key = 16 * (jv & 3) + 8 * (lane >> 5) + ((lane >> 2) & 7);
            dsrc[i] = (unsigned)(((rowbase + key) * PWP + vcol + eb * 32 + (lane & 3) * 8) * 2); ddst[i] = (unsigned)(KBYTES + jv * 1024);
        }
    }
#define MIX_DMA(t) do { const unsigned st_ = Lb + (unsigned)((((t) - t_lo) % NST) * BUFB); \
        _Pragma("unroll") for (int i_ = 0; i_ < PW; ++i_) glds16((const char*)PROJ + (size_t)(t) * (64 * PWP * 2) + dsrc[i_], (unsigned)__builtin_amdgcn_readfirstlane(st_ + ddst[i_])); } while (0)
    const int vlane = (4 * hi + ((lane & 15) >> 2)) * 64 + ((lane >> 4) & 1) * 32 + (lane & 3) * 8;
    asm volatile("s_waitcnt vmcnt(0)" ::: "memory");
#pragma unroll
    for (int s = 0; s < NSUB; ++s) {
        asm volatile("" : "+v"(m_run[s]));
#pragma unroll
        for (int d0 = 0; d0 < 4; ++d0) asm volatile("" : "+v"(qf[s][d0]));
    }
    MIX_DMA(t_lo);
    if (t_lo + 1 < t_hi) MIX_DMA(t_lo + 1);
#pragma unroll 1
    for (int t = t_lo; t < t_hi; ++t) {
        if (t + 1 < t_hi) { if (PW == 2) asm volatile("s_waitcnt vmcnt(2)" ::: "memory"); else if (PW == 3) asm volatile("s_waitcnt vmcnt(3)" ::: "memory"); else asm volatile("s_waitcnt vmcnt(4)" ::: "memory"); }
        else asm volatile("s_waitcnt vmcnt(0)" ::: "memory");
        asm volatile("s_waitcnt lgkmcnt(0)\n\ts_barrier" ::: "memory");
        if (t + 2 < t_hi) MIX_DMA(t + 2);
        const LAS unsigned char* Kb = L + ((t - t_lo) % NST) * BUFB; const LAS unsigned char* Vb = Kb + KBYTES;
        const int k0 = 64 * t;
        const bool active = (k0 <= qw0 + 31) && (MODE != 1 || k0 + 63 >= qw0 - 127);
        if (active) {
#pragma unroll
            for (int s = 0; s < NSUB; ++s) {
                f32x16 p0 = f32x16{}, p1 = f32x16{};
#pragma unroll
                for (int d0 = 0; d0 < 4; ++d0) {
                    const int ch = kch0 + 2 * d0 + hi;
                    const int ofs = (KW == 128) ? (r32 * 256 + ((ch ^ (r32 & 15)) << 4)) : (r32 * 128 + ((ch ^ ((r32 >> 1) & 7)) << 4));
                    const bf16x8 ka = *(const LAS bf16x8*)(Kb + ofs);
                    const bf16x8 kb2 = *(const LAS bf16x8*)(Kb + 32 * KW * 2 + ofs);
                    p0 = __builtin_amdgcn_mfma_f32_32x32x16_bf16(ka, qf[s][d0], p0, 0, 0, 0);
                    p1 = __builtin_amdgcn_mfma_f32_32x32x16_bf16(kb2, qf[s][d0], p1, 0, 0, 0);
                }
                const int qi = qw0 + r32;
                if (MODE == 2) {
#pragma unroll
                    for (int r = 0; r < 16; ++r) { const int d0_ = qi - (k0 + crow(r, hi)), d1_ = d0_ - 32;
                        const float dec = __builtin_amdgcn_exp2f((float)(qi - (k0 & ~127)) * lg2);
                        p0[r] = d0_ >= 0 ? p0[r] * dec : 0.f; p1[r] = d1_ >= 0 ? p1[r] * dec : 0.f; }
                } else {
                    const bool nearb = (MODE == 1) || (k0 + 63 + 128 > qw0);
                    if (nearb) {
                        const LAS float* lrow = lut + ((MODE == 0) ? hh : 6 + hh * 2 + wsel) * LUT_STRIDE;
#pragma unroll
                        for (int r = 0; r < 16; ++r) { const int d0_ = qi - (k0 + crow(r, hi)), d1_ = d0_ - 32;
                            const bool ok0 = (MODE == 0) ? (d0_ >= 0) : (d0_ >= 0 && d0_ < 128), ok1 = (MODE == 0) ? (d1_ >= 0) : (d1_ >= 0 && d1_ < 128);
                            const int i0_ = d0_ < 0 ? 0 : (d0_ > 128 ? 128 : d0_), i1_ = d1_ < 0 ? 0 : (d1_ > 128 ? 128 : d1_);
                            p0[r] = ok0 ? p0[r] + lrow[i0_] : -INFINITY; p1[r] = ok1 ? p1[r] + lrow[i1_] : -INFINITY; }
                    }
                    float rm = fmaxf(p0[0], p1[0]);
#pragma unroll
                    for (int r = 1; r < 16; ++r) rm = fmaxf(rm, fmaxf(p0[r], p1[r]));
                    rm = fmaxf(rm, __shfl_xor(rm, 32));
                    if (__any(rm > m_run[s] + MIX_THR)) {
                        const float mn = fmaxf(m_run[s], rm), al = __builtin_amdgcn_exp2f(m_run[s] - mn);
                        m_run[s] = mn; l_run[s] *= al;
                        if (hi == 0) wsf[r32] = al;
                        LDS_WAIT();
#pragma unroll
                        for (int r = 0; r < 16; ++r) { const float f = wsf[crow(r, hi)];
#pragma unroll
                            for (int e = 0; e < NEB; ++e) o[s][e][r] *= f; }
                        LDS_WAIT();
                    }
                    float ls = 0.f; const float mm = m_run[s];
#pragma unroll
                    for (int r = 0; r < 16; ++r) { p0[r] = __builtin_amdgcn_exp2f(p0[r] - mm); p1[r] = __builtin_amdgcn_exp2f(p1[r] - mm); ls += p0[r] + p1[r]; }
                    l_run[s] += ls;
                }
                s16x4 vlo[2][NEB], vhi[2][NEB];
#pragma unroll
                for (int e = 0; e < NEB; ++e) { vlo[0][e] = vtr(Vb + e * 4096 + vlane); vhi[0][e] = vtr(Vb + e * 4096 + vlane + 512); }
#pragma unroll
                for (int g = 0; g < 4; ++g) {
                    if (g < 3) {
#pragma unroll
                        for (int e = 0; e < NEB; ++e) { vlo[(g + 1) & 1][e] = vtr(Vb + e * 4096 + (g + 1) * 1024 + vlane); vhi[(g + 1) & 1][e] = vtr(Vb + e * 4096 + (g + 1) * 1024 + vlane + 512); }
                    }
                    const bf16x8 pa = pack_p((g >> 1) == 0 ? p0 : p1, g & 1);
#pragma unroll
                    for (int e = 0; e < NEB; ++e) {
                        const s16x4 lo = vlo[g & 1][e], hh2 = vhi[g & 1][e];
                        const bf16x8 vb = (bf16x8){lo[0], lo[1], lo[2], lo[3], hh2[0], hh2[1], hh2[2], hh2[3]};
                        o[s][e] = __builtin_amdgcn_mfma_f32_32x32x16_bf16(pa, vb, o[s][e], 0, 0, 0);
                    }
                }
                if (NSUB > 1) __builtin_amdgcn_sched_barrier(0);
            }
        }
    }
#undef MIX_DMA
    __syncthreads();
    if (MODE == 1) {
#pragma unroll
        for (int s = 0; s < NSUB; ++s) {
            const float sink2 = a.in[5][layer * 12 + hh * 2 + wsel] * LOG2E;
            const float lt = l_run[s] + __shfl_xor(l_run[s], 32) - __builtin_amdgcn_exp2f(sink2 - m_run[s]);
            if (hi == 0) wsf[r32] = 1.f / lt;
            LDS_WAIT();
            bf16* orow = CAT + (size_t)(rowbase + qw0) * DM + 768 + (hh * 2 + wsel) * 64 + r32;
#pragma unroll
            for (int r = 0; r < 16; ++r) { const int qr = crow(r, hi); const float f = wsf[qr];
#pragma unroll
                for (int e = 0; e < NEB; ++e) orow[(size_t)qr * DM + 32 * e] = (bf16)f2bf(o[s][e][r] * f); }
            LDS_WAIT();
        }
    } else if (MODE == 2) {
        const bf16* grow = PROJ + (size_t)(rowbase + qw0) * PWP + C_CG + hh * 128 + r32;
        bf16* orow = CAT + (size_t)(rowbase + qw0) * DM + 1536 + hh * 128 + r32;
#pragma unroll
        for (int r = 0; r < 16; ++r) {
            float s1 = 0.f;
#pragma unroll
            for (int e = 0; e < NEB; ++e) s1 += o[0][e][r];
#pragma unroll
            for (int sh = 1; sh < 32; sh <<= 1) s1 += __shfl_xor(s1, sh);
            const float mu = s1 * (1.f / 128.f); float s2 = 0.f;
#pragma unroll
            for (int e = 0; e < NEB; ++e) { const float d = o[0][e][r] - mu; s2 += d * d; }
#pragma unroll
            for (int sh = 1; sh < 32; sh <<= 1) s2 += __shfl_xor(s2, sh);
            const float rs = 1.f / sqrtf(s2 * (1.f / 128.f) + LN_EPS); const int qr = crow(r, hi);
#pragma unroll
            for (int e = 0; e < NEB; ++e) orow[(size_t)qr * DM + 32 * e] = (bf16)f2bf(pg8::silu_f(bf2f(grow[(size_t)qr * PWP + 32 * e])) * (o[0][e][r] - mu) * rs);
        }
    } else {
        const float lt = l_run[0] + __shfl_xor(l_run[0], 32);
        if (hi == 0) wsf[r32] = 1.f / lt;
        LDS_WAIT();
        LAS float* xb = (LAS float*)L + rg * 4096;
        if (wsel == 1) {
#pragma unroll
            for (int r = 0; r < 16; ++r) { const float f = wsf[crow(r, hi)];
#pragma unroll
                for (int e = 0; e < NEB; ++e) xb[(e * 16 + r) * 64 + lane] = o[0][e][r] * f; }
        }
        __syncthreads();
        if (wsel == 0) {
            const float* subg = a.in[4] + layer * 128; const float post = 1.f - lam_init;
            bf16* orow = CAT + (size_t)(rowbase + qw0) * DM + hh * 128 + r32;
#pragma unroll
            for (int r = 0; r < 16; ++r) { const float f = wsf[crow(r, hi)]; float d[NEB]; float ss = 0.f;
#pragma unroll
                for (int e = 0; e < NEB; ++e) { d[e] = o[0][e][r] * f - lam * xb[(e * 16 + r) * 64 + lane]; ss += d[e] * d[e]; }
#pragma unroll
                for (int sh = 1; sh < 32; sh <<= 1) ss += __shfl_xor(ss, sh);
                const float rs = (1.f / sqrtf(ss * (1.f / 128.f) + LN_EPS)) * post; const int qr = crow(r, hi);
#pragma unroll
                for (int e = 0; e < NEB; ++e) orow[(size_t)qr * DM + 32 * e] = (bf16)f2bf(d[e] * rs * subg[32 * e + r32]); }
        }
    }
    __syncthreads();
}
__device__ __forceinline__ void attn3_unit(Frame& F, const Args& a, int layer, int b, int hh, int qb, float lam, float lam_init) {
    constexpr int KBYTES = 128 * 256, VBYTES = 128 * 256, BUFB = KBYTES + VBYTES;
    static_assert(2 * BUFB <= RING_BYTES, "attn3 LDS ring");
    unsigned char* ws = a.ws; const bf16* PROJ = (const bf16*)(ws + WS_PROJ); bf16* CAT = (bf16*)(ws + WS_CAT);
    const int wave = F.wave; int lane = (int)__builtin_amdgcn_mbcnt_hi(~0u, __builtin_amdgcn_mbcnt_lo(~0u, 0u)); asm volatile("" : "+v"(lane));
    const int r32 = lane & 31, hi = lane >> 5;
    LAS unsigned char* L = F.lds + RING_OFF; const unsigned Lb = (unsigned)(uintptr_t)L;
    LAS float* wsf = (LAS float*)(F.lds + MIX_WSF) + wave * 64;
    const LAS float* lrow = (const LAS float*)(F.lds + LUT_OFF) + hh * LUT_STRIDE;
    const int rowbase = b * SEQ, q0 = qb * 128, rg = wave & 3, wsel = wave >> 2, qw0 = q0 + 32 * rg, t_hi = qb + 1;
    unsigned srcK, srcV;
    { const int row = 4 * wave + (lane >> 4), ch = (lane & 15) ^ (row & 15); srcK = (unsigned)(((rowbase + row) * PWP + C_AK + hh * 128 + ch * 8) * 2);
      const int key = 16 * wave + 8 * (lane >> 5) + ((lane >> 2) & 7); srcV = (unsigned)(((rowbase + key) * PWP + C_AV + hh * 128 + (lane & 3) * 8) * 2); }
#define A3_DMA(t) do { const char* tb_ = (const char*)PROJ + (size_t)(t) * (128 * PWP * 2); const unsigned st_ = (unsigned)__builtin_amdgcn_readfirstlane(Lb + (unsigned)(((t) & 1) * BUFB) + wave * 1024); \
        glds16s<0>(tb_, srcK, st_); glds16s<0>(tb_ + 32 * PWP * 2, srcK, st_ + 8192); glds16s<0>(tb_ + 64 * PWP * 2, srcK, st_ + 16384); glds16s<0>(tb_ + 96 * PWP * 2, srcK, st_ + 24576); \
        glds16s<0>(tb_, srcV, st_ + KBYTES); glds16s<64>(tb_, srcV, st_ + KBYTES + 8192); glds16s<128>(tb_, srcV, st_ + KBYTES + 16384); glds16s<192>(tb_, srcV, st_ + KBYTES + 24576); } while (0)
    const int vlane = (4 * hi + ((lane & 15) >> 2)) * 64 + ((lane >> 4) & 1) * 32 + (lane & 3) * 8;
    A3_DMA(0);
    bf16x8 qf[4];
    { const bf16* qp = PROJ + (size_t)(rowbase + qw0 + r32) * PWP + C_AQ + hh * 128 + wsel * 64 + hi * 8;
#pragma unroll
      for (int d0 = 0; d0 < 4; ++d0) qf[d0] = *(const bf16x8*)(qp + d0 * 16); }
    float m_run = -1.0e30f, l_run = 0.f; f32x16 o[4];
#pragma unroll
    for (int e = 0; e < 4; ++e) o[e] = f32x16{};
    asm volatile("s_waitcnt vmcnt(0)" ::: "memory");
#pragma unroll
    for (int d0 = 0; d0 < 4; ++d0) asm volatile("" : "+v"(qf[d0]));
    asm volatile("s_waitcnt lgkmcnt(0)\n\ts_barrier" ::: "memory");
#pragma unroll 1
    for (int t = 0; t < t_hi; ++t) {
        if (t + 1 < t_hi) A3_DMA(t + 1);
        const LAS unsigned char* Kb = L + (t & 1) * BUFB; const LAS unsigned char* Vb = Kb + KBYTES;
        const int k0 = 128 * t;
        if (k0 <= qw0 + 31) {
            f32x16 p[4];
#pragma unroll
            for (int j = 0; j < 4; ++j) p[j] = f32x16{};
#pragma unroll
            for (int d0 = 0; d0 < 4; ++d0) {
                const int ofs = r32 * 256 + (((8 * wsel + 2 * d0 + hi) ^ (r32 & 15)) << 4);
#pragma unroll
                for (int j = 0; j < 4; ++j) p[j] = __builtin_amdgcn_mfma_f32_32x32x16_bf16(*(const LAS bf16x8*)(Kb + j * 8192 + ofs), qf[d0], p[j], 0, 0, 0);
            }
            const int qi = qw0 + r32;
            if (k0 + 127 + 128 > qw0) {
#pragma unroll
                for (int r = 0; r < 16; ++r) { const int dd = qi - (k0 + crow(r, hi));
#pragma unroll
                    for (int j = 0; j < 4; ++j) { const int dj = dd - 32 * j; const int ij = dj < 0 ? 0 : (dj > 128 ? 128 : dj); p[j][r] = dj >= 0 ? p[j][r] + lrow[ij] : -INFINITY; } }
            }
            float rm = fmaxf(fmaxf(p[0][0], p[1][0]), fmaxf(p[2][0], p[3][0]));
#pragma unroll
            for (int r = 1; r < 16; ++r) rm = fmaxf(rm, fmaxf(fmaxf(p[0][r], p[1][r]), fmaxf(p[2][r], p[3][r])));
            rm = fmaxf(rm, __shfl_xor(rm, 32));
            if (__any(rm > m_run + MIX_THR)) {
                const float mn = fmaxf(m_run, rm), al = __builtin_amdgcn_exp2f(m_run - mn);
                m_run = mn; l_run *= al;
                if (hi == 0) wsf[r32] = al;
                LDS_WAIT();
#pragma unroll
                for (int r = 0; r < 16; ++r) { const float f = wsf[crow(r, hi)];
#pragma unroll
                    for (int e = 0; e < 4; ++e) o[e][r] *= f; }
                LDS_WAIT();
            }
            float ls0 = 0.f, ls1 = 0.f;
#pragma unroll
            for (int r = 0; r < 16; ++r) { p[0][r] = __builtin_amdgcn_exp2f(p[0][r] - m_run); p[1][r] = __builtin_amdgcn_exp2f(p[1][r] - m_run); p[2][r] = __builtin_amdgcn_exp2f(p[2][r] - m_run); p[3][r] = __builtin_amdgcn_exp2f(p[3][r] - m_run);
                ls0 += p[0][r] + p[1][r]; ls1 += p[2][r] + p[3][r]; }
            l_run += ls0 + ls1;
#pragma unroll
            for (int g = 0; g < 8; ++g) {
                const bf16x8 pa = pack_p(p[g >> 1], g & 1);
#pragma unroll
                for (int e = 0; e < 4; ++e) {
                    const LAS unsigned char* vp = Vb + e * 8192 + g * 1024 + vlane;
                    const s16x4 lo = vtr(vp), h2 = vtr(vp + 512);
                    const bf16x8 vb = (bf16x8){lo[0], lo[1], lo[2], lo[3], h2[0], h2[1], h2[2], h2[3]};
                    o[e] = __builtin_amdgcn_mfma_f32_32x32x16_bf16(pa, vb, o[e], 0, 0, 0);
                }
            }
        }
        asm volatile("s_waitcnt vmcnt(0) lgkmcnt(0)\n\ts_barrier" ::: "memory");
    }
#undef A3_DMA
    {
        const float lt = l_run + __shfl_xor(l_run, 32);
        if (hi == 0) wsf[r32] = 1.f / lt;
        LDS_WAIT();
        LAS float* xb = (LAS float*)L + rg * 4096;
        if (wsel == 1) {
#pragma unroll
            for (int r = 0; r < 16; ++r) { const float f = wsf[crow(r, hi)];
#pragma unroll
                for (int e = 0; e < 4; ++e) xb[(e * 16 + r) * 64 + lane] = o[e][r] * f; }
        }
        __syncthreads();
        if (wsel == 0) {
            const float* subg = a.in[4] + layer * 128; const float post = 1.f - lam_init;
            bf16* orow = CAT + (size_t)(rowbase + qw0) * DM + hh * 128 + r32;
#pragma unroll
            for (int r = 0; r < 16; ++r) { const float f = wsf[crow(r, hi)]; float d[4]; float ss = 0.f;
#pragma unroll
                for (int e = 0; e < 4; ++e) { d[e] = o[e][r] * f - lam * xb[(e * 16 + r) * 64 + lane]; ss += d[e] * d[e]; }
#pragma unroll
                for (int sh = 1; sh < 32; sh <<= 1) ss += __shfl_xor(ss, sh);
                const float rs = (1.f / sqrtf(ss * (1.f / 128.f) + LN_EPS)) * post; const int qr = crow(r, hi);
#pragma unroll
                for (int e = 0; e < 4; ++e) orow[(size_t)qr * DM + 32 * e] = (bf16)f2bf(d[e] * rs * subg[32 * e + r32]); }
        }
    }
    __syncthreads();
}
constexpr int C2_KR = 0, C2_KT = 16384, C2_VT = 32768, C2_ST = 65536, C2_STATS = 81920, C2_G = 83968;
static_assert(C2_G + 32768 <= RING_BYTES, "chunkwise retention LDS map");
__device__ __forceinline__ void retention_unit(Frame& F, const Args& a, int b, int hh) {
    unsigned char* ws = a.ws; const bf16* PROJ = (const bf16*)(ws + WS_PROJ); bf16* CAT = (bf16*)(ws + WS_CAT);
    const int wave = F.wave; int lane = (int)__builtin_amdgcn_mbcnt_hi(~0u, __builtin_amdgcn_mbcnt_lo(~0u, 0u)); asm volatile("" : "+v"(lane));
    const int r32 = lane & 31, hi = lane >> 5;
    LAS unsigned char* L = F.lds + RING_OFF; const unsigned Lb = (unsigned)(uintptr_t)L;
    const int rowbase = b * SEQ, rg = wave & 3, eh = wave >> 2, dh = wave & 1, eq = wave >> 1;
    const float lg2 = log2f(1.f - exp2f(-5.f - (float)hh));
    const float gq = __builtin_amdgcn_exp2f(lg2 * (float)(32 * rg + r32));
    const float gC = __builtin_amdgcn_exp2f(lg2 * 128.f), gC1 = __builtin_amdgcn_exp2f(lg2 * 127.f);
    unsigned srcKr, srcKt, srcVt;
    { const int row = 8 * wave + (lane >> 3), ch = (lane & 7) ^ ((row >> 1) & 7); srcKr = (unsigned)(((rowbase + row) * PWP + C_CK + hh * 64 + ch * 8) * 2);
      const int key = 16 * wave + 8 * (lane >> 5) + ((lane >> 2) & 7);
      srcKt = (unsigned)(((rowbase + key) * PWP + C_CK + hh * 64 + (lane & 3) * 8) * 2); srcVt = (unsigned)(((rowbase + key) * PWP + C_CV + hh * 128 + (lane & 3) * 8) * 2); }
    const unsigned srcG = (unsigned)(((rowbase + 4 * wave + (lane >> 4)) * PWP + C_CG + hh * 128 + (lane & 15) * 8) * 2);
#define C2_GDMA(n) do { const char* gb_ = (const char*)PROJ + (size_t)(n) * (128 * PWP * 2); const unsigned wg_ = (unsigned)__builtin_amdgcn_readfirstlane(Lb + C2_G + wave * 1024); \
        glds16s<0>(gb_, srcG, wg_); glds16s<0>(gb_ + 32 * PWP * 2, srcG, wg_ + 8192); glds16s<0>(gb_ + 64 * PWP * 2, srcG, wg_ + 16384); glds16s<0>(gb_ + 96 * PWP * 2, srcG, wg_ + 24576); } while (0)
#define C2_DMA(n) do { const char* cb_ = (const char*)PROJ + (size_t)(n) * (128 * PWP * 2); const char* cb2_ = cb_ + 64 * PWP * 2; const unsigned w1k_ = (unsigned)__builtin_amdgcn_readfirstlane(Lb + wave * 1024); \
        glds16s<0>(cb_, srcKr, w1k_ + C2_KR); glds16s<0>(cb2_, srcKr, w1k_ + C2_KR + 8192); \
        glds16s<0>(cb_, srcKt, w1k_ + C2_KT); glds16s<64>(cb_, srcKt, w1k_ + C2_KT + 8192); \
        glds16s<0>(cb_, srcVt, w1k_ + C2_VT); glds16s<64>(cb_, srcVt, w1k_ + C2_VT + 8192); glds16s<128>(cb_, srcVt, w1k_ + C2_VT + 16384); glds16s<192>(cb_, srcVt, w1k_ + C2_VT + 24576); } while (0)
    const int vlane = (4 * hi + ((lane & 15) >> 2)) * 64 + ((lane >> 4) & 1) * 32 + (lane & 3) * 8;
    const int krow = r32 * 128, kkey = (r32 >> 1) & 7;
    f32x16 Sb = f32x16{};
    bf16x8 qf[4];
    { const bf16* qbase = PROJ + (size_t)(rowbase + 32 * rg + r32) * PWP + C_CQ + hh * 64 + hi * 8;
#pragma unroll
      for (int d0 = 0; d0 < 4; ++d0) qf[d0] = *(const bf16x8*)(qbase + d0 * 16); }
    asm volatile("s_waitcnt vmcnt(0)" ::: "memory");
#pragma unroll
    for (int d0 = 0; d0 < 4; ++d0) asm volatile("" : "+v"(qf[d0]));
    C2_DMA(0);
#pragma unroll 1
    for (int n = 0; n < 16; ++n) {
        asm volatile("s_waitcnt vmcnt(0) lgkmcnt(0)\n\ts_barrier" ::: "memory");
        C2_GDMA(n);
        f32x16 o[2]; o[0] = f32x16{}; o[1] = f32x16{};
        for (int kb = 0; kb <= rg; ++kb) {
            f32x16 T = f32x16{};
#pragma unroll
            for (int d0 = 0; d0 < 4; ++d0) {
                const bf16x8 ka = *(const LAS bf16x8*)(L + C2_KR + kb * 4096 + krow + (((2 * d0 + hi) ^ kkey) << 4));
                T = __builtin_amdgcn_mfma_f32_32x32x16_bf16(ka, qf[d0], T, 0, 0, 0);
            }
#pragma unroll
            for (int r = 0; r < 16; ++r) T[r] = (kb == rg && crow(r, hi) > r32) ? 0.f : T[r] * gq;
#pragma unroll
            for (int s2 = 0; s2 < 2; ++s2) {
                const bf16x8 pa = pack_p(T, s2);
#pragma unroll
                for (int e = 0; e < 2; ++e) {
                    const LAS unsigned char* vp = L + C2_VT + (2 * eh + e) * 8192 + (4 * kb + 2 * s2) * 512 + vlane;
                    const s16x4 lo = vtr(vp), h2 = vtr(vp + 512);
                    const bf16x8 vb = (bf16x8){lo[0], lo[1], lo[2], lo[3], h2[0], h2[1], h2[2], h2[3]};
                    o[e] = __builtin_amdgcn_mfma_f32_32x32x16_bf16(pa, vb, o[e], 0, 0, 0);
                }
                __builtin_amdgcn_sched_barrier(0);
            }
        }
        __builtin_amdgcn_sched_barrier(0);
        if (n > 0) {
            f32x16 oc[2]; oc[0] = f32x16{}; oc[1] = f32x16{};
#pragma unroll
            for (int d0 = 0; d0 < 4; ++d0)
#pragma unroll
                for (int e = 0; e < 2; ++e) {
                    const bf16x8 sb = *(const LAS bf16x8*)(L + C2_ST + (2 * eh + e) * 4096 + krow + (((2 * d0 + hi) ^ kkey) << 4));
                    oc[e] = __builtin_amdgcn_mfma_f32_32x32x16_bf16(qf[d0], sb, oc[e], 0, 0, 0);
                }
#pragma unroll
            for (int r = 0; r < 16; ++r) { const float xi = __builtin_amdgcn_exp2f(lg2 * (float)(32 * rg + crow(r, hi) + 1)); o[0][r] += xi * oc[0][r]; o[1][r] += xi * oc[1][r]; }
        }
        __builtin_amdgcn_sched_barrier(0);
        {
            f32x16 kv = f32x16{};
#pragma unroll
            for (int g = 0; g < 8; ++g) {
                const LAS unsigned char* kp = L + C2_KT + dh * 8192 + (2 * g) * 512 + vlane; const LAS unsigned char* vp = L + C2_VT + eq * 8192 + (2 * g) * 512 + vlane;
                const s16x4 kl = vtr(kp), kh2 = vtr(kp + 512), vl = vtr(vp), vh2 = vtr(vp + 512);
                const bf16x8 ka = (bf16x8){kl[0], kl[1], kl[2], kl[3], kh2[0], kh2[1], kh2[2], kh2[3]}, vb = (bf16x8){vl[0], vl[1], vl[2], vl[3], vh2[0], vh2[1], vh2[2], vh2[3]};
                kv = __builtin_amdgcn_mfma_f32_32x32x16_bf16(ka, vb, kv, 0, 0, 0);
                if (g & 1) __builtin_amdgcn_sched_barrier(0);
            }
#pragma unroll
            for (int r = 0; r < 16; ++r) Sb[r] = gC * Sb[r] + gC1 * kv[r];
        }
        __builtin_amdgcn_sched_barrier(0);
        if (n + 1 < 16) {
            int l2 = lane; asm volatile("" : "+v"(l2));
            const bf16* qn = PROJ + (size_t)(rowbase + 128 * (n + 1) + 32 * rg + (l2 & 31)) * PWP + C_CQ + hh * 64 + (l2 >> 5) * 8;
#pragma unroll
            for (int d0 = 0; d0 < 4; ++d0) qf[d0] = *(const bf16x8*)(qn + d0 * 16);
        }
        LAS float* st = (LAS float*)(L + C2_STATS);
#pragma unroll
        for (int r4 = 0; r4 < 4; ++r4) {
            float s1[4], s2[4];
#pragma unroll
            for (int i = 0; i < 4; ++i) { const int r = 4 * r4 + i; s1[i] = o[0][r] + o[1][r]; s2[i] = o[0][r] * o[0][r] + o[1][r] * o[1][r]; }
#pragma unroll
            for (int sh = 1; sh < 32; sh <<= 1)
#pragma unroll
                for (int i = 0; i < 4; ++i) { s1[i] += __shfl_xor(s1[i], sh); s2[i] += __shfl_xor(s2[i], sh); }
            if (r32 == 0) {
#pragma unroll
                for (int i = 0; i < 4; ++i) { const int qr = crow(4 * r4 + i, hi); st[((rg * 2 + eh) * 32 + qr) * 2 + 0] = s1[i]; st[((rg * 2 + eh) * 32 + qr) * 2 + 1] = s2[i]; }
            }
            __builtin_amdgcn_sched_barrier(0);
        }
        __builtin_amdgcn_sched_barrier(0);
        asm volatile("s_waitcnt vmcnt(0) lgkmcnt(0)\n\ts_barrier" ::: "memory");
        if (n + 1 < 16) C2_DMA(n + 1);
        {
            const int e_ = 32 * eq + r32;
#pragma unroll
            for (int q4 = 0; q4 < 4; ++q4) { v2u w; w.x = cvtpk_s(Sb[4 * q4 + 0], Sb[4 * q4 + 1]); w.y = cvtpk_s(Sb[4 * q4 + 2], Sb[4 * q4 + 3]);
                *(LAS v2u*)(L + C2_ST + e_ * 128 + (((4 * dh + q4) ^ ((e_ >> 1) & 7)) << 4) + 8 * hi) = w; }
        }
        asm volatile("s_waitcnt lgkmcnt(0)\n\ts_barrier" ::: "memory");
        {
            const LAS bf16* grow = (const LAS bf16*)(L + C2_G) + (32 * rg) * 128 + 64 * eh + r32;
            bf16* orow = CAT + (size_t)(rowbase + 128 * n + 32 * rg) * DM + 1536 + hh * 128 + 64 * eh + r32;
#pragma unroll
            for (int r = 0; r < 16; ++r) {
                const int qr = crow(r, hi);
                const float t1 = st[((rg * 2) * 32 + qr) * 2 + 0] + st[((rg * 2 + 1) * 32 + qr) * 2 + 0], t2 = st[((rg * 2) * 32 + qr) * 2 + 1] + st[((rg * 2 + 1) * 32 + qr) * 2 + 1];
                const float mu = t1 * (1.f / 128.f), var = fmaxf(t2 * (1.f / 128.f) - mu * mu, 0.f), rs = 1.f / sqrtf(var + LN_EPS);
#pragma unroll
                for (int e = 0; e < 2; ++e) orow[(size_t)qr * DM + 32 * e] = (bf16)f2bf(pg8::silu_f(bf2f(grow[qr * 128 + 32 * e])) * (o[e][r] - mu) * rs);
                if ((r & 3) == 3) __builtin_amdgcn_sched_barrier(0);
            }
        }
    }
#undef C2_DMA
#undef C2_GDMA
    __syncthreads();
}
constexpr int B2_K = 0, B2_V = 32768;
__device__ __forceinline__ void swa_unit(Frame& F, const Args& a, int layer, int b, int kvh, int qb) {
    unsigned char* ws = a.ws; const bf16* PROJ = (const bf16*)(ws + WS_PROJ); bf16* CAT = (bf16*)(ws + WS_CAT);
    const int wave = F.wave; int lane = (int)__builtin_amdgcn_mbcnt_hi(~0u, __builtin_amdgcn_mbcnt_lo(~0u, 0u)); asm volatile("" : "+v"(lane));
    const int r32 = lane & 31, hi = lane >> 5;
    LAS unsigned char* L = F.lds + RING_OFF; const unsigned Lb = (unsigned)(uintptr_t)L;
    LAS float* wsf = (LAS float*)(F.lds + MIX_WSF) + wave * 64;
    const LAS float* lut = (const LAS float*)(F.lds + LUT_OFF);
    const int rowbase = b * SEQ, q0 = qb * 128;
    const int tl0 = (qb == 0) ? 2 : 0;
    unsigned srcK, srcV;
    { const int row = 8 * wave + (lane >> 3), ch = (lane & 7) ^ ((row >> 1) & 7); srcK = (unsigned)(((rowbase + q0 + row) * PWP + C_BK + kvh * 64 + ch * 8) * 2);
      const int key = 16 * (wave & 3) + 8 * (lane >> 5) + ((lane >> 2) & 7); srcV = (unsigned)(((rowbase + q0 + key) * PWP + C_BV + kvh * 64 + (wave >> 2) * 32 + (lane & 3) * 8) * 2); }
    {
        const unsigned wk = (unsigned)__builtin_amdgcn_readfirstlane(Lb + wave * 1024);
        for (int tl = tl0; tl < 4; ++tl) {
            const char* tb = (const char*)PROJ + (long)(tl - 2) * (64 * PWP * 2);
            glds16s<0>(tb, srcK, wk + B2_K + tl * 8192); glds16s<0>(tb, srcV, wk + B2_V + tl * 8192);
        }
    }
    const int vlane = (4 * hi + ((lane & 15) >> 2)) * 64 + ((lane >> 4) & 1) * 32 + (lane & 3) * 8;
    const int kofs0 = r32 * 128, kkey = (r32 >> 1) & 7;
    const int rg = wave & 3, qw0 = q0 + 32 * rg;
    bf16x8 qf[2][4]; float sink2[2], m_run[2], l_run[2]; f32x16 o[2][2]; const LAS float* lrow[2];
#pragma unroll
    for (int s = 0; s < 2; ++s) {
        const int hq = kvh * 4 + (wave >> 2) + 2 * s;
        const bf16* qp = PROJ + (size_t)(rowbase + qw0 + r32) * PWP + C_BQ + hq * 64 + hi * 8;
#pragma unroll
        for (int d0 = 0; d0 < 4; ++d0) qf[s][d0] = *(const bf16x8*)(qp + d0 * 16);
        sink2[s] = a.in[5][layer * 12 + hq] * LOG2E; m_run[s] = sink2[s]; l_run[s] = 1.f; o[s][0] = f32x16{}; o[s][1] = f32x16{};
        lrow[s] = lut + (6 + hq) * LUT_STRIDE;
    }
    asm volatile("s_waitcnt vmcnt(0)" ::: "memory"); __syncthreads();
    const int t_a = (rg < 2) ? 0 : 1;
    for (int tl = (t_a < tl0 ? tl0 : t_a); tl < t_a + 3; ++tl) {
        const LAS unsigned char* Kb = L + B2_K + tl * 8192; const LAS unsigned char* Vb = L + B2_V + tl * 8192;
        const int k0 = q0 - 128 + 64 * tl;
        f32x16 p0[2], p1[2]; p0[0] = f32x16{}; p0[1] = f32x16{}; p1[0] = f32x16{}; p1[1] = f32x16{};
#pragma unroll
        for (int d0 = 0; d0 < 4; ++d0) {
            const int ofs = kofs0 + (((2 * d0 + hi) ^ kkey) << 4);
            const bf16x8 ka = *(const LAS bf16x8*)(Kb + ofs), kb2 = *(const LAS bf16x8*)(Kb + 4096 + ofs);
#pragma unroll
            for (int s = 0; s < 2; ++s) { p0[s] = __builtin_amdgcn_mfma_f32_32x32x16_bf16(ka, qf[s][d0], p0[s], 0, 0, 0); p1[s] = __builtin_amdgcn_mfma_f32_32x32x16_bf16(kb2, qf[s][d0], p1[s], 0, 0, 0); }
        }
        const int qi = qw0 + r32;
#pragma unroll
        for (int r = 0; r < 16; ++r) { const int d0_ = qi - (k0 + crow(r, hi)), d1_ = d0_ - 32;
            const bool ok0 = (d0_ >= 0 && d0_ < 128), ok1 = (d1_ >= 0 && d1_ < 128);
            const int i0_ = d0_ < 0 ? 0 : (d0_ > 128 ? 128 : d0_), i1_ = d1_ < 0 ? 0 : (d1_ > 128 ? 128 : d1_);
#pragma unroll
            for (int s = 0; s < 2; ++s) { p0[s][r] = ok0 ? p0[s][r] + lrow[s][i0_] : -INFINITY; p1[s][r] = ok1 ? p1[s][r] + lrow[s][i1_] : -INFINITY; } }
#pragma unroll
        for (int s = 0; s < 2; ++s) {
            float rm = fmaxf(p0[s][0], p1[s][0]);
#pragma unroll
            for (int r = 1; r < 16; ++r) rm = fmaxf(rm, fmaxf(p0[s][r], p1[s][r]));
            rm = fmaxf(rm, __shfl_xor(rm, 32));
            if (__any(rm > m_run[s] + MIX_THR)) {
                const float mn = fmaxf(m_run[s], rm), al = __builtin_amdgcn_exp2f(m_run[s] - mn);
                m_run[s] = mn; l_run[s] *= al;
                if (hi == 0) wsf[r32] = al;
                LDS_WAIT();
#pragma unroll
                for (int r = 0; r < 16; ++r) { const float f = wsf[crow(r, hi)]; o[s][0][r] *= f; o[s][1][r] *= f; }
                LDS_WAIT();
            }
            float ls = 0.f;
#pragma unroll
            for (int r = 0; r < 16; ++r) { p0[s][r] = __builtin_amdgcn_exp2f(p0[s][r] - m_run[s]); p1[s][r] = __builtin_amdgcn_exp2f(p1[s][r] - m_run[s]); ls += p0[s][r] + p1[s][r]; }
            l_run[s] += ls;
        }
#pragma unroll
        for (int gq = 0; gq < 4; ++gq) {
            bf16x8 pa[2];
#pragma unroll
            for (int s = 0; s < 2; ++s) pa[s] = pack_p((gq >> 1) == 0 ? p0[s] : p1[s], gq & 1);
#pragma unroll
            for (int e = 0; e < 2; ++e) {
                const LAS unsigned char* vp = Vb + e * 4096 + gq * 1024 + vlane;
                const s16x4 lo = vtr(vp), h2 = vtr(vp + 512);
                const bf16x8 vb = (bf16x8){lo[0], lo[1], lo[2], lo[3], h2[0], h2[1], h2[2], h2[3]};
#pragma unroll
                for (int s = 0; s < 2; ++s) o[s][e] = __builtin_amdgcn_mfma_f32_32x32x16_bf16(pa[s], vb, o[s][e], 0, 0, 0);
            }
        }
    }
#pragma unroll
    for (int s = 0; s < 2; ++s) {
        const int hq = kvh * 4 + (wave >> 2) + 2 * s;
        const float lt = l_run[s] + __shfl_xor(l_run[s], 32) - __builtin_amdgcn_exp2f(sink2[s] - m_run[s]);
        if (hi == 0) wsf[r32] = 1.f / lt;
        LDS_WAIT();
        bf16* orow = CAT + (size_t)(rowbase + qw0) * DM + 768 + hq * 64 + r32;
#pragma unroll
        for (int r = 0; r < 16; ++r) { const int qr = crow(r, hi); const float f = wsf[qr]; orow[(size_t)qr * DM] = (bf16)f2bf(o[s][0][r] * f); orow[(size_t)qr * DM + 32] = (bf16)f2bf(o[s][1][r] * f); }
        LDS_WAIT();
    }
    __syncthreads();
}
template <int MODE> __device__ __forceinline__ void mixer_queue(Frame& F, const Args& a, int layer, int qword, float lam, float lam_init) {
    constexpr int NU = (MODE == 0) ? 768 : (MODE == 1) ? 384 : (MODE == 3) ? 32 : 256;
    LAS int* qw = (LAS int*)(F.lds + MIX_QW);
    const int c_lo = layer * (MOE_CHUNKS / 2), c_hi = c_lo + MOE_CHUNKS / 2;
    for (;;) {
        if (ftid(F) == 0) { qw[0] = (int)__hip_atomic_fetch_add(F.ctl + CW_WQ + 64 * qword, 1u, RLX_AGENT); qw[1] = (MODE == 0) ? (int)__hip_atomic_fetch_add(F.ctl + CW_WQ + 64 * (14 + layer), 1u, RLX_AGENT) : (1 << 30); }
        __syncthreads();
        const int it = __builtin_amdgcn_readfirstlane(qw[0]), ci = c_lo + __builtin_amdgcn_readfirstlane(qw[1]);
        __syncthreads();
        if (it < NU) {
            if (MODE == 3) retention_unit(F, a, it >> 2, it & 3);
            else if (MODE == 0) attn3_unit(F, a, layer, (it % 48) / 6, it % 6, 15 - it / 48, lam, lam_init);
            else swa_unit(F, a, layer, it / 48, (it % 48) / 16, it & 15);
        }
        if (MODE == 0 && ci < c_hi) moe_convert_chunk(F, a, ci);
        if (it >= NU) break;
    }
}
__device__ __forceinline__ void moe_convert_drain(Frame& F, const Args& a, int layer) {
    LAS int* qw = (LAS int*)(F.lds + MIX_QW);
    const int c_lo = layer * (MOE_CHUNKS / 2), c_hi = c_lo + MOE_CHUNKS / 2;
    for (;;) {
        if (ftid(F) == 0) qw[1] = (int)__hip_atomic_fetch_add(F.ctl + CW_WQ + 64 * (14 + layer), 1u, RLX_AGENT);
        __syncthreads();
        const int ci = c_lo + __builtin_amdgcn_readfirstlane(qw[1]);
        __syncthreads();
        if (ci >= c_hi) break;
        moe_convert_chunk(F, a, ci);
    }
}
__device__ __forceinline__ void mixer_phase(Frame& F, const Args& a, int layer, int rep) {
    const int qbase = 3 * (layer + 2 * rep);
    mixer_queue<3>(F, a, layer, qbase + 0, 0.f, 0.f);
    asm volatile("" ::: "memory");
    const float lam_init = 0.8f - 0.6f * __expf(-0.3f * (float)layer);
    const float lam = __builtin_bit_cast(float, __builtin_amdgcn_readfirstlane(__builtin_bit_cast(int, lambda_of(a.in[3] + layer * 256, flane(), lam_init))));
    mixer_queue<0>(F, a, layer, qbase + 1, lam, lam_init);
    mixer_queue<1>(F, a, layer, qbase + 2, lam, lam_init);
    moe_convert_drain(F, a, layer);
}
#ifndef MIXER_NAIVE
#define MIXER_NAIVE 0
#endif
#ifndef PROBE_P0
#define PROBE_P0 1
#endif
#ifndef PROBE_MIX
#define PROBE_MIX 1
#endif
#ifndef PROBE_PROJ
#define PROBE_PROJ 1
#endif
#ifndef PROBE_DUP
#define PROBE_DUP 1
#endif
#ifndef PROBE_MUP
#define PROBE_MUP 1
#endif
#ifndef PROBE_MDN
#define PROBE_MDN 1
#endif
#ifndef PROBE_SPIN_PHASE
#define PROBE_SPIN_PHASE -1
#endif
#define PH_BEGIN(k) do { if (PROBE_SPIN_PHASE == (k)) spin_t0 = __builtin_amdgcn_s_memrealtime(); } while (0)
#define PH_END(k) do { if (PROBE_SPIN_PHASE == (k)) spin_dt = __builtin_amdgcn_s_memrealtime() - spin_t0; } while (0)
#define REPEAT(N) for (int rep = 0; rep < (N); ++rep)
#define TWICE_IF(N, CALL) do { CALL; if ((N) == 2) { xcd_barrier(bar); CALL; } } while (0)
#define REPBAR(N) do { if (rep + 1 < (N)) xcd_barrier(bar); } while (0)
#define IN(k) (lo <= (k) && (k) < hi)
#define SEAM(k) do { if (IN(k) && IN((k) + 1)) xcd_barrier(bar); } while (0)
template <int l> __device__ __forceinline__ void run_layer(Frame& F, const Args& args, const XcdBarrier& bar, int lo, int hi, unsigned long long& spin_t0, unsigned long long& spin_dt) {
    unsigned char* ws = args.ws;
    bf16* XB = (bf16*)(ws + WS_XB); bf16* PROJ = (bf16*)(ws + WS_PROJ); bf16* CAT = (bf16*)(ws + WS_CAT); bf16* HB = (bf16*)(ws + WS_H);
    float* T = args.out;
        const int pb = 1 + 7 * l;
        PH_BEGIN(pb); if (IN(pb)) {
            pg8::Gemm g{XB, (const bf16*)(ws + WS_WIN) + (size_t)l * PWP * DM, NTOK, PWP, DM * 2}; pg8::StaticOrder S; S.init(NTOK, PWP, F.G, (int)blockIdx.x);
            pg8::EpiProj E{PROJ, (const float*)(ws + WS_TAB), (const float*)(ws + WS_TAB + 256 * 1024)};
            TWICE_IF(PROBE_PROJ, (pg8::gemm_phase<pg8::EpiProj, pg8::StaticOrder, true, true>(F.lds + RING_OFF, F.wave, g, S, E)));
        } SEAM(pb); PH_END(pb);
        PH_BEGIN(pb + 1); if (IN(pb + 1)) {
#if MIXER_NAIVE
            naive_mixers(F, args, l);
#else
            REPEAT(PROBE_MIX) { mixer_phase(F, args, l, rep); REPBAR(PROBE_MIX); }
#endif
        } SEAM(pb + 1); PH_END(pb + 1);
        PH_BEGIN(pb + 2); if (IN(pb + 2)) {
            pg8::Gemm g{CAT, (const bf16*)(ws + WS_WOUT) + (size_t)l * DM * DM, NTOK, DM, DM * 2}; pg8::StaticOrder S; S.init(NTOK, DM, F.G, (int)blockIdx.x);
            pg8::EpiResid E{T, XB, 1.f};
            pg8::gemm_phase<pg8::EpiResid, pg8::StaticOrder, true, true>(F.lds + RING_OFF, F.wave, g, S, E);
        } SEAM(pb + 2); PH_END(pb + 2);
        if constexpr (l == 0) {
            PH_BEGIN(4); if (IN(4)) { ln_phase<0>(F, args, T, args.in[7], args.in[8], nullptr); } SEAM(4); PH_END(4);
            PH_BEGIN(5); if (IN(5)) {
                pg8::Gemm g{XB, (const bf16*)(ws + WS_WDGU), NTOK, 2 * DFF, DM * 2}; pg8::StaticOrder S; S.init(NTOK, 2 * DFF, F.G, (int)blockIdx.x);
                pg8::EpiSwiGLU8 E{ws + WS_H, 44, 1.f};
                TWICE_IF(PROBE_DUP, (pg8::gemm_phase<pg8::EpiSwiGLU8, pg8::StaticOrder, true, true, false>(F.lds + RING_OFF, F.wave, g, S, E)));
            } SEAM(5); PH_END(5);
            PH_BEGIN(6); if (IN(6)) {
                pg8::Gemm g{ws + WS_H, ws + WS_WDDN, NTOK, DM, DFF}; pg8::StaticOrder S; S.init(NTOK, DM, F.G, (int)blockIdx.x);
                pg8::EpiResid E{T, XB, 1.f / (pg8::FP8_SH * pg8::FP8_SWD)};
                pg8::gemm_phase<pg8::EpiResid, pg8::StaticOrder, true, true, true>(F.lds + RING_OFF, F.wave, g, S, E);
            } SEAM(6); PH_END(6);
            PH_BEGIN(7); if (IN(7)) { ln_phase<0>(F, args, T, args.in[9], args.in[10], nullptr); } SEAM(7); PH_END(7);
        } else {
            PH_BEGIN(11); if (IN(11)) { ln_phase<1>(F, args, T, args.in[7] + DM, args.in[8] + DM, args.in[14]); } SEAM(11); PH_END(11);
            PH_BEGIN(12); if (IN(12)) { gather_phase(F, args, T); } SEAM(12); PH_END(12);
            if (IN(13) || IN(14) || IN(15)) {
                int ntl_v; const int offv = expert_offsets(F, ntl_v); const int ntl = __builtin_amdgcn_readfirstlane(ntl_v);
                pg8::GroupedOrder S; S.nM = ntl; S.pm0 = 0; S.G = F.G; S.c = (int)blockIdx.x;
#pragma unroll
                for (int e = 0; e < 8; ++e) S.cum[e] = (e < 7) ? __builtin_amdgcn_readfirstlane(__shfl(offv, e + 1) >> 8) : ntl;
                PH_BEGIN(13); if (IN(13)) {
                    S.nN = 44; S.nwg = ntl * 44;
                    pg8::Gemm g{ws + WS_XG, ws + WS_WMGU, ntl * 256, 8 * 2 * DFF, DM};
                    pg8::EpiSwiGLU8 E{ws + WS_H, 44, 1.f / (pg8::FP8_SX * pg8::FP8_SWU)};
                    TWICE_IF(PROBE_MUP, (pg8::gemm_phase<pg8::EpiSwiGLU8, pg8::GroupedOrder, true, true, true>(F.lds + RING_OFF, F.wave, g, S, E)));
                } SEAM(13); PH_END(13);
                PH_BEGIN(14); if (IN(14)) {
                    S.nN = 8; S.pm0 = 0; S.nM = ntl < 128 ? ntl : 128; S.nwg = S.nM * 8;
                    pg8::Gemm g{ws + WS_H, ws + WS_WMDN, ntl * 256, 8 * DM, DFF};
                    pg8::EpiY E{(bf16*)(ws + WS_Y), 8, 1.f / (pg8::FP8_SH * pg8::FP8_SWD)};
                    TWICE_IF(PROBE_MDN, (pg8::gemm_phase<pg8::EpiY, pg8::GroupedOrder, true, true, true>(F.lds + RING_OFF, F.wave, g, S, E)));
                } SEAM(14); PH_END(14);
                PH_BEGIN(15); if (IN(15)) {
                    S.nN = 8; S.pm0 = 128; S.nM = ntl > 128 ? ntl - 128 : 0; S.nwg = S.nM * 8;
                    if (S.nwg > 0) {
                        pg8::Gemm g{ws + WS_H, ws + WS_WMDN, ntl * 256, 8 * DM, DFF};
                        pg8::EpiY E{(bf16*)(ws + WS_Y), 8, 1.f / (pg8::FP8_SH * pg8::FP8_SWD)};
                        pg8::gemm_phase<pg8::EpiY, pg8::GroupedOrder, true, true, true>(F.lds + RING_OFF, F.wave, g, S, E);
                    }
                    {
                        LAS int* qw = (LAS int*)(F.lds + MIX_QW);
                        for (;;) {
                            if (ftid(F) == 0) *qw = (int)__hip_atomic_fetch_add(F.ctl + CW_WQ + 64 * 12, 1u, RLX_AGENT);
                            __syncthreads();
                            const int grp64 = __builtin_amdgcn_readfirstlane(*qw);
                            __syncthreads();
                            if (grp64 >= NTOK / 64) break;
                            ln_phase<2>(F, args, T, args.in[9] + DM, args.in[10] + DM, nullptr, grp64 * 64 + F.wave * 8, 1);
                        }
                    }
                    xcd_barrier(bar);
                    ln_phase<2>(F, args, T, args.in[9] + DM, args.in[10] + DM, nullptr, -1, 2);
                } PH_END(15);
            }
        }
}
constexpr int N_PHASES = 16;
__global__ void __launch_bounds__(NWAVES * 64, 2) hymba_fwd(Args args) {
    extern __shared__ __attribute__((aligned(16))) unsigned char lds[];
    Frame F;
    F.lds = (LAS unsigned char*)lds;
    volatile LAS unsigned* MISC = (volatile LAS unsigned*)(F.lds + MISC_OFF);
    F.wave = __builtin_amdgcn_readfirstlane((int)threadIdx.x >> 6); F.lane = (int)__builtin_amdgcn_mbcnt_hi(~0u, __builtin_amdgcn_mbcnt_lo(~0u, 0u)); F.tid = 0;
    F.G = gridDim.x; { const int bx = blockIdx.x; F.vcu = (F.G % 8 == 0) ? (bx % 8) * (F.G / 8) + bx / 8 : bx; }
    unsigned char* ws = args.ws;
    F.ctl = (gu32*)(ws + WS_CTL);
    for (int u = ftid(F); u < 1024 / 4; u += NWAVES * 64) ((LAS unsigned*)(F.lds + LDSCTL_OFF))[u] = 0u;
    __syncthreads();
    XcdBarrier bar = xcd_barrier_post((unsigned*)(F.ctl + CW_BAR) + args.li * 4096, MISC + 8);
    build_lut(F, args.in[2]);
    __syncthreads();
    const int lo = args.ph_lo, hi = args.ph_hi;
    unsigned long long spin_t0 = 0ull, spin_dt = 0ull;
    PH_BEGIN(0); if (IN(0)) { REPEAT(PROBE_P0) { p0_prologue(F, args); REPBAR(PROBE_P0); } } SEAM(0); PH_END(0);
    run_layer<0>(F, args, bar, lo, hi, spin_t0, spin_dt);
    run_layer<1>(F, args, bar, lo, hi, spin_t0, spin_dt);
    if (PROBE_SPIN_PHASE >= 0 && blockIdx.x == 0) { const unsigned long long te = __builtin_amdgcn_s_memrealtime() + 10ull * spin_dt; while (__builtin_amdgcn_s_memrealtime() < te) __builtin_amdgcn_s_sleep(16); }
#undef IN
#undef SEAM
}

#ifndef N_LAUNCHES
#define N_LAUNCHES 1
#endif
extern "C" void kernel_launch(void* const* d_in, const int* in_sizes, int n_in, void* d_out, int out_size, void* d_ws, size_t ws_size, hipStream_t stream) {
    static int grid = 0;
    if (grid == 0) {
        if (n_in != 18 || in_sizes[0] != NTOK * DM || out_size != NTOK * DM || ws_size < WS_END) { fprintf(stderr, "kernel_launch: unexpected shapes / workspace (%d inputs, ws %zu < %zu)\n", n_in, ws_size, (size_t)WS_END); grid = -1; return; }
        int dev = 0, cus = 0, per_cu = 0;
        if (hipGetDevice(&dev) != hipSuccess || hipDeviceGetAttribute(&cus, hipDeviceAttributeMultiprocessorCount, dev) != hipSuccess) { grid = -1; return; }
        if (hipFuncSetAttribute((const void*)hymba_fwd, hipFuncAttributeMaxDynamicSharedMemorySize, LDS_BYTES) != hipSuccess) { fprintf(stderr, "kernel_launch: hipFuncSetAttribute failed\n"); grid = -1; return; }
        if (hipOccupancyMaxActiveBlocksPerMultiprocessor(&per_cu, (const void*)hymba_fwd, NWAVES * 64, LDS_BYTES) != hipSuccess || per_cu < 1) fprintf(stderr, "kernel_launch: occupancy query reports %d\n", per_cu);
        (void)hipGetLastError();
        grid = (cus == 256) ? 256 : -1;
        if (grid < 0) { fprintf(stderr, "kernel_launch: built for a 256-CU device, found %d CUs\n", cus); return; }
    }
    if (grid < 0) return;
    if (hipMemsetAsync((char*)d_ws + WS_CTL, 0, CTL_ZERO_BYTES, stream) != hipSuccess) return;
    Args a{};
    for (int i = 0; i < 18; ++i) a.in[i] = (const float*)d_in[i];
    a.out = (float*)d_out; a.ws = (unsigned char*)d_ws;
    for (int i = 0; i < 32; ++i) a.invf[i] = (float)(1.0 / pow(10000.0, (double)((float)i / 31.0f)));
#if N_LAUNCHES == 1
    const int cuts[2] = {0, N_PHASES};
#else
    int cuts[N_PHASES + 1]; for (int i = 0; i <= N_PHASES; ++i) cuts[i] = i;
#endif
    const int nl = (N_LAUNCHES == 1) ? 1 : N_PHASES;
    for (int li = 0; li < nl; ++li) {
        a.ph_lo = cuts[li]; a.ph_hi = cuts[li + 1]; a.li = li; a.pad = 0;
        hipLaunchKernelGGL(hymba_fwd, dim3(grid), dim3(NWAVES * 64), LDS_BYTES, stream, a);
        const hipError_t le = hipPeekAtLastError();
        if (le != hipSuccess) { fprintf(stderr, "kernel_launch: launch %d failed: %s\n", li, hipGetErrorName(le)); break; }
    }
}
```
